# Optimizing an MI355X kernel written in HIP

```python
import math
import jax, jax.numpy as jnp
from jax import lax
import numpy as np

D_MODEL = 1024
BATCH = 1
SEQ = 16384
DEPTH = 4

GRID_W = 64
CTX_LEN = 256
N_MIXERS = 3
RMS_EPS = 1e-6
CONV_WIDTH = 3
HGRN_HEADS = 8
HGRN_HEAD_DIM = D_MODEL // HGRN_HEADS
HGRN_CHUNK = 32
S5_GROUP = 16
S5_GROUPS = D_MODEL // S5_GROUP
S5_STATE = 64
S5_MIN_STEP = 1e-3
S5_MAX_STEP = 1e-1
S5_CLIP = 1e-4
PEER_HEADS = 8
PEER_NKEYS = 128
PEER_EXPERTS = PEER_NKEYS * PEER_NKEYS
PEER_QDIM = 256
PEER_HALF = PEER_QDIM // 2
PEER_TOPK = 16
PEER_BLOCK = 128
PEER_V_SCALE = 0.5

kernel_name = 'hybrid_conv_hgrn2_s5_peer_dit'


def _n_layers_of(kind):
    return len(range(kind, DEPTH, N_MIXERS))


def rms_norm(x, g):
    xf = x.astype(jnp.float32)
    y = xf * lax.rsqrt(jnp.mean(xf * xf, axis=-1, keepdims=True) + RMS_EPS)
    return (y * g.astype(jnp.float32)).astype(x.dtype)


def adaln(cond, w, b):
    return jnp.split(jax.nn.silu(cond) @ w + b, 6, axis=-1)


def modulate(h, shift, scale):
    return h * (1 + scale) + shift


def centred_conv3(z, k):
    pad = [(0, 0)] * (z.ndim - 2) + [(1, 1), (0, 0)]
    zp = jnp.pad(z, pad)
    return zp[..., :-2, :] * k[0] + zp[..., 1:-1, :] * k[1] + zp[..., 2:, :] * k[2]


def short_conv_mixer(h, w_in, k, w_out, rows):
    gate_b, gate_c, v = jnp.split(h @ w_in, 3, axis=-1)
    z = gate_c * v
    if rows is None:
        zc = centred_conv3(z, k)
    else:
        bn, t, ch = z.shape
        zc = centred_conv3(z.reshape(bn, rows, GRID_W, ch), k).reshape(bn, t, ch)
    return (gate_b * zc) @ w_out


def gla_chunk_scan(q, k, v, g, s0):
    bn, t, nh, dk = q.shape
    L = HGRN_CHUNK
    n = t // L
    def chunks(a):
        return a.reshape(bn, n, L, nh, a.shape[-1]).transpose(1, 0, 2, 3, 4)
    q, k, v, g = chunks(q), chunks(k), chunks(v), chunks(g)
    b = jnp.cumsum(g, axis=2)
    b_mid = b[:, :, L // 2:L // 2 + 1]
    scores = jnp.einsum('nblhk,nbmhk->nbhlm', q * jnp.exp(b - b_mid), k * jnp.exp(b_mid - b))
    tri = jnp.tril(jnp.ones((L, L), dtype=bool))
    o_intra = jnp.einsum('nbhlm,nbmhv->nblhv', jnp.where(tri, scores, 0.0), v)
    q_dec = q * jnp.exp(b)
    k_dec = k * jnp.exp(b[:, :, -1:] - b)
    decay = jnp.exp(b[:, :, -1])

    def step(s, xs):
        qd, kd, vv, dc = xs
        o = jnp.einsum('blhk,bhkv->blhv', qd, s)
        s = dc[..., None] * s + jnp.einsum('blhk,blhv->bhkv', kd, vv)
        return s, o

    s_last, o_inter = lax.scan(step, s0, (q_dec, k_dec, v, decay))
    o = (o_intra + o_inter).transpose(1, 0, 2, 3, 4).reshape(bn, t, nh, v.shape[-1])
    return o, s_last


def hgrn2_mixer(hc, hx, w_in, lb, norm_g, w_out):
    def project(h):
        bn, t, _ = h.shape
        heads = lambda a: a.astype(jnp.float32).reshape(bn, t, HGRN_HEADS, HGRN_HEAD_DIM)
        q, i, zf_fwd, zf_bwd, zg = jnp.split(h @ w_in, 5, axis=-1)
        dirs = []
        for d, zf in enumerate((zf_fwd, zf_bwd)):
            f = heads(lb[d] + (1.0 - lb[d]) * jax.nn.sigmoid(zf.astype(jnp.float32)))
            dirs.append((1.0 - f, jnp.log(f)))
        return heads(jax.nn.silu(q)), heads(i), dirs, zg

    qc, vc, dc, zgc = project(hc)
    qx, vx, dx, zgx = project(hx)
    s0 = jnp.zeros((hc.shape[0], HGRN_HEADS, HGRN_HEAD_DIM, HGRN_HEAD_DIM), jnp.float32)
    fl = lambda a: jnp.flip(a, axis=1)
    oc_f, sc_f = gla_chunk_scan(qc, dc[0][0], vc, dc[0][1], s0)
    ox_f, _ = gla_chunk_scan(qx, dx[0][0], vx, dx[0][1], sc_f)
    oc_b, sc_b = gla_chunk_scan(fl(qc), fl(dc[1][0]), fl(vc), fl(dc[1][1]), s0)
    ox_b, _ = gla_chunk_scan(fl(qx), fl(dx[1][0]), fl(vx), fl(dx[1][1]), sc_b)

    def readout(o, zg):
        bn, t = o.shape[:2]
        on = rms_norm(o, norm_g.reshape(HGRN_HEADS, HGRN_HEAD_DIM)).reshape(bn, t, D_MODEL)
        return (on.astype(zg.dtype) * jax.nn.silu(zg)) @ w_out

    return readout(oc_f + fl(oc_b), zgc), readout(ox_f + fl(ox_b), zgx)


def s5_discretise(lam_re, lam_im, log_step, b_re, b_im):
    step = jnp.exp(log_step.astype(jnp.float32))[:, None]
    lr = jnp.minimum(lam_re.astype(jnp.float32), -S5_CLIP)
    li = lam_im.astype(jnp.float32)
    ar, ai = step * lr, step * li
    mag = jnp.exp(ar)
    abar_r, abar_i = mag * jnp.cos(ai), mag * jnp.sin(ai)
    den = lr * lr + li * li
    fr = ((abar_r - 1.0) * lr + abar_i * li) / den
    fi = (abar_i * lr - (abar_r - 1.0) * li) / den
    br, bi = b_re.astype(jnp.float32), b_im.astype(jnp.float32)
    bbar_r = fr[..., None] * br - fi[..., None] * bi
    bbar_i = fr[..., None] * bi + fi[..., None] * br
    return (ar, ai), (abar_r, abar_i), (bbar_r, bbar_i)


def diag_ssm_scan(log_a, abar, bu, s0):
    bu_r, bu_i = bu
    if s0 is not None:
        s_r, s_i = s0
        bu_r = bu_r.at[:, 0].add(abar[0] * s_r - abar[1] * s_i)
        bu_i = bu_i.at[:, 0].add(abar[0] * s_i + abar[1] * s_r)
    counts = jnp.ones((1, bu_r.shape[1], 1, 1), jnp.float32)

    def combine(e1, e2):
        n1, r1, i1 = e1
        n2, r2, i2 = e2
        mag = jnp.exp(n2 * log_a[0])
        ang = n2 * log_a[1]
        pr, pi = mag * jnp.cos(ang), mag * jnp.sin(ang)
        return n1 + n2, pr * r1 - pi * i1 + r2, pr * i1 + pi * r1 + i2

    _, sr, si = lax.associative_scan(combine, (counts, bu_r, bu_i), axis=1)
    return sr, si


def s5_mixer(hc, hx, lam_re, lam_im, log_step, b_re, b_im, c_re, c_im, d_skip, w_glu):
    def groups(h):
        return h.astype(jnp.float32).reshape(h.shape[0], h.shape[1], S5_GROUPS, S5_GROUP)
    uc, ux = groups(hc), groups(hx)
    d_g = d_skip.astype(jnp.float32).reshape(S5_GROUPS, S5_GROUP)
    yc, yx = d_g * uc, d_g * ux
    for dn in range(2):
        log_a, abar, bbar = s5_discretise(lam_re[dn], lam_im[dn], log_step[dn], b_re, b_im)
        order = (lambda a: a) if dn == 0 else (lambda a: jnp.flip(a, axis=1))
        def drive(u):
            return (jnp.einsum('btgh,gph->btgp', u, bbar[0]), jnp.einsum('btgh,gph->btgp', u, bbar[1]))
        def read(s):
            return (jnp.einsum('btgp,ghp->btgh', s[0], c_re[dn].astype(jnp.float32))
                    - jnp.einsum('btgp,ghp->btgh', s[1], c_im[dn].astype(jnp.float32)))
        sc = diag_ssm_scan(log_a, abar, drive(order(uc)), None)
        sx = diag_ssm_scan(log_a, abar, drive(order(ux)), (sc[0][:, -1], sc[1][:, -1]))
        yc = yc + order(read(sc))
        yx = yx + order(read(sx))

    def glu(y, h):
        z = jax.nn.gelu(y.reshape(h.shape).astype(jnp.float32), approximate=False).astype(h.dtype)
        val, gate = jnp.split(z @ w_glu, 2, axis=-1)
        return val * jax.nn.sigmoid(gate)

    return glu(yc, hc), glu(yx, hx)


def peer_ffn(h, w_q, keys, u_tab, v_tab):
    bn, t, _ = h.shape
    q = (h @ w_q).astype(jnp.float32).reshape(bn, t, PEER_HEADS, 2, PEER_HALF)
    s = jnp.einsum('bthcd,hckd->bthck', q, keys.astype(jnp.float32))
    s_top, i_top = lax.top_k(s, PEER_TOPK)
    cand_s = (s_top[..., 0, :, None] + s_top[..., 1, None, :]).reshape(bn, t, PEER_HEADS, PEER_TOPK * PEER_TOPK)
    cand_i = (i_top[..., 0, :, None] * PEER_NKEYS + i_top[..., 1, None, :]).reshape(bn, t, PEER_HEADS, PEER_TOPK * PEER_TOPK)
    best_s, pos = lax.top_k(cand_s, PEER_TOPK)
    idx = jnp.take_along_axis(cand_i, pos, axis=-1)
    gates = jax.nn.softmax(best_s, axis=-1)
    n_blocks = bn * t // PEER_BLOCK
    n_sel = PEER_HEADS * PEER_TOPK
    hb = h.reshape(n_blocks, PEER_BLOCK, D_MODEL)
    ib = idx.reshape(n_blocks, PEER_BLOCK, n_sel)
    gb = gates.astype(h.dtype).reshape(n_blocks, PEER_BLOCK, n_sel)

    def experts(args):
        hh, ii, gg = args
        pre = jnp.einsum('ced,cd->ce', jnp.take(u_tab, ii, axis=0), hh)
        act = jax.nn.gelu(pre.astype(jnp.float32), approximate=False).astype(hh.dtype)
        return jnp.einsum('ce,ced->cd', act * gg, jnp.take(v_tab, ii, axis=0))

    return lax.map(experts, (hb, ib, gb)).reshape(bn, t, D_MODEL)


def setup_inputs(seed: int = 0) -> dict:
    key = jax.random.key(seed)
    ks = iter(jax.random.split(key, 40))
    nrm = lambda shape, scale: scale * jax.random.normal(next(ks), shape, jnp.float32)
    n_a, n_b, n_c = (_n_layers_of(kk) for kk in range(N_MIXERS))
    D = D_MODEL
    inv = D ** -0.5
    G, P, GC = S5_GROUPS, S5_STATE, S5_GROUP
    lam_im0 = math.pi * jnp.arange(P, dtype=jnp.float32)
    return {
        'x': nrm((BATCH, SEQ, D), 1.0),
        'c': nrm((BATCH, D), 1.0),
        'ctx': nrm((BATCH, CTX_LEN, D), 1.0),
        'c_ctx': nrm((D,), 1.0),
        'ada_w': nrm((DEPTH, D, 6 * D), 0.5 * inv),
        'ada_b': nrm((DEPTH, 6 * D), 0.02),
        'norm1_g': 1.0 + nrm((DEPTH, D), 0.02),
        'norm2_g': 1.0 + nrm((DEPTH, D), 0.02),
        'conv_w_in': nrm((n_a, D, 3 * D), inv),
        'conv_k': nrm((n_a, CONV_WIDTH, D), CONV_WIDTH ** -0.5),
        'conv_w_out': nrm((n_a, D, D), inv),
        'hgrn_w_in': nrm((n_b, D, 5 * D), inv),
        'hgrn_lb': nrm((DEPTH, 2, D), 0.1),
        'hgrn_norm_g': 1.0 + nrm((n_b, D), 0.02),
        'hgrn_w_out': nrm((n_b, D, D), inv),
        's5_lambda_re': -0.5 + nrm((n_c, 2, G, P), 0.01),
        's5_lambda_im': lam_im0 + nrm((n_c, 2, G, P), 0.01),
        's5_log_step': jax.random.uniform(next(ks), (n_c, 2, G), jnp.float32, math.log(S5_MIN_STEP), math.log(S5_MAX_STEP)),
        's5_b_re': nrm((n_c, G, P, GC), (2 * GC) ** -0.5),
        's5_b_im': nrm((n_c, G, P, GC), (2 * GC) ** -0.5),
        's5_c_re': nrm((n_c, 2, G, GC, P), (2 * P) ** -0.5),
        's5_c_im': nrm((n_c, 2, G, GC, P), (2 * P) ** -0.5),
        's5_d': nrm((n_c, D), 1.0),
        's5_w_glu': nrm((n_c, D, 2 * D), inv),
        'peer_w_q': nrm((DEPTH, D, PEER_HEADS * PEER_QDIM), inv),
        'peer_keys': nrm((DEPTH, PEER_HEADS, 2, PEER_NKEYS, PEER_HALF), PEER_HALF ** -0.5),
        'peer_u': nrm((DEPTH, PEER_EXPERTS, D), inv),
        'peer_v': nrm((DEPTH, PEER_EXPERTS, D), PEER_V_SCALE),
        'final_g': 1.0 + nrm((D,), 0.02),
    }


def reference(x, c, ctx, c_ctx, ada_w, ada_b, norm1_g, norm2_g, conv_w_in, conv_k, conv_w_out,
              hgrn_w_in, hgrn_lb, hgrn_norm_g, hgrn_w_out, s5_lambda_re, s5_lambda_im, s5_log_step,
              s5_b_re, s5_b_im, s5_c_re, s5_c_im, s5_d, s5_w_glu, peer_w_q, peer_keys, peer_u, peer_v,
              final_g):
    rows = x.shape[1] // GRID_W
    lb_soft = jax.nn.softmax(hgrn_lb.astype(jnp.float32), axis=0)
    lower_bounds = jnp.cumsum(lb_soft, axis=0) - lb_soft[0]
    xc = ctx
    for i in range(DEPTH):
        kind, j = i % N_MIXERS, i // N_MIXERS
        last = i == DEPTH - 1
        mx = [m[:, None, :] for m in adaln(c, ada_w[i], ada_b[i])]
        mc = adaln(c_ctx, ada_w[i], ada_b[i]) if (not last or kind != 0) else None
        hx = modulate(rms_norm(x, norm1_g[i]), mx[0], mx[1])
        if kind == 0:
            yx = short_conv_mixer(hx, conv_w_in[j], conv_k[j], conv_w_out[j], rows)
            yc = None if last else short_conv_mixer(modulate(rms_norm(xc, norm1_g[i]), mc[0], mc[1]),
                                                     conv_w_in[j], conv_k[j], conv_w_out[j], None)
        else:
            hc = modulate(rms_norm(xc, norm1_g[i]), mc[0], mc[1])
            if kind == 1:
                yc, yx = hgrn2_mixer(hc, hx, hgrn_w_in[j], lower_bounds[i], hgrn_norm_g[j], hgrn_w_out[j])
            else:
                yc, yx = s5_mixer(hc, hx, s5_lambda_re[j], s5_lambda_im[j], s5_log_step[j], s5_b_re[j],
                                  s5_b_im[j], s5_c_re[j], s5_c_im[j], s5_d[j], s5_w_glu[j])
        x = x + mx[2] * yx
        x = x + mx[5] * peer_ffn(modulate(rms_norm(x, norm2_g[i]), mx[3], mx[4]),
                                 peer_w_q[i], peer_keys[i], peer_u[i], peer_v[i])
        if not last:
            xc = xc + mc[2] * yc
            xc = xc + mc[5] * peer_ffn(modulate(rms_norm(xc, norm2_g[i]), mc[3], mc[4]),
                                       peer_w_q[i], peer_keys[i], peer_u[i], peer_v[i])
    return rms_norm(x, final_g)
```

```cpp
#include <hip/hip_runtime.h>
#include <cstdint>
#include <cstdio>

#define DEVI __device__ __forceinline__
typedef unsigned short bf16_t;
typedef float f32x4 __attribute__((ext_vector_type(4)));
typedef unsigned u32x4 __attribute__((ext_vector_type(4)));
typedef unsigned u32x2 __attribute__((ext_vector_type(2)));
typedef int i32x4 __attribute__((ext_vector_type(4)));
typedef __bf16 bf16x2_t __attribute__((ext_vector_type(2)));

constexpr int D = 1024, T = 16384, TC = 256, MA = T + TC, DEPTH = 4;
constexpr int NTHR = 512, NWV = 8;
constexpr float EPS = 1e-6f;

constexpr size_t MiB = 1u << 20;
constexpr size_t WS_CTL = 0;
constexpr size_t WS_MOD = 1 * MiB;
constexpr size_t WS_LB = WS_MOD + 256 * 1024;
constexpr size_t WS_S5A = 2 * MiB;
constexpr size_t WS_S5B = 3 * MiB;
constexpr size_t WS_X = 8 * MiB;
constexpr size_t WS_XN = 73 * MiB;
constexpr size_t WS_U = 106 * MiB;
constexpr size_t WS_OF = 139 * MiB;
constexpr size_t WS_OB = 172 * MiB;
constexpr size_t WS_G = 205 * MiB;
constexpr size_t WS_SC = 368 * MiB;
constexpr size_t WS_SELI = 498 * MiB;
constexpr size_t WS_SELG = 507 * MiB;
constexpr size_t WS_WQK = 516 * MiB;
constexpr size_t WS_WT = 532 * MiB;
constexpr size_t WT_CIN = 0, WT_COUT = 12 * MiB, WT_HIN = 16 * MiB, WT_HOUT = 26 * MiB, WT_GLU = 28 * MiB;
constexpr size_t WS_PU = 564 * MiB;
constexpr size_t WS_PV = 692 * MiB;
constexpr size_t WS_END = 820 * MiB;

constexpr int LDS_BYTES = 147456;

enum { I_X = 0, I_C, I_CTX, I_CCTX, I_ADAW, I_ADAB, I_N1G, I_N2G, I_CWIN, I_CK, I_CWOUT, I_HWIN, I_HLB, I_HNG, I_HWOUT,
       I_S5LR, I_S5LI, I_S5LS, I_S5BR, I_S5BI, I_S5CR, I_S5CI, I_S5D, I_S5GLU, I_PWQ, I_PKEYS, I_PU, I_PV, I_FG, N_IN };

struct P {
    const float* in[N_IN];
    float* out;
    unsigned char* ws;
    int ph, arg;
};

DEVI unsigned f2bf(float f) { unsigned u = __float_as_uint(f); return (u + 0x7fffu + ((u >> 16) & 1u)) >> 16; }
DEVI unsigned pk2(float lo, float hi) { return f2bf(lo) | (f2bf(hi) << 16); }
DEVI float bflo(unsigned w) { return __uint_as_float(w << 16); }
DEVI float bfhi(unsigned w) { return __uint_as_float(w & 0xffff0000u); }
DEVI float bf2f(bf16_t b) { return __uint_as_float((unsigned)b << 16); }
DEVI float sigmoidf_(float x) { return 1.0f / (1.0f + __expf(-x)); }
DEVI float siluf_(float x) { return x * sigmoidf_(x); }
DEVI float geluf_(float x) { return 0.5f * x * (1.0f + erff(x * 0.70710678118654752f)); }
DEVI float dot2bf(unsigned a, unsigned b, float c) { return __builtin_amdgcn_fdot2_f32_bf16(__builtin_bit_cast(bf16x2_t, a), __builtin_bit_cast(bf16x2_t, b), c, false); }
DEVI float wave_sum(float v) {
#pragma unroll
    for (int o = 1; o < 64; o <<= 1) v += __shfl_xor(v, o);
    return v;
}
DEVI int row_cls(int r) { return r < TC ? 1 : 0; }
DEVI const float* mod_ptr(const P& p, int layer, int cls, int chunk) { return (const float*)(p.ws + WS_MOD) + ((size_t)(layer * 2 + cls) * 6 + chunk) * D; }

struct Row16 { float v[16]; };
DEVI void load_row_f32(const float* row, int lane, Row16& o) {
    const f32x4* a = (const f32x4*)(row + 8 * lane); const f32x4* b = (const f32x4*)(row + 512 + 8 * lane);
    f32x4 a0 = a[0], a1 = a[1], b0 = b[0], b1 = b[1];
#pragma unroll
    for (int j = 0; j < 4; ++j) { o.v[j] = a0[j]; o.v[4 + j] = a1[j]; o.v[8 + j] = b0[j]; o.v[12 + j] = b1[j]; }
}
DEVI void store_row_f32(float* row, int lane, const Row16& o) {
    f32x4* a = (f32x4*)(row + 8 * lane); f32x4* b = (f32x4*)(row + 512 + 8 * lane);
    a[0] = (f32x4){o.v[0], o.v[1], o.v[2], o.v[3]}; a[1] = (f32x4){o.v[4], o.v[5], o.v[6], o.v[7]};
    b[0] = (f32x4){o.v[8], o.v[9], o.v[10], o.v[11]}; b[1] = (f32x4){o.v[12], o.v[13], o.v[14], o.v[15]};
}
DEVI void load_row_bf16(const bf16_t* row, int lane, Row16& o) {
    const u32x4 a = *(const u32x4*)(row + 8 * lane), b = *(const u32x4*)(row + 512 + 8 * lane);
#pragma unroll
    for (int j = 0; j < 4; ++j) { o.v[2 * j] = bflo(a[j]); o.v[2 * j + 1] = bfhi(a[j]); o.v[8 + 2 * j] = bflo(b[j]); o.v[8 + 2 * j + 1] = bfhi(b[j]); }
}
DEVI void store_row_bf16(bf16_t* row, int lane, const Row16& o) {
    u32x4 a, b;
#pragma unroll
    for (int j = 0; j < 4; ++j) { a[j] = pk2(o.v[2 * j], o.v[2 * j + 1]); b[j] = pk2(o.v[8 + 2 * j], o.v[8 + 2 * j + 1]); }
    *(u32x4*)(row + 8 * lane) = a; *(u32x4*)(row + 512 + 8 * lane) = b;
}
DEVI void norm_mod(const Row16& x, const float* g, const float* shift, const float* scale, int lane, Row16& o) {
    float ss = 0.f;
#pragma unroll
    for (int j = 0; j < 16; ++j) ss += x.v[j] * x.v[j];
    ss = wave_sum(ss);
    const float rstd = rsqrtf(ss * (1.0f / D) + EPS);
    Row16 gg, sh, sc; load_row_f32(g, lane, gg); load_row_f32(shift, lane, sh); load_row_f32(scale, lane, sc);
#pragma unroll
    for (int j = 0; j < 16; ++j) o.v[j] = x.v[j] * rstd * gg.v[j] * (1.0f + sc.v[j]) + sh.v[j];
}

DEVI void ph_ada(const P& p, unsigned char* lds) {
    float* sc = (float*)lds;
    float* red = sc + 2048;
    const int tid = threadIdx.x;
    for (int k = tid; k < 1024; k += NTHR) { sc[k] = siluf_(p.in[I_C][k]); sc[1024 + k] = siluf_(p.in[I_CCTX][k]); }
    __syncthreads();
    const int kg = tid >> 4, cl = tid & 15;
    for (int item = blockIdx.x; item < 4 * 96; item += gridDim.x) {
        const int i = item / 96, n0 = (item % 96) * 64 + cl * 4;
        const float* w = p.in[I_ADAW] + (size_t)i * 1024 * 6144 + n0;
        f32x4 a0 = {0, 0, 0, 0}, a1 = {0, 0, 0, 0};
#pragma unroll 4
        for (int k = kg; k < 1024; k += 32) { const f32x4 wv = *(const f32x4*)(w + (size_t)k * 6144); a0 += wv * sc[k]; a1 += wv * sc[1024 + k]; }
        float* r = red + (kg * 16 + cl) * 8;
#pragma unroll
        for (int j = 0; j < 4; ++j) { r[j] = a0[j]; r[4 + j] = a1[j]; }
        __syncthreads();
        if (tid < 128) {
            const int c2 = tid >> 3, j = tid & 7; float s = 0.f;
            for (int g = 0; g < 32; ++g) s += red[(g * 16 + c2) * 8 + j];
            const int cls = j >> 2, n = (item % 96) * 64 + c2 * 4 + (j & 3);
            ((float*)(p.ws + WS_MOD))[(size_t)(i * 2 + cls) * 6144 + n] = s + p.in[I_ADAB][i * 6144 + n];
        }
        __syncthreads();
    }
}
DEVI void ph_lb(const P& p) {
    const int gt = blockIdx.x * NTHR + threadIdx.x;
    if (gt < 2048) {
        const float* l = p.in[I_HLB];
        float m = -1e30f; for (int i = 0; i < 4; ++i) m = fmaxf(m, l[i * 2048 + gt]);
        float s = 0.f; for (int i = 0; i < 4; ++i) s += expf(l[i * 2048 + gt] - m);
        ((float*)(p.ws + WS_LB))[gt] = expf(l[2048 + gt] - m) / s;
    }
}
DEVI void ph_s5disc(const P& p) {
    const int gt = blockIdx.x * NTHR + threadIdx.x;
    if (gt < 2 * 64 * 64) {
        const int dn = gt >> 12, g = (gt >> 6) & 63, pp = gt & 63;
        const float step = expf(p.in[I_S5LS][dn * 64 + g]);
        const float lr = fminf(p.in[I_S5LR][gt], -1e-4f), li = p.in[I_S5LI][gt];
        const float ar = step * lr, ai = step * li, mag = expf(ar);
        float sn, cs; sincosf(ai, &sn, &cs);
        const float abr = mag * cs, abi = mag * sn, den = lr * lr + li * li;
        const float fr = ((abr - 1.0f) * lr + abi * li) / den, fi = (abi * lr - (abr - 1.0f) * li) / den;
        float* A = (float*)(p.ws + WS_S5A) + (size_t)gt * 2; A[0] = abr; A[1] = abi;
        float* B = (float*)(p.ws + WS_S5B) + (size_t)gt * 32;
        const float* br = p.in[I_S5BR] + (size_t)(g * 64 + pp) * 16; const float* bi = p.in[I_S5BI] + (size_t)(g * 64 + pp) * 16;
        for (int h = 0; h < 16; ++h) { B[h] = fr * br[h] - fi * bi[h]; B[16 + h] = fr * bi[h] + fi * br[h]; }
    }
}
DEVI void transpose_item(const float* W, int K, int N, bf16_t* WT, float* scr, int item, int lane) {
    const int nblk = N / 32, kb = item / nblk, nb = item % nblk, k0 = 64 * kb, n0 = 32 * nb;
#pragma unroll 8
    for (int i = 0; i < 32; ++i) { const int kk = 2 * i + (lane >> 5); scr[kk * 33 + (lane & 31)] = W[(size_t)(k0 + kk) * N + n0 + (lane & 31)]; }
    __builtin_amdgcn_s_waitcnt(0); asm volatile("" ::: "memory");
    const int c = lane & 7;
#pragma unroll
    for (int j = 0; j < 4; ++j) { const int n = (lane >> 3) + 8 * j; const float* s = scr + (8 * c) * 33 + n;
        u32x4 o; o.x = pk2(s[0 * 33], s[1 * 33]); o.y = pk2(s[2 * 33], s[3 * 33]); o.z = pk2(s[4 * 33], s[5 * 33]); o.w = pk2(s[6 * 33], s[7 * 33]);
        *(u32x4*)(WT + (size_t)(n0 + n) * K + k0 + 8 * c) = o; }
    __builtin_amdgcn_s_waitcnt(0); asm volatile("" ::: "memory");
}
DEVI void ph_transposes(const P& p, unsigned char* lds) {
    const int wave = threadIdx.x >> 6, lane = threadIdx.x & 63;
    float* scr = (float*)lds + wave * (64 * 33);
    const int gw = blockIdx.x * NWV + wave, NGW = gridDim.x * NWV;
    bf16_t* WT = (bf16_t*)(p.ws + WS_WT);
    constexpr int I_A = (1024 / 64) * (3072 / 32), I_B = (1024 / 64) * (1024 / 32), I_C5 = (1024 / 64) * (5120 / 32), I_G = (1024 / 64) * (2048 / 32);
    constexpr int NIT = 2 * I_A + 2 * I_B + I_C5 + I_B + I_G;
    for (int it = gw; it < NIT; it += NGW) {
        int r = it;
        if (r < 2 * I_A) { const int j = r / I_A; transpose_item(p.in[I_CWIN] + (size_t)j * 1024 * 3072, 1024, 3072, WT + WT_CIN / 2 + (size_t)j * 3072 * 1024, scr, r % I_A, lane); continue; } r -= 2 * I_A;
        if (r < 2 * I_B) { const int j = r / I_B; transpose_item(p.in[I_CWOUT] + (size_t)j * 1024 * 1024, 1024, 1024, WT + WT_COUT / 2 + (size_t)j * 1024 * 1024, scr, r % I_B, lane); continue; } r -= 2 * I_B;
        if (r < I_C5) { transpose_item(p.in[I_HWIN], 1024, 5120, WT + WT_HIN / 2, scr, r, lane); continue; } r -= I_C5;
        if (r < I_B) { transpose_item(p.in[I_HWOUT], 1024, 1024, WT + WT_HOUT / 2, scr, r, lane); continue; } r -= I_B;
        transpose_item(p.in[I_S5GLU], 1024, 2048, WT + WT_GLU / 2, scr, r, lane);
    }
}
DEVI void ph_tables(const P& p) {
    const size_t n8 = (size_t)4 * 16384 * 1024 / 8;
    const size_t gt = (size_t)blockIdx.x * NTHR + threadIdx.x, nt = (size_t)gridDim.x * NTHR;
    for (int w = 0; w < 2; ++w) {
        const f32x4* src = (const f32x4*)p.in[w ? I_PV : I_PU]; u32x4* dst = (u32x4*)(p.ws + (w ? WS_PV : WS_PU));
        for (size_t i = gt; i < n8; i += nt) { const f32x4 a = src[2 * i], b = src[2 * i + 1]; u32x4 o; o.x = pk2(a[0], a[1]); o.y = pk2(a[2], a[3]); o.z = pk2(b[0], b[1]); o.w = pk2(b[2], b[3]); dst[i] = o; }
    }
}
DEVI void ph_fold(const P& p, unsigned char* lds) {
    float* A = (float*)lds;
    float* B = A + 64 * 129;
    const int tid = threadIdx.x, kq = tid & 7, keyg = tid >> 3;
    for (int item = blockIdx.x; item < 4 * 16 * 16; item += gridDim.x) {
        const int i = item >> 8, hc = (item >> 4) & 15, kb = item & 15;
        const float* wq = p.in[I_PWQ] + ((size_t)i * 1024 + kb * 64) * 2048 + hc * 128;
        const float* ky = p.in[I_PKEYS] + ((size_t)i * 16 + hc) * 128 * 128;
        for (int e = tid; e < 64 * 128; e += NTHR) A[(e >> 7) * 129 + (e & 127)] = wq[(size_t)(e >> 7) * 2048 + (e & 127)];
        for (int e = tid; e < 128 * 128; e += NTHR) B[(e >> 7) * 129 + (e & 127)] = ky[e];
        __syncthreads();
        float acc[2][8];
#pragma unroll
        for (int a = 0; a < 2; ++a)
#pragma unroll
            for (int j = 0; j < 8; ++j) acc[a][j] = 0.f;
        for (int d = 0; d < 128; ++d) {
            const float b0 = B[keyg * 129 + d], b1 = B[(keyg + 64) * 129 + d];
#pragma unroll
            for (int j = 0; j < 8; ++j) { const float a = A[(kq * 8 + j) * 129 + d]; acc[0][j] += a * b0; acc[1][j] += a * b1; }
        }
        bf16_t* out = (bf16_t*)(p.ws + WS_WQK) + ((size_t)i * 2048 + hc * 128) * 1024 + kb * 64 + kq * 8;
#pragma unroll
        for (int a = 0; a < 2; ++a) { u32x4 o; o.x = pk2(acc[a][0], acc[a][1]); o.y = pk2(acc[a][2], acc[a][3]); o.z = pk2(acc[a][4], acc[a][5]); o.w = pk2(acc[a][6], acc[a][7]);
            *(u32x4*)(out + (size_t)(keyg + 64 * a) * 1024) = o; }
        __syncthreads();
    }
}

DEVI void ph_init_norm(const P& p) {
    const int wave = threadIdx.x >> 6, lane = threadIdx.x & 63, gw = blockIdx.x * NWV + wave, NGW = gridDim.x * NWV;
    for (int r = gw; r < MA; r += NGW) {
        const float* src = r < TC ? p.in[I_CTX] + (size_t)r * D : p.in[I_X] + (size_t)(r - TC) * D;
        Row16 x, o; load_row_f32(src, lane, x);
        store_row_f32((float*)(p.ws + WS_X) + (size_t)r * D, lane, x);
        const int cls = row_cls(r);
        norm_mod(x, p.in[I_N1G], mod_ptr(p, 0, cls, 0), mod_ptr(p, 0, cls, 1), lane, o);
        store_row_bf16((bf16_t*)(p.ws + WS_XN) + (size_t)r * D, lane, o);
    }
}
DEVI void ph_norm2(const P& p, int layer, int r0) {
    const int wave = threadIdx.x >> 6, lane = threadIdx.x & 63, gw = blockIdx.x * NWV + wave, NGW = gridDim.x * NWV;
    for (int r = r0 + gw; r < MA; r += NGW) {
        Row16 x, o; load_row_f32((const float*)(p.ws + WS_X) + (size_t)r * D, lane, x);
        const int cls = row_cls(r);
        norm_mod(x, p.in[I_N2G] + layer * D, mod_ptr(p, layer, cls, 3), mod_ptr(p, layer, cls, 4), lane, o);
        store_row_bf16((bf16_t*)(p.ws + WS_XN) + (size_t)r * D, lane, o);
    }
}

struct EpiStoreBf16 { bf16_t* O; int ldc; DEVI void operator()(int r, int c, float v) const { O[(size_t)r * ldc + c] = (bf16_t)f2bf(v); } };
struct EpiStoreF32 { float* O; int ldc; DEVI void operator()(int r, int c, float v) const { O[(size_t)r * ldc + c] = v; } };
struct EpiResidual { float* X; const float* gate0; const float* gate1; DEVI void operator()(int r, int c, float v) const { const float g = (r < TC ? gate1 : gate0)[c]; X[(size_t)r * D + c] += g * v; } };
template <class Epi>
DEVI void gemm_naive(const bf16_t* A, int lda, const bf16_t* Bt, int ldb, int m_lo, int M, int N, int K, const Epi& epi, unsigned char* lds) {
    float* As = (float*)lds;
    float* Bs = As + 32 * 132;
    const int tid = threadIdx.x, ty = tid >> 4, tx = tid & 15, lr = tid >> 2, lk = (tid & 3) * 8;
    const int nM = (M - m_lo) / 128, nN = N / 128;
    for (int tile = blockIdx.x; tile < nM * nN; tile += gridDim.x) {
        const int m0 = m_lo + (tile / nN) * 128, n0 = (tile % nN) * 128;
        float acc[4][8];
#pragma unroll
        for (int i = 0; i < 4; ++i)
#pragma unroll
            for (int j = 0; j < 8; ++j) acc[i][j] = 0.f;
        for (int k0 = 0; k0 < K; k0 += 32) {
            const u32x4 av = *(const u32x4*)(A + (size_t)(m0 + lr) * lda + k0 + lk);
            const u32x4 bv = *(const u32x4*)(Bt + (size_t)(n0 + lr) * ldb + k0 + lk);
            __syncthreads();
#pragma unroll
            for (int j = 0; j < 4; ++j) { As[(lk + 2 * j) * 132 + lr] = bflo(av[j]); As[(lk + 2 * j + 1) * 132 + lr] = bfhi(av[j]);
                                          Bs[(lk + 2 * j) * 132 + lr] = bflo(bv[j]); Bs[(lk + 2 * j + 1) * 132 + lr] = bfhi(bv[j]); }
            __syncthreads();
#pragma unroll 8
            for (int k = 0; k < 32; ++k) {
                const f32x4 a = *(const f32x4*)(As + k * 132 + ty * 4);
                const f32x4 b0 = *(const f32x4*)(Bs + k * 132 + tx * 8), b1 = *(const f32x4*)(Bs + k * 132 + tx * 8 + 4);
#pragma unroll
                for (int i = 0; i < 4; ++i)
#pragma unroll
                    for (int j = 0; j < 4; ++j) { acc[i][j] += a[i] * b0[j]; acc[i][4 + j] += a[i] * b1[j]; }
            }
        }
#pragma unroll
        for (int i = 0; i < 4; ++i)
#pragma unroll
            for (int j = 0; j < 8; ++j) epi(m0 + ty * 4 + i, n0 + tx * 8 + j, acc[i][j]);
    }
}

DEVI void ph_conv(const P& p, int j, int r0) {
    const int wave = threadIdx.x >> 6, lane = threadIdx.x & 63, gw = blockIdx.x * NWV + wave, NGW = gridDim.x * NWV;
    const bf16_t* G = (const bf16_t*)(p.ws + WS_G);
    Row16 k0, k1, k2;
    load_row_f32(p.in[I_CK] + (size_t)(j * 3 + 0) * D, lane, k0); load_row_f32(p.in[I_CK] + (size_t)(j * 3 + 1) * D, lane, k1); load_row_f32(p.in[I_CK] + (size_t)(j * 3 + 2) * D, lane, k2);
    for (int r = r0 + gw; r < MA; r += NGW) {
        bool hasp, hasn;
        if (r < TC) { hasp = r > 0; hasn = r < TC - 1; } else { const int t = (r - TC) & 63; hasp = t != 0; hasn = t != 63; }
        Row16 gb, gc, v, acc;
        load_row_bf16(G + (size_t)r * 3072, lane, gb); load_row_bf16(G + (size_t)r * 3072 + 1024, lane, gc); load_row_bf16(G + (size_t)r * 3072 + 2048, lane, v);
#pragma unroll
        for (int e = 0; e < 16; ++e) acc.v[e] = gc.v[e] * v.v[e] * k1.v[e];
        if (hasp) { load_row_bf16(G + (size_t)(r - 1) * 3072 + 1024, lane, gc); load_row_bf16(G + (size_t)(r - 1) * 3072 + 2048, lane, v);
#pragma unroll
            for (int e = 0; e < 16; ++e) acc.v[e] += gc.v[e] * v.v[e] * k0.v[e]; }
        if (hasn) { load_row_bf16(G + (size_t)(r + 1) * 3072 + 1024, lane, gc); load_row_bf16(G + (size_t)(r + 1) * 3072 + 2048, lane, v);
#pragma unroll
            for (int e = 0; e < 16; ++e) acc.v[e] += gc.v[e] * v.v[e] * k2.v[e]; }
#pragma unroll
        for (int e = 0; e < 16; ++e) acc.v[e] *= gb.v[e];
        store_row_bf16((bf16_t*)(p.ws + WS_U) + (size_t)r * D, lane, acc);
    }
}

DEVI int scan_row(int n, int dir) {
    if (dir == 0) return n;
    return n < TC ? (TC - 1 - n) : (TC + (T - 1 - (n - TC)));
}
DEVI void ph_hgrn_naive(const P& p, unsigned char* lds) {
    const int tid = threadIdx.x, sub = tid >> 7, kk = tid & 127;
    const int unit = blockIdx.x * 4 + sub;
    if (blockIdx.x >= 4) return;
    const int dir = unit >> 3, h = unit & 7;
    float* Ls = (float*)lds + sub * (4 * 8 * 128);
    float* LQ = Ls, *LF = Ls + 1024, *LK = Ls + 2048, *LV = Ls + 3072;
    const bf16_t* G = (const bf16_t*)(p.ws + WS_G);
    bf16_t* O = (bf16_t*)(p.ws + (dir ? WS_OB : WS_OF));
    const float lb = ((const float*)(p.ws + WS_LB))[dir * 1024 + h * 128 + kk];
    float S[128];
#pragma unroll
    for (int i = 0; i < 128; ++i) S[i] = 0.f;
    for (int n0 = 0; n0 < MA; n0 += 8) {
        __syncthreads();
#pragma unroll
        for (int t = 0; t < 8; ++t) {
            const int r = scan_row(n0 + t, dir); const bf16_t* g = G + (size_t)r * 5120 + h * 128 + kk;
            const float q = bf2f(g[0]), vi = bf2f(g[1024]), zf = bf2f(g[2048 + dir * 1024]);
            const float f = lb + (1.0f - lb) * sigmoidf_(zf);
            LQ[t * 128 + kk] = siluf_(q); LF[t * 128 + kk] = f; LK[t * 128 + kk] = 1.0f - f; LV[t * 128 + kk] = vi;
        }
        __syncthreads();
        for (int t = 0; t < 8; ++t) {
            const float v = LV[t * 128 + kk]; float o = 0.f;
#pragma unroll
            for (int i = 0; i < 128; i += 4) {
                const f32x4 f4 = *(const f32x4*)(LF + t * 128 + i), k4 = *(const f32x4*)(LK + t * 128 + i), q4 = *(const f32x4*)(LQ + t * 128 + i);
#pragma unroll
                for (int e = 0; e < 4; ++e) { S[i + e] = f4[e] * S[i + e] + k4[e] * v; o += S[i + e] * q4[e]; }
            }
            const int r = scan_row(n0 + t, dir);
            O[(size_t)r * D + h * 128 + kk] = (bf16_t)f2bf(o);
        }
    }
}
DEVI void ph_hgrn_readout(const P& p) {
    const int wave = threadIdx.x >> 6, lane = threadIdx.x & 63, gw = blockIdx.x * NWV + wave, NGW = gridDim.x * NWV;
    Row16 ng; load_row_f32(p.in[I_HNG], lane, ng);
    for (int r = gw; r < MA; r += NGW) {
        Row16 a, b, zg, o;
        load_row_bf16((const bf16_t*)(p.ws + WS_OF) + (size_t)r * D, lane, a); load_row_bf16((const bf16_t*)(p.ws + WS_OB) + (size_t)r * D, lane, b);
        load_row_bf16((const bf16_t*)(p.ws + WS_G) + (size_t)r * 5120 + 4096, lane, zg);
        float s0 = 0.f, s1 = 0.f;
#pragma unroll
        for (int e = 0; e < 8; ++e) { a.v[e] += b.v[e]; a.v[8 + e] += b.v[8 + e]; s0 += a.v[e] * a.v[e]; s1 += a.v[8 + e] * a.v[8 + e]; }
#pragma unroll
        for (int m = 1; m < 16; m <<= 1) { s0 += __shfl_xor(s0, m); s1 += __shfl_xor(s1, m); }
        const float r0 = rsqrtf(s0 * (1.0f / 128.0f) + EPS), r1 = rsqrtf(s1 * (1.0f / 128.0f) + EPS);
#pragma unroll
        for (int e = 0; e < 8; ++e) { o.v[e] = a.v[e] * r0 * ng.v[e] * siluf_(zg.v[e]); o.v[8 + e] = a.v[8 + e] * r1 * ng.v[8 + e] * siluf_(zg.v[8 + e]); }
        store_row_bf16((bf16_t*)(p.ws + WS_U) + (size_t)r * D, lane, o);
    }
}

DEVI float reduce16(float (&v)[16], int lane) {
    float w8[8], w4[4], w2[2];
    const bool b5 = lane & 32, b4 = lane & 16, b3 = lane & 8, b2 = lane & 4;
#pragma unroll
    for (int i = 0; i < 8; ++i) { const float keep = b5 ? v[i + 8] : v[i], send = b5 ? v[i] : v[i + 8]; w8[i] = keep + __shfl_xor(send, 32); }
#pragma unroll
    for (int i = 0; i < 4; ++i) { const float keep = b4 ? w8[i + 4] : w8[i], send = b4 ? w8[i] : w8[i + 4]; w4[i] = keep + __shfl_xor(send, 16); }
#pragma unroll
    for (int i = 0; i < 2; ++i) { const float keep = b3 ? w4[i + 2] : w4[i], send = b3 ? w4[i] : w4[i + 2]; w2[i] = keep + __shfl_xor(send, 8); }
    const float keep = b2 ? w2[1] : w2[0], send = b2 ? w2[0] : w2[1];
    float r = keep + __shfl_xor(send, 4);
    r += __shfl_xor(r, 2); r += __shfl_xor(r, 1);
    return r;
}
DEVI void ph_s5_naive(const P& p) {
    const int wave = threadIdx.x >> 6, lane = threadIdx.x & 63, gw = blockIdx.x * NWV + wave;
    if (gw >= 128) return;
    const int dn = gw >> 6, g = gw & 63;
    const float* A = (const float*)(p.ws + WS_S5A) + (size_t)((dn * 64 + g) * 64 + lane) * 2;
    const float abr = A[0], abi = A[1];
    float bbr[16], bbi[16], cr[16], ci[16];
    const float* B = (const float*)(p.ws + WS_S5B) + (size_t)((dn * 64 + g) * 64 + lane) * 32;
#pragma unroll
    for (int h = 0; h < 16; ++h) { bbr[h] = B[h]; bbi[h] = B[16 + h];
        cr[h] = p.in[I_S5CR][((size_t)(dn * 64 + g) * 16 + h) * 64 + lane]; ci[h] = p.in[I_S5CI][((size_t)(dn * 64 + g) * 16 + h) * 64 + lane]; }
    const bf16_t* XN = (const bf16_t*)(p.ws + WS_XN);
    bf16_t* Y = (bf16_t*)(p.ws + (dn ? WS_OB : WS_OF));
    float xr = 0.f, xi = 0.f;
    for (int n = 0; n < MA; ++n) {
        const int r = scan_row(n, dn);
        const u32x4 u0 = *(const u32x4*)(XN + (size_t)r * D + g * 16), u1 = *(const u32x4*)(XN + (size_t)r * D + g * 16 + 8);
        float u[16];
#pragma unroll
        for (int j = 0; j < 4; ++j) { u[2 * j] = bflo(u0[j]); u[2 * j + 1] = bfhi(u0[j]); u[8 + 2 * j] = bflo(u1[j]); u[8 + 2 * j + 1] = bfhi(u1[j]); }
        float br = 0.f, bi = 0.f;
#pragma unroll
        for (int h = 0; h < 16; ++h) { br += bbr[h] * u[h]; bi += bbi[h] * u[h]; }
        const float nr = abr * xr - abi * xi + br, ni = abr * xi + abi * xr + bi;
        xr = nr; xi = ni;
        float y[16];
#pragma unroll
        for (int h = 0; h < 16; ++h) y[h] = cr[h] * xr - ci[h] * xi;
        const float tot = reduce16(y, lane);
        if ((lane & 3) == 0) Y[(size_t)r * D + g * 16 + (lane >> 2)] = (bf16_t)f2bf(tot);
    }
}
DEVI void ph_s5_elem(const P& p) {
    const int wave = threadIdx.x >> 6, lane = threadIdx.x & 63, gw = blockIdx.x * NWV + wave, NGW = gridDim.x * NWV;
    Row16 dd; load_row_f32(p.in[I_S5D], lane, dd);
    for (int r = gw; r < MA; r += NGW) {
        Row16 u, a, b, o;
        load_row_bf16((const bf16_t*)(p.ws + WS_XN) + (size_t)r * D, lane, u);
        load_row_bf16((const bf16_t*)(p.ws + WS_OF) + (size_t)r * D, lane, a); load_row_bf16((const bf16_t*)(p.ws + WS_OB) + (size_t)r * D, lane, b);
#pragma unroll
        for (int e = 0; e < 16; ++e) o.v[e] = geluf_(dd.v[e] * u.v[e] + a.v[e] + b.v[e]);
        store_row_bf16((bf16_t*)(p.ws + WS_U) + (size_t)r * D, lane, o);
    }
}
DEVI void ph_glu_res(const P& p, int layer, int r0) {
    const int wave = threadIdx.x >> 6, lane = threadIdx.x & 63, gw = blockIdx.x * NWV + wave, NGW = gridDim.x * NWV;
    for (int r = r0 + gw; r < MA; r += NGW) {
        Row16 val, gt, x, g1;
        load_row_bf16((const bf16_t*)(p.ws + WS_G) + (size_t)r * 2048, lane, val); load_row_bf16((const bf16_t*)(p.ws + WS_G) + (size_t)r * 2048 + 1024, lane, gt);
        float* xr = (float*)(p.ws + WS_X) + (size_t)r * D; load_row_f32(xr, lane, x); load_row_f32(mod_ptr(p, layer, row_cls(r), 2), lane, g1);
#pragma unroll
        for (int e = 0; e < 16; ++e) x.v[e] += g1.v[e] * val.v[e] * sigmoidf_(gt.v[e]);
        store_row_f32(xr, lane, x);
    }
}

DEVI unsigned score_key(float s, int e) { unsigned u = __float_as_uint(s); u ^= (u >> 31) ? 0xffffffffu : 0x80000000u; return (u & 0xffffff80u) | (unsigned)e; }
DEVI float key_score(unsigned k) { unsigned u = k & 0xffffff80u; u = (u & 0x80000000u) ? (u ^ 0x80000000u) : ~u; return __uint_as_float(u); }
DEVI void top16_of_128(const float* s, unsigned (&L)[16]) {
#pragma unroll
    for (int j = 0; j < 16; ++j) L[j] = 0u;
#pragma unroll 2
    for (int q = 0; q < 32; ++q) {
        const f32x4 v = *(const f32x4*)(s + 4 * q);
#pragma unroll
        for (int e = 0; e < 4; ++e) {
            unsigned x = score_key(v[e], 4 * q + e);
#pragma unroll
            for (int j = 0; j < 16; ++j) { const unsigned hi = max(L[j], x), lo = min(L[j], x); L[j] = hi; x = lo; }
        }
    }
}
DEVI void ph_topk(const P& p, int r0) {
    const int nitems = (MA - r0) * 8;
    const float* SC = (const float*)(p.ws + WS_SC);
    for (int it = blockIdx.x * NTHR + threadIdx.x; it < nitems; it += gridDim.x * NTHR) {
        const int r = r0 + (it >> 3), h = it & 7;
        const float* s = SC + (size_t)r * 2048 + h * 256;
        unsigned L0[16], L1[16];
        top16_of_128(s, L0); top16_of_128(s + 128, L1);
        float a[16], b[16];
#pragma unroll
        for (int j = 0; j < 16; ++j) { a[j] = key_score(L0[j]); b[j] = key_score(L1[j]); }
        float fs[16]; int fi[16];
#pragma unroll
        for (int j = 0; j < 16; ++j) { fs[j] = -3.0e38f; fi[j] = 0; }
#pragma unroll
        for (int i = 0; i < 16; ++i)
#pragma unroll
            for (int j = 0; j < 16; ++j)
                if ((i + 1) * (j + 1) <= 16) {
                    float x = a[i] + b[j]; int xi = (int)(L0[i] & 127u) * 128 + (int)(L1[j] & 127u);
#pragma unroll
                    for (int q = 0; q < 16; ++q) if (q >= (i + 1) * (j + 1) - 1) { const bool gt = x > fs[q]; const float tv = gt ? fs[q] : x; const int ti = gt ? fi[q] : xi; fs[q] = gt ? x : fs[q]; fi[q] = gt ? xi : fi[q]; x = tv; xi = ti; }
                }
        float sum = 0.f, e[16];
#pragma unroll
        for (int j = 0; j < 16; ++j) { e[j] = __expf(fs[j] - fs[0]); sum += e[j]; }
        const float inv = 1.0f / sum;
        i32x4* oi = (i32x4*)((int*)(p.ws + WS_SELI) + (size_t)r * 128 + h * 16); f32x4* og = (f32x4*)((float*)(p.ws + WS_SELG) + (size_t)r * 128 + h * 16);
#pragma unroll
        for (int j = 0; j < 4; ++j) { oi[j] = (i32x4){fi[4 * j], fi[4 * j + 1], fi[4 * j + 2], fi[4 * j + 3]}; og[j] = (f32x4){e[4 * j] * inv, e[4 * j + 1] * inv, e[4 * j + 2] * inv, e[4 * j + 3] * inv}; }
    }
}

DEVI void ph_gather(const P& p, int layer, int r0, int next_mode) {
    const int wave = threadIdx.x >> 6, lane = threadIdx.x & 63, gw = blockIdx.x * NWV + wave, NGW = gridDim.x * NWV;
    const bf16_t* PU = (const bf16_t*)(p.ws + WS_PU) + (size_t)layer * 16384 * 1024;
    const bf16_t* PV = (const bf16_t*)(p.ws + WS_PV) + (size_t)layer * 16384 * 1024;
    for (int r = r0 + gw; r < MA; r += NGW) {
        bf16_t* xn = (bf16_t*)(p.ws + WS_XN) + (size_t)r * D;
        const u32x4 ha = *(const u32x4*)(xn + 8 * lane), hb = *(const u32x4*)(xn + 512 + 8 * lane);
        const int* si = (const int*)(p.ws + WS_SELI) + (size_t)r * 128; const float* sg = (const float*)(p.ws + WS_SELG) + (size_t)r * 128;
        const int i0 = si[lane], i1 = si[64 + lane]; const float g0 = sg[lane], g1 = sg[64 + lane];
        float acc[16];
#pragma unroll
        for (int j = 0; j < 16; ++j) acc[j] = 0.f;
        for (int b = 0; b < 8; ++b) {
            float pd[16];
#pragma unroll
            for (int e = 0; e < 16; ++e) {
                const int src = (b * 16 + e) & 63; const int iv = (b < 4) ? i0 : i1;
                const int idx = __builtin_amdgcn_readlane(iv, src);
                const bf16_t* ur = PU + (size_t)idx * 1024;
                const u32x4 ua = *(const u32x4*)(ur + 8 * lane), ub = *(const u32x4*)(ur + 512 + 8 * lane);
                float d = 0.f;
#pragma unroll
                for (int j = 0; j < 4; ++j) { d = dot2bf(ua[j], ha[j], d); d = dot2bf(ub[j], hb[j], d); }
                pd[e] = d;
            }
            const float pre = reduce16(pd, lane);
            const float gsel = (b < 4) ? g0 : g1;
            const float gate = __shfl(gsel, ((b * 16) & 63) + ((lane >> 2) & 15));
            const float w = geluf_(pre) * gate;
#pragma unroll
            for (int e = 0; e < 16; ++e) {
                const int src = (b * 16 + e) & 63; const int iv = (b < 4) ? i0 : i1;
                const int idx = __builtin_amdgcn_readlane(iv, src);
                const float we = __uint_as_float(__builtin_amdgcn_readlane(__float_as_uint(w), e * 4));
                const bf16_t* vr = PV + (size_t)idx * 1024;
                const u32x4 va = *(const u32x4*)(vr + 8 * lane), vb = *(const u32x4*)(vr + 512 + 8 * lane);
#pragma unroll
                for (int j = 0; j < 4; ++j) { acc[2 * j] += we * bflo(va[j]); acc[2 * j + 1] += we * bfhi(va[j]); acc[8 + 2 * j] += we * bflo(vb[j]); acc[8 + 2 * j + 1] += we * bfhi(vb[j]); }
            }
        }
        const int cls = row_cls(r);
        float* xr = (float*)(p.ws + WS_X) + (size_t)r * D;
        Row16 x, g2; load_row_f32(xr, lane, x); load_row_f32(mod_ptr(p, layer, cls, 5), lane, g2);
#pragma unroll
        for (int j = 0; j < 16; ++j) x.v[j] += g2.v[j] * acc[j];
        if (next_mode == 0) {
            store_row_f32(xr, lane, x);
            Row16 o; norm_mod(x, p.in[I_N1G] + (layer + 1) * D, mod_ptr(p, layer + 1, cls, 0), mod_ptr(p, layer + 1, cls, 1), lane, o);
            store_row_bf16(xn, lane, o);
        } else if (next_mode == 1) {
            if (r >= TC) {
                float ss = 0.f;
#pragma unroll
                for (int j = 0; j < 16; ++j) ss += x.v[j] * x.v[j];
                ss = wave_sum(ss); const float rstd = rsqrtf(ss * (1.0f / D) + EPS);
                Row16 fg, o; load_row_f32(p.in[I_FG], lane, fg);
#pragma unroll
                for (int j = 0; j < 16; ++j) o.v[j] = x.v[j] * rstd * fg.v[j];
                store_row_f32(p.out + (size_t)(r - TC) * D, lane, o);
            }
        } else store_row_f32(xr, lane, x);
    }
}

enum { PH_P0A = 0, PH_P0B, PH_P0C, PH_P0D, PH_INIT, PH_GEMM_IN, PH_MIX1, PH_MIX2, PH_MIX3, PH_GEMM_OUT, PH_GLU_RES, PH_NORM2, PH_SCORES, PH_TOPK, PH_GATHER };

__global__ void __launch_bounds__(NTHR, 2) k_phase(P p) {
    extern __shared__ __attribute__((aligned(16))) unsigned char lds[];
    const int layer = p.arg, kind = layer % 3, jj = layer / 3;
    const int r0 = (layer >= 2) ? TC : 0;
    bf16_t* WT = (bf16_t*)(p.ws + WS_WT);
    switch (p.ph) {
    case PH_P0A: ph_ada(p, lds); ph_lb(p); ph_s5disc(p); break;
    case PH_P0B: ph_transposes(p, lds); break;
    case PH_P0C: ph_tables(p); break;
    case PH_P0D: ph_fold(p, lds); break;
    case PH_INIT: ph_init_norm(p); break;
    case PH_GEMM_IN:
        if (kind == 0) { EpiStoreBf16 e{(bf16_t*)(p.ws + WS_G), 3072}; gemm_naive((const bf16_t*)(p.ws + WS_XN), D, WT + WT_CIN / 2 + (size_t)jj * 3072 * 1024, D, r0, MA, 3072, D, e, lds); }
        else if (kind == 1) { EpiStoreBf16 e{(bf16_t*)(p.ws + WS_G), 5120}; gemm_naive((const bf16_t*)(p.ws + WS_XN), D, WT + WT_HIN / 2, D, 0, MA, 5120, D, e, lds); }
        break;
    case PH_MIX1:
        if (kind == 0) ph_conv(p, jj, r0); else if (kind == 1) ph_hgrn_naive(p, lds); else ph_s5_naive(p);
        break;
    case PH_MIX2:
        if (kind == 1) ph_hgrn_readout(p); else if (kind == 2) ph_s5_elem(p);
        break;
    case PH_GEMM_OUT:
        if (kind == 0) { EpiResidual e{(float*)(p.ws + WS_X), mod_ptr(p, layer, 0, 2), mod_ptr(p, layer, 1, 2)}; gemm_naive((const bf16_t*)(p.ws + WS_U), D, WT + WT_COUT / 2 + (size_t)jj * 1024 * 1024, D, r0, MA, 1024, D, e, lds); }
        else if (kind == 1) { EpiResidual e{(float*)(p.ws + WS_X), mod_ptr(p, layer, 0, 2), mod_ptr(p, layer, 1, 2)}; gemm_naive((const bf16_t*)(p.ws + WS_U), D, WT + WT_HOUT / 2, D, 0, MA, 1024, D, e, lds); }
        else { EpiStoreBf16 e{(bf16_t*)(p.ws + WS_G), 2048}; gemm_naive((const bf16_t*)(p.ws + WS_U), D, WT + WT_GLU / 2, D, TC, MA, 2048, D, e, lds); }
        break;
    case PH_GLU_RES: ph_glu_res(p, layer, TC); break;
    case PH_NORM2: ph_norm2(p, layer, r0); break;
    case PH_SCORES: { EpiStoreF32 e{(float*)(p.ws + WS_SC), 2048}; gemm_naive((const bf16_t*)(p.ws + WS_XN), D, (const bf16_t*)(p.ws + WS_WQK) + (size_t)layer * 2048 * 1024, D, r0, MA, 2048, D, e, lds); } break;
    case PH_TOPK: ph_topk(p, r0); break;
    case PH_GATHER: ph_gather(p, layer, r0, layer == 3 ? 1 : 0); break;
    }
}

extern "C" void kernel_launch(void* const* d_in, const int* in_sizes, int n_in, void* d_out, int out_size, void* d_ws, size_t ws_size, hipStream_t stream) {
    static int grid = 0;
    if (grid == 0) {
        if (n_in != N_IN || out_size != T * D || ws_size < WS_END) { fprintf(stderr, "kernel_launch: unexpected shapes n_in %d out %d ws %zu\n", n_in, out_size, ws_size); grid = -1; return; }
        int dev = 0, cus = 0;
        if (hipGetDevice(&dev) != hipSuccess || hipDeviceGetAttribute(&cus, hipDeviceAttributeMultiprocessorCount, dev) != hipSuccess) { grid = -1; return; }
        if (hipFuncSetAttribute((const void*)k_phase, hipFuncAttributeMaxDynamicSharedMemorySize, LDS_BYTES) != hipSuccess) { fprintf(stderr, "kernel_launch: hipFuncSetAttribute failed\n"); grid = -1; return; }
        grid = cus;
    }
    if (grid < 0) return;
    P p{};
    for (int i = 0; i < N_IN; ++i) p.in[i] = (const float*)d_in[i];
    p.out = (float*)d_out; p.ws = (unsigned char*)d_ws;
    auto launch = [&](int ph, int arg) { p.ph = ph; p.arg = arg; hipLaunchKernelGGL(k_phase, dim3(grid), dim3(NTHR), LDS_BYTES, stream, p); };
    launch(PH_P0A, 0); launch(PH_P0B, 0); launch(PH_P0C, 0); launch(PH_P0D, 0); launch(PH_INIT, 0);
    for (int layer = 0; layer < DEPTH; ++layer) {
        const int kind = layer % 3;
        if (kind != 2) launch(PH_GEMM_IN, layer);
        launch(PH_MIX1, layer);
        if (kind != 0) launch(PH_MIX2, layer);
        launch(PH_GEMM_OUT, layer);
        if (kind == 2) launch(PH_GLU_RES, layer);
        launch(PH_NORM2, layer); launch(PH_SCORES, layer); launch(PH_TOPK, layer); launch(PH_GATHER, layer);
    }
}
```

```cpp
#include <hip/hip_runtime.h>
#include <cstdint>
#include <cstdio>

#define DEVI __device__ __forceinline__
#define LAS __attribute__((address_space(3)))
typedef unsigned short bf16_t;
typedef float f32x4 __attribute__((ext_vector_type(4)));
typedef unsigned u32x4 __attribute__((ext_vector_type(4)));
typedef unsigned u32x2 __attribute__((ext_vector_type(2)));
typedef int i32x4 __attribute__((ext_vector_type(4)));
typedef __bf16 bf16x2_t __attribute__((ext_vector_type(2)));

constexpr int D = 1024, T = 16384, TC = 256, MA = T + TC, DEPTH = 4;
constexpr int NTHR = 512, NWV = 8;
constexpr float EPS = 1e-6f;

constexpr size_t MiB = 1u << 20;
constexpr size_t WS_CTL = 0;
constexpr size_t WS_MOD = 1 * MiB;
constexpr size_t WS_LB = WS_MOD + 256 * 1024;
constexpr size_t WS_S5A = 2 * MiB;
constexpr size_t WS_S5B = 3 * MiB;
constexpr size_t WS_X = 8 * MiB;
constexpr size_t WS_XN = 73 * MiB;
constexpr size_t WS_U = 106 * MiB;
constexpr size_t WS_OF = 139 * MiB;
constexpr size_t WS_OB = 172 * MiB;
constexpr size_t WS_G = 205 * MiB;
constexpr size_t WS_SC = 368 * MiB;
constexpr size_t WS_SELI = 498 * MiB;
constexpr size_t WS_SELG = 507 * MiB;
constexpr size_t WS_WQK = 516 * MiB;
constexpr size_t WS_WT = 532 * MiB;
constexpr size_t WT_CIN = 0, WT_COUT = 12 * MiB, WT_HIN = 16 * MiB, WT_HOUT = 26 * MiB, WT_GLU = 28 * MiB;
constexpr size_t WS_PU = 564 * MiB;
constexpr size_t WS_PV = 628 * MiB;
constexpr size_t WS_SCL = 692 * MiB;
constexpr size_t WS_H8 = 770 * MiB;
constexpr size_t WS_HS = 788 * MiB;
constexpr size_t WS_SCH = 704 * MiB;
constexpr size_t WS_SELU = 694 * MiB;
constexpr size_t WS_XE = 820 * MiB;
constexpr size_t WS_END = 822 * MiB;

constexpr int LDS_BYTES = 147456;

enum { I_X = 0, I_C, I_CTX, I_CCTX, I_ADAW, I_ADAB, I_N1G, I_N2G, I_CWIN, I_CK, I_CWOUT, I_HWIN, I_HLB, I_HNG, I_HWOUT,
       I_S5LR, I_S5LI, I_S5LS, I_S5BR, I_S5BI, I_S5CR, I_S5CI, I_S5D, I_S5GLU, I_PWQ, I_PKEYS, I_PU, I_PV, I_FG, N_IN };

struct P {
    const float* in[N_IN];
    float* out;
    unsigned char* ws;
    int ph, arg;
};

DEVI unsigned f2bf(float f) { unsigned u = __float_as_uint(f); return (u + 0x7fffu + ((u >> 16) & 1u)) >> 16; }
typedef float f32x2_t __attribute__((ext_vector_type(2)));
DEVI unsigned pk2(float lo, float hi) { f32x2_t f = {lo, hi}; return __builtin_bit_cast(unsigned, __builtin_convertvector(f, bf16x2_t)); }
DEVI float bflo(unsigned w) { return __uint_as_float(w << 16); }
DEVI float bfhi(unsigned w) { return __uint_as_float(w & 0xffff0000u); }
DEVI float bf2f(bf16_t b) { return __uint_as_float((unsigned)b << 16); }
DEVI float sigmoidf_(float x) { return 1.0f / (1.0f + __expf(-x)); }
DEVI float siluf_(float x) { return x * sigmoidf_(x); }
DEVI float geluf_(float x) { return 0.5f * x * (1.0f + erff(x * 0.70710678118654752f)); }
DEVI float dot2bf(unsigned a, unsigned b, float c) { return __builtin_amdgcn_fdot2_f32_bf16(__builtin_bit_cast(bf16x2_t, a), __builtin_bit_cast(bf16x2_t, b), c, false); }
DEVI int otid() { int t = threadIdx.x; asm volatile("" : "+v"(t)); return t; }
template <int CTRL> DEVI float dpp_mov_f(float v) { return __uint_as_float(__builtin_amdgcn_update_dpp(0u, __float_as_uint(v), CTRL, 0xf, 0xf, true)); }
DEVI void rows_swap16(float& a, float& b) { const auto r = __builtin_amdgcn_permlane16_swap(__float_as_uint(a), __float_as_uint(b), false, false); a = __uint_as_float(r[0]); b = __uint_as_float(r[1]); }
DEVI void rows_swap32(float& a, float& b) { const auto r = __builtin_amdgcn_permlane32_swap(__float_as_uint(a), __float_as_uint(b), false, false); a = __uint_as_float(r[0]); b = __uint_as_float(r[1]); }
DEVI float wave_sum(float v) {
    v += dpp_mov_f<0xB1>(v); v += dpp_mov_f<0x4E>(v); v += dpp_mov_f<0x141>(v); v += dpp_mov_f<0x140>(v);
    { float a = v, b = v; rows_swap16(a, b); v = a + b; }
    { float a = v, b = v; rows_swap32(a, b); v = a + b; }
    return v;
}
DEVI float wave_max_f(float v) {
    v = __builtin_fmaxf(v, dpp_mov_f<0xB1>(v)); v = __builtin_fmaxf(v, dpp_mov_f<0x4E>(v)); v = __builtin_fmaxf(v, dpp_mov_f<0x141>(v)); v = __builtin_fmaxf(v, dpp_mov_f<0x140>(v));
    { float a = v, b = v; rows_swap16(a, b); v = __builtin_fmaxf(a, b); }
    { float a = v, b = v; rows_swap32(a, b); v = __builtin_fmaxf(a, b); }
    return v;
}
DEVI float row16_sum(float v) { v += dpp_mov_f<0xB1>(v); v += dpp_mov_f<0x4E>(v); v += dpp_mov_f<0x141>(v); v += dpp_mov_f<0x140>(v); return v; }
DEVI unsigned pk4_i8(float a, float b, float c, float d) {
    const int ia = (int)__builtin_rintf(a), ib = (int)__builtin_rintf(b), ic = (int)__builtin_rintf(c), id = (int)__builtin_rintf(d);
    return (unsigned)(ia & 255) | ((unsigned)(ib & 255) << 8) | ((unsigned)(ic & 255) << 16) | ((unsigned)id << 24);
}
DEVI int row_cls(int r) { return r < TC ? 1 : 0; }
DEVI const float* mod_ptr(const P& p, int layer, int cls, int chunk) { return (const float*)(p.ws + WS_MOD) + ((size_t)(layer * 2 + cls) * 6 + chunk) * D; }

struct Row16 { float v[16]; };
DEVI void load_row_f32(const float* row, int lane, Row16& o) {
    const f32x4* a = (const f32x4*)(row + 8 * lane); const f32x4* b = (const f32x4*)(row + 512 + 8 * lane);
    f32x4 a0 = a[0], a1 = a[1], b0 = b[0], b1 = b[1];
#pragma unroll
    for (int j = 0; j < 4; ++j) { o.v[j] = a0[j]; o.v[4 + j] = a1[j]; o.v[8 + j] = b0[j]; o.v[12 + j] = b1[j]; }
}
DEVI void store_row_f32(float* row, int lane, const Row16& o) {
    f32x4* a = (f32x4*)(row + 8 * lane); f32x4* b = (f32x4*)(row + 512 + 8 * lane);
    a[0] = (f32x4){o.v[0], o.v[1], o.v[2], o.v[3]}; a[1] = (f32x4){o.v[4], o.v[5], o.v[6], o.v[7]};
    b[0] = (f32x4){o.v[8], o.v[9], o.v[10], o.v[11]}; b[1] = (f32x4){o.v[12], o.v[13], o.v[14], o.v[15]};
}
DEVI void load_row_bf16(const bf16_t* row, int lane, Row16& o) {
    const u32x4 a = *(const u32x4*)(row + 8 * lane), b = *(const u32x4*)(row + 512 + 8 * lane);
#pragma unroll
    for (int j = 0; j < 4; ++j) { o.v[2 * j] = bflo(a[j]); o.v[2 * j + 1] = bfhi(a[j]); o.v[8 + 2 * j] = bflo(b[j]); o.v[8 + 2 * j + 1] = bfhi(b[j]); }
}
DEVI void store_row_bf16(bf16_t* row, int lane, const Row16& o) {
    u32x4 a, b;
#pragma unroll
    for (int j = 0; j < 4; ++j) { a[j] = pk2(o.v[2 * j], o.v[2 * j + 1]); b[j] = pk2(o.v[8 + 2 * j], o.v[8 + 2 * j + 1]); }
    *(u32x4*)(row + 8 * lane) = a; *(u32x4*)(row + 512 + 8 * lane) = b;
}
DEVI void norm_mod(const Row16& x, const float* g, const float* shift, const float* scale, int lane, Row16& o) {
    float ss = 0.f;
#pragma unroll
    for (int j = 0; j < 16; ++j) ss += x.v[j] * x.v[j];
    ss = wave_sum(ss);
    const float rstd = rsqrtf(ss * (1.0f / D) + EPS);
    Row16 gg, sh, sc; load_row_f32(g, lane, gg); load_row_f32(shift, lane, sh); load_row_f32(scale, lane, sc);
#pragma unroll
    for (int j = 0; j < 16; ++j) o.v[j] = x.v[j] * rstd * gg.v[j] * (1.0f + sc.v[j]) + sh.v[j];
}

DEVI void ph_ada(const P& p, unsigned char* lds) {
    const int otid_ = otid();
    float* sc = (float*)lds;
    float* red = sc + 2048;
    const int tid = otid_;
    for (int k = tid; k < 1024; k += NTHR) { sc[k] = siluf_(p.in[I_C][k]); sc[1024 + k] = siluf_(p.in[I_CCTX][k]); }
    __syncthreads();
    const int kg = tid >> 3, cl = tid & 7;
    for (int item = blockIdx.x; item < 4 * 192; item += gridDim.x) {
        const int i = item / 192, n0 = (item % 192) * 32 + cl * 4;
        const float* w = p.in[I_ADAW] + (size_t)i * 1024 * 6144 + n0 + (size_t)kg * 6144;
        f32x4 wv[16];
#pragma unroll
        for (int m = 0; m < 16; ++m) wv[m] = *(const f32x4*)(w + (size_t)m * 64 * 6144);
        f32x4 a0 = {0, 0, 0, 0}, a1 = {0, 0, 0, 0};
#pragma unroll
        for (int m = 0; m < 16; ++m) { a0 += wv[m] * sc[kg + 64 * m]; a1 += wv[m] * sc[1024 + kg + 64 * m]; }
        float* r = red + (kg * 8 + cl) * 8;
#pragma unroll
        for (int j = 0; j < 4; ++j) { r[j] = a0[j]; r[4 + j] = a1[j]; }
        __syncthreads();
        if (tid < 64) {
            const int c2 = tid >> 3, j = tid & 7; float s_ = 0.f;
            for (int g = 0; g < 64; ++g) s_ += red[(g * 8 + c2) * 8 + j];
            const int cls = j >> 2, n = (item % 192) * 32 + c2 * 4 + (j & 3);
            ((float*)(p.ws + WS_MOD))[(size_t)(i * 2 + cls) * 6144 + n] = s_ + p.in[I_ADAB][i * 6144 + n];
        }
        __syncthreads();
    }
}
DEVI void ph_lb(const P& p) {
    const int otid_ = otid();
    const int gt = blockIdx.x * NTHR + otid_;
    if (gt < 2048) {
        const float* l = p.in[I_HLB];
        float m = -1e30f; for (int i = 0; i < 4; ++i) m = fmaxf(m, l[i * 2048 + gt]);
        float s = 0.f; for (int i = 0; i < 4; ++i) s += expf(l[i * 2048 + gt] - m);
        ((float*)(p.ws + WS_LB))[gt] = expf(l[2048 + gt] - m) / s;
    }
}
DEVI void ph_s5disc(const P& p) {
    const int otid_ = otid();
    const int gt = blockIdx.x * NTHR + otid_;
    if (gt < 2 * 64 * 64) {
        const int dn = gt >> 12, g = (gt >> 6) & 63, pp = gt & 63;
        const float step = expf(p.in[I_S5LS][dn * 64 + g]);
        const float lr = fminf(p.in[I_S5LR][gt], -1e-4f), li = p.in[I_S5LI][gt];
        const float ar = step * lr, ai = step * li, mag = expf(ar);
        float sn, cs; sincosf(ai, &sn, &cs);
        const float abr = mag * cs, abi = mag * sn, den = lr * lr + li * li;
        const float fr = ((abr - 1.0f) * lr + abi * li) / den, fi = (abi * lr - (abr - 1.0f) * li) / den;
        float* A = (float*)(p.ws + WS_S5A) + (size_t)gt * 2; A[0] = abr; A[1] = abi;
        float* B = (float*)(p.ws + WS_S5B) + (size_t)gt * 32;
        const float* br = p.in[I_S5BR] + (size_t)(g * 64 + pp) * 16; const float* bi = p.in[I_S5BI] + (size_t)(g * 64 + pp) * 16;
        for (int h = 0; h < 16; ++h) { B[h] = fr * br[h] - fi * bi[h]; B[16 + h] = fr * bi[h] + fi * br[h]; }
    }
}
DEVI void transpose_item(const float* W, int K, int N, bf16_t* WT, float* scr, int item, int lane, bool glu_pair = false) {
    const int nblk = N / 32, kb = item / nblk, nb = item % nblk, k0 = 64 * kb, n0 = 32 * nb;
#pragma unroll 8
    for (int i = 0; i < 32; ++i) { const int kk = 2 * i + (lane >> 5); scr[kk * 33 + (lane & 31)] = W[(size_t)(k0 + kk) * N + n0 + (lane & 31)]; }
    __builtin_amdgcn_s_waitcnt(0); asm volatile("" ::: "memory");
    const int c = lane & 7;
#pragma unroll
    for (int j = 0; j < 4; ++j) { const int n = (lane >> 3) + 8 * j; const float* s = scr + (8 * c) * 33 + n;
        u32x4 o; o.x = pk2(s[0 * 33], s[1 * 33]); o.y = pk2(s[2 * 33], s[3 * 33]); o.z = pk2(s[4 * 33], s[5 * 33]); o.w = pk2(s[6 * 33], s[7 * 33]);
        const int dn = glu_pair ? (((n0 & 1023) >> 7) * 256 + (n0 >> 10) * 128 + (n0 & 127)) : n0;
        *(u32x4*)(WT + (size_t)(dn + n) * K + k0 + 8 * c) = o; }
    __builtin_amdgcn_s_waitcnt(0); asm volatile("" ::: "memory");
}
DEVI void ph_transposes(const P& p, unsigned char* lds) {
    const int otid_ = otid();
    const int wave = otid_ >> 6, lane = otid_ & 63;
    float* scr = (float*)lds + wave * (64 * 33);
    const int gw = blockIdx.x * NWV + wave, NGW = gridDim.x * NWV;
    bf16_t* WT = (bf16_t*)(p.ws + WS_WT);
    constexpr int I_A = (1024 / 64) * (3072 / 32), I_B = (1024 / 64) * (1024 / 32), I_C5 = (1024 / 64) * (5120 / 32), I_G = (1024 / 64) * (2048 / 32);
    constexpr int NIT = 2 * I_A + 2 * I_B + I_C5 + I_B + I_G;
    for (int it = gw; it < NIT; it += NGW) {
        int r = it;
        if (r < 2 * I_A) { const int j = r / I_A; transpose_item(p.in[I_CWIN] + (size_t)j * 1024 * 3072, 1024, 3072, WT + WT_CIN / 2 + (size_t)j * 3072 * 1024, scr, r % I_A, lane); continue; } r -= 2 * I_A;
        if (r < 2 * I_B) { const int j = r / I_B; transpose_item(p.in[I_CWOUT] + (size_t)j * 1024 * 1024, 1024, 1024, WT + WT_COUT / 2 + (size_t)j * 1024 * 1024, scr, r % I_B, lane); continue; } r -= 2 * I_B;
        if (r < I_C5) { transpose_item(p.in[I_HWIN], 1024, 5120, WT + WT_HIN / 2, scr, r, lane); continue; } r -= I_C5;
        if (r < I_B) { transpose_item(p.in[I_HWOUT], 1024, 1024, WT + WT_HOUT / 2, scr, r, lane); continue; } r -= I_B;
        transpose_item(p.in[I_S5GLU], 1024, 2048, WT + WT_GLU / 2, scr, r, lane, true);
    }
}
DEVI void ph_tables(const P& p) {
    const int otid_ = otid();
    const int wave = otid_ >> 6, lane = otid_ & 63, gw = blockIdx.x * NWV + wave, NGW = gridDim.x * NWV;
    float* SCL = (float*)(p.ws + WS_SCL);
    for (int row = gw; row < 2 * 4 * 16384; row += NGW) {
        const int w = row >> 16, rr = row & 65535;
        const f32x4* src = (const f32x4*)(p.in[w ? I_PV : I_PU] + (size_t)rr * 1024 + 16 * lane);
        const f32x4 a0 = src[0], a1 = src[1], a2 = src[2], a3 = src[3];
        float m = 0.f;
#pragma unroll
        for (int j = 0; j < 4; ++j) m = fmaxf(fmaxf(m, fmaxf(fabsf(a0[j]), fabsf(a1[j]))), fmaxf(fabsf(a2[j]), fabsf(a3[j])));
        m = wave_max_f(m);
        const float qmax = w ? 224.0f : 127.0f;
        const float sc = m > 0.f ? qmax / m : 1.0f;
        u32x4 q;
        if (w) {
            { unsigned t = 0; t = __builtin_amdgcn_cvt_pk_fp8_f32(a0[0] * sc, a0[1] * sc, t, false); t = __builtin_amdgcn_cvt_pk_fp8_f32(a0[2] * sc, a0[3] * sc, t, true); q[0] = t; }
            { unsigned t = 0; t = __builtin_amdgcn_cvt_pk_fp8_f32(a1[0] * sc, a1[1] * sc, t, false); t = __builtin_amdgcn_cvt_pk_fp8_f32(a1[2] * sc, a1[3] * sc, t, true); q[1] = t; }
            { unsigned t = 0; t = __builtin_amdgcn_cvt_pk_fp8_f32(a2[0] * sc, a2[1] * sc, t, false); t = __builtin_amdgcn_cvt_pk_fp8_f32(a2[2] * sc, a2[3] * sc, t, true); q[2] = t; }
            { unsigned t = 0; t = __builtin_amdgcn_cvt_pk_fp8_f32(a3[0] * sc, a3[1] * sc, t, false); t = __builtin_amdgcn_cvt_pk_fp8_f32(a3[2] * sc, a3[3] * sc, t, true); q[3] = t; }
        } else {
            q[0] = pk4_i8(a0[0] * sc, a0[1] * sc, a0[2] * sc, a0[3] * sc); q[1] = pk4_i8(a1[0] * sc, a1[1] * sc, a1[2] * sc, a1[3] * sc);
            q[2] = pk4_i8(a2[0] * sc, a2[1] * sc, a2[2] * sc, a2[3] * sc); q[3] = pk4_i8(a3[0] * sc, a3[1] * sc, a3[2] * sc, a3[3] * sc);
        }
        *(u32x4*)(p.ws + (w ? WS_PV : WS_PU) + (size_t)(rr >> 14) * (16384 * 1024) + (size_t)(lane >> 3) * (16384 * 128) + (size_t)(rr & 16383) * 128 + 16 * (lane & 7)) = q;
        if (lane == 0) SCL[2 * rr + w] = m > 0.f ? m / qmax : 1.0f;
    }
}
DEVI void ph_fold(const P& p) {
    const int otid_ = otid();
    const int wave = otid_ >> 6, lane = otid_ & 63, c = lane & 15, q4 = lane >> 4, gw = blockIdx.x * NWV + wave, NGW = gridDim.x * NWV;
    for (int item = gw; item < 4 * 16 * 8 * 4; item += NGW) {
        const int i = item >> 9, hc = (item >> 5) & 15, kt = (item >> 2) & 7, kq = item & 3;
        const float* ky = p.in[I_PKEYS] + (((size_t)i * 16 + hc) * 128 + 16 * kt + c) * 128 + 4 * q4;
        f32x4 kf[8];
#pragma unroll
        for (int s8 = 0; s8 < 8; ++s8) kf[s8] = *(const f32x4*)(ky + 16 * s8);
        bf16_t* out = (bf16_t*)(p.ws + WS_WQK) + ((size_t)i * 2048 + hc * 128 + 16 * kt + c) * 1024 + 4 * q4;
#pragma unroll 1
        for (int tt = 0; tt < 16; ++tt) {
            const int k1 = (kq * 16 + tt) * 16;
            const float* wq = p.in[I_PWQ] + ((size_t)i * 1024 + k1 + c) * 2048 + hc * 128 + 4 * q4;
            f32x4 wf[8];
#pragma unroll
            for (int s8 = 0; s8 < 8; ++s8) wf[s8] = *(const f32x4*)(wq + 16 * s8);
            f32x4 acc = {0.f, 0.f, 0.f, 0.f};
#pragma unroll
            for (int s8 = 0; s8 < 8; ++s8)
#pragma unroll
                for (int j = 0; j < 4; ++j) acc = __builtin_amdgcn_mfma_f32_16x16x4f32(wf[s8][j], kf[s8][j], acc, 0, 0, 0);
            *(u32x2*)(out + k1) = (u32x2){pk2(acc[0], acc[1]), pk2(acc[2], acc[3])};
        }
    }
}

struct NormAB { Row16 A, B; };
DEVI void normab_load(NormAB& n, const float* g, const float* shift, const float* scale, int lane) {
    Row16 gg, sc; load_row_f32(g, lane, gg); load_row_f32(scale, lane, sc); load_row_f32(shift, lane, n.B);
#pragma unroll
    for (int j = 0; j < 16; ++j) n.A.v[j] = gg.v[j] * (1.0f + sc.v[j]);
}
DEVI void norm_ab(const Row16& x, const NormAB& n, Row16& o) {
    float ss = 0.f;
#pragma unroll
    for (int j = 0; j < 16; ++j) ss += x.v[j] * x.v[j];
    ss = wave_sum(ss);
    const float rstd = rsqrtf(ss * (1.0f / D) + EPS);
#pragma unroll
    for (int j = 0; j < 16; ++j) o.v[j] = x.v[j] * rstd * n.A.v[j] + n.B.v[j];
}
DEVI void ph_init_norm(const P& p) {
    const int otid_ = otid();
    const int wave = __builtin_amdgcn_readfirstlane(otid_ >> 6), lane = otid_ & 63, gw = blockIdx.x * NWV + wave, NGW = gridDim.x * NWV;
    NormAB nl; normab_load(nl, p.in[I_N1G], mod_ptr(p, 0, 0, 0), mod_ptr(p, 0, 0, 1), lane);
    for (int r = gw; r < MA; r += 2 * NGW) {
        const int r1 = r + NGW;
        Row16 x0, x1, o;
        load_row_f32(r < TC ? p.in[I_CTX] + (size_t)r * D : p.in[I_X] + (size_t)(r - TC) * D, lane, x0);
        if (r1 < MA) load_row_f32(p.in[I_X] + (size_t)(r1 - TC) * D, lane, x1);
        NormAB n0 = nl;
        if (r < TC) normab_load(n0, p.in[I_N1G], mod_ptr(p, 0, 1, 0), mod_ptr(p, 0, 1, 1), lane);
        store_row_f32((float*)(p.ws + WS_X) + (size_t)r * D, lane, x0);
        norm_ab(x0, n0, o); store_row_bf16((bf16_t*)(p.ws + WS_XN) + (size_t)r * D, lane, o);
        if (r1 < MA) { store_row_f32((float*)(p.ws + WS_X) + (size_t)r1 * D, lane, x1); norm_ab(x1, nl, o); store_row_bf16((bf16_t*)(p.ws + WS_XN) + (size_t)r1 * D, lane, o); }
    }
}
DEVI void norm2_row(const P& p, int r, int lane, const Row16& x, const NormAB& n) {
    Row16 o; norm_ab(x, n, o);
    store_row_bf16((bf16_t*)(p.ws + WS_XN) + (size_t)r * D, lane, o);
    float m = 0.f;
#pragma unroll
    for (int j = 0; j < 16; ++j) m = fmaxf(m, fabsf(o.v[j]));
    m = wave_max_f(m);
    const float sc = m > 0.f ? 127.0f / m : 1.0f;
    unsigned char* h8 = p.ws + WS_H8 + (size_t)r * D;
    *(u32x2*)(h8 + 8 * lane) = (u32x2){pk4_i8(o.v[0] * sc, o.v[1] * sc, o.v[2] * sc, o.v[3] * sc), pk4_i8(o.v[4] * sc, o.v[5] * sc, o.v[6] * sc, o.v[7] * sc)};
    *(u32x2*)(h8 + 512 + 8 * lane) = (u32x2){pk4_i8(o.v[8] * sc, o.v[9] * sc, o.v[10] * sc, o.v[11] * sc), pk4_i8(o.v[12] * sc, o.v[13] * sc, o.v[14] * sc, o.v[15] * sc)};
    if (lane == 0) ((float*)(p.ws + WS_HS))[r] = m > 0.f ? m / 127.0f : 1.0f;
}
DEVI void ph_norm2(const P& p, int layer, int r0) {
    const int otid_ = otid();
    const int wave = __builtin_amdgcn_readfirstlane(otid_ >> 6), lane = otid_ & 63, gw = blockIdx.x * NWV + wave, NGW = gridDim.x * NWV;
    NormAB nl; normab_load(nl, p.in[I_N2G] + layer * D, mod_ptr(p, layer, 0, 3), mod_ptr(p, layer, 0, 4), lane);
    for (int r = r0 + gw; r < MA; r += 2 * NGW) {
        const int r1 = r + NGW;
        Row16 x0, x1; load_row_f32((const float*)(p.ws + WS_X) + (size_t)r * D, lane, x0);
        if (r1 < MA) load_row_f32((const float*)(p.ws + WS_X) + (size_t)r1 * D, lane, x1);
        NormAB n0 = nl;
        if (r < TC) normab_load(n0, p.in[I_N2G] + layer * D, mod_ptr(p, layer, 1, 3), mod_ptr(p, layer, 1, 4), lane);
        norm2_row(p, r, lane, x0, n0);
        if (r1 < MA) norm2_row(p, r1, lane, x1, nl);
    }
}

namespace pg8 {
#define PG8_LAS __attribute__((address_space(3)))
typedef unsigned short bf16_t;
typedef short bf16x8 __attribute__((ext_vector_type(8)));
typedef float f32x4 __attribute__((ext_vector_type(4)));
typedef unsigned u32x4 __attribute__((ext_vector_type(4)));
constexpr int BM = 256, BK = 64, HALF = 128, HTB = HALF * BK * 2  , STAGE_BYTES = 8 * HTB, NXCD = 8, WGM = 8;

__host__ __device__ __forceinline__ int lds_byte(int r, int c) { const int st = (r >> 4) * 2 + (c >> 5), rr = r & 15, cc = c & 31, ob = rr * 64 + cc * 2; return st * 1024 + (ob ^ (((ob >> 9) & 1) << 5)); }
__host__ __device__ __forceinline__ void stage_rc(int b, int& R, int& C) { const int st = b / 1024, sb = b % 1024, swz = sb ^ (((sb >> 9) & 1) << 5); R = (st >> 1) * 16 + swz / 64; C = (st & 1) * 32 + (swz % 64) / 2; }
__host__ __device__ __forceinline__ int perm32(int rho) { const int n = rho >> 4, i = rho & 15; return 8 * (i >> 2) + 4 * n + (i & 3); }

struct Unit { int pm, pn; };
struct Gemm { const bf16_t* A; const bf16_t* Bt; int M, N, K; };

struct StaticOrder {
    int nM, nN, nwg, G, c;
    __host__ __device__ void init(int M, int N, int G_, int c_) { nM = M / BM; nN = N / BM; nwg = nM * nN; G = G_; c = c_; }
    __host__ __device__ bool next(int i, Unit& u) const {
        const long L = (long)i * G + c; if (L >= nwg) return false;
        int wgid = (int)L; { const int q = nwg / NXCD, r = nwg % NXCD, xcd = wgid % NXCD, off = wgid / NXCD; wgid = (xcd < r ? xcd * (q + 1) : r * (q + 1) + (xcd - r) * q) + off; }
        const int nig = WGM * nN, gid = wgid / nig, fm = gid * WGM, gsz = (nM - fm) < WGM ? (nM - fm) : WGM;
        u.pm = fm + ((wgid % nig) % gsz); u.pn = (wgid % nig) / gsz; return true;
    }
    __device__ __forceinline__ void a_ready(const Unit&) const {}
    __device__ __forceinline__ void done(const Unit&) const {}
};
__device__ __forceinline__ unsigned cvt_pk_bf16(float lo, float hi) { unsigned r; asm volatile("v_cvt_pk_bf16_f32 %0, %1, %2" : "=v"(r) : "v"(lo), "v"(hi)); return r; }

struct EpiBf16 {
    static constexpr bool PERM = true, AFTER_DRAIN = false;
    bf16_t* O; int ldc; int row_base;
    __device__ __forceinline__ void operator()(const f32x4 (&acc)[2][2][4][2], const Unit& u, int wr, int wc, int fr, int fq) const {
        const int row0 = row_base + u.pm * BM + wr * 64 + fr, col0 = u.pn * BM + wc * 32 + 8 * fq;
#pragma unroll
        for (int ai = 0; ai < 2; ++ai)
#pragma unroll
            for (int m = 0; m < 4; ++m) { bf16_t* rowp = O + (size_t)(row0 + ai * HALF + m * 16) * ldc + col0;
#pragma unroll
                for (int bj = 0; bj < 2; ++bj) { const f32x4 v0 = acc[ai][bj][m][0], v1 = acc[ai][bj][m][1];
                    u32x4 w; w.x = ::pk2(v0[0], v0[1]); w.y = ::pk2(v0[2], v0[3]); w.z = ::pk2(v1[0], v1[1]); w.w = ::pk2(v1[2], v1[3]);
                    *(u32x4*)(rowp + bj * HALF) = w; } }
    }
};
struct EpiHgrnIn {
    static constexpr bool PERM = true, AFTER_DRAIN = false;
    bf16_t* O; int ldc; int row_base; const float* lbv;
    __device__ __forceinline__ void operator()(const f32x4 (&acc)[2][2][4][2], const Unit& u, int wr, int wc, int fr, int fq) const {
        const int row0 = row_base + u.pm * BM + wr * 64 + fr, col0 = u.pn * BM + wc * 32 + 8 * fq;
        const int blk = u.pn >> 2;
#pragma unroll
        for (int bj = 0; bj < 2; ++bj) {
            float lb8[8];
#pragma unroll
            for (int j = 0; j < 8; ++j) lb8[j] = (blk == 2 || blk == 3) ? lbv[(blk - 2) * 1024 + ((col0 + bj * HALF) & 1023) + j] : 0.f;
#pragma unroll
            for (int ai = 0; ai < 2; ++ai)
#pragma unroll
                for (int m = 0; m < 4; ++m) { const f32x4 v0 = acc[ai][bj][m][0], v1 = acc[ai][bj][m][1]; float x[8] = {v0[0], v0[1], v0[2], v0[3], v1[0], v1[1], v1[2], v1[3]};
#pragma unroll
                    for (int j = 0; j < 8; ++j) {
                        if (blk == 0 || blk == 4) x[j] = x[j] / (1.0f + __expf(-x[j]));
                        else if (blk == 2 || blk == 3) x[j] = __logf(lb8[j] + (1.0f - lb8[j]) / (1.0f + __expf(-x[j])));
                    }
                    u32x4 w; w.x = ::pk2(x[0], x[1]); w.y = ::pk2(x[2], x[3]); w.z = ::pk2(x[4], x[5]); w.w = ::pk2(x[6], x[7]);
                    *(u32x4*)(O + (size_t)(row0 + ai * HALF + m * 16) * ldc + col0 + bj * HALF) = w; }
        }
    }
};
typedef _Float16 f16x2_t __attribute__((ext_vector_type(2)));
__device__ __forceinline__ unsigned pkh2(float lo, float hi) { ::f32x2_t f = {lo, hi}; return __builtin_bit_cast(unsigned, __builtin_convertvector(f, f16x2_t)); }
struct EpiF16 {
    static constexpr bool PERM = true, AFTER_DRAIN = false;
    unsigned short* O; int ldc; int row_base;
    __device__ __forceinline__ void operator()(const f32x4 (&acc)[2][2][4][2], const Unit& u, int wr, int wc, int fr, int fq) const {
        const int row0 = row_base + u.pm * BM + wr * 64 + fr, col0 = u.pn * BM + wc * 32 + 8 * fq;
#pragma unroll
        for (int ai = 0; ai < 2; ++ai)
#pragma unroll
            for (int m = 0; m < 4; ++m) { unsigned short* rowp = O + (size_t)(row0 + ai * HALF + m * 16) * ldc + col0;
#pragma unroll
                for (int bj = 0; bj < 2; ++bj) { const f32x4 v0 = acc[ai][bj][m][0], v1 = acc[ai][bj][m][1];
                    u32x4 w; w.x = pkh2(v0[0], v0[1]); w.y = pkh2(v0[2], v0[3]); w.z = pkh2(v1[0], v1[1]); w.w = pkh2(v1[2], v1[3]);
                    *(u32x4*)(rowp + bj * HALF) = w; } }
    }
};
struct EpiGluResid {
    static constexpr bool PERM = false, AFTER_DRAIN = false;
    float* X; const float* gate1; int row_base;
    __device__ __forceinline__ void operator()(const f32x4 (&acc)[2][2][4][2], const Unit& u, int wr, int wc, int fr, int fq) const {
        const int row0 = row_base + u.pm * BM + wr * 64 + fr, ch0 = u.pn * HALF + wc * 32 + 4 * fq;
        f32x4 gv[2];
#pragma unroll
        for (int n = 0; n < 2; ++n) gv[n] = *(const f32x4*)(gate1 + ch0 + n * 16);
#pragma unroll
        for (int ai = 0; ai < 2; ++ai)
#pragma unroll
            for (int m = 0; m < 4; ++m) { float* rowp = X + (size_t)(row0 + ai * HALF + m * 16) * 1024 + ch0;
#pragma unroll
                for (int n = 0; n < 2; ++n) { const f32x4 v = acc[ai][0][m][n], g = acc[ai][1][m][n]; f32x4 o;
#pragma unroll
                    for (int j = 0; j < 4; ++j) o[j] = gv[n][j] * v[j] / (1.0f + __expf(-g[j]));
                    f32x4* q = (f32x4*)(rowp + n * 16); *q = *q + o; } }
    }
};
struct EpiResid {
    static constexpr bool PERM = false, AFTER_DRAIN = false;
    float* X; const float* gate_lat; const float* gate_ctx; int row_base; int tc_rows;
    __device__ __forceinline__ void operator()(const f32x4 (&acc)[2][2][4][2], const Unit& u, int wr, int wc, int fr, int fq) const {
        const int row0 = row_base + u.pm * BM + wr * 64 + fr, col0 = u.pn * BM + wc * 32 + 4 * fq;
        const float* gate = (row_base + u.pm * BM) < tc_rows ? gate_ctx : gate_lat;
        f32x4 gv[2][2];
#pragma unroll
        for (int bj = 0; bj < 2; ++bj)
#pragma unroll
            for (int n = 0; n < 2; ++n) gv[bj][n] = *(const f32x4*)(gate + col0 + bj * HALF + n * 16);
#pragma unroll
        for (int ai = 0; ai < 2; ++ai)
#pragma unroll
            for (int m = 0; m < 4; ++m) { float* rowp = X + (size_t)(row0 + ai * HALF + m * 16) * 1024 + col0;
#pragma unroll
                for (int bj = 0; bj < 2; ++bj)
#pragma unroll
                    for (int n = 0; n < 2; ++n) { f32x4* q = (f32x4*)(rowp + bj * HALF + n * 16); *q = *q + gv[bj][n] * acc[ai][bj][m][n]; } }
    }
};

template <class Epi, class Sched, bool ALIGN_EPI = false, bool SP2 = false>
__device__ __forceinline__ void gemm_phase(PG8_LAS unsigned char* lds, const Gemm g, const Sched& S, const Epi& E) {
    const int tid = otid(), wid = __builtin_amdgcn_readfirstlane(tid >> 6), lane = tid & 63, wr = wid >> 2, wc = wid & 3, fr = lane & 15, fq = lane >> 4;
    const int K = g.K, nt = K / BK;
    unsigned voffA[2], voffB[2];
#pragma unroll
    for (int i = 0; i < 2; ++i) { int R, C; stage_rc(tid * 16 + i * 8192, R, C); const int Rb = Epi::PERM ? ((R & ~31) + perm32(R & 31)) : R;
        voffA[i] = (unsigned)(R * K + C) * 2u; voffB[i] = (unsigned)(Rb * K + C) * 2u; }
    const size_t kstep = (size_t)(BK * 2);
    const size_t hstep = (size_t)HALF * K * 2;
    const size_t tstep = 2 * hstep;
    const unsigned ldsw = (unsigned)wid * 1024u;
    const int aoff = lds_byte(wr * 64 + fr, fq * 8), boff = lds_byte(wc * 32 + fr, fq * 8);
#define PG8_SA(b, h) (((b) * 2 + (h)) * HTB)
#define PG8_SB(b, h) ((4 + (b) * 2 + (h)) * HTB)
#define PG8_STAGE(bufoff, gbase, voff) do { _Pragma("unroll") for (int _i = 0; _i < 2; ++_i) \
        __builtin_amdgcn_global_load_lds((const unsigned*)((const char*)(gbase) + (voff)[_i]), (PG8_LAS unsigned*)(lds + (bufoff) + ldsw + _i * 8192), 16, 0, 0); } while (0)
#define PG8_LDA(dst, b, h) do { _Pragma("unroll") for (int m = 0; m < 4; ++m) _Pragma("unroll") for (int k = 0; k < 2; ++k) dst[m][k] = *(const PG8_LAS bf16x8*)(lds + PG8_SA(b, h) + aoff + m * 2048 + k * 1024); } while (0)
#define PG8_LDB(dst, b, h) do { _Pragma("unroll") for (int n = 0; n < 2; ++n) _Pragma("unroll") for (int k = 0; k < 2; ++k) dst[n][k] = *(const PG8_LAS bf16x8*)(lds + PG8_SB(b, h) + boff + n * 2048 + k * 1024); } while (0)
#define PG8_MMA(ai, bj, At, Bt) do { __builtin_amdgcn_s_setprio(1); _Pragma("unroll") for (int m = 0; m < 4; ++m) _Pragma("unroll") for (int n = 0; n < 2; ++n) _Pragma("unroll") for (int k = 0; k < 2; ++k) \
        acc[ai][bj][m][n] = __builtin_amdgcn_mfma_f32_16x16x32_bf16(Bt[n][k], At[m][k], acc[ai][bj][m][n], 0, 0, 0); __builtin_amdgcn_s_setprio(0); } while (0)
#define PG8_WAIT_V(n) asm volatile("s_waitcnt vmcnt(" #n ")" ::: "memory")
#define PG8_WAIT_L(n) asm volatile("s_waitcnt lgkmcnt(" #n ")" ::: "memory")
#define PG8_BAR __builtin_amdgcn_s_barrier()
#define PG8_SCHED __builtin_amdgcn_sched_barrier(0)
    Unit cur, nxt; int ui = 0;
    if (!S.next(0, cur)) return;
    f32x4 acc[2][2][4][2];
#pragma unroll
    for (int a = 0; a < 2; ++a)
#pragma unroll
        for (int b = 0; b < 2; ++b)
#pragma unroll
            for (int m = 0; m < 4; ++m)
#pragma unroll
                for (int n = 0; n < 2; ++n) acc[a][b][m][n] = (f32x4){0.f, 0.f, 0.f, 0.f};
    bf16x8 At[4][2], B0[2][2], B1[2][2];
    const char* cA = (const char*)g.A + (size_t)cur.pm * tstep; const char* cB = (const char*)g.Bt + (size_t)cur.pn * tstep;
    S.a_ready(cur);
    if constexpr (SP2) {
        PG8_STAGE(PG8_SB(0, 0), cB, voffB); PG8_STAGE(PG8_SB(0, 1), cB + hstep, voffB); PG8_STAGE(PG8_SA(0, 0), cA, voffA); PG8_STAGE(PG8_SA(0, 1), cA + hstep, voffA);
        if (wr == 1) PG8_BAR;
        PG8_WAIT_V(2); PG8_BAR;
        PG8_STAGE(PG8_SB(1, 0), cB + kstep, voffB); PG8_STAGE(PG8_SA(1, 0), cA + kstep, voffA); PG8_STAGE(PG8_SB(1, 1), cB + hstep + kstep, voffB);
        PG8_WAIT_V(6); PG8_BAR;
    } else {
        PG8_STAGE(PG8_SB(0, 0), cB, voffB); PG8_STAGE(PG8_SA(0, 0), cA, voffA); PG8_STAGE(PG8_SB(0, 1), cB + hstep, voffB); PG8_STAGE(PG8_SA(0, 1), cA + hstep, voffA);
        if (wr == 1) PG8_BAR;
        PG8_WAIT_V(4); PG8_BAR;
        PG8_STAGE(PG8_SB(1, 0), cB + kstep, voffB); PG8_STAGE(PG8_SA(1, 0), cA + kstep, voffA); PG8_STAGE(PG8_SB(1, 1), cB + hstep + kstep, voffB);
        PG8_WAIT_V(6); PG8_BAR;
    }
    for (;;) {
        const bool has_next = S.next(ui + 1, nxt);
        const char* nA = has_next ? (const char*)g.A + (size_t)nxt.pm * tstep : cA; const char* nB = has_next ? (const char*)g.Bt + (size_t)nxt.pn * tstep : cB;
        for (int t = 0; t < nt; t += 2) {
            const bool last = (t == nt - 2);
            const char* a1 = cA + (size_t)(t + 1) * kstep;
            const char* a2 = last ? nA : cA + (size_t)(t + 2) * kstep; const char* b2 = last ? nB : cB + (size_t)(t + 2) * kstep;
            const char* a3 = a2 + kstep; const char* b3 = b2 + kstep;
            if (last && has_next) S.a_ready(nxt);
            if constexpr (SP2) {
            PG8_LDB(B0, 0, 0); PG8_LDB(B1, 0, 1); PG8_SCHED; PG8_LDA(At, 0, 0); PG8_STAGE(PG8_SA(1, 1), a1 + hstep, voffA);
            PG8_WAIT_V(8); PG8_WAIT_L(0); PG8_BAR; PG8_MMA(0, 0, At, B0); PG8_MMA(0, 1, At, B1); PG8_BAR; PG8_SCHED;
            PG8_LDA(At, 0, 1); PG8_STAGE(PG8_SB(0, 0), b2, voffB); PG8_STAGE(PG8_SB(0, 1), b2 + hstep, voffB); PG8_STAGE(PG8_SA(0, 0), a2, voffA);
            PG8_WAIT_V(8); PG8_WAIT_L(0); PG8_BAR; PG8_MMA(1, 0, At, B0); PG8_MMA(1, 1, At, B1); PG8_BAR; PG8_SCHED;
            PG8_LDB(B0, 1, 0); PG8_LDB(B1, 1, 1); PG8_SCHED; PG8_LDA(At, 1, 0); PG8_STAGE(PG8_SA(0, 1), a2 + hstep, voffA);
            PG8_WAIT_V(8); PG8_WAIT_L(0); PG8_BAR; PG8_MMA(0, 0, At, B0); PG8_MMA(0, 1, At, B1); PG8_BAR; PG8_SCHED;
            PG8_LDA(At, 1, 1); PG8_STAGE(PG8_SB(1, 0), b3, voffB); PG8_STAGE(PG8_SB(1, 1), b3 + hstep, voffB); PG8_STAGE(PG8_SA(1, 0), a3, voffA);
            PG8_WAIT_V(8); PG8_WAIT_L(0); PG8_BAR; PG8_MMA(1, 0, At, B0); PG8_MMA(1, 1, At, B1); PG8_BAR; PG8_SCHED;
            } else {
            PG8_LDB(B0, 0, 0); PG8_SCHED; PG8_LDA(At, 0, 0); PG8_STAGE(PG8_SA(1, 1), a1 + hstep, voffA);
            PG8_WAIT_L(8); PG8_BAR; PG8_WAIT_L(0); PG8_MMA(0, 0, At, B0); PG8_BAR; PG8_SCHED;
            PG8_LDB(B1, 0, 1); PG8_STAGE(PG8_SB(0, 0), b2, voffB);
            PG8_BAR; PG8_WAIT_L(0); PG8_MMA(0, 1, At, B1); PG8_BAR;
            PG8_LDA(At, 0, 1); PG8_STAGE(PG8_SA(0, 0), a2, voffA);
            PG8_BAR; PG8_WAIT_L(0); PG8_MMA(1, 0, At, B0); PG8_BAR; PG8_SCHED;
            PG8_STAGE(PG8_SB(0, 1), b2 + hstep, voffB);
            PG8_WAIT_V(6); PG8_BAR; PG8_MMA(1, 1, At, B1); PG8_BAR;
            PG8_LDB(B0, 1, 0); PG8_SCHED; PG8_LDA(At, 1, 0); PG8_STAGE(PG8_SA(0, 1), a2 + hstep, voffA);
            PG8_WAIT_L(8); PG8_BAR; PG8_WAIT_L(0); PG8_MMA(0, 0, At, B0); PG8_BAR; PG8_SCHED;
            PG8_LDB(B1, 1, 1); PG8_STAGE(PG8_SB(1, 0), b3, voffB);
            PG8_BAR; PG8_WAIT_L(0); PG8_MMA(0, 1, At, B1); PG8_BAR;
            PG8_LDA(At, 1, 1); PG8_STAGE(PG8_SA(1, 0), a3, voffA);
            PG8_BAR; PG8_WAIT_L(0); PG8_MMA(1, 0, At, B0); PG8_BAR; PG8_SCHED;
            PG8_STAGE(PG8_SB(1, 1), b3 + hstep, voffB);
            PG8_WAIT_V(6); PG8_BAR; PG8_MMA(1, 1, At, B1); PG8_BAR;
            }
        }
        if constexpr (ALIGN_EPI) { if (wr == 0) PG8_BAR; }
        if constexpr (!Epi::AFTER_DRAIN) { E(acc, cur, wr, wc, fr, fq); S.done(cur); }
        if (!has_next) break;
#pragma unroll
        for (int a = 0; a < 2; ++a)
#pragma unroll
            for (int b = 0; b < 2; ++b)
#pragma unroll
                for (int m = 0; m < 4; ++m)
#pragma unroll
                    for (int n = 0; n < 2; ++n) acc[a][b][m][n] = (f32x4){0.f, 0.f, 0.f, 0.f};
        cur = nxt; cA = nA; cB = nB; ++ui;
        if constexpr (ALIGN_EPI) { if (wr == 1) PG8_BAR; }
    }
    PG8_WAIT_V(0);
    if constexpr (!ALIGN_EPI) { if (wr == 0) PG8_BAR; }
    PG8_BAR;
    if constexpr (Epi::AFTER_DRAIN) { E.fused(acc, cur, wr, wc, fr, fq, lds, wid, lane); S.done(cur); }
#undef PG8_SA
#undef PG8_SB
#undef PG8_STAGE
#undef PG8_LDA
#undef PG8_LDB
#undef PG8_MMA
#undef PG8_WAIT_V
#undef PG8_WAIT_L
#undef PG8_BAR
#undef PG8_SCHED
}
}

DEVI void ph_conv(const P& p, int j, int r0) {
    const int otid_ = otid();
    const int wave = otid_ >> 6, lane = otid_ & 63, gw = blockIdx.x * NWV + wave, NGW = gridDim.x * NWV;
    const bf16_t* G = (const bf16_t*)(p.ws + WS_G);
    Row16 k0, k1, k2;
    load_row_f32(p.in[I_CK] + (size_t)(j * 3 + 0) * D, lane, k0); load_row_f32(p.in[I_CK] + (size_t)(j * 3 + 1) * D, lane, k1); load_row_f32(p.in[I_CK] + (size_t)(j * 3 + 2) * D, lane, k2);
    for (int r = r0 + gw; r < MA; r += NGW) {
        bool hasp, hasn;
        if (r < TC) { hasp = r > 0; hasn = r < TC - 1; } else { const int t = (r - TC) & 63; hasp = t != 0; hasn = t != 63; }
        Row16 gb, gc, v, acc;
        load_row_bf16(G + (size_t)r * 3072, lane, gb); load_row_bf16(G + (size_t)r * 3072 + 1024, lane, gc); load_row_bf16(G + (size_t)r * 3072 + 2048, lane, v);
#pragma unroll
        for (int e = 0; e < 16; ++e) acc.v[e] = gc.v[e] * v.v[e] * k1.v[e];
        if (hasp) { load_row_bf16(G + (size_t)(r - 1) * 3072 + 1024, lane, gc); load_row_bf16(G + (size_t)(r - 1) * 3072 + 2048, lane, v);
#pragma unroll
            for (int e = 0; e < 16; ++e) acc.v[e] += gc.v[e] * v.v[e] * k0.v[e]; }
        if (hasn) { load_row_bf16(G + (size_t)(r + 1) * 3072 + 1024, lane, gc); load_row_bf16(G + (size_t)(r + 1) * 3072 + 2048, lane, v);
#pragma unroll
            for (int e = 0; e < 16; ++e) acc.v[e] += gc.v[e] * v.v[e] * k2.v[e]; }
#pragma unroll
        for (int e = 0; e < 16; ++e) acc.v[e] *= gb.v[e];
        store_row_bf16((bf16_t*)(p.ws + WS_U) + (size_t)r * D, lane, acc);
    }
}

DEVI int scan_row(int n, int dir) {
    if (dir == 0) return n;
    return n < TC ? (TC - 1 - n) : (TC + (T - 1 - (n - TC)));
}
namespace hg {
typedef short bf16x8 __attribute__((ext_vector_type(8)));
constexpr int NSEG = 16, NUNIT = 2 * 8 * NSEG;
constexpr int QSB = 272, TSB = 80;
constexpr int OFF_QT = 0, OFF_KT = 32 * QSB, OFF_QD = 2 * 32 * QSB, OFF_KDT = 3 * 32 * QSB, OFF_VT = OFF_KDT + 128 * TSB, OFF_DEC = OFF_VT + 128 * TSB, OFF_T = OFF_DEC + 512, BUFB = OFF_T + 4096;
static_assert(2 * BUFB <= 131072, "hgrn LDS");
DEVI bf16x8 mk8(unsigned a, unsigned b, unsigned c, unsigned d) { u32x4 v = {a, b, c, d}; return __builtin_bit_cast(bf16x8, v); }
DEVI unsigned cvtpk(float lo, float hi) { return pk2(lo, hi); }
#define HG_MFMA(a, b, c) __builtin_amdgcn_mfma_f32_16x16x32_bf16((a), (b), (c), 0, 0, 0)
#define HG_BAR() do { asm volatile("s_waitcnt lgkmcnt(0)" ::: "memory"); __builtin_amdgcn_s_barrier(); asm volatile("" ::: "memory"); } while (0)
template <bool PASS2>
DEVI void scan(const P& p, unsigned char* lds_) {
    for (int unit = blockIdx.x; unit < NUNIT; unit += gridDim.x) {
    __syncthreads();
    const int tid = otid(), lane = tid & 63, w = __builtin_amdgcn_readfirstlane(tid >> 6), c = lane & 15, q4 = lane >> 4;
    const int kp = tid & 63, lo = tid >> 6;
    const int d = unit / (8 * NSEG), h = (unit / NSEG) & 7, seg = unit % NSEG;
    LAS unsigned char* lds = (LAS unsigned char*)lds_;
    const bf16_t* G = (const bf16_t*)(p.ws + WS_G);
    bf16_t* O = (bf16_t*)(p.ws + (d ? WS_OB : WS_OF));
    float* SLOC = (float*)(p.ws + WS_SC);
    float* GSUM = SLOC + (size_t)NUNIT * 16384;
    f32x4 S[8];
#pragma unroll
    for (int t = 0; t < 8; ++t) S[t] = (f32x4){0.f, 0.f, 0.f, 0.f};
    if (PASS2) {
        for (int j = 0; j < seg; ++j) {
            const float* gs = GSUM + (size_t)(unit - seg + j) * 128; const float* sl = SLOC + (size_t)(unit - seg + j) * 16384 + (size_t)w * 2048;
#pragma unroll
            for (int t = 0; t < 8; ++t) { const f32x4 gg = *(const f32x4*)(gs + 16 * t + 4 * q4);
#pragma unroll
                for (int r = 0; r < 4; ++r) S[t][r] = S[t][r] * __expf(gg[r]) + sl[(t * 4 + r) * 64 + lane]; }
        }
    }
    float gsum0 = 0.f, gsum1 = 0.f;
    unsigned rq[4], ri[4], rz[4];
    const int CPS = 32 + (seg < 8 ? 1 : 0), ci0 = 32 * seg + (seg < 8 ? seg : 8);
    const bf16_t* Gk = G + h * 128 + 2 * kp + (d ? 1024 : 0);
    const long rstep = d ? -5120 : 5120;
#define HG_FETCH(ci) do { const bf16_t* g_ = Gk + (long)scan_row(32 * (ci) + 4 * lo, d) * 5120; _Pragma("unroll") for (int j = 0; j < 4; ++j) { \
        if (PASS2) rq[j] = *(const unsigned*)(g_ + (d ? -1024 : 0)); ri[j] = *(const unsigned*)(g_ + (d ? 0 : 1024)); rz[j] = *(const unsigned*)(g_ + 2048); g_ += rstep; } } while (0)
    HG_FETCH(ci0);
    for (int cc = 0; cc < CPS; ++cc) {
        const int ci = ci0 + cc;
        LAS unsigned char* B = lds + (cc & 1) * BUFB;
        float bl0[4], bl1[4], kv0[4], kv1[4]; float run0 = 0.f, run1 = 0.f;
#pragma unroll
        for (int j = 0; j < 4; ++j) { const float z0 = bflo(rz[j]), z1 = bfhi(rz[j]); run0 += z0; run1 += z1; bl0[j] = run0; bl1[j] = run1; kv0[j] = 1.0f - __expf(z0); kv1[j] = 1.0f - __expf(z1); }
        unsigned qp[4], vp[4];
#pragma unroll
        for (int j = 0; j < 4; ++j) { vp[j] = ri[j]; if (PASS2) qp[j] = rq[j]; }
        *(LAS f32x2_t*)(B + OFF_T + (lo * 128 + 2 * kp) * 4) = (f32x2_t){run0, run1};
        if (cc + 1 < CPS) HG_FETCH(ci + 1);
        HG_BAR();
        {
            float off0 = 0.f, off1 = 0.f, b15_0 = 0.f, b15_1 = 0.f, bla0 = 0.f, bla1 = 0.f;
#pragma unroll
            for (int x8 = 0; x8 < 8; ++x8) { const f32x2_t tt = *(const LAS f32x2_t*)(B + OFF_T + (x8 * 128 + 2 * kp) * 4);
                if (x8 < lo) { off0 += tt.x; off1 += tt.y; } if (x8 < 4) { b15_0 += tt.x; b15_1 += tt.y; } bla0 += tt.x; bla1 += tt.y; }
            const float e15_0 = __expf(b15_0), e15_1 = __expf(b15_1), el0 = __expf(bla0 - b15_0), el1 = __expf(bla1 - b15_1);
            float kd0[4], kd1[4];
#pragma unroll
            for (int j = 0; j < 4; ++j) {
                const int l = 4 * lo + j;
                const float b0 = bl0[j] + off0, b1 = bl1[j] + off1;
                const float kt0 = kv0[j] * __expf(b15_0 - b0), kt1 = kv1[j] * __expf(b15_1 - b1);
                kd0[j] = kt0 * el0; kd1[j] = kt1 * el1;
                if (PASS2) {
                    const float qt0 = bflo(qp[j]) * __expf(b0 - b15_0), qt1 = bfhi(qp[j]) * __expf(b1 - b15_1);
                    *(LAS unsigned*)(B + OFF_QT + l * QSB + 4 * kp) = pk2(qt0, qt1); *(LAS unsigned*)(B + OFF_QD + l * QSB + 4 * kp) = pk2(qt0 * e15_0, qt1 * e15_1);
                    *(LAS unsigned*)(B + OFF_KT + l * QSB + 4 * kp) = pk2(kt0, kt1);
                }
            }
            *(LAS u32x2*)(B + OFF_KDT + (2 * kp) * TSB + 8 * lo) = (u32x2){pk2(kd0[0], kd0[1]), pk2(kd0[2], kd0[3])};
            *(LAS u32x2*)(B + OFF_KDT + (2 * kp + 1) * TSB + 8 * lo) = (u32x2){pk2(kd1[0], kd1[1]), pk2(kd1[2], kd1[3])};
            *(LAS u32x2*)(B + OFF_VT + (2 * kp) * TSB + 8 * lo) = (u32x2){(vp[0] & 0xffffu) | (vp[1] << 16), (vp[2] & 0xffffu) | (vp[3] << 16)};
            *(LAS u32x2*)(B + OFF_VT + (2 * kp + 1) * TSB + 8 * lo) = (u32x2){(vp[0] >> 16) | (vp[1] & 0xffff0000u), (vp[2] >> 16) | (vp[3] & 0xffff0000u)};
            if (lo == 0) { *(LAS f32x2_t*)(B + OFF_DEC + 8 * kp) = (f32x2_t){__expf(bla0), __expf(bla1)}; gsum0 += bla0; gsum1 += bla1; }
        }
        HG_BAR();
        if (PASS2) {
            f32x4 p00 = {0.f, 0.f, 0.f, 0.f}, p01 = p00, p11 = p00;
#pragma unroll
            for (int s4 = 0; s4 < 4; ++s4) {
                const bf16x8 a0 = *(const LAS bf16x8*)(B + OFF_KT + c * QSB + 64 * s4 + 16 * q4), a1 = *(const LAS bf16x8*)(B + OFF_KT + (16 + c) * QSB + 64 * s4 + 16 * q4);
                const bf16x8 b0 = *(const LAS bf16x8*)(B + OFF_QT + c * QSB + 64 * s4 + 16 * q4), b1 = *(const LAS bf16x8*)(B + OFF_QT + (16 + c) * QSB + 64 * s4 + 16 * q4);
                p00 = HG_MFMA(a0, b0, p00); p01 = HG_MFMA(a0, b1, p01); p11 = HG_MFMA(a1, b1, p11);
            }
#pragma unroll
            for (int r = 0; r < 4; ++r) { const bool keep = (4 * q4 + r) <= c; p00[r] = keep ? p00[r] : 0.f; p11[r] = keep ? p11[r] : 0.f; }
            const bf16x8 bp0 = mk8(cvtpk(p00[0], p00[1]), cvtpk(p00[2], p00[3]), 0u, 0u);
            const bf16x8 bp1 = mk8(cvtpk(p01[0], p01[1]), cvtpk(p01[2], p01[3]), cvtpk(p11[0], p11[1]), cvtpk(p11[2], p11[3]));
            const u32x2 v0 = *(const LAS u32x2*)(B + OFF_VT + (16 * w + c) * TSB + 8 * q4), v1 = *(const LAS u32x2*)(B + OFF_VT + (16 * w + c) * TSB + 32 + 8 * q4);
            const bf16x8 va = mk8(v0.x, v0.y, v1.x, v1.y);
            f32x4 o0 = {0.f, 0.f, 0.f, 0.f}, o1 = o0;
            o0 = HG_MFMA(va, bp0, o0); o1 = HG_MFMA(va, bp1, o1);
#pragma unroll
            for (int s4 = 0; s4 < 4; ++s4) {
                const bf16x8 sa = mk8(cvtpk(S[2 * s4][0], S[2 * s4][1]), cvtpk(S[2 * s4][2], S[2 * s4][3]), cvtpk(S[2 * s4 + 1][0], S[2 * s4 + 1][1]), cvtpk(S[2 * s4 + 1][2], S[2 * s4 + 1][3]));
                const u32x2 x0 = *(const LAS u32x2*)(B + OFF_QD + c * QSB + 64 * s4 + 8 * q4), x1 = *(const LAS u32x2*)(B + OFF_QD + c * QSB + 64 * s4 + 32 + 8 * q4);
                const u32x2 y0 = *(const LAS u32x2*)(B + OFF_QD + (16 + c) * QSB + 64 * s4 + 8 * q4), y1 = *(const LAS u32x2*)(B + OFF_QD + (16 + c) * QSB + 64 * s4 + 32 + 8 * q4);
                o0 = HG_MFMA(sa, mk8(x0.x, x0.y, x1.x, x1.y), o0); o1 = HG_MFMA(sa, mk8(y0.x, y0.y, y1.x, y1.y), o1);
            }
            {
                const int ra = scan_row(32 * ci + c, d), rb = scan_row(32 * ci + 16 + c, d);
                *(u32x2*)(O + (size_t)ra * D + h * 128 + 16 * w + 4 * q4) = (u32x2){cvtpk(o0[0], o0[1]), cvtpk(o0[2], o0[3])};
                *(u32x2*)(O + (size_t)rb * D + h * 128 + 16 * w + 4 * q4) = (u32x2){cvtpk(o1[0], o1[1]), cvtpk(o1[2], o1[3])};
            }
        }
        {
            const bf16x8 vb = *(const LAS bf16x8*)(B + OFF_VT + (16 * w + c) * TSB + 16 * q4);
#pragma unroll
            for (int t = 0; t < 8; ++t) {
                const f32x4 dec = *(const LAS f32x4*)(B + OFF_DEC + (16 * t + 4 * q4) * 4);
                const bf16x8 ka = *(const LAS bf16x8*)(B + OFF_KDT + (16 * t + c) * TSB + 16 * q4);
                S[t] = HG_MFMA(ka, vb, S[t] * dec);
            }
        }
    }
    if (!PASS2) {
        float* sl = SLOC + (size_t)unit * 16384 + (size_t)w * 2048;
#pragma unroll
        for (int t = 0; t < 8; ++t)
#pragma unroll
            for (int r = 0; r < 4; ++r) sl[(t * 4 + r) * 64 + lane] = S[t][r];
        if (lo == 0) { GSUM[(size_t)unit * 128 + 2 * kp] = gsum0; GSUM[(size_t)unit * 128 + 2 * kp + 1] = gsum1; }
    }
#undef HG_FETCH
    }
}
}

DEVI void hgrn_readout_row(const P& p, int r, int lane, Row16& a, const Row16& b, const Row16& zg, const Row16& ng) {
    Row16 o; float s0 = 0.f, s1 = 0.f;
#pragma unroll
    for (int e = 0; e < 8; ++e) { a.v[e] += b.v[e]; a.v[8 + e] += b.v[8 + e]; s0 += a.v[e] * a.v[e]; s1 += a.v[8 + e] * a.v[8 + e]; }
    s0 = row16_sum(s0); s1 = row16_sum(s1);
    const float r0 = rsqrtf(s0 * (1.0f / 128.0f) + EPS), r1 = rsqrtf(s1 * (1.0f / 128.0f) + EPS);
#pragma unroll
    for (int e = 0; e < 8; ++e) { o.v[e] = a.v[e] * r0 * ng.v[e] * zg.v[e]; o.v[8 + e] = a.v[8 + e] * r1 * ng.v[8 + e] * zg.v[8 + e]; }
    store_row_bf16((bf16_t*)(p.ws + WS_U) + (size_t)r * D, lane, o);
}
DEVI void ph_hgrn_readout(const P& p) {
    const int otid_ = otid();
    const int wave = __builtin_amdgcn_readfirstlane(otid_ >> 6), lane = otid_ & 63, gw = blockIdx.x * NWV + wave, NGW = gridDim.x * NWV;
    Row16 ng; load_row_f32(p.in[I_HNG], lane, ng);
    for (int r = gw; r < MA; r += 2 * NGW) {
        const int r1 = r + NGW;
        Row16 a0, b0, z0, a1, b1, z1;
        load_row_bf16((const bf16_t*)(p.ws + WS_OF) + (size_t)r * D, lane, a0); load_row_bf16((const bf16_t*)(p.ws + WS_OB) + (size_t)r * D, lane, b0);
        load_row_bf16((const bf16_t*)(p.ws + WS_G) + (size_t)r * 5120 + 4096, lane, z0);
        if (r1 < MA) { load_row_bf16((const bf16_t*)(p.ws + WS_OF) + (size_t)r1 * D, lane, a1); load_row_bf16((const bf16_t*)(p.ws + WS_OB) + (size_t)r1 * D, lane, b1);
            load_row_bf16((const bf16_t*)(p.ws + WS_G) + (size_t)r1 * 5120 + 4096, lane, z1); }
        hgrn_readout_row(p, r, lane, a0, b0, z0, ng);
        if (r1 < MA) hgrn_readout_row(p, r1, lane, a1, b1, z1, ng);
    }
}

DEVI float reduce16(float (&v)[16], int lane) {
    float w8[8], w4[4], w2[2];
    const bool b5 = lane & 32, b4 = lane & 16, b3 = lane & 8, b2 = lane & 4;
#pragma unroll
    for (int i = 0; i < 8; ++i) { const float keep = b5 ? v[i + 8] : v[i], send = b5 ? v[i] : v[i + 8]; w8[i] = keep + __shfl_xor(send, 32); }
#pragma unroll
    for (int i = 0; i < 4; ++i) { const float keep = b4 ? w8[i + 4] : w8[i], send = b4 ? w8[i] : w8[i + 4]; w4[i] = keep + __shfl_xor(send, 16); }
#pragma unroll
    for (int i = 0; i < 2; ++i) { const float keep = b3 ? w4[i + 2] : w4[i], send = b3 ? w4[i] : w4[i + 2]; w2[i] = keep + __shfl_xor(send, 8); }
    const float keep = b2 ? w2[1] : w2[0], send = b2 ? w2[0] : w2[1];
    float r = keep + __shfl_xor(send, 4);
    r += __shfl_xor(r, 2); r += __shfl_xor(r, 1);
    return r;
}
namespace s5 {
typedef short bf16x8 __attribute__((ext_vector_type(8)));
constexpr int NSEG = 16, SEGLEN = MA / NSEG, CPS = SEGLEN / 16;
static_assert(SEGLEN * NSEG == MA && CPS * 16 == SEGLEN, "s5 segments");
constexpr int XSB = 272, BSB = 528, WAVE_LDS = 16 * BSB + 16 * XSB;
DEVI bf16x8 mk8(unsigned a, unsigned b, unsigned c, unsigned d) { u32x4 v = {a, b, c, d}; return __builtin_bit_cast(bf16x8, v); }
template <bool PASS2>
DEVI void scan(const P& p, unsigned char* lds_) {
    const int tid = otid(), lane = tid & 63, w = __builtin_amdgcn_readfirstlane(tid >> 6), c = lane & 15, q4 = lane >> 4;
    for (int blk = blockIdx.x; blk < 256; blk += gridDim.x) {
    const int dn = blk >> 7, seg = (blk >> 3) & 15, g = (blk & 7) * 8 + w;
    LAS unsigned char* BUS = (LAS unsigned char*)lds_ + w * WAVE_LDS; LAS unsigned char* XS = BUS + 16 * BSB;
    const bf16_t* XN = (const bf16_t*)(p.ws + WS_XN);
    bf16_t* Y = (bf16_t*)(p.ws + (dn ? WS_OB : WS_OF));
    float* XE = (float*)(p.ws + WS_XE);
    const float* Aab = (const float*)(p.ws + WS_S5A) + (size_t)((dn * 64 + g) * 64 + lane) * 2;
    const float abr = Aab[0], abi = Aab[1];
    bf16x8 bfr[8];
#pragma unroll
    for (int n = 0; n < 8; ++n) {
        if (q4 < 2) { const float* B = (const float*)(p.ws + WS_S5B) + (size_t)((dn * 64 + g) * 64 + 8 * n + (c >> 1)) * 32 + (c & 1) * 16 + 8 * q4;
            const f32x4 b0 = *(const f32x4*)B, b1 = *(const f32x4*)(B + 4); bfr[n] = mk8(pk2(b0[0], b0[1]), pk2(b0[2], b0[3]), pk2(b1[0], b1[1]), pk2(b1[2], b1[3])); }
        else bfr[n] = mk8(0u, 0u, 0u, 0u);
    }
    bf16x8 cfr[4];
    if (PASS2) {
#pragma unroll
        for (int s4 = 0; s4 < 4; ++s4) {
            const size_t o = ((size_t)(dn * 64 + g) * 16 + c) * 64 + 16 * s4 + 4 * q4;
            const f32x4 cr = *(const f32x4*)(p.in[I_S5CR] + o), ci = *(const f32x4*)(p.in[I_S5CI] + o);
            cfr[s4] = mk8(pk2(cr[0], -ci[0]), pk2(cr[1], -ci[1]), pk2(cr[2], -ci[2]), pk2(cr[3], -ci[3]));
        }
    }
    float xr = 0.f, xi = 0.f;
    if (PASS2 && seg > 0) {
        float pr = 1.f, pi = 0.f, br = abr, bi = abi;
#define S5_PIN(x) asm volatile("" : "+v"(x))
#pragma unroll 1
        for (int n = SEGLEN; n; n >>= 1) {
            if (n & 1) { float t = pr * br; S5_PIN(t); t = __builtin_fmaf(-pi, bi, t); S5_PIN(t); float u = pr * bi; S5_PIN(u); u = __builtin_fmaf(pi, br, u); S5_PIN(u); pr = t; pi = u; }
            float t2 = br * br; S5_PIN(t2); t2 = __builtin_fmaf(-bi, bi, t2); S5_PIN(t2); float u2 = 2.f * br * bi; S5_PIN(u2); br = t2; bi = u2;
        }
        for (int j = 0; j < seg; ++j) { const float* e = XE + ((size_t)((dn * 64 + g) * 16 + j) * 64 + lane) * 2; const float er = e[0], ei = e[1];
            float t = __builtin_fmaf(pr, xr, er); S5_PIN(t); t = __builtin_fmaf(-pi, xi, t); S5_PIN(t); float u = __builtin_fmaf(pr, xi, ei); S5_PIN(u); u = __builtin_fmaf(pi, xr, u); S5_PIN(u); xr = t; xi = u; }
#undef S5_PIN
    }
    const int n0 = seg * SEGLEN;
    const unsigned amask = q4 < 2 ? 0xffffffffu : 0u;
    u32x4 araw = *(const u32x4*)(XN + (size_t)scan_row(n0 + c, dn) * D + g * 16 + 8 * (q4 & 1));
#pragma unroll 1
    for (int cc = 0; cc < CPS; ++cc) {
        const u32x4 am = {araw[0] & amask, araw[1] & amask, araw[2] & amask, araw[3] & amask};
        const bf16x8 afr = __builtin_bit_cast(bf16x8, am);
        { const int cn = cc + 1 < CPS ? cc + 1 : cc; araw = *(const u32x4*)(XN + (size_t)scan_row(n0 + 16 * cn + c, dn) * D + g * 16 + 8 * (q4 & 1)); }
#pragma unroll
        for (int n = 0; n < 8; ++n) {
            const f32x4 dv = __builtin_amdgcn_mfma_f32_16x16x32_bf16(bfr[n], afr, (f32x4){0.f, 0.f, 0.f, 0.f}, 0, 0, 0);
            *(LAS f32x4*)(BUS + c * BSB + (16 * n + 4 * q4) * 4) = dv;
        }
        asm volatile("s_waitcnt lgkmcnt(0)" ::: "memory");
        f32x2_t bu[16];
#pragma unroll
        for (int t = 0; t < 16; ++t) bu[t] = *(const LAS f32x2_t*)(BUS + t * BSB + 8 * lane);
        unsigned xs[16];
#pragma unroll
        for (int t = 0; t < 16; ++t) {
            float nr = __builtin_fmaf(abr, xr, bu[t].x); asm volatile("" : "+v"(nr)); nr = __builtin_fmaf(-abi, xi, nr); asm volatile("" : "+v"(nr));
            float ni = __builtin_fmaf(abr, xi, bu[t].y); asm volatile("" : "+v"(ni)); ni = __builtin_fmaf(abi, xr, ni); asm volatile("" : "+v"(ni));
            xr = nr; xi = ni;
            if (PASS2) xs[t] = pk2(xr, xi);
        }
        if (PASS2) {
#pragma unroll
            for (int t = 0; t < 16; ++t) *(LAS unsigned*)(XS + t * XSB + 4 * lane) = xs[t];
        }
        asm volatile("s_waitcnt lgkmcnt(0)" ::: "memory");
        if (PASS2) {
            f32x4 y = {0.f, 0.f, 0.f, 0.f};
#pragma unroll
            for (int s4 = 0; s4 < 4; ++s4) { const bf16x8 xf = *(const LAS bf16x8*)(XS + c * XSB + 64 * s4 + 16 * q4); y = __builtin_amdgcn_mfma_f32_16x16x32_bf16(cfr[s4], xf, y, 0, 0, 0); }
            *(u32x2*)(Y + (size_t)scan_row(n0 + 16 * cc + c, dn) * D + g * 16 + 4 * q4) = (u32x2){pk2(y[0], y[1]), pk2(y[2], y[3])};
        }
    }
    if (!PASS2) { float* e = XE + ((size_t)((dn * 64 + g) * 16 + seg) * 64 + lane) * 2; e[0] = xr; e[1] = xi; }
    }
}
}

DEVI void ph_s5_elem(const P& p) {
    const int otid_ = otid();
    const int wave = __builtin_amdgcn_readfirstlane(otid_ >> 6), lane = otid_ & 63, gw = blockIdx.x * NWV + wave, NGW = gridDim.x * NWV;
    Row16 dd; load_row_f32(p.in[I_S5D], lane, dd);
    for (int r = gw; r < MA; r += 2 * NGW) {
        const int r1 = r + NGW;
        Row16 u0, a0, b0, u1, a1, b1, o;
        load_row_bf16((const bf16_t*)(p.ws + WS_XN) + (size_t)r * D, lane, u0);
        load_row_bf16((const bf16_t*)(p.ws + WS_OF) + (size_t)r * D, lane, a0); load_row_bf16((const bf16_t*)(p.ws + WS_OB) + (size_t)r * D, lane, b0);
        if (r1 < MA) { load_row_bf16((const bf16_t*)(p.ws + WS_XN) + (size_t)r1 * D, lane, u1);
            load_row_bf16((const bf16_t*)(p.ws + WS_OF) + (size_t)r1 * D, lane, a1); load_row_bf16((const bf16_t*)(p.ws + WS_OB) + (size_t)r1 * D, lane, b1); }
#pragma unroll
        for (int e = 0; e < 16; ++e) o.v[e] = geluf_(dd.v[e] * u0.v[e] + a0.v[e] + b0.v[e]);
        store_row_bf16((bf16_t*)(p.ws + WS_U) + (size_t)r * D, lane, o);
        if (r1 < MA) {
#pragma unroll
            for (int e = 0; e < 16; ++e) o.v[e] = geluf_(dd.v[e] * u1.v[e] + a1.v[e] + b1.v[e]);
            store_row_bf16((bf16_t*)(p.ws + WS_U) + (size_t)r1 * D, lane, o);
        }
    }
}
DEVI float score_key(float s, int e) { return __uint_as_float((__float_as_uint(s) & 0xffffff80u) | (unsigned)e); }
DEVI float key_score(float k) { return k; }
DEVI int key_idx(float k) { return (int)(__float_as_uint(k) & 127u); }
DEVI float h2f_lo(unsigned w) { return (float)__builtin_bit_cast(pg8::f16x2_t, w).x; }
DEVI float h2f_hi(unsigned w) { return (float)__builtin_bit_cast(pg8::f16x2_t, w).y; }
DEVI void topk_wave_item(const P& p, int layer, int r, int h, int lane) {
    const unsigned short* s = (const unsigned short*)(p.ws + WS_SCH) + (size_t)r * 2048 + h * 256;
    const unsigned w0 = *(const unsigned*)(s + 2 * lane), w1 = *(const unsigned*)(s + 128 + 2 * lane);
    const float NEG = -__builtin_inff();
    float k00 = score_key(h2f_lo(w0), 2 * lane), k01 = score_key(h2f_hi(w0), 2 * lane + 1), k10 = score_key(h2f_lo(w1), 2 * lane), k11 = score_key(h2f_hi(w1), 2 * lane + 1);
    float A[16], B[16];
#pragma unroll
    for (int i = 0; i < 16; ++i) {
        const float ma = wave_max_f(__builtin_fmaxf(k00, k01)), mb = wave_max_f(__builtin_fmaxf(k10, k11));
        A[i] = ma; B[i] = mb;
        k00 = (k00 == ma) ? NEG : k00; k01 = (k01 == ma) ? NEG : k01; k10 = (k10 == mb) ? NEG : k10; k11 = (k11 == mb) ? NEG : k11;
    }
    int ci = -1, cj = 0, base = 0;
#pragma unroll
    for (int i = 0; i < 16; ++i) { const int cnt = 16 / (i + 1); if (ci < 0 && lane < base + cnt) { ci = i; cj = lane - base; } base += cnt; }
    float av = A[0], bv = B[0];
#pragma unroll
    for (int i = 1; i < 16; ++i) { av = (ci == i) ? A[i] : av; bv = (cj == i) ? B[i] : bv; }
    const int payload = key_idx(av) * 128 + key_idx(bv);
    const float sum = key_score(av) + key_score(bv);
    float ck = (ci >= 0) ? __uint_as_float((__float_as_uint(sum) & 0xffffffc0u) | (unsigned)lane) : NEG;
    float mys = 0.f, best = 0.f; int myidx = 0;
#pragma unroll
    for (int j = 0; j < 16; ++j) {
        const float mm = wave_max_f(ck);
        const int src = __builtin_amdgcn_readfirstlane((int)(__float_as_uint(mm) & 63u));
        const int pl = __builtin_amdgcn_readlane(payload, src);
        if (lane == j) { mys = mm; myidx = pl; }
        if (j == 0) best = mm;
        ck = (lane == src) ? NEG : ck;
    }
    const float e = lane < 16 ? __expf(mys - best) : 0.f;
    const float tot = wave_sum(e);
    if (lane < 16) {
        const f32x2_t sc2 = ((const f32x2_t*)(p.ws + WS_SCL) + (size_t)layer * 16384)[myidx];
        const size_t o = (size_t)r * 128 + h * 16 + lane;
        ((int*)(p.ws + WS_SELI))[o] = myidx; ((float*)(p.ws + WS_SELG))[o] = e / tot * sc2.y; ((float*)(p.ws + WS_SELU))[o] = sc2.x;
    }
}
constexpr int TK_ITEM_B = 144;
DEVI void ph_topk(const P& p, int layer, int r0, unsigned char* lds_) {
    const int otid_ = otid();
    const int wave = otid_ >> 6, lane = otid_ & 63;
    const int nall = (MA - r0) * 8, nthr = (int)gridDim.x * NTHR;
    const int nleft = nall % nthr;
    const int nitems = (nleft > 0 && nleft <= nthr / 8) ? nall - nleft : nall;
    for (int e = blockIdx.x * NWV + wave + nitems; e < nall; e += (int)gridDim.x * NWV) topk_wave_item(p, layer, r0 + (e >> 3), e & 7, lane);
    const unsigned char* SCb = (const unsigned char*)(p.ws + WS_SCH);
    LAS unsigned char* tile = (LAS unsigned char*)lds_ + wave * (64 * TK_ITEM_B);
    for (int it = blockIdx.x * NTHR + otid_; it < nitems; it += gridDim.x * NTHR) {
        const int r = r0 + (it >> 3), h = it & 7;
        const unsigned char* wbase = SCb + ((size_t)(r0 + ((it - lane) >> 3)) * 2048) * 2;
        const unsigned goff = (unsigned)(lane >> 3) * 512u + 16u * (unsigned)(lane & 7);
        u32x4 g[8];
#pragma unroll
        for (int j = 0; j < 8; ++j) g[j] = *(const u32x4*)(wbase + goff + 4096 * j);
        float L0[16], L1[16];
#pragma unroll 1
        for (int k = 0; k < 4; ++k) {
#pragma unroll
            for (int j = 0; j < 8; ++j) *(LAS u32x4*)(tile + (8 * j + (lane >> 3)) * TK_ITEM_B + 16 * (lane & 7)) = g[j];
            if (k < 3) {
#pragma unroll
                for (int j = 0; j < 8; ++j) g[j] = *(const u32x4*)(wbase + goff + 4096 * j + 128 * (k + 1));
            }
            u32x4 m[8];
#pragma unroll
            for (int i = 0; i < 8; ++i) m[i] = *(const LAS u32x4*)(tile + lane * TK_ITEM_B + 16 * i);
            float L[16];
            if (k & 1) {
#pragma unroll
                for (int j = 0; j < 16; ++j) L[j] = (k == 1) ? L0[j] : L1[j];
            } else {
#pragma unroll
                for (int j = 0; j < 16; ++j) L[j] = -__builtin_inff();
            }
            const int ebase = 64 * (k & 1);
#pragma unroll
            for (int gq = 0; gq < 4; ++gq) {
                float G[16];
#pragma unroll
                for (int e = 0; e < 16; ++e) { const unsigned wd = m[2 * gq + (e >> 3)][(e & 7) >> 1]; G[e] = score_key((e & 1) ? h2f_hi(wd) : h2f_lo(wd), ebase + 16 * gq + e); }
#define CE(a, b) { const float hi_ = __builtin_fmaxf(G[a], G[b]), lo_ = __builtin_fminf(G[a], G[b]); G[a] = hi_; G[b] = lo_; }
                CE(0,1) CE(2,3) CE(0,2) CE(1,3) CE(1,2) CE(4,5) CE(6,7) CE(4,6) CE(5,7) CE(5,6) CE(0,4) CE(2,6) CE(2,4) CE(1,5) CE(3,7) CE(3,5) CE(1,2) CE(3,4) CE(5,6) CE(8,9) CE(10,11) CE(8,10) CE(9,11) CE(9,10) CE(12,13) CE(14,15) CE(12,14) CE(13,15) CE(13,14) CE(8,12) CE(10,14) CE(10,12) CE(9,13) CE(11,15) CE(11,13) CE(9,10) CE(11,12) CE(13,14) CE(0,8) CE(4,12) CE(4,8) CE(2,10) CE(6,14) CE(6,10) CE(2,4) CE(6,8) CE(10,12) CE(1,9) CE(5,13) CE(5,9) CE(3,11) CE(7,15) CE(7,11) CE(3,5) CE(7,9) CE(11,13) CE(1,2) CE(3,4) CE(5,6) CE(7,8) CE(9,10) CE(11,12) CE(13,14)
#undef CE
#pragma unroll
                for (int i = 0; i < 16; ++i) L[i] = __builtin_fmaxf(L[i], G[15 - i]);
#pragma unroll
                for (int jj = 8; jj > 0; jj >>= 1)
#pragma unroll
                    for (int i = 0; i < 16; ++i) { const int l = i ^ jj; if (l > i) { const float hi = __builtin_fmaxf(L[i], L[l]), lo = __builtin_fminf(L[i], L[l]); L[i] = hi; L[l] = lo; } }
            }
            if (k < 2) {
#pragma unroll
                for (int j = 0; j < 16; ++j) L0[j] = L[j];
            } else {
#pragma unroll
                for (int j = 0; j < 16; ++j) L1[j] = L[j];
            }
        }
        const float amx = __builtin_fmaxf(__builtin_fmaxf(__builtin_fabsf(L0[0]), __builtin_fabsf(L0[15])), __builtin_fmaxf(__builtin_fabsf(L1[0]), __builtin_fabsf(L1[15])));
        const float ksc = 65000.0f / __builtin_fmaxf(amx, 1e-30f), kinv = 1.0f / (ksc * 16384.0f);
        int KA[16], KB[16];
#pragma unroll
        for (int j = 0; j < 16; ++j) { KA[j] = ((int)__builtin_rintf(L0[j] * ksc) << 14) | (key_idx(L0[j]) << 7); KB[j] = ((int)__builtin_rintf(L1[j] * ksc) << 14) | key_idx(L1[j]); }
        int fk[16];
#pragma unroll
        for (int j = 0; j < 16; ++j) fk[j] = KA[0] + KB[j];
#pragma unroll
        for (int i = 1; i < 16; ++i)
#pragma unroll
            for (int j = 0; j < 16; ++j)
                if ((i + 1) * (j + 1) <= 16) {
                    int xk = KA[i] + KB[j];
#pragma unroll
                    for (int q = 0; q < 16; ++q) if (q >= (i + 1) * (j + 1) - 1) { const int hi = xk > fk[q] ? xk : fk[q], lo = xk > fk[q] ? fk[q] : xk; fk[q] = hi; xk = lo; }
                }
        float fs[16]; int fi[16];
#pragma unroll
        for (int j = 0; j < 16; ++j) { fs[j] = (float)fk[j] * kinv; fi[j] = fk[j] & 16383; }
        float sum = 0.f, e[16];
#pragma unroll
        for (int j = 0; j < 16; ++j) { e[j] = __expf(fs[j] - fs[0]); sum += e[j]; }
        const float inv = 1.0f / sum;
        const f32x2_t* SC2 = (const f32x2_t*)(p.ws + WS_SCL) + (size_t)layer * 16384;
        float su[16];
#pragma unroll
        for (int j = 0; j < 16; ++j) { const f32x2_t sc2 = SC2[fi[j]]; su[j] = sc2.x; e[j] = e[j] * inv * sc2.y; }
        i32x4* oi = (i32x4*)((int*)(p.ws + WS_SELI) + (size_t)r * 128 + h * 16); f32x4* og = (f32x4*)((float*)(p.ws + WS_SELG) + (size_t)r * 128 + h * 16); f32x4* ou = (f32x4*)((float*)(p.ws + WS_SELU) + (size_t)r * 128 + h * 16);
#pragma unroll
        for (int j = 0; j < 4; ++j) { oi[j] = (i32x4){fi[4 * j], fi[4 * j + 1], fi[4 * j + 2], fi[4 * j + 3]}; og[j] = (f32x4){e[4 * j], e[4 * j + 1], e[4 * j + 2], e[4 * j + 3]}; ou[j] = (f32x4){su[4 * j], su[4 * j + 1], su[4 * j + 2], su[4 * j + 3]}; }
    }
}

DEVI void fmac_vv(float& acc, float a, float b) { asm("v_fmac_f32 %0, %1, %2" : "+v"(acc) : "v"(a), "v"(b)); }

DEVI void pkfma(f32x2_t& acc, f32x2_t a, f32x2_t b) { asm("v_pk_fma_f32 %0, %1, %2, %0" : "+v"(acc) : "v"(a), "v"(b)); }
DEVI float dot16_i8(const u32x4 q, const u32x4 h) {
    int a = __builtin_amdgcn_sdot4((int)q[0], (int)h[0], 0, false); a = __builtin_amdgcn_sdot4((int)q[1], (int)h[1], a, false);
    a = __builtin_amdgcn_sdot4((int)q[2], (int)h[2], a, false); a = __builtin_amdgcn_sdot4((int)q[3], (int)h[3], a, false);
    return (float)a;
}
template <int HI, bool FIRST> DEVI void pkfma_bc(f32x2_t& acc, f32x2_t wp, f32x2_t b) {
    if (FIRST) {
        if (HI) asm volatile("v_pk_mul_f32 %0, %1, %2 op_sel:[1,0] op_sel_hi:[1,1]" : "=&v"(acc) : "v"(wp), "v"(b));
        else    asm volatile("v_pk_mul_f32 %0, %1, %2 op_sel:[0,0] op_sel_hi:[0,1]" : "=&v"(acc) : "v"(wp), "v"(b));
    } else {
        if (HI) asm volatile("v_pk_fma_f32 %0, %1, %2, %0 op_sel:[1,0,0] op_sel_hi:[1,1,1]" : "+v"(acc) : "v"(wp), "v"(b));
        else    asm volatile("v_pk_fma_f32 %0, %1, %2, %0 op_sel:[0,0,0] op_sel_hi:[0,1,1]" : "+v"(acc) : "v"(wp), "v"(b));
    }
}
template <int HI, bool FIRST> DEVI void axpy16_fp8(const u32x4 q, f32x2_t wp, f32x2_t (&acc)[8]) {
#pragma unroll
    for (int j = 0; j < 4; ++j) { const f32x2_t lo = __builtin_amdgcn_cvt_pk_f32_fp8(q[j], false), hi = __builtin_amdgcn_cvt_pk_f32_fp8(q[j], true); pkfma_bc<HI, FIRST>(acc[2 * j], wp, lo); pkfma_bc<HI, FIRST>(acc[2 * j + 1], wp, hi); }
}
template <int K, bool FIRST> DEVI void axpy_row(const u32x4 q, const f32x4 w4, f32x2_t (&acc)[8]) {
    const f32x2_t wp = (K & 2) ? __builtin_shufflevector(w4, w4, 2, 3) : __builtin_shufflevector(w4, w4, 0, 1);
    axpy16_fp8<K & 1, FIRST>(q, wp, acc);
}
DEVI void swap32f(float& a, float& b) { const auto r = __builtin_amdgcn_permlane32_swap(__float_as_uint(a), __float_as_uint(b), false, false); a = __uint_as_float(r[0]); b = __uint_as_float(r[1]); }
DEVI void swap16f(float& a, float& b) { const auto r = __builtin_amdgcn_permlane16_swap(__float_as_uint(a), __float_as_uint(b), false, false); a = __uint_as_float(r[0]); b = __uint_as_float(r[1]); }
struct SliceGeo { int x, rank, n; };
struct Seg8 { u32x4 q[8]; };
struct Idx16 { i32x4 v[4]; };
DEVI void idx16_load(Idx16& I, const int* SI, int t, int r8) { const i32x4* s = (const i32x4*)(SI + (size_t)t * 128 + r8 * 16); I.v[0] = s[0]; I.v[1] = s[1]; I.v[2] = s[2]; I.v[3] = s[3]; }
DEVI void seg8_load(Seg8& s, const __amdgpu_buffer_rsrc_t tab, const Idx16& I, int half, unsigned coff) {
#pragma unroll
    for (int k = 0; k < 8; ++k) { const int row = I.v[2 * half + (k >> 2)][k & 3]; s.q[k] = __builtin_amdgcn_raw_buffer_load_b128(tab, (unsigned)row * 128u + coff, 0, 0); }
}
DEVI float reduce8_c8(const float (&d)[8], int lane) {
    const bool b2 = lane & 4, b1 = lane & 2, b0 = lane & 1;
    float r4[4], r2[2];
#pragma unroll
    for (int i = 0; i < 4; ++i) { const float keep = b2 ? d[i + 4] : d[i], send = b2 ? d[i] : d[i + 4]; r4[i] = keep + __shfl_xor(send, 4); }
#pragma unroll
    for (int i = 0; i < 2; ++i) { const float keep = b1 ? r4[i + 2] : r4[i], send = b1 ? r4[i] : r4[i + 2]; r2[i] = keep + __shfl_xor(send, 2); }
    const float keep = b0 ? r2[1] : r2[0], send = b0 ? r2[0] : r2[1];
    return keep + __shfl_xor(send, 1);
}
struct Seg16 { u32x4 q[16]; };
template <int M> DEVI void peer_u_mm(const __amdgpu_buffer_rsrc_t PU, Seg16& Q, const Idx16& In, const i32x4 (&hc)[2], unsigned coff, i32x4 (&acc)[8]) {
    asm volatile("" : "+v"(Q.q[M]));
    if (M & 1) acc[M >> 1] = __builtin_amdgcn_mfma_i32_16x16x64_i8(hc[1], (i32x4)Q.q[M], acc[M >> 1], 0, 0, 0);
    else       acc[M >> 1] = __builtin_amdgcn_mfma_i32_16x16x64_i8(hc[0], (i32x4)Q.q[M], (i32x4){0, 0, 0, 0}, 0, 0, 0);
    Q.q[M] = __builtin_amdgcn_raw_buffer_load_b128(PU, (unsigned)In.v[M >> 2][M & 3] * 128u + coff, 0, 0);
    asm volatile("" ::: "memory");
}
DEVI int qp_xor2(int v) { return __builtin_amdgcn_update_dpp(0, v, 0x4E, 0xf, 0xf, true); }
DEVI int qp_xor1(int v) { return __builtin_amdgcn_update_dpp(0, v, 0xB1, 0xf, 0xf, true); }
typedef unsigned u32x2 __attribute__((ext_vector_type(2)));
DEVI u32x2 slot_raw_load(const void* base, int t, int lane) { return *(const u32x2*)((const unsigned*)base + (size_t)t * 128 + 2 * lane); }
DEVI void slot_redist(LAS unsigned char* wl, const u32x2 raw, int lane, int l8, Idx16& I) {
    *(LAS u32x2*)(wl + 8 * lane) = raw;
    const LAS i32x4* s = (const LAS i32x4*)(wl + 64 * l8);
    I.v[0] = s[0]; I.v[1] = s[1]; I.v[2] = s[2]; I.v[3] = s[3];
}
DEVI void peer_u_token(const __amdgpu_buffer_rsrc_t PU, const int* SI, const unsigned char* H8, const float* HS, unsigned* PREP, LAS unsigned char* wl, int t, int t1, int t3, int x, int lane, int l8,
                       unsigned coff, bool act0, bool act1, const Idx16& In, Idx16& Inn, const u32x2 rawUse, u32x2& rawLoad, const i32x4 hraw, i32x4& hrawN, Seg16& Q) {
    rawLoad = slot_raw_load(SI, t3, lane);
    hrawN = *(const i32x4*)(H8 + (size_t)t1 * D);
    const float hs = HS[t];
    asm volatile("" ::: "memory");
    i32x4 hc[2];
#pragma unroll
    for (int e = 0; e < 4; ++e) { hc[0][e] = act0 ? hraw[e] : 0; hc[1][e] = act1 ? hraw[e] : 0; }
    i32x4 acc[8];
    peer_u_mm<0>(PU, Q, In, hc, coff, acc); peer_u_mm<1>(PU, Q, In, hc, coff, acc); peer_u_mm<2>(PU, Q, In, hc, coff, acc); peer_u_mm<3>(PU, Q, In, hc, coff, acc);
    peer_u_mm<4>(PU, Q, In, hc, coff, acc); peer_u_mm<5>(PU, Q, In, hc, coff, acc); peer_u_mm<6>(PU, Q, In, hc, coff, acc); peer_u_mm<7>(PU, Q, In, hc, coff, acc);
    peer_u_mm<8>(PU, Q, In, hc, coff, acc); peer_u_mm<9>(PU, Q, In, hc, coff, acc); peer_u_mm<10>(PU, Q, In, hc, coff, acc); peer_u_mm<11>(PU, Q, In, hc, coff, acc);
    peer_u_mm<12>(PU, Q, In, hc, coff, acc); peer_u_mm<13>(PU, Q, In, hc, coff, acc); peer_u_mm<14>(PU, Q, In, hc, coff, acc); peer_u_mm<15>(PU, Q, In, hc, coff, acc);
    slot_redist(wl, rawUse, lane, l8, Inn);
    const bool c1 = lane & 1, c2 = lane & 2;
    int w[8], r4[4], f[2];
#pragma unroll
    for (int a = 0; a < 8; ++a) { const int lo = c1 ? acc[a][1] : acc[a][0], hi = c1 ? acc[a][3] : acc[a][2]; w[a] = c2 ? hi : lo; }
#pragma unroll
    for (int i = 0; i < 4; ++i) { const int keep = c2 ? w[4 + i] : w[i], send = c2 ? w[i] : w[4 + i]; r4[i] = keep + qp_xor2(send); }
#pragma unroll
    for (int i = 0; i < 2; ++i) { const int keep = c1 ? r4[2 + i] : r4[i], send = c1 ? r4[i] : r4[2 + i]; f[i] = keep + qp_xor1(send); }
    PREP[((size_t)t * 8 + x) * 64 + lane] = pk2((float)f[0] * hs, (float)f[1] * hs);
}
DEVI void ph_peer_u(const P& p, int layer, int r0, const SliceGeo sg, unsigned char* lds) {
    const int otid_ = otid();
    const int wave = otid_ >> 6, lane = otid_ & 63, q = lane >> 4, j = lane & 15;
    const int x = __builtin_amdgcn_readfirstlane(sg.x), nws = __builtin_amdgcn_readfirstlane(sg.n * NWV);
    const __amdgpu_buffer_rsrc_t PU = __builtin_amdgcn_make_buffer_rsrc((void*)(p.ws + WS_PU + (size_t)layer * 16384 * 1024 + (size_t)x * 16384 * 128), (short)0, 16384 * 128, 0x00020000);
    const int* SI = (const int*)(p.ws + WS_SELI); const float* HS = (const float*)(p.ws + WS_HS);
    unsigned* PREP = (unsigned*)(p.ws + WS_SC);
    LAS unsigned char* wl = (LAS unsigned char*)lds + 1024 * wave;
    const int l8 = (q >> 1) * 4 + (j >> 2);
    const unsigned coff = 64u * (q & 1) + 16u * (j & 3);
    const unsigned char* H8 = p.ws + WS_H8 + 128 * x + coff;
    const bool act = (q >> 1) == ((j >> 2) & 1), act0 = act && (j >> 3) == 0, act1 = act && (j >> 3) == 1;
    int t = __builtin_amdgcn_readfirstlane(r0 + sg.rank * NWV + wave);
    if (t >= MA) return;
    Idx16 I0, I1; idx16_load(I0, SI, t, l8);
    asm volatile("" ::: "memory");
    u32x2 R0, R1; i32x4 H0, H1;
    { const int t1 = t + nws < MA ? t + nws : t, t2 = t + 2 * nws < MA ? t + 2 * nws : t1; idx16_load(I1, SI, t1, l8); R0 = slot_raw_load(SI, t2, lane); }
    H0 = *(const i32x4*)(H8 + (size_t)t * D);
    asm volatile("" ::: "memory");
    Seg16 Q;
#pragma unroll
    for (int k = 0; k < 16; ++k) { Q.q[k] = __builtin_amdgcn_raw_buffer_load_b128(PU, (unsigned)I0.v[k >> 2][k & 3] * 128u + coff, 0, 0); asm volatile("" ::: "memory"); }
    while (t < MA) {
        const int t1 = t + nws < MA ? t + nws : t, t2 = t + 2 * nws < MA ? t + 2 * nws : t1, t3 = t + 3 * nws < MA ? t + 3 * nws : t2, t4 = t + 4 * nws < MA ? t + 4 * nws : t3;
        peer_u_token(PU, SI, H8, HS, PREP, wl, t, t1, t3, x, lane, l8, coff, act0, act1, I1, I0, R0, R1, H0, H1, Q);
        peer_u_token(PU, SI, H8, HS, PREP, wl, t1, t2, t4, x, lane, l8, coff, act0, act1, I0, I1, R1, R0, H1, H0, Q);
        t += 2 * nws;
    }
}
struct PwLoad { unsigned pw[8]; float su0, su1, sg0, sg1; };
DEVI void peer_w_load(PwLoad& L, const P& p, int t, int lane, int sa, int sb) {
    const unsigned* pp = (const unsigned*)(p.ws + WS_SC) + (size_t)t * 512 + lane;
    const float* SG = (const float*)(p.ws + WS_SELG) + (size_t)t * 128; const float* SU = (const float*)(p.ws + WS_SELU) + (size_t)t * 128;
#pragma unroll
    for (int xx = 0; xx < 8; ++xx) L.pw[xx] = pp[xx * 64];
    L.su0 = SU[sa]; L.su1 = SU[sb]; L.sg0 = SG[sa]; L.sg1 = SG[sb];
}
DEVI void peer_w_finish(const PwLoad& L, const P& p, int t, int lane, int sa, int sb) {
    float p0 = 0.f, p1 = 0.f;
#pragma unroll
    for (int xx = 0; xx < 8; ++xx) { p0 += bflo(L.pw[xx]); p1 += bfhi(L.pw[xx]); }
    const float w0 = geluf_(p0 * L.su0) * L.sg0, w1 = geluf_(p1 * L.su1) * L.sg1;
    const float amax = wave_max_f(fmaxf(fabsf(w0), fabsf(w1)));
    const float sc = amax > 0.f ? 224.0f / amax : 1.0f;
    const float a0 = w0 * sc, a1 = w1 * sc;
    const unsigned hi = __builtin_amdgcn_cvt_pk_fp8_f32(a0, a1, 0u, false);
    const float h0 = __builtin_amdgcn_cvt_f32_fp8(hi, 0), h1 = __builtin_amdgcn_cvt_f32_fp8(hi, 1);
    const unsigned lo = __builtin_amdgcn_cvt_pk_fp8_f32(a0 - h0, a1 - h1, 0u, false);
    unsigned char* wt = p.ws + WS_SELU + (size_t)t * 512;
    wt[sa] = (unsigned char)(hi & 0xffu); wt[sb] = (unsigned char)((hi >> 8) & 0xffu); wt[128 + sa] = (unsigned char)(lo & 0xffu); wt[128 + sb] = (unsigned char)((lo >> 8) & 0xffu);
    if (lane == 0) *(float*)(wt + 256) = 1.0f / sc;
}
DEVI void ph_peer_w(const P& p, int r0) {
    const int otid_ = otid();
    const int wave = otid_ >> 6, lane = otid_ & 63, gw = blockIdx.x * NWV + wave, NGW = gridDim.x * NWV;
    const int sa = (4 * ((lane >> 4) & 1) + ((lane >> 2) & 3)) * 16 + 4 * (lane & 3) + (lane >> 5), sb = sa + 2;
    for (int t = r0 + gw; t < MA; t += 2 * NGW) {
        const int t1 = t + NGW;
        PwLoad A, B;
        peer_w_load(A, p, t, lane, sa, sb);
        if (t1 < MA) peer_w_load(B, p, t1, lane, sa, sb);
        asm volatile("" ::: "memory");
        peer_w_finish(A, p, t, lane, sa, sb);
        if (t1 < MA) peer_w_finish(B, p, t1, lane, sa, sb);
    }
}
template <int M> DEVI void peer_v_mm(const __amdgpu_buffer_rsrc_t PV, Seg16& Q, const i32x4 WH, const i32x4 WL, const Idx16& In, unsigned coff, const unsigned (&sel0)[4], const unsigned (&sel1)[4], f32x4 (&acc)[4]) {
    asm volatile("" : "+v"(Q.q[M]));
    const unsigned sh = (unsigned)WH[M >> 2], sl = (unsigned)WL[M >> 2];
    const unsigned h0 = __builtin_amdgcn_perm(sh, sh, sel0[M & 3]), h1 = __builtin_amdgcn_perm(sh, sh, sel1[M & 3]);
    const unsigned l0 = __builtin_amdgcn_perm(sl, sl, sel0[M & 3]), l1 = __builtin_amdgcn_perm(sl, sl, sel1[M & 3]);
    const long AH = (long)(((unsigned long)h1 << 32) | (unsigned long)h0), AL = (long)(((unsigned long)l1 << 32) | (unsigned long)l0);
    const long B0 = (long)(((unsigned long)Q.q[M][1] << 32) | (unsigned long)Q.q[M][0]), B1 = (long)(((unsigned long)Q.q[M][3] << 32) | (unsigned long)Q.q[M][2]);
    acc[0] = __builtin_amdgcn_mfma_f32_16x16x32_fp8_fp8(AH, B0, acc[0], 0, 0, 0); acc[1] = __builtin_amdgcn_mfma_f32_16x16x32_fp8_fp8(AH, B1, acc[1], 0, 0, 0);
    acc[2] = __builtin_amdgcn_mfma_f32_16x16x32_fp8_fp8(AL, B0, acc[2], 0, 0, 0); acc[3] = __builtin_amdgcn_mfma_f32_16x16x32_fp8_fp8(AL, B1, acc[3], 0, 0, 0);
    Q.q[M] = __builtin_amdgcn_raw_buffer_load_b128(PV, (unsigned)In.v[M >> 2][M & 3] * 128u + coff, 0, 0);
    asm volatile("" ::: "memory");
}
DEVI void ph_peer_v(const P& p, int layer, int r0, const SliceGeo sg, unsigned char* lds) {
    const int otid_ = otid();
    const int wave = otid_ >> 6, lane = otid_ & 63, q = lane >> 4, j = lane & 15;
    const int x = __builtin_amdgcn_readfirstlane(sg.x), nws = __builtin_amdgcn_readfirstlane(sg.n * NWV);
    const __amdgpu_buffer_rsrc_t PV = __builtin_amdgcn_make_buffer_rsrc((void*)(p.ws + WS_PV + (size_t)layer * 16384 * 1024 + (size_t)x * 16384 * 128), (short)0, 16384 * 128, 0x00020000);
    const int* SI = (const int*)(p.ws + WS_SELI); const unsigned char* W8 = p.ws + WS_SELU;
    bf16_t* OUTP = (bf16_t*)(p.ws + WS_SC + (size_t)MA * 4096);
    LAS unsigned char* wl = (LAS unsigned char*)lds + 1024 * wave;
    const int l8 = 2 * q + (j >> 3);
    const unsigned coff = 16u * (j & 7);
    unsigned sel0[4], sel1[4];
#pragma unroll
    for (int k = 0; k < 4; ++k) { const unsigned pl = 0x0c0c0c0cu ^ ((0x0cu ^ (unsigned)k) << (8 * (j & 3))); sel0[k] = (j & 4) ? 0x0c0c0c0cu : pl; sel1[k] = (j & 4) ? pl : 0x0c0c0c0cu; }
    const int bp = 4 * ((lane + 40) & 63);
    int t = __builtin_amdgcn_readfirstlane(r0 + sg.rank * NWV + wave);
    if (t >= MA) return;
    Idx16 In; i32x4 WH, WL; Seg16 Q; u32x2 rawI, rawW; float sinv;
    {
        const int t1 = t + nws < MA ? t + nws : t, t2 = t + 2 * nws < MA ? t + 2 * nws : t1;
        const u32x2 ri0 = slot_raw_load(SI, t, lane), ri1 = slot_raw_load(SI, t1, lane), rw0 = slot_raw_load(W8, t, lane);
        asm volatile("" ::: "memory");
        rawI = slot_raw_load(SI, t2, lane); rawW = slot_raw_load(W8, t1, lane);
        asm volatile("" ::: "memory");
        slot_redist(wl, ri0, lane, l8, In);
#pragma unroll
        for (int m = 0; m < 16; ++m) { Q.q[m] = __builtin_amdgcn_raw_buffer_load_b128(PV, (unsigned)In.v[m >> 2][m & 3] * 128u + coff, 0, 0); asm volatile("" ::: "memory"); }
        slot_redist(wl, ri1, lane, l8, In);
        *(LAS u32x2*)(wl + 512 + 8 * lane) = rw0;
        WH = *(const LAS i32x4*)(wl + 512 + 16 * l8); WL = *(const LAS i32x4*)(wl + 640 + 16 * l8); sinv = *(const LAS float*)(wl + 768);
    }
    while (t < MA) {
        const int t1 = t + nws < MA ? t + nws : t, t2 = t + 2 * nws < MA ? t + 2 * nws : t1, t3 = t + 3 * nws < MA ? t + 3 * nws : t2;
        const u32x2 rawIn = slot_raw_load(SI, t3, lane), rawWn = slot_raw_load(W8, t2, lane);
        asm volatile("" ::: "memory");
        f32x4 acc[4] = {(f32x4){0.f, 0.f, 0.f, 0.f}, (f32x4){0.f, 0.f, 0.f, 0.f}, (f32x4){0.f, 0.f, 0.f, 0.f}, (f32x4){0.f, 0.f, 0.f, 0.f}};
        peer_v_mm<0>(PV, Q, WH, WL, In, coff, sel0, sel1, acc); peer_v_mm<1>(PV, Q, WH, WL, In, coff, sel0, sel1, acc); peer_v_mm<2>(PV, Q, WH, WL, In, coff, sel0, sel1, acc); peer_v_mm<3>(PV, Q, WH, WL, In, coff, sel0, sel1, acc);
        peer_v_mm<4>(PV, Q, WH, WL, In, coff, sel0, sel1, acc); peer_v_mm<5>(PV, Q, WH, WL, In, coff, sel0, sel1, acc); peer_v_mm<6>(PV, Q, WH, WL, In, coff, sel0, sel1, acc); peer_v_mm<7>(PV, Q, WH, WL, In, coff, sel0, sel1, acc);
        peer_v_mm<8>(PV, Q, WH, WL, In, coff, sel0, sel1, acc); peer_v_mm<9>(PV, Q, WH, WL, In, coff, sel0, sel1, acc); peer_v_mm<10>(PV, Q, WH, WL, In, coff, sel0, sel1, acc); peer_v_mm<11>(PV, Q, WH, WL, In, coff, sel0, sel1, acc);
        peer_v_mm<12>(PV, Q, WH, WL, In, coff, sel0, sel1, acc); peer_v_mm<13>(PV, Q, WH, WL, In, coff, sel0, sel1, acc); peer_v_mm<14>(PV, Q, WH, WL, In, coff, sel0, sel1, acc); peer_v_mm<15>(PV, Q, WH, WL, In, coff, sel0, sel1, acc);
        const float sv = sinv;
        slot_redist(wl, rawI, lane, l8, In);
        *(LAS u32x2*)(wl + 512 + 8 * lane) = rawW;
        WH = *(const LAS i32x4*)(wl + 512 + 16 * l8); WL = *(const LAS i32x4*)(wl + 640 + 16 * l8); sinv = *(const LAS float*)(wl + 768);
        float A[4], Bv[4];
#pragma unroll
        for (int r = 0; r < 4; ++r) {
            const float a = acc[0][r] + acc[2][r], b = acc[1][r] + acc[3][r];
            A[r] = (a + __int_as_float(__builtin_amdgcn_ds_bpermute(bp, __float_as_int(a)))) * sv;
            Bv[r] = (b + __int_as_float(__builtin_amdgcn_ds_bpermute(bp, __float_as_int(b)))) * sv;
        }
#pragma unroll
        for (int r = 0; r < 4; ++r) swap16f(A[r], Bv[r]);
        if (j < 8 && q < 2) { u32x4 pk; pk[0] = pk2(A[0], A[1]); pk[1] = pk2(A[2], A[3]); pk[2] = pk2(Bv[0], Bv[1]); pk[3] = pk2(Bv[2], Bv[3]);
            *(u32x4*)(OUTP + (size_t)t * D + 128 * x + 16 * j + 8 * q) = pk; }
        rawI = rawIn; rawW = rawWn; t += nws;
    }
}
struct FinPar { Row16 g2; NormAB n; };
DEVI void finpar_load(FinPar& f, const P& p, int layer, int cls, int next_mode, int lane) {
    load_row_f32(mod_ptr(p, layer, cls, 5), lane, f.g2);
    const int ln = next_mode == 0 ? layer + 1 : layer; const float m = next_mode == 0 ? 1.0f : 0.0f;
    Row16 gg, sc, sh; load_row_f32(next_mode == 0 ? p.in[I_N1G] + ln * D : p.in[I_FG], lane, gg); load_row_f32(mod_ptr(p, ln, cls, 1), lane, sc); load_row_f32(mod_ptr(p, ln, cls, 0), lane, sh);
#pragma unroll
    for (int j = 0; j < 16; ++j) { f.n.A.v[j] = gg.v[j] * (1.0f + m * sc.v[j]); f.n.B.v[j] = m * sh.v[j]; }
}
DEVI void fin_row(const P& p, int r, int lane, int next_mode, Row16& x, const Row16& a, const FinPar& f) {
#pragma unroll
    for (int j = 0; j < 16; ++j) x.v[j] += f.g2.v[j] * a.v[j];
    if (next_mode == 0) {
        store_row_f32((float*)(p.ws + WS_X) + (size_t)r * D, lane, x);
        Row16 o; norm_ab(x, f.n, o);
        store_row_bf16((bf16_t*)(p.ws + WS_XN) + (size_t)r * D, lane, o);
    } else if (r >= TC) {
        Row16 o; norm_ab(x, f.n, o);
        store_row_f32(p.out + (size_t)(r - TC) * D, lane, o);
    }
}
DEVI void ph_peer_fin(const P& p, int layer, int r0, int next_mode) {
    const int otid_ = otid();
    const int wave = __builtin_amdgcn_readfirstlane(otid_ >> 6), lane = otid_ & 63, gw = blockIdx.x * NWV + wave, NGW = gridDim.x * NWV;
    const bf16_t* OUTP = (const bf16_t*)(p.ws + WS_SC + (size_t)MA * 4096);
    FinPar fl; finpar_load(fl, p, layer, 0, next_mode, lane);
    for (int r = r0 + gw; r < MA; r += 2 * NGW) {
        const int r1 = r + NGW;
        Row16 x0, a0, x1, a1;
        load_row_f32((const float*)(p.ws + WS_X) + (size_t)r * D, lane, x0); load_row_bf16(OUTP + (size_t)r * D, lane, a0);
        if (r1 < MA) { load_row_f32((const float*)(p.ws + WS_X) + (size_t)r1 * D, lane, x1); load_row_bf16(OUTP + (size_t)r1 * D, lane, a1); }
        FinPar f0 = fl;
        if (r < TC) finpar_load(f0, p, layer, 1, next_mode, lane);
        fin_row(p, r, lane, next_mode, x0, a0, f0);
        if (r1 < MA) fin_row(p, r1, lane, next_mode, x1, a1, fl);
    }
}

#define XB_TMO      128
#define XB_XCNT(j)  (256  + 64 * (j))
#define XB_XSUB(j)  (1280 + 64 * (j))
#define XB_XGEN(j)  (2304 + 64 * (j))
#define XB_TOP      3328
#define XB_TOPGEN   3392
#define XCD_BAR_WORDS 3456
#define XB_SPIN_CAP (1u << 20)
DEVI unsigned xb_ld(unsigned* p)              { return __hip_atomic_load(p, __ATOMIC_RELAXED, __HIP_MEMORY_SCOPE_AGENT); }
DEVI unsigned xb_add(unsigned* p, unsigned v) { return __hip_atomic_fetch_add(p, v, __ATOMIC_RELAXED, __HIP_MEMORY_SCOPE_AGENT); }
DEVI unsigned xb_xcc_id() { return (unsigned)__builtin_amdgcn_s_getreg((3 << 11) | 20) & 0xFu; }
#define XB_SPIN(cond, bar) do { unsigned _sp = 0; while (cond) { __builtin_amdgcn_s_sleep(1); \
    if ((++_sp & 255u) == 0u) { if (xb_ld(&(bar)[XB_TMO])) break; if (_sp > XB_SPIN_CAP) { atomicAdd(&(bar)[XB_TMO], 1u); break; } } } } while (0)
struct XcdBarrier { unsigned* bar; unsigned x; volatile LAS unsigned* st; };
DEVI XcdBarrier xcd_barrier_post(unsigned* bar, volatile LAS unsigned* st) {
    XcdBarrier b; b.bar = bar; b.x = xb_xcc_id(); b.st = st;
    if (threadIdx.x == 0) st[2] = xb_add(&bar[XB_XCNT(b.x)], 1u);
    return b;
}
DEVI void xcd_barrier_complete(unsigned* bar, unsigned x, unsigned& nloc, unsigned& nx) {
    const unsigned G = gridDim.x * gridDim.y * gridDim.z;
    unsigned sum, cnt, mine, sp = 0u;
    for (;;) {
        sum = 0u; cnt = 0u; mine = 0u;
#pragma unroll
        for (unsigned j = 0; j < 16; ++j) { const unsigned c = xb_ld(&bar[XB_XCNT(j)]); sum += c; cnt += (c > 0u) ? 1u : 0u; mine = (j == x) ? c : mine; }
        if (sum == G) break;
        __builtin_amdgcn_s_sleep(1);
        if ((++sp & 255u) == 0u) { if (xb_ld(&bar[XB_TMO])) break; if (sp > XB_SPIN_CAP) { atomicAdd(&bar[XB_TMO], 1u); break; } }
    }
    nloc = mine > 0u ? mine : 1u; nx = cnt > 0u ? cnt : 1u;
}
DEVI void xcd_barrier(const XcdBarrier& b) {
    asm volatile("s_waitcnt vmcnt(0)" ::: "memory");
    __syncthreads();
    if (threadIdx.x == 0) {
        unsigned* bar = b.bar;
        __builtin_amdgcn_s_waitcnt(0);
        unsigned nloc = b.st[0], nx = b.st[1];
        if (nloc == 0u) { xcd_barrier_complete(bar, b.x, nloc, nx); b.st[0] = nloc; b.st[1] = nx; }
        const unsigned old = xb_add(&bar[XB_XSUB(b.x)], 1u);
        const unsigned gen = old / nloc;
        if (old + 1u == (gen + 1u) * nloc) {
            __builtin_amdgcn_fence(__ATOMIC_RELEASE, "agent");
            asm volatile("s_waitcnt vmcnt(0)" ::: "memory");
            const unsigned og = xb_add(&bar[XB_TOP], 1u);
            const unsigned tg = og / nx;
            if (og + 1u == (tg + 1u) * nx) xb_add(&bar[XB_TOPGEN], 1u);
            else XB_SPIN(xb_ld(&bar[XB_TOPGEN]) == tg, bar);
            __builtin_amdgcn_fence(__ATOMIC_ACQUIRE, "agent");
            xb_add(&bar[XB_XGEN(b.x)], 1u);
            asm volatile("s_waitcnt vmcnt(0)" ::: "memory");
        } else {
            XB_SPIN(xb_ld(&bar[XB_XGEN(b.x)]) == gen, bar);
            __builtin_amdgcn_fence(__ATOMIC_ACQUIRE, "agent");
            asm volatile("s_waitcnt vmcnt(0)" ::: "memory");
        }
    }
    __syncthreads();
}

DEVI SliceGeo slice_geo(const P& p, unsigned char* lds) {
    SliceGeo g;
    unsigned* bar = (unsigned*)(p.ws + WS_CTL);
    volatile LAS unsigned* st = (volatile LAS unsigned*)(lds + LDS_BYTES - 64);
    unsigned cnt[8]; unsigned tot = 0; bool ok = true;
#pragma unroll
    for (int j = 0; j < 8; ++j) { cnt[j] = xb_ld(&bar[XB_XCNT(j)]); tot += cnt[j]; ok = ok && cnt[j] > 0u; }
    const unsigned xcc = xb_xcc_id();
    if (ok && tot == gridDim.x && xcc < 8u) { g.x = (int)xcc; g.rank = (int)st[2]; g.n = 0;
#pragma unroll
        for (int j = 0; j < 8; ++j) g.n = (j == (int)xcc) ? (int)cnt[j] : g.n; }
    else { g.x = blockIdx.x & 7; g.rank = blockIdx.x >> 3; g.n = ((int)gridDim.x - g.x + 7) >> 3; }
    g.x = __builtin_amdgcn_readfirstlane(g.x); g.rank = __builtin_amdgcn_readfirstlane(g.rank); g.n = __builtin_amdgcn_readfirstlane(g.n);
    return g;
}

struct CtxBf16 { bf16_t* O; int ldc; DEVI void operator()(int tok, int n, const f32x4 v) const { *(u32x2*)(O + (size_t)tok * ldc + n) = (u32x2){pk2(v[0], v[1]), pk2(v[2], v[3])}; } };
struct CtxHgrnIn { bf16_t* O; const float* lbv;
    DEVI void operator()(int tok, int n, const f32x4 v) const { const int blk = n >> 10; float x[4] = {v[0], v[1], v[2], v[3]};
#pragma unroll
        for (int j = 0; j < 4; ++j) {
            if (blk == 0 || blk == 4) x[j] = x[j] / (1.0f + __expf(-x[j]));
            else if (blk == 2 || blk == 3) { const float lb = lbv[(blk - 2) * 1024 + (n & 1023) + j]; x[j] = __logf(lb + (1.0f - lb) / (1.0f + __expf(-x[j]))); } }
        *(u32x2*)(O + (size_t)tok * 5120 + n) = (u32x2){pk2(x[0], x[1]), pk2(x[2], x[3])}; } };
struct CtxF16 { unsigned short* O; int ldc; DEVI void operator()(int tok, int n, const f32x4 v) const { *(u32x2*)(O + (size_t)tok * ldc + n) = (u32x2){pg8::pkh2(v[0], v[1]), pg8::pkh2(v[2], v[3])}; } };
struct CtxResid { float* X; const float* gate; DEVI void operator()(int tok, int n, const f32x4 v) const { f32x4* q = (f32x4*)(X + (size_t)tok * D + n); *q = *q + *(const f32x4*)(gate + n) * v; } };
template <class Epi>
DEVI void ctx_gemm(const bf16_t* A, const bf16_t* Bt, int N, const Epi& epi, unsigned char* lds_) {
    typedef short bf16x8 __attribute__((ext_vector_type(8)));
    const int otid_ = otid();
    const int wave = otid_ >> 6, lane = otid_ & 63, c = lane & 15, q4 = lane >> 4;
    LAS f32x4* red = (LAS f32x4*)lds_;
    const int npieces = (TC / 32) * (N / 64);
    for (int pc = blockIdx.x; pc < npieces; pc += gridDim.x) {
        const int mt = pc & 7, nt = pc >> 3;
        const bf16_t* ap = A + (size_t)(32 * mt + c) * D + 8 * q4 + 128 * wave;
        const bf16_t* bp = Bt + (size_t)(64 * nt + c) * D + 8 * q4 + 128 * wave;
        bf16x8 a0[4], a1[4], bf[4][4];
#pragma unroll
        for (int s4 = 0; s4 < 4; ++s4) { a0[s4] = *(const bf16x8*)(ap + 32 * s4); a1[s4] = *(const bf16x8*)(ap + 16 * D + 32 * s4);
#pragma unroll
            for (int j = 0; j < 4; ++j) bf[j][s4] = *(const bf16x8*)(bp + (size_t)(16 * j) * D + 32 * s4); }
        f32x4 acc[4][2];
#pragma unroll
        for (int j = 0; j < 4; ++j) { acc[j][0] = (f32x4){0.f, 0.f, 0.f, 0.f}; acc[j][1] = acc[j][0]; }
#pragma unroll
        for (int s4 = 0; s4 < 4; ++s4)
#pragma unroll
            for (int j = 0; j < 4; ++j) { acc[j][0] = __builtin_amdgcn_mfma_f32_16x16x32_bf16(bf[j][s4], a0[s4], acc[j][0], 0, 0, 0); acc[j][1] = __builtin_amdgcn_mfma_f32_16x16x32_bf16(bf[j][s4], a1[s4], acc[j][1], 0, 0, 0); }
        __syncthreads();
#pragma unroll
        for (int j = 0; j < 4; ++j)
#pragma unroll
            for (int i = 0; i < 2; ++i) red[(wave * 8 + (j * 2 + i)) * 64 + lane] = acc[j][i];
        __syncthreads();
        f32x4 sum = {0.f, 0.f, 0.f, 0.f};
#pragma unroll
        for (int ww = 0; ww < 8; ++ww) sum += red[(ww * 8 + wave) * 64 + lane];
        epi(32 * mt + 16 * (wave & 1) + c, 64 * nt + 16 * (wave >> 1) + 4 * q4, sum);
    }
    __syncthreads();
}

DEVI void gemm_bf16(const P& p, const bf16_t* A, const bf16_t* Bt, int r0, int N, bf16_t* O, int ldc, unsigned char* lds) {
    pg8::Gemm g{A + (size_t)r0 * D, Bt, MA - r0, N, D}; pg8::StaticOrder S; S.init(MA - r0, N, (int)gridDim.x, (int)blockIdx.x);
    pg8::EpiBf16 E{O, ldc, r0};
    pg8::gemm_phase<pg8::EpiBf16, pg8::StaticOrder, true, true>((PG8_LAS unsigned char*)lds, g, S, E);
}
DEVI void gemm_hgrn_in(const P& p, const bf16_t* A, const bf16_t* Bt, unsigned char* lds) {
    pg8::Gemm g{A + (size_t)TC * D, Bt, T, 5120, D}; pg8::StaticOrder S; S.init(T, 5120, (int)gridDim.x, (int)blockIdx.x);
    pg8::EpiHgrnIn E{(bf16_t*)(p.ws + WS_G), 5120, TC, (const float*)(p.ws + WS_LB)};
    pg8::gemm_phase<pg8::EpiHgrnIn, pg8::StaticOrder, true, true>((PG8_LAS unsigned char*)lds, g, S, E);
}
DEVI void gemm_f16(const P& p, const bf16_t* A, const bf16_t* Bt, int r0, int N, unsigned short* O, int ldc, unsigned char* lds) {
    pg8::Gemm g{A + (size_t)r0 * D, Bt, MA - r0, N, D}; pg8::StaticOrder S; S.init(MA - r0, N, (int)gridDim.x, (int)blockIdx.x);
    pg8::EpiF16 E{O, ldc, r0};
    pg8::gemm_phase<pg8::EpiF16, pg8::StaticOrder, true, true>((PG8_LAS unsigned char*)lds, g, S, E);
}
DEVI void gemm_glu_resid(const P& p, const bf16_t* A, const bf16_t* Bt, int layer, unsigned char* lds) {
    pg8::Gemm g{A + (size_t)TC * D, Bt, T, 2048, D}; pg8::StaticOrder S; S.init(T, 2048, (int)gridDim.x, (int)blockIdx.x);
    pg8::EpiGluResid E{(float*)(p.ws + WS_X), mod_ptr(p, layer, 0, 2), TC};
    pg8::gemm_phase<pg8::EpiGluResid, pg8::StaticOrder, true, true>((PG8_LAS unsigned char*)lds, g, S, E);
}
DEVI void gemm_resid(const P& p, const bf16_t* A, const bf16_t* Bt, int r0, int layer, unsigned char* lds) {
    pg8::Gemm g{A + (size_t)r0 * D, Bt, MA - r0, D, D}; pg8::StaticOrder S; S.init(MA - r0, D, (int)gridDim.x, (int)blockIdx.x);
    pg8::EpiResid E{(float*)(p.ws + WS_X), mod_ptr(p, layer, 0, 2), mod_ptr(p, layer, 1, 2), r0, TC};
    pg8::gemm_phase<pg8::EpiResid, pg8::StaticOrder, true, true>((PG8_LAS unsigned char*)lds, g, S, E);
}

enum { PH_P0 = 0, PH_INIT, PH_GEMM_IN, PH_HGP1, PH_MIX1, PH_MIX2, PH_GEMM_OUT, PH_NORM2, PH_SCORES, PH_TOPK, PH_PEERU, PH_PEERW, PH_PEERV, PH_PEERF };

DEVI void run_phase(const P& p, int ph, int layer, unsigned char* lds) {
    const int kind = layer % 3, jj = layer / 3;
    const int r0 = (layer >= 2) ? TC : 0;
    bf16_t* WT = (bf16_t*)(p.ws + WS_WT);
    switch (ph) {
    case PH_P0: ph_ada(p, lds); ph_lb(p); ph_s5disc(p); __syncthreads(); ph_transposes(p, lds); __syncthreads(); ph_fold(p); ph_tables(p); break;
    case PH_INIT: ph_init_norm(p); break;
    case PH_GEMM_IN:
        if (kind == 0) { const bf16_t* W = WT + WT_CIN / 2 + (size_t)jj * 3072 * 1024;
            if (r0 == 0) ctx_gemm((const bf16_t*)(p.ws + WS_XN), W, 3072, CtxBf16{(bf16_t*)(p.ws + WS_G), 3072}, lds);
            gemm_bf16(p, (const bf16_t*)(p.ws + WS_XN), W, TC, 3072, (bf16_t*)(p.ws + WS_G), 3072, lds); }
        else if (kind == 1) { ctx_gemm((const bf16_t*)(p.ws + WS_XN), WT + WT_HIN / 2, 5120, CtxHgrnIn{(bf16_t*)(p.ws + WS_G), (const float*)(p.ws + WS_LB)}, lds);
            gemm_hgrn_in(p, (const bf16_t*)(p.ws + WS_XN), WT + WT_HIN / 2, lds); }
        break;
    case PH_HGP1: if (kind == 1) hg::scan<false>(p, lds); else s5::scan<false>(p, lds); break;
    case PH_MIX1:
        if (kind == 0) ph_conv(p, jj, r0); else if (kind == 1) hg::scan<true>(p, lds); else s5::scan<true>(p, lds);
        break;
    case PH_MIX2:
        if (kind == 1) ph_hgrn_readout(p); else if (kind == 2) ph_s5_elem(p);
        break;
    case PH_GEMM_OUT:
        if (kind == 0) { const bf16_t* W = WT + WT_COUT / 2 + (size_t)jj * 1024 * 1024;
            if (r0 == 0) ctx_gemm((const bf16_t*)(p.ws + WS_U), W, 1024, CtxResid{(float*)(p.ws + WS_X), mod_ptr(p, layer, 1, 2)}, lds);
            gemm_resid(p, (const bf16_t*)(p.ws + WS_U), W, TC, layer, lds); }
        else if (kind == 1) { ctx_gemm((const bf16_t*)(p.ws + WS_U), WT + WT_HOUT / 2, 1024, CtxResid{(float*)(p.ws + WS_X), mod_ptr(p, layer, 1, 2)}, lds);
            gemm_resid(p, (const bf16_t*)(p.ws + WS_U), WT + WT_HOUT / 2, TC, layer, lds); }
        else gemm_glu_resid(p, (const bf16_t*)(p.ws + WS_U), WT + WT_GLU / 2, layer, lds);
        break;
    case PH_NORM2: ph_norm2(p, layer, r0); break;
    case PH_SCORES: { const bf16_t* W = (const bf16_t*)(p.ws + WS_WQK) + (size_t)layer * 2048 * 1024;
        if (r0 == 0) ctx_gemm((const bf16_t*)(p.ws + WS_XN), W, 2048, CtxF16{(unsigned short*)(p.ws + WS_SCH), 2048}, lds);
        gemm_f16(p, (const bf16_t*)(p.ws + WS_XN), W, TC, 2048, (unsigned short*)(p.ws + WS_SCH), 2048, lds); } break;
    case PH_TOPK: ph_topk(p, layer, r0, lds); break;
    case PH_PEERU: ph_peer_u(p, layer, r0, slice_geo(p, lds), lds); break;
    case PH_PEERW: ph_peer_w(p, r0); break;
    case PH_PEERV: ph_peer_v(p, layer, r0, slice_geo(p, lds), lds); break;
    case PH_PEERF: ph_peer_fin(p, layer, r0, layer == 3 ? 1 : 0); break;
    }
}

#ifndef MK_MULTI
#define MK_MULTI 0
#endif
#if MK_MULTI
__global__ void __launch_bounds__(NTHR, 2) k_fwd(P p) {
    extern __shared__ __attribute__((aligned(16))) unsigned char lds[];
    run_phase(p, p.ph, p.arg, lds);
}
#else
__global__ void __launch_bounds__(NTHR, 2) k_fwd(P p) {
    extern __shared__ __attribute__((aligned(16))) unsigned char lds[];
    volatile LAS unsigned* st = (volatile LAS unsigned*)(lds + LDS_BYTES - 64);
    if (threadIdx.x < 16) st[threadIdx.x] = 0u;
    __syncthreads();
    const XcdBarrier bar = xcd_barrier_post((unsigned*)(p.ws + WS_CTL), st);
#define SYNC() xcd_barrier(bar)
    run_phase(p, PH_P0, 0, lds); SYNC();
    run_phase(p, PH_INIT, 0, lds); SYNC();
#pragma unroll 1
    for (int layer = 0; layer < DEPTH; ++layer) {
        const int kind = layer % 3;
        if (kind != 2) { run_phase(p, PH_GEMM_IN, layer, lds); SYNC(); }
        if (kind != 0) { run_phase(p, PH_HGP1, layer, lds); SYNC(); }
        run_phase(p, PH_MIX1, layer, lds); SYNC();
        if (kind != 0) { run_phase(p, PH_MIX2, layer, lds); SYNC(); }
        run_phase(p, PH_GEMM_OUT, layer, lds); SYNC();
        run_phase(p, PH_NORM2, layer, lds); SYNC();
        run_phase(p, PH_SCORES, layer, lds); SYNC();
        run_phase(p, PH_TOPK, layer, lds); SYNC();
        run_phase(p, PH_PEERU, layer, lds); SYNC();
        run_phase(p, PH_PEERW, layer, lds); SYNC();
        run_phase(p, PH_PEERV, layer, lds); SYNC();
        run_phase(p, PH_PEERF, layer, lds);
        if (layer != DEPTH - 1) SYNC();
    }
}
#endif

extern "C" void kernel_launch(void* const* d_in, const int* in_sizes, int n_in, void* d_out, int out_size, void* d_ws, size_t ws_size, hipStream_t stream) {
    static int grid = 0;
    if (grid == 0) {
        if (n_in != N_IN || out_size != T * D || ws_size < WS_END) { fprintf(stderr, "kernel_launch: unexpected shapes n_in %d out %d ws %zu\n", n_in, out_size, ws_size); grid = -1; return; }
        int dev = 0, cus = 0, per_cu = 0;
        if (hipGetDevice(&dev) != hipSuccess || hipDeviceGetAttribute(&cus, hipDeviceAttributeMultiprocessorCount, dev) != hipSuccess) { grid = -1; return; }
        if (hipFuncSetAttribute((const void*)k_fwd, hipFuncAttributeMaxDynamicSharedMemorySize, LDS_BYTES) != hipSuccess) { fprintf(stderr, "kernel_launch: hipFuncSetAttribute failed\n"); grid = -1; return; }
        if (hipOccupancyMaxActiveBlocksPerMultiprocessor(&per_cu, (const void*)k_fwd, NTHR, LDS_BYTES) != hipSuccess || per_cu < 1) { fprintf(stderr, "kernel_launch: occupancy query says %d blocks/CU\n", per_cu); }
        (void)hipGetLastError();
        grid = cus;
    }
    if (grid < 0) return;
    P p{};
    for (int i = 0; i < N_IN; ++i) p.in[i] = (const float*)d_in[i];
    p.out = (float*)d_out; p.ws = (unsigned char*)d_ws;
#if MK_MULTI
    auto launch = [&](int ph, int arg) { p.ph = ph; p.arg = arg; hipLaunchKernelGGL(k_fwd, dim3(grid), dim3(NTHR), LDS_BYTES, stream, p); };
    launch(PH_P0, 0); launch(PH_INIT, 0);
    for (int layer = 0; layer < DEPTH; ++layer) {
        const int kind = layer % 3;
        if (kind != 2) launch(PH_GEMM_IN, layer);
        if (kind != 0) launch(PH_HGP1, layer);
        launch(PH_MIX1, layer);
        if (kind != 0) launch(PH_MIX2, layer);
        launch(PH_GEMM_OUT, layer);
        launch(PH_NORM2, layer); launch(PH_SCORES, layer); launch(PH_TOPK, layer); launch(PH_PEERU, layer); launch(PH_PEERW, layer); launch(PH_PEERV, layer); launch(PH_PEERF, layer);
    }
#else
    if (hipMemsetAsync((char*)d_ws + WS_CTL, 0, 65536, stream) != hipSuccess) { fprintf(stderr, "kernel_launch: memset failed\n"); return; }
    void* args[] = {&p};
    const hipError_t e = hipLaunchCooperativeKernel((const void*)k_fwd, dim3(grid), dim3(NTHR), args, LDS_BYTES, stream);
    if (e != hipSuccess) fprintf(stderr, "kernel_launch: cooperative launch failed: %s (grid %d)\n", hipGetErrorString(e), grid);
#endif
}
```

```cpp
#include <hip/hip_runtime.h>
#include <cstdint>
#include <cstdio>

#define DEVI __device__ __forceinline__
#define LAS __attribute__((address_space(3)))
typedef unsigned short bf16_t;
typedef float f32x4 __attribute__((ext_vector_type(4)));
typedef unsigned u32x4 __attribute__((ext_vector_type(4)));
typedef unsigned u32x2 __attribute__((ext_vector_type(2)));
typedef int i32x4 __attribute__((ext_vector_type(4)));
typedef __bf16 bf16x2_t __attribute__((ext_vector_type(2)));

constexpr int D = 1024, T = 16384, TC = 256, MA = T + TC, DEPTH = 4;
constexpr int NTHR = 512, NWV = 8;
constexpr float EPS = 1e-6f;

constexpr size_t MiB = 1u << 20;
constexpr size_t WS_CTL = 0;
constexpr size_t WS_MOD = 1 * MiB;
constexpr size_t WS_LB = WS_MOD + 256 * 1024;
constexpr size_t WS_S5A = 2 * MiB;
constexpr size_t WS_S5B = 3 * MiB;
constexpr size_t WS_X = 8 * MiB;
constexpr size_t WS_XN = 73 * MiB;
constexpr size_t WS_U = 106 * MiB;
constexpr size_t WS_OF = 139 * MiB;
constexpr size_t WS_OB = 172 * MiB;
constexpr size_t WS_G = 205 * MiB;
constexpr size_t WS_SC = 368 * MiB;
constexpr size_t WS_SELI = 498 * MiB;
constexpr size_t WS_SELG = 507 * MiB;
constexpr size_t WS_WQK = 516 * MiB;
constexpr size_t WS_WT = 532 * MiB;
constexpr size_t WT_CIN = 0, WT_COUT = 12 * MiB, WT_HIN = 16 * MiB, WT_HOUT = 26 * MiB, WT_GLU = 28 * MiB;
constexpr size_t WS_PU = 564 * MiB;
constexpr size_t WS_PV = 628 * MiB;
constexpr size_t WS_SCL = 692 * MiB;
constexpr size_t WS_H8 = 770 * MiB;
constexpr size_t WS_HS = 788 * MiB;
constexpr size_t WS_SCH = 704 * MiB;
constexpr size_t WS_SELU = 694 * MiB;
constexpr size_t WS_XE = 820 * MiB;
constexpr size_t WS_END = 822 * MiB;

constexpr int LDS_BYTES = 147456;

enum { I_X = 0, I_C, I_CTX, I_CCTX, I_ADAW, I_ADAB, I_N1G, I_N2G, I_CWIN, I_CK, I_CWOUT, I_HWIN, I_HLB, I_HNG, I_HWOUT,
       I_S5LR, I_S5LI, I_S5LS, I_S5BR, I_S5BI, I_S5CR, I_S5CI, I_S5D, I_S5GLU, I_PWQ, I_PKEYS, I_PU, I_PV, I_FG, N_IN };

struct P {
    const float* in[N_IN];
    float* out;
    unsigned char* ws;
    int ph, arg;
};

DEVI unsigned f2bf(float f) { unsigned u = __float_as_uint(f); return (u + 0x7fffu + ((u >> 16) & 1u)) >> 16; }
typedef float f32x2_t __attribute__((ext_vector_type(2)));
DEVI unsigned pk2(float lo, float hi) { f32x2_t f = {lo, hi}; return __builtin_bit_cast(unsigned, __builtin_convertvector(f, bf16x2_t)); }
DEVI float bflo(unsigned w) { return __uint_as_float(w << 16); }
DEVI float bfhi(unsigned w) { return __uint_as_float(w & 0xffff0000u); }
DEVI float bf2f(bf16_t b) { return __uint_as_float((unsigned)b << 16); }
DEVI float sigmoidf_(float x) { return 1.0f / (1.0f + __expf(-x)); }
DEVI float siluf_(float x) { return x * sigmoidf_(x); }
DEVI float geluf_(float x) { return 0.5f * x * (1.0f + erff(x * 0.70710678118654752f)); }
DEVI float dot2bf(unsigned a, unsigned b, float c) { return __builtin_amdgcn_fdot2_f32_bf16(__builtin_bit_cast(bf16x2_t, a), __builtin_bit_cast(bf16x2_t, b), c, false); }
DEVI int otid() { int t = threadIdx.x; asm volatile("" : "+v"(t)); return t; }
template <int CTRL> DEVI float dpp_mov_f(float v) { return __uint_as_float(__builtin_amdgcn_update_dpp(0u, __float_as_uint(v), CTRL, 0xf, 0xf, true)); }
DEVI void rows_swap16(float& a, float& b) { const auto r = __builtin_amdgcn_permlane16_swap(__float_as_uint(a), __float_as_uint(b), false, false); a = __uint_as_float(r[0]); b = __uint_as_float(r[1]); }
DEVI void rows_swap32(float& a, float& b) { const auto r = __builtin_amdgcn_permlane32_swap(__float_as_uint(a), __float_as_uint(b), false, false); a = __uint_as_float(r[0]); b = __uint_as_float(r[1]); }
DEVI float wave_sum(float v) {
    v += dpp_mov_f<0xB1>(v); v += dpp_mov_f<0x4E>(v); v += dpp_mov_f<0x141>(v); v += dpp_mov_f<0x140>(v);
    { float a = v, b = v; rows_swap16(a, b); v = a + b; }
    { float a = v, b = v; rows_swap32(a, b); v = a + b; }
    return v;
}
DEVI float wave_max_f(float v) {
    v = __builtin_fmaxf(v, dpp_mov_f<0xB1>(v)); v = __builtin_fmaxf(v, dpp_mov_f<0x4E>(v)); v = __builtin_fmaxf(v, dpp_mov_f<0x141>(v)); v = __builtin_fmaxf(v, dpp_mov_f<0x140>(v));
    { float a = v, b = v; rows_swap16(a, b); v = __builtin_fmaxf(a, b); }
    { float a = v, b = v; rows_swap32(a, b); v = __builtin_fmaxf(a, b); }
    return v;
}
DEVI float row16_sum(float v) { v += dpp_mov_f<0xB1>(v); v += dpp_mov_f<0x4E>(v); v += dpp_mov_f<0x141>(v); v += dpp_mov_f<0x140>(v); return v; }
DEVI unsigned pk4_i8(float a, float b, float c, float d) {
    const int ia = (int)__builtin_rintf(a), ib = (int)__builtin_rintf(b), ic = (int)__builtin_rintf(c), id = (int)__builtin_rintf(d);
    return (unsigned)(ia & 255) | ((unsigned)(ib & 255) << 8) | ((unsigned)(ic & 255) << 16) | ((unsigned)id << 24);
}
DEVI int row_cls(int r) { return r < TC ? 1 : 0; }
DEVI const float* mod_ptr(const P& p, int layer, int cls, int chunk) { return (const float*)(p.ws + WS_MOD) + ((size_t)(layer * 2 + cls) * 6 + chunk) * D; }

struct Row16 { float v[16]; };
DEVI void load_row_f32(const float* row, int lane, Row16& o) {
    const f32x4* a = (const f32x4*)(row + 8 * lane); const f32x4* b = (const f32x4*)(row + 512 + 8 * lane);
    f32x4 a0 = a[0], a1 = a[1], b0 = b[0], b1 = b[1];
#pragma unroll
    for (int j = 0; j < 4; ++j) { o.v[j] = a0[j]; o.v[4 + j] = a1[j]; o.v[8 + j] = b0[j]; o.v[12 + j] = b1[j]; }
}
DEVI void store_row_f32(float* row, int lane, const Row16& o) {
    f32x4* a = (f32x4*)(row + 8 * lane); f32x4* b = (f32x4*)(row + 512 + 8 * lane);
    a[0] = (f32x4){o.v[0], o.v[1], o.v[2], o.v[3]}; a[1] = (f32x4){o.v[4], o.v[5], o.v[6], o.v[7]};
    b[0] = (f32x4){o.v[8], o.v[9], o.v[10], o.v[11]}; b[1] = (f32x4){o.v[12], o.v[13], o.v[14], o.v[15]};
}
DEVI void load_row_bf16(const bf16_t* row, int lane, Row16& o) {
    const u32x4 a = *(const u32x4*)(row + 8 * lane), b = *(const u32x4*)(row + 512 + 8 * lane);
#pragma unroll
    for (int j = 0; j < 4; ++j) { o.v[2 * j] = bflo(a[j]); o.v[2 * j + 1] = bfhi(a[j]); o.v[8 + 2 * j] = bflo(b[j]); o.v[8 + 2 * j + 1] = bfhi(b[j]); }
}
DEVI void store_row_bf16(bf16_t* row, int lane, const Row16& o) {
    u32x4 a, b;
#pragma unroll
    for (int j = 0; j < 4; ++j) { a[j] = pk2(o.v[2 * j], o.v[2 * j + 1]); b[j] = pk2(o.v[8 + 2 * j], o.v[8 + 2 * j + 1]); }
    *(u32x4*)(row + 8 * lane) = a; *(u32x4*)(row + 512 + 8 * lane) = b;
}
DEVI void norm_mod(const Row16& x, const float* g, const float* shift, const float* scale, int lane, Row16& o) {
    float ss = 0.f;
#pragma unroll
    for (int j = 0; j < 16; ++j) ss += x.v[j] * x.v[j];
    ss = wave_sum(ss);
    const float rstd = rsqrtf(ss * (1.0f / D) + EPS);
    Row16 gg, sh, sc; load_row_f32(g, lane, gg); load_row_f32(shift, lane, sh); load_row_f32(scale, lane, sc);
#pragma unroll
    for (int j = 0; j < 16; ++j) o.v[j] = x.v[j] * rstd * gg.v[j] * (1.0f + sc.v[j]) + sh.v[j];
}

DEVI void ph_ada(const P& p, unsigned char* lds) {
    const int otid_ = otid();
    float* sc = (float*)lds;
    float* red = sc + 2048;
    const int tid = otid_;
    for (int k = tid; k < 1024; k += NTHR) { sc[k] = siluf_(p.in[I_C][k]); sc[1024 + k] = siluf_(p.in[I_CCTX][k]); }
    __syncthreads();
    const int kg = tid >> 3, cl = tid & 7;
    for (int item = blockIdx.x; item < 4 * 192; item += gridDim.x) {
        const int i = item / 192, n0 = (item % 192) * 32 + cl * 4;
        const float* w = p.in[I_ADAW] + (size_t)i * 1024 * 6144 + n0 + (size_t)kg * 6144;
        f32x4 wv[16];
#pragma unroll
        for (int m = 0; m < 16; ++m) wv[m] = *(const f32x4*)(w + (size_t)m * 64 * 6144);
        f32x4 a0 = {0, 0, 0, 0}, a1 = {0, 0, 0, 0};
#pragma unroll
        for (int m = 0; m < 16; ++m) { a0 += wv[m] * sc[kg + 64 * m]; a1 += wv[m] * sc[1024 + kg + 64 * m]; }
        float* r = red + (kg * 8 + cl) * 8;
#pragma unroll
        for (int j = 0; j < 4; ++j) { r[j] = a0[j]; r[4 + j] = a1[j]; }
        __syncthreads();
        if (tid < 64) {
            const int c2 = tid >> 3, j = tid & 7; float s_ = 0.f;
            for (int g = 0; g < 64; ++g) s_ += red[(g * 8 + c2) * 8 + j];
            const int cls = j >> 2, n = (item % 192) * 32 + c2 * 4 + (j & 3);
            ((float*)(p.ws + WS_MOD))[(size_t)(i * 2 + cls) * 6144 + n] = s_ + p.in[I_ADAB][i * 6144 + n];
        }
        __syncthreads();
    }
}
DEVI void ph_lb(const P& p) {
    const int otid_ = otid();
    const int gt = blockIdx.x * NTHR + otid_;
    if (gt < 2048) {
        const float* l = p.in[I_HLB];
        float m = -1e30f; for (int i = 0; i < 4; ++i) m = fmaxf(m, l[i * 2048 + gt]);
        float s = 0.f; for (int i = 0; i < 4; ++i) s += expf(l[i * 2048 + gt] - m);
        ((float*)(p.ws + WS_LB))[gt] = expf(l[2048 + gt] - m) / s;
    }
}
DEVI void ph_s5disc(const P& p) {
    const int otid_ = otid();
    const int gt = blockIdx.x * NTHR + otid_;
    if (gt < 2 * 64 * 64) {
        const int dn = gt >> 12, g = (gt >> 6) & 63, pp = gt & 63;
        const float step = expf(p.in[I_S5LS][dn * 64 + g]);
        const float lr = fminf(p.in[I_S5LR][gt], -1e-4f), li = p.in[I_S5LI][gt];
        const float ar = step * lr, ai = step * li, mag = expf(ar);
        float sn, cs; sincosf(ai, &sn, &cs);
        const float abr = mag * cs, abi = mag * sn, den = lr * lr + li * li;
        const float fr = ((abr - 1.0f) * lr + abi * li) / den, fi = (abi * lr - (abr - 1.0f) * li) / den;
        float* A = (float*)(p.ws + WS_S5A) + (size_t)gt * 2; A[0] = abr; A[1] = abi;
        float* B = (float*)(p.ws + WS_S5B) + (size_t)gt * 32;
        const float* br = p.in[I_S5BR] + (size_t)(g * 64 + pp) * 16; const float* bi = p.in[I_S5BI] + (size_t)(g * 64 + pp) * 16;
        for (int h = 0; h < 16; ++h) { B[h] = fr * br[h] - fi * bi[h]; B[16 + h] = fr * bi[h] + fi * br[h]; }
    }
}
DEVI void transpose_item(const float* W, int K, int N, bf16_t* WT, float* scr, int item, int lane, bool glu_pair = false) {
    const int nblk = N / 32, kb = item / nblk, nb = item % nblk, k0 = 64 * kb, n0 = 32 * nb;
#pragma unroll 8
    for (int i = 0; i < 32; ++i) { const int kk = 2 * i + (lane >> 5); scr[kk * 33 + (lane & 31)] = W[(size_t)(k0 + kk) * N + n0 + (lane & 31)]; }
    __builtin_amdgcn_s_waitcnt(0); asm volatile("" ::: "memory");
    const int c = lane & 7;
#pragma unroll
    for (int j = 0; j < 4; ++j) { const int n = (lane >> 3) + 8 * j; const float* s = scr + (8 * c) * 33 + n;
        u32x4 o; o.x = pk2(s[0 * 33], s[1 * 33]); o.y = pk2(s[2 * 33], s[3 * 33]); o.z = pk2(s[4 * 33], s[5 * 33]); o.w = pk2(s[6 * 33], s[7 * 33]);
        const int dn = glu_pair ? (((n0 & 1023) >> 7) * 256 + (n0 >> 10) * 128 + (n0 & 127)) : n0;
        *(u32x4*)(WT + (size_t)(dn + n) * K + k0 + 8 * c) = o; }
    __builtin_amdgcn_s_waitcnt(0); asm volatile("" ::: "memory");
}
DEVI void ph_transposes(const P& p, unsigned char* lds) {
    const int otid_ = otid();
    const int wave = otid_ >> 6, lane = otid_ & 63;
    float* scr = (float*)lds + wave * (64 * 33);
    const int gw = blockIdx.x * NWV + wave, NGW = gridDim.x * NWV;
    bf16_t* WT = (bf16_t*)(p.ws + WS_WT);
    constexpr int I_A = (1024 / 64) * (3072 / 32), I_B = (1024 / 64) * (1024 / 32), I_C5 = (1024 / 64) * (5120 / 32), I_G = (1024 / 64) * (2048 / 32);
    constexpr int NIT = 2 * I_A + 2 * I_B + I_C5 + I_B + I_G;
    for (int it = gw; it < NIT; it += NGW) {
        int r = it;
        if (r < 2 * I_A) { const int j = r / I_A; transpose_item(p.in[I_CWIN] + (size_t)j * 1024 * 3072, 1024, 3072, WT + WT_CIN / 2 + (size_t)j * 3072 * 1024, scr, r % I_A, lane); continue; } r -= 2 * I_A;
        if (r < 2 * I_B) { const int j = r / I_B; transpose_item(p.in[I_CWOUT] + (size_t)j * 1024 * 1024, 1024, 1024, WT + WT_COUT / 2 + (size_t)j * 1024 * 1024, scr, r % I_B, lane); continue; } r -= 2 * I_B;
        if (r < I_C5) { transpose_item(p.in[I_HWIN], 1024, 5120, WT + WT_HIN / 2, scr, r, lane); continue; } r -= I_C5;
        if (r < I_B) { transpose_item(p.in[I_HWOUT], 1024, 1024, WT + WT_HOUT / 2, scr, r, lane); continue; } r -= I_B;
        transpose_item(p.in[I_S5GLU], 1024, 2048, WT + WT_GLU / 2, scr, r, lane, true);
    }
}
DEVI void ph_tables(const P& p) {
    const int otid_ = otid();
    const int wave = otid_ >> 6, lane = otid_ & 63, gw = blockIdx.x * NWV + wave, NGW = gridDim.x * NWV;
    float* SCL = (float*)(p.ws + WS_SCL);
    for (int row = gw; row < 2 * 4 * 16384; row += NGW) {
        const int w = row >> 16, rr = row & 65535;
        const f32x4* src = (const f32x4*)(p.in[w ? I_PV : I_PU] + (size_t)rr * 1024 + 16 * lane);
        const f32x4 a0 = src[0], a1 = src[1], a2 = src[2], a3 = src[3];
        float m = 0.f;
#pragma unroll
        for (int j = 0; j < 4; ++j) m = fmaxf(fmaxf(m, fmaxf(fabsf(a0[j]), fabsf(a1[j]))), fmaxf(fabsf(a2[j]), fabsf(a3[j])));
        m = wave_max_f(m);
        const float qmax = w ? 224.0f : 127.0f;
        const float sc = m > 0.f ? qmax / m : 1.0f;
        u32x4 q;
        if (w) {
            { unsigned t = 0; t = __builtin_amdgcn_cvt_pk_fp8_f32(a0[0] * sc, a0[1] * sc, t, false); t = __builtin_amdgcn_cvt_pk_fp8_f32(a0[2] * sc, a0[3] * sc, t, true); q[0] = t; }
            { unsigned t = 0; t = __builtin_amdgcn_cvt_pk_fp8_f32(a1[0] * sc, a1[1] * sc, t, false); t = __builtin_amdgcn_cvt_pk_fp8_f32(a1[2] * sc, a1[3] * sc, t, true); q[1] = t; }
            { unsigned t = 0; t = __builtin_amdgcn_cvt_pk_fp8_f32(a2[0] * sc, a2[1] * sc, t, false); t = __builtin_amdgcn_cvt_pk_fp8_f32(a2[2] * sc, a2[3] * sc, t, true); q[2] = t; }
            { unsigned t = 0; t = __builtin_amdgcn_cvt_pk_fp8_f32(a3[0] * sc, a3[1] * sc, t, false); t = __builtin_amdgcn_cvt_pk_fp8_f32(a3[2] * sc, a3[3] * sc, t, true); q[3] = t; }
        } else {
            q[0] = pk4_i8(a0[0] * sc, a0[1] * sc, a0[2] * sc, a0[3] * sc); q[1] = pk4_i8(a1[0] * sc, a1[1] * sc, a1[2] * sc, a1[3] * sc);
            q[2] = pk4_i8(a2[0] * sc, a2[1] * sc, a2[2] * sc, a2[3] * sc); q[3] = pk4_i8(a3[0] * sc, a3[1] * sc, a3[2] * sc, a3[3] * sc);
        }
        *(u32x4*)(p.ws + (w ? WS_PV : WS_PU) + (size_t)(rr >> 14) * (16384 * 1024) + (size_t)(lane >> 3) * (16384 * 128) + (size_t)(rr & 16383) * 128 + 16 * (lane & 7)) = q;
        if (lane == 0) SCL[2 * rr + w] = m > 0.f ? m / qmax : 1.0f;
    }
}
DEVI void ph_fold(const P& p) {
    const int otid_ = otid();
    const int wave = otid_ >> 6, lane = otid_ & 63, c = lane & 15, q4 = lane >> 4, gw = blockIdx.x * NWV + wave, NGW = gridDim.x * NWV;
    for (int item = gw; item < 4 * 16 * 8 * 4; item += NGW) {
        const int i = item >> 9, hc = (item >> 5) & 15, kt = (item >> 2) & 7, kq = item & 3;
        const float* ky = p.in[I_PKEYS] + (((size_t)i * 16 + hc) * 128 + 16 * kt + c) * 128 + 4 * q4;
        f32x4 kf[8];
#pragma unroll
        for (int s8 = 0; s8 < 8; ++s8) kf[s8] = *(const f32x4*)(ky + 16 * s8);
        bf16_t* out = (bf16_t*)(p.ws + WS_WQK) + ((size_t)i * 2048 + hc * 128 + 16 * kt + c) * 1024 + 4 * q4;
#pragma unroll 1
        for (int tt = 0; tt < 16; ++tt) {
            const int k1 = (kq * 16 + tt) * 16;
            const float* wq = p.in[I_PWQ] + ((size_t)i * 1024 + k1 + c) * 2048 + hc * 128 + 4 * q4;
            f32x4 wf[8];
#pragma unroll
            for (int s8 = 0; s8 < 8; ++s8) wf[s8] = *(const f32x4*)(wq + 16 * s8);
            f32x4 acc = {0.f, 0.f, 0.f, 0.f};
#pragma unroll
            for (int s8 = 0; s8 < 8; ++s8)
#pragma unroll
                for (int j = 0; j < 4; ++j) acc = __builtin_amdgcn_mfma_f32_16x16x4f32(wf[s8][j], kf[s8][j], acc, 0, 0, 0);
            *(u32x2*)(out + k1) = (u32x2){pk2(acc[0], acc[1]), pk2(acc[2], acc[3])};
        }
    }
}

struct NormAB { Row16 A, B; };
DEVI void normab_load(NormAB& n, const float* g, const float* shift, const float* scale, int lane) {
    Row16 gg, sc; load_row_f32(g, lane, gg); load_row_f32(scale, lane, sc); load_row_f32(shift, lane, n.B);
#pragma unroll
    for (int j = 0; j < 16; ++j) n.A.v[j] = gg.v[j] * (1.0f + sc.v[j]);
}
DEVI void norm_ab(const Row16& x, const NormAB& n, Row16& o) {
    float ss = 0.f;
#pragma unroll
    for (int j = 0; j < 16; ++j) ss += x.v[j] * x.v[j];
    ss = wave_sum(ss);
    const float rstd = rsqrtf(ss * (1.0f / D) + EPS);
#pragma unroll
    for (int j = 0; j < 16; ++j) o.v[j] = x.v[j] * rstd * n.A.v[j] + n.B.v[j];
}
DEVI void ph_init_norm(const P& p) {
    const int otid_ = otid();
    const int wave = __builtin_amdgcn_readfirstlane(otid_ >> 6), lane = otid_ & 63, gw = blockIdx.x * NWV + wave, NGW = gridDim.x * NWV;
    NormAB nl; normab_load(nl, p.in[I_N1G], mod_ptr(p, 0, 0, 0), mod_ptr(p, 0, 0, 1), lane);
    for (int r = gw; r < MA; r += 2 * NGW) {
        const int r1 = r + NGW;
        Row16 x0, x1, o;
        load_row_f32(r < TC ? p.in[I_CTX] + (size_t)r * D : p.in[I_X] + (size_t)(r - TC) * D, lane, x0);
        if (r1 < MA) load_row_f32(p.in[I_X] + (size_t)(r1 - TC) * D, lane, x1);
        NormAB n0 = nl;
        if (r < TC) normab_load(n0, p.in[I_N1G], mod_ptr(p, 0, 1, 0), mod_ptr(p, 0, 1, 1), lane);
        store_row_f32((float*)(p.ws + WS_X) + (size_t)r * D, lane, x0);
        norm_ab(x0, n0, o); store_row_bf16((bf16_t*)(p.ws + WS_XN) + (size_t)r * D, lane, o);
        if (r1 < MA) { store_row_f32((float*)(p.ws + WS_X) + (size_t)r1 * D, lane, x1); norm_ab(x1, nl, o); store_row_bf16((bf16_t*)(p.ws + WS_XN) + (size_t)r1 * D, lane, o); }
    }
}
DEVI void norm2_row(const P& p, int r, int lane, const Row16& x, const NormAB& n) {
    Row16 o; norm_ab(x, n, o);
    store_row_bf16((bf16_t*)(p.ws + WS_XN) + (size_t)r * D, lane, o);
    float m = 0.f;
#pragma unroll
    for (int j = 0; j < 16; ++j) m = fmaxf(m, fabsf(o.v[j]));
    m = wave_max_f(m);
    const float sc = m > 0.f ? 127.0f / m : 1.0f;
    unsigned char* h8 = p.ws + WS_H8 + (size_t)r * D;
    *(u32x2*)(h8 + 8 * lane) = (u32x2){pk4_i8(o.v[0] * sc, o.v[1] * sc, o.v[2] * sc, o.v[3] * sc), pk4_i8(o.v[4] * sc, o.v[5] * sc, o.v[6] * sc, o.v[7] * sc)};
    *(u32x2*)(h8 + 512 + 8 * lane) = (u32x2){pk4_i8(o.v[8] * sc, o.v[9] * sc, o.v[10] * sc, o.v[11] * sc), pk4_i8(o.v[12] * sc, o.v[13] * sc, o.v[14] * sc, o.v[15] * sc)};
    if (lane == 0) ((float*)(p.ws + WS_HS))[r] = m > 0.f ? m / 127.0f : 1.0f;
}
DEVI void ph_norm2(const P& p, int layer, int r0) {
    const int otid_ = otid();
    const int wave = __builtin_amdgcn_readfirstlane(otid_ >> 6), lane = otid_ & 63, gw = blockIdx.x * NWV + wave, NGW = gridDim.x * NWV;
    NormAB nl; normab_load(nl, p.in[I_N2G] + layer * D, mod_ptr(p, layer, 0, 3), mod_ptr(p, layer, 0, 4), lane);
    for (int r = r0 + gw; r < MA; r += 2 * NGW) {
        const int r1 = r + NGW;
        Row16 x0, x1; load_row_f32((const float*)(p.ws + WS_X) + (size_t)r * D, lane, x0);
        if (r1 < MA) load_row_f32((const float*)(p.ws + WS_X) + (size_t)r1 * D, lane, x1);
        NormAB n0 = nl;
        if (r < TC) normab_load(n0, p.in[I_N2G] + layer * D, mod_ptr(p, layer, 1, 3), mod_ptr(p, layer, 1, 4), lane);
        norm2_row(p, r, lane, x0, n0);
        if (r1 < MA) norm2_row(p, r1, lane, x1, nl);
    }
}

namespace pg8 {
#define PG8_LAS __attribute__((address_space(3)))
typedef unsigned short bf16_t;
typedef short bf16x8 __attribute__((ext_vector_type(8)));
typedef float f32x4 __attribute__((ext_vector_type(4)));
typedef unsigned u32x4 __attribute__((ext_vector_type(4)));
constexpr int BM = 256, BK = 64, HALF = 128, HTB = HALF * BK * 2  , STAGE_BYTES = 8 * HTB, NXCD = 8, WGM = 8;

__host__ __device__ __forceinline__ int lds_byte(int r, int c) { const int st = (r >> 4) * 2 + (c >> 5), rr = r & 15, cc = c & 31, ob = rr * 64 + cc * 2; return st * 1024 + (ob ^ (((ob >> 9) & 1) << 5)); }
__host__ __device__ __forceinline__ void stage_rc(int b, int& R, int& C) { const int st = b / 1024, sb = b % 1024, swz = sb ^ (((sb >> 9) & 1) << 5); R = (st >> 1) * 16 + swz / 64; C = (st & 1) * 32 + (swz % 64) / 2; }
__host__ __device__ __forceinline__ int perm32(int rho) { const int n = rho >> 4, i = rho & 15; return 8 * (i >> 2) + 4 * n + (i & 3); }

struct Unit { int pm, pn; };
struct Gemm { const bf16_t* A; const bf16_t* Bt; int M, N, K; };

struct StaticOrder {
    int nM, nN, nwg, G, c;
    __host__ __device__ void init(int M, int N, int G_, int c_) { nM = M / BM; nN = N / BM; nwg = nM * nN; G = G_; c = c_; }
    __host__ __device__ bool next(int i, Unit& u) const {
        const long L = (long)i * G + c; if (L >= nwg) return false;
        int wgid = (int)L; { const int q = nwg / NXCD, r = nwg % NXCD, xcd = wgid % NXCD, off = wgid / NXCD; wgid = (xcd < r ? xcd * (q + 1) : r * (q + 1) + (xcd - r) * q) + off; }
        const int nig = WGM * nN, gid = wgid / nig, fm = gid * WGM, gsz = (nM - fm) < WGM ? (nM - fm) : WGM;
        u.pm = fm + ((wgid % nig) % gsz); u.pn = (wgid % nig) / gsz; return true;
    }
    __device__ __forceinline__ void a_ready(const Unit&) const {}
    __device__ __forceinline__ void done(const Unit&) const {}
};
__device__ __forceinline__ unsigned cvt_pk_bf16(float lo, float hi) { unsigned r; asm volatile("v_cvt_pk_bf16_f32 %0, %1, %2" : "=v"(r) : "v"(lo), "v"(hi)); return r; }

struct EpiBf16 {
    static constexpr bool PERM = true, AFTER_DRAIN = false;
    bf16_t* O; int ldc; int row_base;
    __device__ __forceinline__ void operator()(const f32x4 (&acc)[2][2][4][2], const Unit& u, int wr, int wc, int fr, int fq) const {
        const int row0 = row_base + u.pm * BM + wr * 64 + fr, col0 = u.pn * BM + wc * 32 + 8 * fq;
#pragma unroll
        for (int ai = 0; ai < 2; ++ai)
#pragma unroll
            for (int m = 0; m < 4; ++m) { bf16_t* rowp = O + (size_t)(row0 + ai * HALF + m * 16) * ldc + col0;
#pragma unroll
                for (int bj = 0; bj < 2; ++bj) { const f32x4 v0 = acc[ai][bj][m][0], v1 = acc[ai][bj][m][1];
                    u32x4 w; w.x = ::pk2(v0[0], v0[1]); w.y = ::pk2(v0[2], v0[3]); w.z = ::pk2(v1[0], v1[1]); w.w = ::pk2(v1[2], v1[3]);
                    *(u32x4*)(rowp + bj * HALF) = w; } }
    }
};
struct EpiHgrnIn {
    static constexpr bool PERM = true, AFTER_DRAIN = false;
    bf16_t* O; int ldc; int row_base; const float* lbv;
    __device__ __forceinline__ void operator()(const f32x4 (&acc)[2][2][4][2], const Unit& u, int wr, int wc, int fr, int fq) const {
        const int row0 = row_base + u.pm * BM + wr * 64 + fr, col0 = u.pn * BM + wc * 32 + 8 * fq;
        const int blk = u.pn >> 2;
#pragma unroll
        for (int bj = 0; bj < 2; ++bj) {
            float lb8[8];
#pragma unroll
            for (int j = 0; j < 8; ++j) lb8[j] = (blk == 2 || blk == 3) ? lbv[(blk - 2) * 1024 + ((col0 + bj * HALF) & 1023) + j] : 0.f;
#pragma unroll
            for (int ai = 0; ai < 2; ++ai)
#pragma unroll
                for (int m = 0; m < 4; ++m) { const f32x4 v0 = acc[ai][bj][m][0], v1 = acc[ai][bj][m][1]; float x[8] = {v0[0], v0[1], v0[2], v0[3], v1[0], v1[1], v1[2], v1[3]};
#pragma unroll
                    for (int j = 0; j < 8; ++j) {
                        if (blk == 0 || blk == 4) x[j] = x[j] / (1.0f + __expf(-x[j]));
                        else if (blk == 2 || blk == 3) x[j] = __logf(lb8[j] + (1.0f - lb8[j]) / (1.0f + __expf(-x[j])));
                    }
                    u32x4 w; w.x = ::pk2(x[0], x[1]); w.y = ::pk2(x[2], x[3]); w.z = ::pk2(x[4], x[5]); w.w = ::pk2(x[6], x[7]);
                    *(u32x4*)(O + (size_t)(row0 + ai * HALF + m * 16) * ldc + col0 + bj * HALF) = w; }
        }
    }
};
typedef _Float16 f16x2_t __attribute__((ext_vector_type(2)));
__device__ __forceinline__ unsigned pkh2(float lo, float hi) { ::f32x2_t f = {lo, hi}; return __builtin_bit_cast(unsigned, __builtin_convertvector(f, f16x2_t)); }
struct EpiF16 {
    static constexpr bool PERM = true, AFTER_DRAIN = false;
    unsigned short* O; int ldc; int row_base;
    __device__ __forceinline__ void operator()(const f32x4 (&acc)[2][2][4][2], const Unit& u, int wr, int wc, int fr, int fq) const {
        const int row0 = row_base + u.pm * BM + wr * 64 + fr, col0 = u.pn * BM + wc * 32 + 8 * fq;
#pragma unroll
        for (int ai = 0; ai < 2; ++ai)
#pragma unroll
            for (int m = 0; m < 4; ++m) { unsigned short* rowp = O + (size_t)(row0 + ai * HALF + m * 16) * ldc + col0;
#pragma unroll
                for (int bj = 0; bj < 2; ++bj) { const f32x4 v0 = acc[ai][bj][m][0], v1 = acc[ai][bj][m][1];
                    u32x4 w; w.x = pkh2(v0[0], v0[1]); w.y = pkh2(v0[2], v0[3]); w.z = pkh2(v1[0], v1[1]); w.w = pkh2(v1[2], v1[3]);
                    *(u32x4*)(rowp + bj * HALF) = w; } }
    }
};
struct EpiGluResid {
    static constexpr bool PERM = false, AFTER_DRAIN = false;
    float* X; const float* gate1; int row_base;
    __device__ __forceinline__ void operator()(const f32x4 (&acc)[2][2][4][2], const Unit& u, int wr, int wc, int fr, int fq) const {
        const int row0 = row_base + u.pm * BM + wr * 64 + fr, ch0 = u.pn * HALF + wc * 32 + 4 * fq;
        f32x4 gv[2];
#pragma unroll
        for (int n = 0; n < 2; ++n) gv[n] = *(const f32x4*)(gate1 + ch0 + n * 16);
#pragma unroll
        for (int ai = 0; ai < 2; ++ai)
#pragma unroll
            for (int m = 0; m < 4; ++m) { float* rowp = X + (size_t)(row0 + ai * HALF + m * 16) * 1024 + ch0;
#pragma unroll
                for (int n = 0; n < 2; ++n) { const f32x4 v = acc[ai][0][m][n], g = acc[ai][1][m][n]; f32x4 o;
#pragma unroll
                    for (int j = 0; j < 4; ++j) o[j] = gv[n][j] * v[j] / (1.0f + __expf(-g[j]));
                    f32x4* q = (f32x4*)(rowp + n * 16); *q = *q + o; } }
    }
};
struct EpiResid {
    static constexpr bool PERM = false, AFTER_DRAIN = false;
    float* X; const float* gate_lat; const float* gate_ctx; int row_base; int tc_rows;
    __device__ __forceinline__ void operator()(const f32x4 (&acc)[2][2][4][2], const Unit& u, int wr, int wc, int fr, int fq) const {
        const int row0 = row_base + u.pm * BM + wr * 64 + fr, col0 = u.pn * BM + wc * 32 + 4 * fq;
        const float* gate = (row_base + u.pm * BM) < tc_rows ? gate_ctx : gate_lat;
        f32x4 gv[2][2];
#pragma unroll
        for (int bj = 0; bj < 2; ++bj)
#pragma unroll
            for (int n = 0; n < 2; ++n) gv[bj][n] = *(const f32x4*)(gate + col0 + bj * HALF + n * 16);
#pragma unroll
        for (int ai = 0; ai < 2; ++ai)
#pragma unroll
            for (int m = 0; m < 4; ++m) { float* rowp = X + (size_t)(row0 + ai * HALF + m * 16) * 1024 + col0;
#pragma unroll
                for (int bj = 0; bj < 2; ++bj)
#pragma unroll
                    for (int n = 0; n < 2; ++n) { f32x4* q = (f32x4*)(rowp + bj * HALF + n * 16); *q = *q + gv[bj][n] * acc[ai][bj][m][n]; } }
    }
};

template <class Epi, class Sched, bool ALIGN_EPI = false, bool SP2 = false>
__device__ __forceinline__ void gemm_phase(PG8_LAS unsigned char* lds, const Gemm g, const Sched& S, const Epi& E) {
    const int tid = otid(), wid = __builtin_amdgcn_readfirstlane(tid >> 6), lane = tid & 63, wr = wid >> 2, wc = wid & 3, fr = lane & 15, fq = lane >> 4;
    const int K = g.K, nt = K / BK;
    unsigned voffA[2], voffB[2];
#pragma unroll
    for (int i = 0; i < 2; ++i) { int R, C; stage_rc(tid * 16 + i * 8192, R, C); const int Rb = Epi::PERM ? ((R & ~31) + perm32(R & 31)) : R;
        voffA[i] = (unsigned)(R * K + C) * 2u; voffB[i] = (unsigned)(Rb * K + C) * 2u; }
    const size_t kstep = (size_t)(BK * 2);
    const size_t hstep = (size_t)HALF * K * 2;
    const size_t tstep = 2 * hstep;
    const unsigned ldsw = (unsigned)wid * 1024u;
    const int aoff = lds_byte(wr * 64 + fr, fq * 8), boff = lds_byte(wc * 32 + fr, fq * 8);
#define PG8_SA(b, h) (((b) * 2 + (h)) * HTB)
#define PG8_SB(b, h) ((4 + (b) * 2 + (h)) * HTB)
#define PG8_STAGE(bufoff, gbase, voff) do { _Pragma("unroll") for (int _i = 0; _i < 2; ++_i) \
        __builtin_amdgcn_global_load_lds((const unsigned*)((const char*)(gbase) + (voff)[_i]), (PG8_LAS unsigned*)(lds + (bufoff) + ldsw + _i * 8192), 16, 0, 0); } while (0)
#define PG8_LDA(dst, b, h) do { _Pragma("unroll") for (int m = 0; m < 4; ++m) _Pragma("unroll") for (int k = 0; k < 2; ++k) dst[m][k] = *(const PG8_LAS bf16x8*)(lds + PG8_SA(b, h) + aoff + m * 2048 + k * 1024); } while (0)
#define PG8_LDB(dst, b, h) do { _Pragma("unroll") for (int n = 0; n < 2; ++n) _Pragma("unroll") for (int k = 0; k < 2; ++k) dst[n][k] = *(const PG8_LAS bf16x8*)(lds + PG8_SB(b, h) + boff + n * 2048 + k * 1024); } while (0)
#define PG8_MMA(ai, bj, At, Bt) do { __builtin_amdgcn_s_setprio(1); _Pragma("unroll") for (int m = 0; m < 4; ++m) _Pragma("unroll") for (int n = 0; n < 2; ++n) _Pragma("unroll") for (int k = 0; k < 2; ++k) \
        acc[ai][bj][m][n] = __builtin_amdgcn_mfma_f32_16x16x32_bf16(Bt[n][k], At[m][k], acc[ai][bj][m][n], 0, 0, 0); __builtin_amdgcn_s_setprio(0); } while (0)
#define PG8_WAIT_V(n) asm volatile("s_waitcnt vmcnt(" #n ")" ::: "memory")
#define PG8_WAIT_L(n) asm volatile("s_waitcnt lgkmcnt(" #n ")" ::: "memory")
#define PG8_BAR __builtin_amdgcn_s_barrier()
#define PG8_SCHED __builtin_amdgcn_sched_barrier(0)
    Unit cur, nxt; int ui = 0;
    if (!S.next(0, cur)) return;
    f32x4 acc[2][2][4][2];
#pragma unroll
    for (int a = 0; a < 2; ++a)
#pragma unroll
        for (int b = 0; b < 2; ++b)
#pragma unroll
            for (int m = 0; m < 4; ++m)
#pragma unroll
                for (int n = 0; n < 2; ++n) acc[a][b][m][n] = (f32x4){0.f, 0.f, 0.f, 0.f};
    bf16x8 At[4][2], B0[2][2], B1[2][2];
    const char* cA = (const char*)g.A + (size_t)cur.pm * tstep; const char* cB = (const char*)g.Bt + (size_t)cur.pn * tstep;
    S.a_ready(cur);
    if constexpr (SP2) {
        PG8_STAGE(PG8_SB(0, 0), cB, voffB); PG8_STAGE(PG8_SB(0, 1), cB + hstep, voffB); PG8_STAGE(PG8_SA(0, 0), cA, voffA); PG8_STAGE(PG8_SA(0, 1), cA + hstep, voffA);
        if (wr == 1) PG8_BAR;
        PG8_WAIT_V(2); PG8_BAR;
        PG8_STAGE(PG8_SB(1, 0), cB + kstep, voffB); PG8_STAGE(PG8_SA(1, 0), cA + kstep, voffA); PG8_STAGE(PG8_SB(1, 1), cB + hstep + kstep, voffB);
        PG8_WAIT_V(6); PG8_BAR;
    } else {
        PG8_STAGE(PG8_SB(0, 0), cB, voffB); PG8_STAGE(PG8_SA(0, 0), cA, voffA); PG8_STAGE(PG8_SB(0, 1), cB + hstep, voffB); PG8_STAGE(PG8_SA(0, 1), cA + hstep, voffA);
        if (wr == 1) PG8_BAR;
        PG8_WAIT_V(4); PG8_BAR;
        PG8_STAGE(PG8_SB(1, 0), cB + kstep, voffB); PG8_STAGE(PG8_SA(1, 0), cA + kstep, voffA); PG8_STAGE(PG8_SB(1, 1), cB + hstep + kstep, voffB);
        PG8_WAIT_V(6); PG8_BAR;
    }
    for (;;) {
        const bool has_next = S.next(ui + 1, nxt);
        const char* nA = has_next ? (const char*)g.A + (size_t)nxt.pm * tstep : cA; const char* nB = has_next ? (const char*)g.Bt + (size_t)nxt.pn * tstep : cB;
        for (int t = 0; t < nt; t += 2) {
            const bool last = (t == nt - 2);
            const char* a1 = cA + (size_t)(t + 1) * kstep;
            const char* a2 = last ? nA : cA + (size_t)(t + 2) * kstep; const char* b2 = last ? nB : cB + (size_t)(t + 2) * kstep;
            const char* a3 = a2 + kstep; const char* b3 = b2 + kstep;
            if (last && has_next) S.a_ready(nxt);
            if constexpr (SP2) {
            PG8_LDB(B0, 0, 0); PG8_LDB(B1, 0, 1); PG8_SCHED; PG8_LDA(At, 0, 0); PG8_STAGE(PG8_SA(1, 1), a1 + hstep, voffA);
            PG8_WAIT_V(8); PG8_WAIT_L(0); PG8_BAR; PG8_MMA(0, 0, At, B0); PG8_MMA(0, 1, At, B1); PG8_BAR; PG8_SCHED;
            PG8_LDA(At, 0, 1); PG8_STAGE(PG8_SB(0, 0), b2, voffB); PG8_STAGE(PG8_SB(0, 1), b2 + hstep, voffB); PG8_STAGE(PG8_SA(0, 0), a2, voffA);
            PG8_WAIT_V(8); PG8_WAIT_L(0); PG8_BAR; PG8_MMA(1, 0, At, B0); PG8_MMA(1, 1, At, B1); PG8_BAR; PG8_SCHED;
            PG8_LDB(B0, 1, 0); PG8_LDB(B1, 1, 1); PG8_SCHED; PG8_LDA(At, 1, 0); PG8_STAGE(PG8_SA(0, 1), a2 + hstep, voffA);
            PG8_WAIT_V(8); PG8_WAIT_L(0); PG8_BAR; PG8_MMA(0, 0, At, B0); PG8_MMA(0, 1, At, B1); PG8_BAR; PG8_SCHED;
            PG8_LDA(At, 1, 1); PG8_STAGE(PG8_SB(1, 0), b3, voffB); PG8_STAGE(PG8_SB(1, 1), b3 + hstep, voffB); PG8_STAGE(PG8_SA(1, 0), a3, voffA);
            PG8_WAIT_V(8); PG8_WAIT_L(0); PG8_BAR; PG8_MMA(1, 0, At, B0); PG8_MMA(1, 1, At, B1); PG8_BAR; PG8_SCHED;
            } else {
            PG8_LDB(B0, 0, 0); PG8_SCHED; PG8_LDA(At, 0, 0); PG8_STAGE(PG8_SA(1, 1), a1 + hstep, voffA);
            PG8_WAIT_L(8); PG8_BAR; PG8_WAIT_L(0); PG8_MMA(0, 0, At, B0); PG8_BAR; PG8_SCHED;
            PG8_LDB(B1, 0, 1); PG8_STAGE(PG8_SB(0, 0), b2, voffB);
            PG8_BAR; PG8_WAIT_L(0); PG8_MMA(0, 1, At, B1); PG8_BAR;
            PG8_LDA(At, 0, 1); PG8_STAGE(PG8_SA(0, 0), a2, voffA);
            PG8_BAR; PG8_WAIT_L(0); PG8_MMA(1, 0, At, B0); PG8_BAR; PG8_SCHED;
            PG8_STAGE(PG8_SB(0, 1), b2 + hstep, voffB);
            PG8_WAIT_V(6); PG8_BAR; PG8_MMA(1, 1, At, B1); PG8_BAR;
            PG8_LDB(B0, 1, 0); PG8_SCHED; PG8_LDA(At, 1, 0); PG8_STAGE(PG8_SA(0, 1), a2 + hstep, voffA);
            PG8_WAIT_L(8); PG8_BAR; PG8_WAIT_L(0); PG8_MMA(0, 0, At, B0); PG8_BAR; PG8_SCHED;
            PG8_LDB(B1, 1, 1); PG8_STAGE(PG8_SB(1, 0), b3, voffB);
            PG8_BAR; PG8_WAIT_L(0); PG8_MMA(0, 1, At, B1); PG8_BAR;
            PG8_LDA(At, 1, 1); PG8_STAGE(PG8_SA(1, 0), a3, voffA);
            PG8_BAR; PG8_WAIT_L(0); PG8_MMA(1, 0, At, B0); PG8_BAR; PG8_SCHED;
            PG8_STAGE(PG8_SB(1, 1), b3 + hstep, voffB);
            PG8_WAIT_V(6); PG8_BAR; PG8_MMA(1, 1, At, B1); PG8_BAR;
            }
        }
        if constexpr (ALIGN_EPI) { if (wr == 0) PG8_BAR; }
        if constexpr (!Epi::AFTER_DRAIN) { E(acc, cur, wr, wc, fr, fq); S.done(cur); }
        if (!has_next) break;
#pragma unroll
        for (int a = 0; a < 2; ++a)
#pragma unroll
            for (int b = 0; b < 2; ++b)
#pragma unroll
                for (int m = 0; m < 4; ++m)
#pragma unroll
                    for (int n = 0; n < 2; ++n) acc[a][b][m][n] = (f32x4){0.f, 0.f, 0.f, 0.f};
        cur = nxt; cA = nA; cB = nB; ++ui;
        if constexpr (ALIGN_EPI) { if (wr == 1) PG8_BAR; }
    }
    PG8_WAIT_V(0);
    if constexpr (!ALIGN_EPI) { if (wr == 0) PG8_BAR; }
    PG8_BAR;
    if constexpr (Epi::AFTER_DRAIN) { E.fused(acc, cur, wr, wc, fr, fq, lds, wid, lane); S.done(cur); }
#undef PG8_SA
#undef PG8_SB
#undef PG8_STAGE
#undef PG8_LDA
#undef PG8_LDB
#undef PG8_MMA
#undef PG8_WAIT_V
#undef PG8_WAIT_L
#undef PG8_BAR
#undef PG8_SCHED
}
}

DEVI void ph_conv(const P& p, int j, int r0) {
    const int otid_ = otid();
    const int wave = otid_ >> 6, lane = otid_ & 63, gw = blockIdx.x * NWV + wave, NGW = gridDim.x * NWV;
    const bf16_t* G = (const bf16_t*)(p.ws + WS_G);
    Row16 k0, k1, k2;
    load_row_f32(p.in[I_CK] + (size_t)(j * 3 + 0) * D, lane, k0); load_row_f32(p.in[I_CK] + (size_t)(j * 3 + 1) * D, lane, k1); load_row_f32(p.in[I_CK] + (size_t)(j * 3 + 2) * D, lane, k2);
    for (int r = r0 + gw; r < MA; r += NGW) {
        bool hasp, hasn;
        if (r < TC) { hasp = r > 0; hasn = r < TC - 1; } else { const int t = (r - TC) & 63; hasp = t != 0; hasn = t != 63; }
        Row16 gb, gc, v, acc;
        load_row_bf16(G + (size_t)r * 3072, lane, gb); load_row_bf16(G + (size_t)r * 3072 + 1024, lane, gc); load_row_bf16(G + (size_t)r * 3072 + 2048, lane, v);
#pragma unroll
        for (int e = 0; e < 16; ++e) acc.v[e] = gc.v[e] * v.v[e] * k1.v[e];
        if (hasp) { load_row_bf16(G + (size_t)(r - 1) * 3072 + 1024, lane, gc); load_row_bf16(G + (size_t)(r - 1) * 3072 + 2048, lane, v);
#pragma unroll
            for (int e = 0; e < 16; ++e) acc.v[e] += gc.v[e] * v.v[e] * k0.v[e]; }
        if (hasn) { load_row_bf16(G + (size_t)(r + 1) * 3072 + 1024, lane, gc); load_row_bf16(G + (size_t)(r + 1) * 3072 + 2048, lane, v);
#pragma unroll
            for (int e = 0; e < 16; ++e) acc.v[e] += gc.v[e] * v.v[e] * k2.v[e]; }
#pragma unroll
        for (int e = 0; e < 16; ++e) acc.v[e] *= gb.v[e];
        store_row_bf16((bf16_t*)(p.ws + WS_U) + (size_t)r * D, lane, acc);
    }
}

DEVI int scan_row(int n, int dir) {
    if (dir == 0) return n;
    return n < TC ? (TC - 1 - n) : (TC + (T - 1 - (n - TC)));
}
namespace hg {
typedef short bf16x8 __attribute__((ext_vector_type(8)));
constexpr int NSEG = 16, NUNIT = 2 * 8 * NSEG;
constexpr int QSB = 272, TSB = 80;
constexpr int OFF_QT = 0, OFF_KT = 32 * QSB, OFF_QD = 2 * 32 * QSB, OFF_KDT = 3 * 32 * QSB, OFF_VT = OFF_KDT + 128 * TSB, OFF_DEC = OFF_VT + 128 * TSB, OFF_T = OFF_DEC + 512, BUFB = OFF_T + 4096;
static_assert(2 * BUFB <= 131072, "hgrn LDS");
DEVI bf16x8 mk8(unsigned a, unsigned b, unsigned c, unsigned d) { u32x4 v = {a, b, c, d}; return __builtin_bit_cast(bf16x8, v); }
DEVI unsigned cvtpk(float lo, float hi) { return pk2(lo, hi); }
#define HG_MFMA(a, b, c) __builtin_amdgcn_mfma_f32_16x16x32_bf16((a), (b), (c), 0, 0, 0)
#define HG_BAR() do { asm volatile("s_waitcnt lgkmcnt(0)" ::: "memory"); __builtin_amdgcn_s_barrier(); asm volatile("" ::: "memory"); } while (0)
template <bool PASS2>
DEVI void scan(const P& p, unsigned char* lds_) {
    for (int unit = blockIdx.x; unit < NUNIT; unit += gridDim.x) {
    __syncthreads();
    const int tid = otid(), lane = tid & 63, w = __builtin_amdgcn_readfirstlane(tid >> 6), c = lane & 15, q4 = lane >> 4;
    const int kp = tid & 63, lo = tid >> 6;
    const int d = unit / (8 * NSEG), h = (unit / NSEG) & 7, seg = unit % NSEG;
    LAS unsigned char* lds = (LAS unsigned char*)lds_;
    const bf16_t* G = (const bf16_t*)(p.ws + WS_G);
    bf16_t* O = (bf16_t*)(p.ws + (d ? WS_OB : WS_OF));
    float* SLOC = (float*)(p.ws + WS_SC);
    float* GSUM = SLOC + (size_t)NUNIT * 16384;
    f32x4 S[8];
#pragma unroll
    for (int t = 0; t < 8; ++t) S[t] = (f32x4){0.f, 0.f, 0.f, 0.f};
    if (PASS2) {
        for (int j = 0; j < seg; ++j) {
            const float* gs = GSUM + (size_t)(unit - seg + j) * 128; const float* sl = SLOC + (size_t)(unit - seg + j) * 16384 + (size_t)w * 2048;
#pragma unroll
            for (int t = 0; t < 8; ++t) { const f32x4 gg = *(const f32x4*)(gs + 16 * t + 4 * q4);
#pragma unroll
                for (int r = 0; r < 4; ++r) S[t][r] = S[t][r] * __expf(gg[r]) + sl[(t * 4 + r) * 64 + lane]; }
        }
    }
    float gsum0 = 0.f, gsum1 = 0.f;
    unsigned rq[4], ri[4], rz[4];
    const int CPS = 32 + (seg < 8 ? 1 : 0), ci0 = 32 * seg + (seg < 8 ? seg : 8);
    const bf16_t* Gk = G + h * 128 + 2 * kp + (d ? 1024 : 0);
    const long rstep = d ? -5120 : 5120;
#define HG_FETCH(ci) do { const bf16_t* g_ = Gk + (long)scan_row(32 * (ci) + 4 * lo, d) * 5120; _Pragma("unroll") for (int j = 0; j < 4; ++j) { \
        if (PASS2) rq[j] = *(const unsigned*)(g_ + (d ? -1024 : 0)); ri[j] = *(const unsigned*)(g_ + (d ? 0 : 1024)); rz[j] = *(const unsigned*)(g_ + 2048); g_ += rstep; } } while (0)
    HG_FETCH(ci0);
    for (int cc = 0; cc < CPS; ++cc) {
        const int ci = ci0 + cc;
        LAS unsigned char* B = lds + (cc & 1) * BUFB;
        float bl0[4], bl1[4], kv0[4], kv1[4]; float run0 = 0.f, run1 = 0.f;
#pragma unroll
        for (int j = 0; j < 4; ++j) { const float z0 = bflo(rz[j]), z1 = bfhi(rz[j]); run0 += z0; run1 += z1; bl0[j] = run0; bl1[j] = run1; kv0[j] = 1.0f - __expf(z0); kv1[j] = 1.0f - __expf(z1); }
        unsigned qp[4], vp[4];
#pragma unroll
        for (int j = 0; j < 4; ++j) { vp[j] = ri[j]; if (PASS2) qp[j] = rq[j]; }
        *(LAS f32x2_t*)(B + OFF_T + (lo * 128 + 2 * kp) * 4) = (f32x2_t){run0, run1};
        if (cc + 1 < CPS) HG_FETCH(ci + 1);
        HG_BAR();
        {
            float off0 = 0.f, off1 = 0.f, b15_0 = 0.f, b15_1 = 0.f, bla0 = 0.f, bla1 = 0.f;
#pragma unroll
            for (int x8 = 0; x8 < 8; ++x8) { const f32x2_t tt = *(const LAS f32x2_t*)(B + OFF_T + (x8 * 128 + 2 * kp) * 4);
                if (x8 < lo) { off0 += tt.x; off1 += tt.y; } if (x8 < 4) { b15_0 += tt.x; b15_1 += tt.y; } bla0 += tt.x; bla1 += tt.y; }
            const float e15_0 = __expf(b15_0), e15_1 = __expf(b15_1), el0 = __expf(bla0 - b15_0), el1 = __expf(bla1 - b15_1);
            float kd0[4], kd1[4];
#pragma unroll
            for (int j = 0; j < 4; ++j) {
                const int l = 4 * lo + j;
                const float b0 = bl0[j] + off0, b1 = bl1[j] + off1;
                const float kt0 = kv0[j] * __expf(b15_0 - b0), kt1 = kv1[j] * __expf(b15_1 - b1);
                kd0[j] = kt0 * el0; kd1[j] = kt1 * el1;
                if (PASS2) {
                    const float qt0 = bflo(qp[j]) * __expf(b0 - b15_0), qt1 = bfhi(qp[j]) * __expf(b1 - b15_1);
                    *(LAS unsigned*)(B + OFF_QT + l * QSB + 4 * kp) = pk2(qt0, qt1); *(LAS unsigned*)(B + OFF_QD + l * QSB + 4 * kp) = pk2(qt0 * e15_0, qt1 * e15_1);
                    *(LAS unsigned*)(B + OFF_KT + l * QSB + 4 * kp) = pk2(kt0, kt1);
                }
            }
            *(LAS u32x2*)(B + OFF_KDT + (2 * kp) * TSB + 8 * lo) = (u32x2){pk2(kd0[0], kd0[1]), pk2(kd0[2], kd0[3])};
            *(LAS u32x2*)(B + OFF_KDT + (2 * kp + 1) * TSB + 8 * lo) = (u32x2){pk2(kd1[0], kd1[1]), pk2(kd1[2], kd1[3])};
            *(LAS u32x2*)(B + OFF_VT + (2 * kp) * TSB + 8 * lo) = (u32x2){(vp[0] & 0xffffu) | (vp[1] << 16), (vp[2] & 0xffffu) | (vp[3] << 16)};
            *(LAS u32x2*)(B + OFF_VT + (2 * kp + 1) * TSB + 8 * lo) = (u32x2){(vp[0] >> 16) | (vp[1] & 0xffff0000u), (vp[2] >> 16) | (vp[3] & 0xffff0000u)};
            if (lo == 0) { *(LAS f32x2_t*)(B + OFF_DEC + 8 * kp) = (f32x2_t){__expf(bla0), __expf(bla1)}; gsum0 += bla0; gsum1 += bla1; }
        }
        HG_BAR();
        if (PASS2) {
            f32x4 p00 = {0.f, 0.f, 0.f, 0.f}, p01 = p00, p11 = p00;
#pragma unroll
            for (int s4 = 0; s4 < 4; ++s4) {
                const bf16x8 a0 = *(const LAS bf16x8*)(B + OFF_KT + c * QSB + 64 * s4 + 16 * q4), a1 = *(const LAS bf16x8*)(B + OFF_KT + (16 + c) * QSB + 64 * s4 + 16 * q4);
                const bf16x8 b0 = *(const LAS bf16x8*)(B + OFF_QT + c * QSB + 64 * s4 + 16 * q4), b1 = *(const LAS bf16x8*)(B + OFF_QT + (16 + c) * QSB + 64 * s4 + 16 * q4);
                p00 = HG_MFMA(a0, b0, p00); p01 = HG_MFMA(a0, b1, p01); p11 = HG_MFMA(a1, b1, p11);
            }
#pragma unroll
            for (int r = 0; r < 4; ++r) { const bool keep = (4 * q4 + r) <= c; p00[r] = keep ? p00[r] : 0.f; p11[r] = keep ? p11[r] : 0.f; }
            const bf16x8 bp0 = mk8(cvtpk(p00[0], p00[1]), cvtpk(p00[2], p00[3]), 0u, 0u);
            const bf16x8 bp1 = mk8(cvtpk(p01[0], p01[1]), cvtpk(p01[2], p01[3]), cvtpk(p11[0], p11[1]), cvtpk(p11[2], p11[3]));
            const u32x2 v0 = *(const LAS u32x2*)(B + OFF_VT + (16 * w + c) * TSB + 8 * q4), v1 = *(const LAS u32x2*)(B + OFF_VT + (16 * w + c) * TSB + 32 + 8 * q4);
            const bf16x8 va = mk8(v0.x, v0.y, v1.x, v1.y);
            f32x4 o0 = {0.f, 0.f, 0.f, 0.f}, o1 = o0;
            o0 = HG_MFMA(va, bp0, o0); o1 = HG_MFMA(va, bp1, o1);
#pragma unroll
            for (int s4 = 0; s4 < 4; ++s4) {
                const bf16x8 sa = mk8(cvtpk(S[2 * s4][0], S[2 * s4][1]), cvtpk(S[2 * s4][2], S[2 * s4][3]), cvtpk(S[2 * s4 + 1][0], S[2 * s4 + 1][1]), cvtpk(S[2 * s4 + 1][2], S[2 * s4 + 1][3]));
                const u32x2 x0 = *(const LAS u32x2*)(B + OFF_QD + c * QSB + 64 * s4 + 8 * q4), x1 = *(const LAS u32x2*)(B + OFF_QD + c * QSB + 64 * s4 + 32 + 8 * q4);
                const u32x2 y0 = *(const LAS u32x2*)(B + OFF_QD + (16 + c) * QSB + 64 * s4 + 8 * q4), y1 = *(const LAS u32x2*)(B + OFF_QD + (16 + c) * QSB + 64 * s4 + 32 + 8 * q4);
                o0 = HG_MFMA(sa, mk8(x0.x, x0.y, x1.x, x1.y), o0); o1 = HG_MFMA(sa, mk8(y0.x, y0.y, y1.x, y1.y), o1);
            }
            {
                const int ra = scan_row(32 * ci + c, d), rb = scan_row(32 * ci + 16 + c, d);
                *(u32x2*)(O + (size_t)ra * D + h * 128 + 16 * w + 4 * q4) = (u32x2){cvtpk(o0[0], o0[1]), cvtpk(o0[2], o0[3])};
                *(u32x2*)(O + (size_t)rb * D + h * 128 + 16 * w + 4 * q4) = (u32x2){cvtpk(o1[0], o1[1]), cvtpk(o1[2], o1[3])};
            }
        }
        {
            const bf16x8 vb = *(const LAS bf16x8*)(B + OFF_VT + (16 * w + c) * TSB + 16 * q4);
#pragma unroll
            for (int t = 0; t < 8; ++t) {
                const f32x4 dec = *(const LAS f32x4*)(B + OFF_DEC + (16 * t + 4 * q4) * 4);
                const bf16x8 ka = *(const LAS bf16x8*)(B + OFF_KDT + (16 * t + c) * TSB + 16 * q4);
                S[t] = HG_MFMA(ka, vb, S[t] * dec);
            }
        }
    }
    if (!PASS2) {
        float* sl = SLOC + (size_t)unit * 16384 + (size_t)w * 2048;
#pragma unroll
        for (int t = 0; t < 8; ++t)
#pragma unroll
            for (int r = 0; r < 4; ++r) sl[(t * 4 + r) * 64 + lane] = S[t][r];
        if (lo == 0) { GSUM[(size_t)unit * 128 + 2 * kp] = gsum0; GSUM[(size_t)unit * 128 + 2 * kp + 1] = gsum1; }
    }
#undef HG_FETCH
    }
}
}

DEVI void hgrn_readout_row(const P& p, int r, int lane, Row16& a, const Row16& b, const Row16& zg, const Row16& ng) {
    Row16 o; float s0 = 0.f, s1 = 0.f;
#pragma unroll
    for (int e = 0; e < 8; ++e) { a.v[e] += b.v[e]; a.v[8 + e] += b.v[8 + e]; s0 += a.v[e] * a.v[e]; s1 += a.v[8 + e] * a.v[8 + e]; }
    s0 = row16_sum(s0); s1 = row16_sum(s1);
    const float r0 = rsqrtf(s0 * (1.0f / 128.0f) + EPS), r1 = rsqrtf(s1 * (1.0f / 128.0f) + EPS);
#pragma unroll
    for (int e = 0; e < 8; ++e) { o.v[e] = a.v[e] * r0 * ng.v[e] * zg.v[e]; o.v[8 + e] = a.v[8 + e] * r1 * ng.v[8 + e] * zg.v[8 + e]; }
    store_row_bf16((bf16_t*)(p.ws + WS_U) + (size_t)r * D, lane, o);
}
DEVI void ph_hgrn_readout(const P& p) {
    const int otid_ = otid();
    const int wave = __builtin_amdgcn_readfirstlane(otid_ >> 6), lane = otid_ & 63, gw = blockIdx.x * NWV + wave, NGW = gridDim.x * NWV;
    Row16 ng; load_row_f32(p.in[I_HNG], lane, ng);
    for (int r = gw; r < MA; r += 2 * NGW) {
        const int r1 = r + NGW;
        Row16 a0, b0, z0, a1, b1, z1;
        load_row_bf16((const bf16_t*)(p.ws + WS_OF) + (size_t)r * D, lane, a0); load_row_bf16((const bf16_t*)(p.ws + WS_OB) + (size_t)r * D, lane, b0);
        load_row_bf16((const bf16_t*)(p.ws + WS_G) + (size_t)r * 5120 + 4096, lane, z0);
        if (r1 < MA) { load_row_bf16((const bf16_t*)(p.ws + WS_OF) + (size_t)r1 * D, lane, a1); load_row_bf16((const bf16_t*)(p.ws + WS_OB) + (size_t)r1 * D, lane, b1);
            load_row_bf16((const bf16_t*)(p.ws + WS_G) + (size_t)r1 * 5120 + 4096, lane, z1); }
        hgrn_readout_row(p, r, lane, a0, b0, z0, ng);
        if (r1 < MA) hgrn_readout_row(p, r1, lane, a1, b1, z1, ng);
    }
}

DEVI float reduce16(float (&v)[16], int lane) {
    float w8[8], w4[4], w2[2];
    const bool b5 = lane & 32, b4 = lane & 16, b3 = lane & 8, b2 = lane & 4;
#pragma unroll
    for (int i = 0; i < 8; ++i) { const float keep = b5 ? v[i + 8] : v[i], send = b5 ? v[i] : v[i + 8]; w8[i] = keep + __shfl_xor(send, 32); }
#pragma unroll
    for (int i = 0; i < 4; ++i) { const float keep = b4 ? w8[i + 4] : w8[i], send = b4 ? w8[i] : w8[i + 4]; w4[i] = keep + __shfl_xor(send, 16); }
#pragma unroll
    for (int i = 0; i < 2; ++i) { const float keep = b3 ? w4[i + 2] : w4[i], send = b3 ? w4[i] : w4[i + 2]; w2[i] = keep + __shfl_xor(send, 8); }
    const float keep = b2 ? w2[1] : w2[0], send = b2 ? w2[0] : w2[1];
    float r = keep + __shfl_xor(send, 4);
    r += __shfl_xor(r, 2); r += __shfl_xor(r, 1);
    return r;
}
namespace s5 {
typedef short bf16x8 __attribute__((ext_vector_type(8)));
constexpr int NSEG = 16, SEGLEN = MA / NSEG, CPS = SEGLEN / 16;
static_assert(SEGLEN * NSEG == MA && CPS * 16 == SEGLEN, "s5 segments");
constexpr int XSB = 272, BSB = 528, WAVE_LDS = 16 * BSB + 16 * XSB;
DEVI bf16x8 mk8(unsigned a, unsigned b, unsigned c, unsigned d) { u32x4 v = {a, b, c, d}; return __builtin_bit_cast(bf16x8, v); }
template <bool PASS2>
DEVI void scan(const P& p, unsigned char* lds_) {
    const int tid = otid(), lane = tid & 63, w = __builtin_amdgcn_readfirstlane(tid >> 6), c = lane & 15, q4 = lane >> 4;
    for (int blk = blockIdx.x; blk < 256; blk += gridDim.x) {
    const int dn = blk >> 7, seg = (blk >> 3) & 15, g = (blk & 7) * 8 + w;
    LAS unsigned char* BUS = (LAS unsigned char*)lds_ + w * WAVE_LDS; LAS unsigned char* XS = BUS + 16 * BSB;
    const bf16_t* XN = (const bf16_t*)(p.ws + WS_XN);
    bf16_t* Y = (bf16_t*)(p.ws + (dn ? WS_OB : WS_OF));
    float* XE = (float*)(p.ws + WS_XE);
    const float* Aab = (const float*)(p.ws + WS_S5A) + (size_t)((dn * 64 + g) * 64 + lane) * 2;
    const float abr = Aab[0], abi = Aab[1];
    bf16x8 bfr[8];
#pragma unroll
    for (int n = 0; n < 8; ++n) {
        if (q4 < 2) { const float* B = (const float*)(p.ws + WS_S5B) + (size_t)((dn * 64 + g) * 64 + 8 * n + (c >> 1)) * 32 + (c & 1) * 16 + 8 * q4;
            const f32x4 b0 = *(const f32x4*)B, b1 = *(const f32x4*)(B + 4); bfr[n] = mk8(pk2(b0[0], b0[1]), pk2(b0[2], b0[3]), pk2(b1[0], b1[1]), pk2(b1[2], b1[3])); }
        else bfr[n] = mk8(0u, 0u, 0u, 0u);
    }
    bf16x8 cfr[4];
    if (PASS2) {
#pragma unroll
        for (int s4 = 0; s4 < 4; ++s4) {
            const size_t o = ((size_t)(dn * 64 + g) * 16 + c) * 64 + 16 * s4 + 4 * q4;
            const f32x4 cr = *(const f32x4*)(p.in[I_S5CR] + o), ci = *(const f32x4*)(p.in[I_S5CI] + o);
            cfr[s4] = mk8(pk2(cr[0], -ci[0]), pk2(cr[1], -ci[1]), pk2(cr[2], -ci[2]), pk2(cr[3], -ci[3]));
        }
    }
    float xr = 0.f, xi = 0.f;
    if (PASS2 && seg > 0) {
        float pr = 1.f, pi = 0.f, br = abr, bi = abi;
#define S5_PIN(x) asm volatile("" : "+v"(x))
#pragma unroll 1
        for (int n = SEGLEN; n; n >>= 1) {
            if (n & 1) { float t = pr * br; S5_PIN(t); t = __builtin_fmaf(-pi, bi, t); S5_PIN(t); float u = pr * bi; S5_PIN(u); u = __builtin_fmaf(pi, br, u); S5_PIN(u); pr = t; pi = u; }
            float t2 = br * br; S5_PIN(t2); t2 = __builtin_fmaf(-bi, bi, t2); S5_PIN(t2); float u2 = 2.f * br * bi; S5_PIN(u2); br = t2; bi = u2;
        }
        for (int j = 0; j < seg; ++j) { const float* e = XE + ((size_t)((dn * 64 + g) * 16 + j) * 64 + lane) * 2; const float er = e[0], ei = e[1];
            float t = __builtin_fmaf(pr, xr, er); S5_PIN(t); t = __builtin_fmaf(-pi, xi, t); S5_PIN(t); float u = __builtin_fmaf(pr, xi, ei); S5_PIN(u); u = __builtin_fmaf(pi, xr, u); S5_PIN(u); xr = t; xi = u; }
#undef S5_PIN
    }
    const int n0 = seg * SEGLEN;
    const unsigned amask = q4 < 2 ? 0xffffffffu : 0u;
    u32x4 araw = *(const u32x4*)(XN + (size_t)scan_row(n0 + c, dn) * D + g * 16 + 8 * (q4 & 1));
#pragma unroll 1
    for (int cc = 0; cc < CPS; ++cc) {
        const u32x4 am = {araw[0] & amask, araw[1] & amask, araw[2] & amask, araw[3] & amask};
        const bf16x8 afr = __builtin_bit_cast(bf16x8, am);
        { const int cn = cc + 1 < CPS ? cc + 1 : cc; araw = *(const u32x4*)(XN + (size_t)scan_row(n0 + 16 * cn + c, dn) * D + g * 16 + 8 * (q4 & 1)); }
#pragma unroll
        for (int n = 0; n < 8; ++n) {
            const f32x4 dv = __builtin_amdgcn_mfma_f32_16x16x32_bf16(bfr[n], afr, (f32x4){0.f, 0.f, 0.f, 0.f}, 0, 0, 0);
            *(LAS f32x4*)(BUS + c * BSB + (16 * n + 4 * q4) * 4) = dv;
        }
        asm volatile("s_waitcnt lgkmcnt(0)" ::: "memory");
        f32x2_t bu[16];
#pragma unroll
        for (int t = 0; t < 16; ++t) bu[t] = *(const LAS f32x2_t*)(BUS + t * BSB + 8 * lane);
        unsigned xs[16];
#pragma unroll
        for (int t = 0; t < 16; ++t) {
            float nr = __builtin_fmaf(abr, xr, bu[t].x); asm volatile("" : "+v"(nr)); nr = __builtin_fmaf(-abi, xi, nr); asm volatile("" : "+v"(nr));
            float ni = __builtin_fmaf(abr, xi, bu[t].y); asm volatile("" : "+v"(ni)); ni = __builtin_fmaf(abi, xr, ni); asm volatile("" : "+v"(ni));
            xr = nr; xi = ni;
            if (PASS2) xs[t] = pk2(xr, xi);
        }
        if (PASS2) {
#pragma unroll
            for (int t = 0; t < 16; ++t) *(LAS unsigned*)(XS + t * XSB + 4 * lane) = xs[t];
        }
        asm volatile("s_waitcnt lgkmcnt(0)" ::: "memory");
        if (PASS2) {
            f32x4 y = {0.f, 0.f, 0.f, 0.f};
#pragma unroll
            for (int s4 = 0; s4 < 4; ++s4) { const bf16x8 xf = *(const LAS bf16x8*)(XS + c * XSB + 64 * s4 + 16 * q4); y = __builtin_amdgcn_mfma_f32_16x16x32_bf16(cfr[s4], xf, y, 0, 0, 0); }
            *(u32x2*)(Y + (size_t)scan_row(n0 + 16 * cc + c, dn) * D + g * 16 + 4 * q4) = (u32x2){pk2(y[0], y[1]), pk2(y[2], y[3])};
        }
    }
    if (!PASS2) { float* e = XE + ((size_t)((dn * 64 + g) * 16 + seg) * 64 + lane) * 2; e[0] = xr; e[1] = xi; }
    }
}
}

DEVI void ph_s5_elem(const P& p) {
    const int otid_ = otid();
    const int wave = __builtin_amdgcn_readfirstlane(otid_ >> 6), lane = otid_ & 63, gw = blockIdx.x * NWV + wave, NGW = gridDim.x * NWV;
    Row16 dd; load_row_f32(p.in[I_S5D], lane, dd);
    for (int r = gw; r < MA; r += 2 * NGW) {
        const int r1 = r + NGW;
        Row16 u0, a0, b0, u1, a1, b1, o;
        load_row_bf16((const bf16_t*)(p.ws + WS_XN) + (size_t)r * D, lane, u0);
        load_row_bf16((const bf16_t*)(p.ws + WS_OF) + (size_t)r * D, lane, a0); load_row_bf16((const bf16_t*)(p.ws + WS_OB) + (size_t)r * D, lane, b0);
        if (r1 < MA) { load_row_bf16((const bf16_t*)(p.ws + WS_XN) + (size_t)r1 * D, lane, u1);
            load_row_bf16((const bf16_t*)(p.ws + WS_OF) + (size_t)r1 * D, lane, a1); load_row_bf16((const bf16_t*)(p.ws + WS_OB) + (size_t)r1 * D, lane, b1); }
#pragma unroll
        for (int e = 0; e < 16; ++e) o.v[e] = geluf_(dd.v[e] * u0.v[e] + a0.v[e] + b0.v[e]);
        store_row_bf16((bf16_t*)(p.ws + WS_U) + (size_t)r * D, lane, o);
        if (r1 < MA) {
#pragma unroll
            for (int e = 0; e < 16; ++e) o.v[e] = geluf_(dd.v[e] * u1.v[e] + a1.v[e] + b1.v[e]);
            store_row_bf16((bf16_t*)(p.ws + WS_U) + (size_t)r1 * D, lane, o);
        }
    }
}
DEVI float score_key(float s, int e) { return __uint_as_float((__float_as_uint(s) & 0xffffff80u) | (unsigned)e); }
DEVI float key_score(float k) { return k; }
DEVI int key_idx(float k) { return (int)(__float_as_uint(k) & 127u); }
DEVI float h2f_lo(unsigned w) { return (float)__builtin_bit_cast(pg8::f16x2_t, w).x; }
DEVI float h2f_hi(unsigned w) { return (float)__builtin_bit_cast(pg8::f16x2_t, w).y; }
DEVI void topk_wave_item(const P& p, int layer, int r, int h, int lane) {
    const unsigned short* s = (const unsigned short*)(p.ws + WS_SCH) + (size_t)r * 2048 + h * 256;
    const unsigned w0 = *(const unsigned*)(s + 2 * lane), w1 = *(const unsigned*)(s + 128 + 2 * lane);
    const float NEG = -__builtin_inff();
    float k00 = score_key(h2f_lo(w0), 2 * lane), k01 = score_key(h2f_hi(w0), 2 * lane + 1), k10 = score_key(h2f_lo(w1), 2 * lane), k11 = score_key(h2f_hi(w1), 2 * lane + 1);
    float A[16], B[16];
#pragma unroll
    for (int i = 0; i < 16; ++i) {
        const float ma = wave_max_f(__builtin_fmaxf(k00, k01)), mb = wave_max_f(__builtin_fmaxf(k10, k11));
        A[i] = ma; B[i] = mb;
        k00 = (k00 == ma) ? NEG : k00; k01 = (k01 == ma) ? NEG : k01; k10 = (k10 == mb) ? NEG : k10; k11 = (k11 == mb) ? NEG : k11;
    }
    int ci = -1, cj = 0, base = 0;
#pragma unroll
    for (int i = 0; i < 16; ++i) { const int cnt = 16 / (i + 1); if (ci < 0 && lane < base + cnt) { ci = i; cj = lane - base; } base += cnt; }
    float av = A[0], bv = B[0];
#pragma unroll
    for (int i = 1; i < 16; ++i) { av = (ci == i) ? A[i] : av; bv = (cj == i) ? B[i] : bv; }
    const int payload = key_idx(av) * 128 + key_idx(bv);
    const float sum = key_score(av) + key_score(bv);
    float ck = (ci >= 0) ? __uint_as_float((__float_as_uint(sum) & 0xffffffc0u) | (unsigned)lane) : NEG;
    float mys = 0.f, best = 0.f; int myidx = 0;
#pragma unroll
    for (int j = 0; j < 16; ++j) {
        const float mm = wave_max_f(ck);
        const int src = __builtin_amdgcn_readfirstlane((int)(__float_as_uint(mm) & 63u));
        const int pl = __builtin_amdgcn_readlane(payload, src);
        if (lane == j) { mys = mm; myidx = pl; }
        if (j == 0) best = mm;
        ck = (lane == src) ? NEG : ck;
    }
    const float e = lane < 16 ? __expf(mys - best) : 0.f;
    const float tot = wave_sum(e);
    if (lane < 16) {
        const f32x2_t sc2 = ((const f32x2_t*)(p.ws + WS_SCL) + (size_t)layer * 16384)[myidx];
        const size_t o = (size_t)r * 128 + h * 16 + lane;
        ((int*)(p.ws + WS_SELI))[o] = myidx; ((float*)(p.ws + WS_SELG))[o] = e / tot * sc2.y; ((float*)(p.ws + WS_SELU))[o] = sc2.x;
    }
}
constexpr int TK_ITEM_B = 144;
DEVI void ph_topk(const P& p, int layer, int r0, unsigned char* lds_) {
    const int otid_ = otid();
    const int wave = otid_ >> 6, lane = otid_ & 63;
    const int nall = (MA - r0) * 8, nthr = (int)gridDim.x * NTHR;
    const int nleft = nall % nthr;
    const int nitems = (nleft > 0 && nleft <= nthr / 8) ? nall - nleft : nall;
    for (int e = blockIdx.x * NWV + wave + nitems; e < nall; e += (int)gridDim.x * NWV) topk_wave_item(p, layer, r0 + (e >> 3), e & 7, lane);
    const unsigned char* SCb = (const unsigned char*)(p.ws + WS_SCH);
    LAS unsigned char* tile = (LAS unsigned char*)lds_ + wave * (64 * TK_ITEM_B);
    for (int it = blockIdx.x * NTHR + otid_; it < nitems; it += gridDim.x * NTHR) {
        const int r = r0 + (it >> 3), h = it & 7;
        const unsigned char* wbase = SCb + ((size_t)(r0 + ((it - lane) >> 3)) * 2048) * 2;
        const unsigned goff = (unsigned)(lane >> 3) * 512u + 16u * (unsigned)(lane & 7);
        u32x4 g[8];
#pragma unroll
        for (int j = 0; j < 8; ++j) g[j] = *(const u32x4*)(wbase + goff + 4096 * j);
        float L0[16], L1[16];
#pragma unroll 1
        for (int k = 0; k < 4; ++k) {
#pragma unroll
            for (int j = 0; j < 8; ++j) *(LAS u32x4*)(tile + (8 * j + (lane >> 3)) * TK_ITEM_B + 16 * (lane & 7)) = g[j];
            if (k < 3) {
#pragma unroll
                for (int j = 0; j < 8; ++j) g[j] = *(const u32x4*)(wbase + goff + 4096 * j + 128 * (k + 1));
            }
            u32x4 m[8];
#pragma unroll
            for (int i = 0; i < 8; ++i) m[i] = *(const LAS u32x4*)(tile + lane * TK_ITEM_B + 16 * i);
            float L[16];
            if (k & 1) {
#pragma unroll
                for (int j = 0; j < 16; ++j) L[j] = (k == 1) ? L0[j] : L1[j];
            } else {
#pragma unroll
                for (int j = 0; j < 16; ++j) L[j] = -__builtin_inff();
            }
            const int ebase = 64 * (k & 1);
#pragma unroll
            for (int gq = 0; gq < 4; ++gq) {
                float G[16];
#pragma unroll
                for (int e = 0; e < 16; ++e) { const unsigned wd = m[2 * gq + (e >> 3)][(e & 7) >> 1]; G[e] = score_key((e & 1) ? h2f_hi(wd) : h2f_lo(wd), ebase + 16 * gq + e); }
#define CE(a, b) { const float hi_ = __builtin_fmaxf(G[a], G[b]), lo_ = __builtin_fminf(G[a], G[b]); G[a] = hi_; G[b] = lo_; }
                CE(0,1) CE(2,3) CE(0,2) CE(1,3) CE(1,2) CE(4,5) CE(6,7) CE(4,6) CE(5,7) CE(5,6) CE(0,4) CE(2,6) CE(2,4) CE(1,5) CE(3,7) CE(3,5) CE(1,2) CE(3,4) CE(5,6) CE(8,9) CE(10,11) CE(8,10) CE(9,11) CE(9,10) CE(12,13) CE(14,15) CE(12,14) CE(13,15) CE(13,14) CE(8,12) CE(10,14) CE(10,12) CE(9,13) CE(11,15) CE(11,13) CE(9,10) CE(11,12) CE(13,14) CE(0,8) CE(4,12) CE(4,8) CE(2,10) CE(6,14) CE(6,10) CE(2,4) CE(6,8) CE(10,12) CE(1,9) CE(5,13) CE(5,9) CE(3,11) CE(7,15) CE(7,11) CE(3,5) CE(7,9) CE(11,13) CE(1,2) CE(3,4) CE(5,6) CE(7,8) CE(9,10) CE(11,12) CE(13,14)
#undef CE
#pragma unroll
                for (int i = 0; i < 16; ++i) L[i] = __builtin_fmaxf(L[i], G[15 - i]);
#pragma unroll
                for (int jj = 8; jj > 0; jj >>= 1)
#pragma unroll
                    for (int i = 0; i < 16; ++i) { const int l = i ^ jj; if (l > i) { const float hi = __builtin_fmaxf(L[i], L[l]), lo = __builtin_fminf(L[i], L[l]); L[i] = hi; L[l] = lo; } }
            }
            if (k < 2) {
#pragma unroll
                for (int j = 0; j < 16; ++j) L0[j] = L[j];
            } else {
#pragma unroll
                for (int j = 0; j < 16; ++j) L1[j] = L[j];
            }
        }
        const float amx = __builtin_fmaxf(__builtin_fmaxf(__builtin_fabsf(L0[0]), __builtin_fabsf(L0[15])), __builtin_fmaxf(__builtin_fabsf(L1[0]), __builtin_fabsf(L1[15])));
        const float ksc = 65000.0f / __builtin_fmaxf(amx, 1e-30f), kinv = 1.0f / (ksc * 16384.0f);
        int KA[16], KB[16];
#pragma unroll
        for (int j = 0; j < 16; ++j) { KA[j] = ((int)__builtin_rintf(L0[j] * ksc) << 14) | (key_idx(L0[j]) << 7); KB[j] = ((int)__builtin_rintf(L1[j] * ksc) << 14) | key_idx(L1[j]); }
        int fk[16];
#pragma unroll
        for (int j = 0; j < 16; ++j) fk[j] = KA[0] + KB[j];
#pragma unroll
        for (int i = 1; i < 16; ++i)
#pragma unroll
            for (int j = 0; j < 16; ++j)
                if ((i + 1) * (j + 1) <= 16) {
                    int xk = KA[i] + KB[j];
#pragma unroll
                    for (int q = 0; q < 16; ++q) if (q >= (i + 1) * (j + 1) - 1) { const int hi = xk > fk[q] ? xk : fk[q], lo = xk > fk[q] ? fk[q] : xk; fk[q] = hi; xk = lo; }
                }
        float fs[16]; int fi[16];
#pragma unroll
        for (int j = 0; j < 16; ++j) { fs[j] = (float)fk[j] * kinv; fi[j] = fk[j] & 16383; }
        float sum = 0.f, e[16];
#pragma unroll
        for (int j = 0; j < 16; ++j) { e[j] = __expf(fs[j] - fs[0]); sum += e[j]; }
        const float inv = 1.0f / sum;
        const f32x2_t* SC2 = (const f32x2_t*)(p.ws + WS_SCL) + (size_t)layer * 16384;
        float su[16];
#pragma unroll
        for (int j = 0; j < 16; ++j) { const f32x2_t sc2 = SC2[fi[j]]; su[j] = sc2.x; e[j] = e[j] * inv * sc2.y; }
        i32x4* oi = (i32x4*)((int*)(p.ws + WS_SELI) + (size_t)r * 128 + h * 16); f32x4* og = (f32x4*)((float*)(p.ws + WS_SELG) + (size_t)r * 128 + h * 16); f32x4* ou = (f32x4*)((float*)(p.ws + WS_SELU) + (size_t)r * 128 + h * 16);
#pragma unroll
        for (int j = 0; j < 4; ++j) { oi[j] = (i32x4){fi[4 * j], fi[4 * j + 1], fi[4 * j + 2], fi[4 * j + 3]}; og[j] = (f32x4){e[4 * j], e[4 * j + 1], e[4 * j + 2], e[4 * j + 3]}; ou[j] = (f32x4){su[4 * j], su[4 * j + 1], su[4 * j + 2], su[4 * j + 3]}; }
    }
}

DEVI void fmac_vv(float& acc, float a, float b) { asm("v_fmac_f32 %0, %1, %2" : "+v"(acc) : "v"(a), "v"(b)); }

DEVI void pkfma(f32x2_t& acc, f32x2_t a, f32x2_t b) { asm("v_pk_fma_f32 %0, %1, %2, %0" : "+v"(acc) : "v"(a), "v"(b)); }
DEVI float dot16_i8(const u32x4 q, const u32x4 h) {
    int a = __builtin_amdgcn_sdot4((int)q[0], (int)h[0], 0, false); a = __builtin_amdgcn_sdot4((int)q[1], (int)h[1], a, false);
    a = __builtin_amdgcn_sdot4((int)q[2], (int)h[2], a, false); a = __builtin_amdgcn_sdot4((int)q[3], (int)h[3], a, false);
    return (float)a;
}
template <int HI, bool FIRST> DEVI void pkfma_bc(f32x2_t& acc, f32x2_t wp, f32x2_t b) {
    if (FIRST) {
        if (HI) asm volatile("v_pk_mul_f32 %0, %1, %2 op_sel:[1,0] op_sel_hi:[1,1]" : "=&v"(acc) : "v"(wp), "v"(b));
        else    asm volatile("v_pk_mul_f32 %0, %1, %2 op_sel:[0,0] op_sel_hi:[0,1]" : "=&v"(acc) : "v"(wp), "v"(b));
    } else {
        if (HI) asm volatile("v_pk_fma_f32 %0, %1, %2, %0 op_sel:[1,0,0] op_sel_hi:[1,1,1]" : "+v"(acc) : "v"(wp), "v"(b));
        else    asm volatile("v_pk_fma_f32 %0, %1, %2, %0 op_sel:[0,0,0] op_sel_hi:[0,1,1]" : "+v"(acc) : "v"(wp), "v"(b));
    }
}
template <int HI, bool FIRST> DEVI void axpy16_fp8(const u32x4 q, f32x2_t wp, f32x2_t (&acc)[8]) {
#pragma unroll
    for (int j = 0; j < 4; ++j) { const f32x2_t lo = __builtin_amdgcn_cvt_pk_f32_fp8(q[j], false), hi = __builtin_amdgcn_cvt_pk_f32_fp8(q[j], true); pkfma_bc<HI, FIRST>(acc[2 * j], wp, lo); pkfma_bc<HI, FIRST>(acc[2 * j + 1], wp, hi); }
}
template <int K, bool FIRST> DEVI void axpy_row(const u32x4 q, const f32x4 w4, f32x2_t (&acc)[8]) {
    const f32x2_t wp = (K & 2) ? __builtin_shufflevector(w4, w4, 2, 3) : __builtin_shufflevector(w4, w4, 0, 1);
    axpy16_fp8<K & 1, FIRST>(q, wp, acc);
}
DEVI void swap32f(float& a, float& b) { const auto r = __builtin_amdgcn_permlane32_swap(__float_as_uint(a), __float_as_uint(b), false, false); a = __uint_as_float(r[0]); b = __uint_as_float(r[1]); }
DEVI void swap16f(float& a, float& b) { const auto r = __builtin_amdgcn_permlane16_swap(__float_as_uint(a), __float_as_uint(b), false, false); a = __uint_as_float(r[0]); b = __uint_as_float(r[1]); }
struct SliceGeo { int x, rank, n; };
struct Seg8 { u32x4 q[8]; };
struct Idx16 { i32x4 v[4]; };
DEVI void idx16_load(Idx16& I, const int* SI, int t, int r8) { const i32x4* s = (const i32x4*)(SI + (size_t)t * 128 + r8 * 16); I.v[0] = s[0]; I.v[1] = s[1]; I.v[2] = s[2]; I.v[3] = s[3]; }
DEVI void seg8_load(Seg8& s, const __amdgpu_buffer_rsrc_t tab, const Idx16& I, int half, unsigned coff) {
#pragma unroll
    for (int k = 0; k < 8; ++k) { const int row = I.v[2 * half + (k >> 2)][k & 3]; s.q[k] = __builtin_amdgcn_raw_buffer_load_b128(tab, (unsigned)row * 128u + coff, 0, 0); }
}
DEVI float reduce8_c8(const float (&d)[8], int lane) {
    const bool b2 = lane & 4, b1 = lane & 2, b0 = lane & 1;
    float r4[4], r2[2];
#pragma unroll
    for (int i = 0; i < 4; ++i) { const float keep = b2 ? d[i + 4] : d[i], send = b2 ? d[i] : d[i + 4]; r4[i] = keep + __shfl_xor(send, 4); }
#pragma unroll
    for (int i = 0; i < 2; ++i) { const float keep = b1 ? r4[i + 2] : r4[i], send = b1 ? r4[i] : r4[i + 2]; r2[i] = keep + __shfl_xor(send, 2); }
    const float keep = b0 ? r2[1] : r2[0], send = b0 ? r2[0] : r2[1];
    return keep + __shfl_xor(send, 1);
}
struct Seg16 { u32x4 q[16]; };
template <int M> DEVI void peer_u_mm(const __amdgpu_buffer_rsrc_t PU, Seg16& Q, const Idx16& In, const i32x4 (&hc)[2], unsigned coff, i32x4 (&acc)[8]) {
    asm volatile("" : "+v"(Q.q[M]));
    if (M & 1) acc[M >> 1] = __builtin_amdgcn_mfma_i32_16x16x64_i8(hc[1], (i32x4)Q.q[M], acc[M >> 1], 0, 0, 0);
    else       acc[M >> 1] = __builtin_amdgcn_mfma_i32_16x16x64_i8(hc[0], (i32x4)Q.q[M], (i32x4){0, 0, 0, 0}, 0, 0, 0);
    Q.q[M] = __builtin_amdgcn_raw_buffer_load_b128(PU, (unsigned)In.v[M >> 2][M & 3] * 128u + coff, 0, 0);
    asm volatile("" ::: "memory");
}
DEVI int qp_xor2(int v) { return __builtin_amdgcn_update_dpp(0, v, 0x4E, 0xf, 0xf, true); }
DEVI int qp_xor1(int v) { return __builtin_amdgcn_update_dpp(0, v, 0xB1, 0xf, 0xf, true); }
typedef unsigned u32x2 __attribute__((ext_vector_type(2)));
DEVI u32x2 slot_raw_load(const void* base, int t, int lane) { return *(const u32x2*)((const unsigned*)base + (size_t)t * 128 + 2 * lane); }
DEVI void slot_redist(LAS unsigned char* wl, const u32x2 raw, int lane, int l8, Idx16& I) {
    *(LAS u32x2*)(wl + 8 * lane) = raw;
    const LAS i32x4* s = (const LAS i32x4*)(wl + 64 * l8);
    I.v[0] = s[0]; I.v[1] = s[1]; I.v[2] = s[2]; I.v[3] = s[3];
}
DEVI void peer_u_token(const __amdgpu_buffer_rsrc_t PU, const int* SI, const unsigned char* H8, const float* HS, unsigned* PREP, LAS unsigned char* wl, int t, int t1, int t3, int x, int lane, int l8,
                       unsigned coff, bool act0, bool act1, const Idx16& In, Idx16& Inn, const u32x2 rawUse, u32x2& rawLoad, const i32x4 hraw, i32x4& hrawN, Seg16& Q) {
    rawLoad = slot_raw_load(SI, t3, lane);
    hrawN = *(const i32x4*)(H8 + (size_t)t1 * D);
    const float hs = HS[t];
    asm volatile("" ::: "memory");
    i32x4 hc[2];
#pragma unroll
    for (int e = 0; e < 4; ++e) { hc[0][e] = act0 ? hraw[e] : 0; hc[1][e] = act1 ? hraw[e] : 0; }
    i32x4 acc[8];
    peer_u_mm<0>(PU, Q, In, hc, coff, acc); peer_u_mm<1>(PU, Q, In, hc, coff, acc); peer_u_mm<2>(PU, Q, In, hc, coff, acc); peer_u_mm<3>(PU, Q, In, hc, coff, acc);
    peer_u_mm<4>(PU, Q, In, hc, coff, acc); peer_u_mm<5>(PU, Q, In, hc, coff, acc); peer_u_mm<6>(PU, Q, In, hc, coff, acc); peer_u_mm<7>(PU, Q, In, hc, coff, acc);
    peer_u_mm<8>(PU, Q, In, hc, coff, acc); peer_u_mm<9>(PU, Q, In, hc, coff, acc); peer_u_mm<10>(PU, Q, In, hc, coff, acc); peer_u_mm<11>(PU, Q, In, hc, coff, acc);
    peer_u_mm<12>(PU, Q, In, hc, coff, acc); peer_u_mm<13>(PU, Q, In, hc, coff, acc); peer_u_mm<14>(PU, Q, In, hc, coff, acc); peer_u_mm<15>(PU, Q, In, hc, coff, acc);
    slot_redist(wl, rawUse, lane, l8, Inn);
    const bool c1 = lane & 1, c2 = lane & 2;
    int w[8], r4[4], f[2];
#pragma unroll
    for (int a = 0; a < 8; ++a) { const int lo = c1 ? acc[a][1] : acc[a][0], hi = c1 ? acc[a][3] : acc[a][2]; w[a] = c2 ? hi : lo; }
#pragma unroll
    for (int i = 0; i < 4; ++i) { const int keep = c2 ? w[4 + i] : w[i], send = c2 ? w[i] : w[4 + i]; r4[i] = keep + qp_xor2(send); }
#pragma unroll
    for (int i = 0; i < 2; ++i) { const int keep = c1 ? r4[2 + i] : r4[i], send = c1 ? r4[i] : r4[2 + i]; f[i] = keep + qp_xor1(send); }
    PREP[((size_t)t * 8 + x) * 64 + lane] = pk2((float)f[0] * hs, (float)f[1] * hs);
}
DEVI void ph_peer_u(const P& p, int layer, int r0, const SliceGeo sg, unsigned char* lds) {
    const int otid_ = otid();
    const int wave = otid_ >> 6, lane = otid_ & 63, q = lane >> 4, j = lane & 15;
    const int x = __builtin_amdgcn_readfirstlane(sg.x), nws = __builtin_amdgcn_readfirstlane(sg.n * NWV);
    const __amdgpu_buffer_rsrc_t PU = __builtin_amdgcn_make_buffer_rsrc((void*)(p.ws + WS_PU + (size_t)layer * 16384 * 1024 + (size_t)x * 16384 * 128), (short)0, 16384 * 128, 0x00020000);
    const int* SI = (const int*)(p.ws + WS_SELI); const float* HS = (const float*)(p.ws + WS_HS);
    unsigned* PREP = (unsigned*)(p.ws + WS_SC);
    LAS unsigned char* wl = (LAS unsigned char*)lds + 1024 * wave;
    const int l8 = (q >> 1) * 4 + (j >> 2);
    const unsigned coff = 64u * (q & 1) + 16u * (j & 3);
    const unsigned char* H8 = p.ws + WS_H8 + 128 * x + coff;
    const bool act = (q >> 1) == ((j >> 2) & 1), act0 = act && (j >> 3) == 0, act1 = act && (j >> 3) == 1;
    int t = __builtin_amdgcn_readfirstlane(r0 + sg.rank * NWV + wave);
    if (t >= MA) return;
    Idx16 I0, I1; idx16_load(I0, SI, t, l8);
    asm volatile("" ::: "memory");
    u32x2 R0, R1; i32x4 H0, H1;
    { const int t1 = t + nws < MA ? t + nws : t, t2 = t + 2 * nws < MA ? t + 2 * nws : t1; idx16_load(I1, SI, t1, l8); R0 = slot_raw_load(SI, t2, lane); }
    H0 = *(const i32x4*)(H8 + (size_t)t * D);
    asm volatile("" ::: "memory");
    Seg16 Q;
#pragma unroll
    for (int k = 0; k < 16; ++k) { Q.q[k] = __builtin_amdgcn_raw_buffer_load_b128(PU, (unsigned)I0.v[k >> 2][k & 3] * 128u + coff, 0, 0); asm volatile("" ::: "memory"); }
    while (t < MA) {
        const int t1 = t + nws < MA ? t + nws : t, t2 = t + 2 * nws < MA ? t + 2 * nws : t1, t3 = t + 3 * nws < MA ? t + 3 * nws : t2, t4 = t + 4 * nws < MA ? t + 4 * nws : t3;
        peer_u_token(PU, SI, H8, HS, PREP, wl, t, t1, t3, x, lane, l8, coff, act0, act1, I1, I0, R0, R1, H0, H1, Q);
        peer_u_token(PU, SI, H8, HS, PREP, wl, t1, t2, t4, x, lane, l8, coff, act0, act1, I0, I1, R1, R0, H1, H0, Q);
        t += 2 * nws;
    }
}
struct PwLoad { unsigned pw[8]; float su0, su1, sg0, sg1; };
DEVI void peer_w_load(PwLoad& L, const P& p, int t, int lane, int sa, int sb) {
    const unsigned* pp = (const unsigned*)(p.ws + WS_SC) + (size_t)t * 512 + lane;
    const float* SG = (const float*)(p.ws + WS_SELG) + (size_t)t * 128; const float* SU = (const float*)(p.ws + WS_SELU) + (size_t)t * 128;
#pragma unroll
    for (int xx = 0; xx < 8; ++xx) L.pw[xx] = pp[xx * 64];
    L.su0 = SU[sa]; L.su1 = SU[sb]; L.sg0 = SG[sa]; L.sg1 = SG[sb];
}
DEVI void peer_w_finish(const PwLoad& L, const P& p, int t, int lane, int sa, int sb) {
    float p0 = 0.f, p1 = 0.f;
#pragma unroll
    for (int xx = 0; xx < 8; ++xx) { p0 += bflo(L.pw[xx]); p1 += bfhi(L.pw[xx]); }
    const float w0 = geluf_(p0 * L.su0) * L.sg0, w1 = geluf_(p1 * L.su1) * L.sg1;
    const float amax = wave_max_f(fmaxf(fabsf(w0), fabsf(w1)));
    const float sc = amax > 0.f ? 224.0f / amax : 1.0f;
    const float a0 = w0 * sc, a1 = w1 * sc;
    const unsigned hi = __builtin_amdgcn_cvt_pk_fp8_f32(a0, a1, 0u, false);
    const float h0 = __builtin_amdgcn_cvt_f32_fp8(hi, 0), h1 = __builtin_amdgcn_cvt_f32_fp8(hi, 1);
    const unsigned lo = __builtin_amdgcn_cvt_pk_fp8_f32(a0 - h0, a1 - h1, 0u, false);
    unsigned char* wt = p.ws + WS_SELU + (size_t)t * 512;
    wt[sa] = (unsigned char)(hi & 0xffu); wt[sb] = (unsigned char)((hi >> 8) & 0xffu); wt[128 + sa] = (unsigned char)(lo & 0xffu); wt[128 + sb] = (unsigned char)((lo >> 8) & 0xffu);
    if (lane == 0) *(float*)(wt + 256) = 1.0f / sc;
}
DEVI void ph_peer_w(const P& p, int r0) {
    const int otid_ = otid();
    const int wave = otid_ >> 6, lane = otid_ & 63, gw = blockIdx.x * NWV + wave, NGW = gridDim.x * NWV;
    const int sa = (4 * ((lane >> 4) & 1) + ((lane >> 2) & 3)) * 16 + 4 * (lane & 3) + (lane >> 5), sb = sa + 2;
    for (int t = r0 + gw; t < MA; t += 2 * NGW) {
        const int t1 = t + NGW;
        PwLoad A, B;
        peer_w_load(A, p, t, lane, sa, sb);
        if (t1 < MA) peer_w_load(B, p, t1, lane, sa, sb);
        asm volatile("" ::: "memory");
        peer_w_finish(A, p, t, lane, sa, sb);
        if (t1 < MA) peer_w_finish(B, p, t1, lane, sa, sb);
    }
}
template <int M> DEVI void peer_v_mm(const __amdgpu_buffer_rsrc_t PV, Seg16& Q, const i32x4 WH, const i32x4 WL, const Idx16& In, unsigned coff, const unsigned (&sel0)[4], const unsigned (&sel1)[4], f32x4 (&acc)[4]) {
    asm volatile("" : "+v"(Q.q[M]));
    const unsigned sh = (unsigned)WH[M >> 2], sl = (unsigned)WL[M >> 2];
    const unsigned h0 = __builtin_amdgcn_perm(sh, sh, sel0[M & 3]), h1 = __builtin_amdgcn_perm(sh, sh, sel1[M & 3]);
    const unsigned l0 = __builtin_amdgcn_perm(sl, sl, sel0[M & 3]), l1 = __builtin_amdgcn_perm(sl, sl, sel1[M & 3]);
    const long AH = (long)(((unsigned long)h1 << 32) | (unsigned long)h0), AL = (long)(((unsigned long)l1 << 32) | (unsigned long)l0);
    const long B0 = (long)(((unsigned long)Q.q[M][1] << 32) | (unsigned long)Q.q[M][0]), B1 = (long)(((unsigned long)Q.q[M][3] << 32) | (unsigned long)Q.q[M][2]);
    acc[0] = __builtin_amdgcn_mfma_f32_16x16x32_fp8_fp8(AH, B0, acc[0], 0, 0, 0); acc[1] = __builtin_amdgcn_mfma_f32_16x16x32_fp8_fp8(AH, B1, acc[1], 0, 0, 0);
    acc[2] = __builtin_amdgcn_mfma_f32_16x16x32_fp8_fp8(AL, B0, acc[2], 0, 0, 0); acc[3] = __builtin_amdgcn_mfma_f32_16x16x32_fp8_fp8(AL, B1, acc[3], 0, 0, 0);
    Q.q[M] = __builtin_amdgcn_raw_buffer_load_b128(PV, (unsigned)In.v[M >> 2][M & 3] * 128u + coff, 0, 0);
    asm volatile("" ::: "memory");
}
DEVI void ph_peer_v(const P& p, int layer, int r0, const SliceGeo sg, unsigned char* lds) {
    const int otid_ = otid();
    const int wave = otid_ >> 6, lane = otid_ & 63, q = lane >> 4, j = lane & 15;
    const int x = __builtin_amdgcn_readfirstlane(sg.x), nws = __builtin_amdgcn_readfirstlane(sg.n * NWV);
    const __amdgpu_buffer_rsrc_t PV = __builtin_amdgcn_make_buffer_rsrc((void*)(p.ws + WS_PV + (size_t)layer * 16384 * 1024 + (size_t)x * 16384 * 128), (short)0, 16384 * 128, 0x00020000);
    const int* SI = (const int*)(p.ws + WS_SELI); const unsigned char* W8 = p.ws + WS_SELU;
    bf16_t* OUTP = (bf16_t*)(p.ws + WS_SC + (size_t)MA * 4096);
    LAS unsigned char* wl = (LAS unsigned char*)lds + 1024 * wave;
    const int l8 = 2 * q + (j >> 3);
    const unsigned coff = 16u * (j & 7);
    unsigned sel0[4], sel1[4];
#pragma unroll
    for (int k = 0; k < 4; ++k) { const unsigned pl = 0x0c0c0c0cu ^ ((0x0cu ^ (unsigned)k) << (8 * (j & 3))); sel0[k] = (j & 4) ? 0x0c0c0c0cu : pl; sel1[k] = (j & 4) ? pl : 0x0c0c0c0cu; }
    const int bp = 4 * ((lane + 40) & 63);
    int t = __builtin_amdgcn_readfirstlane(r0 + sg.rank * NWV + wave);
    if (t >= MA) return;
    Idx16 In; i32x4 WH, WL; Seg16 Q; u32x2 rawI, rawW; float sinv;
    {
        const int t1 = t + nws < MA ? t + nws : t, t2 = t + 2 * nws < MA ? t + 2 * nws : t1;
        const u32x2 ri0 = slot_raw_load(SI, t, lane), ri1 = slot_raw_load(SI, t1, lane), rw0 = slot_raw_load(W8, t, lane);
        asm volatile("" ::: "memory");
        rawI = slot_raw_load(SI, t2, lane); rawW = slot_raw_load(W8, t1, lane);
        asm volatile("" ::: "memory");
        slot_redist(wl, ri0, lane, l8, In);
#pragma unroll
        for (int m = 0; m < 16; ++m) { Q.q[m] = __builtin_amdgcn_raw_buffer_load_b128(PV, (unsigned)In.v[m >> 2][m & 3] * 128u + coff, 0, 0); asm volatile("" ::: "memory"); }
        slot_redist(wl, ri1, lane, l8, In);
        *(LAS u32x2*)(wl + 512 + 8 * lane) = rw0;
        WH = *(const LAS i32x4*)(wl + 512 + 16 * l8); WL = *(const LAS i32x4*)(wl + 640 + 16 * l8); sinv = *(const LAS float*)(wl + 768);
    }
    while (t < MA) {
        const int t1 = t + nws < MA ? t + nws : t, t2 = t + 2 * nws < MA ? t + 2 * nws : t1, t3 = t + 3 * nws < MA ? t + 3 * nws : t2;
        const u32x2 rawIn = slot_raw_load(SI, t3, lane), rawWn = slot_raw_load(W8, t2, lane);
        asm volatile("" ::: "memory");
        f32x4 acc[4] = {(f32x4){0.f, 0.f, 0.f, 0.f}, (f32x4){0.f, 0.f, 0.f, 0.f}, (f32x4){0.f, 0.f, 0.f, 0.f}, (f32x4){0.f, 0.f, 0.f, 0.f}};
        peer_v_mm<0>(PV, Q, WH, WL, In, coff, sel0, sel1, acc); peer_v_mm<1>(PV, Q, WH, WL, In, coff, sel0, sel1, acc); peer_v_mm<2>(PV, Q, WH, WL, In, coff, sel0, sel1, acc); peer_v_mm<3>(PV, Q, WH, WL, In, coff, sel0, sel1, acc);
        peer_v_mm<4>(PV, Q, WH, WL, In, coff, sel0, sel1, acc); peer_v_mm<5>(PV, Q, WH, WL, In, coff, sel0, sel1, acc); peer_v_mm<6>(PV, Q, WH, WL, In, coff, sel0, sel1, acc); peer_v_mm<7>(PV, Q, WH, WL, In, coff, sel0, sel1, acc);
        peer_v_mm<8>(PV, Q, WH, WL, In, coff, sel0, sel1, acc); peer_v_mm<9>(PV, Q, WH, WL, In, coff, sel0, sel1, acc); peer_v_mm<10>(PV, Q, WH, WL, In, coff, sel0, sel1, acc); peer_v_mm<11>(PV, Q, WH, WL, In, coff, sel0, sel1, acc);
        peer_v_mm<12>(PV, Q, WH, WL, In, coff, sel0, sel1, acc); peer_v_mm<13>(PV, Q, WH, WL, In, coff, sel0, sel1, acc); peer_v_mm<14>(PV, Q, WH, WL, In, coff, sel0, sel1, acc); peer_v_mm<15>(PV, Q, WH, WL, In, coff, sel0, sel1, acc);
        const float sv = sinv;
        slot_redist(wl, rawI, lane, l8, In);
        *(LAS u32x2*)(wl + 512 + 8 * lane) = rawW;
        WH = *(const LAS i32x4*)(wl + 512 + 16 * l8); WL = *(const LAS i32x4*)(wl + 640 + 16 * l8); sinv = *(const LAS float*)(wl + 768);
        float A[4], Bv[4];
#pragma unroll
        for (int r = 0; r < 4; ++r) {
            const float a = acc[0][r] + acc[2][r], b = acc[1][r] + acc[3][r];
            A[r] = (a + __int_as_float(__builtin_amdgcn_ds_bpermute(bp, __float_as_int(a)))) * sv;
            Bv[r] = (b + __int_as_float(__builtin_amdgcn_ds_bpermute(bp, __float_as_int(b)))) * sv;
        }
#pragma unroll
        for (int r = 0; r < 4; ++r) swap16f(A[r], Bv[r]);
        if (j < 8 && q < 2) { u32x4 pk; pk[0] = pk2(A[0], A[1]); pk[1] = pk2(A[2], A[3]); pk[2] = pk2(Bv[0], Bv[1]); pk[3] = pk2(Bv[2], Bv[3]);
            *(u32x4*)(OUTP + (size_t)t * D + 128 * x + 16 * j + 8 * q) = pk; }
        rawI = rawIn; rawW = rawWn; t += nws;
    }
}
struct FinPar { Row16 g2; NormAB n; };
DEVI void finpar_load(FinPar& f, const P& p, int layer, int cls, int next_mode, int lane) {
    load_row_f32(mod_ptr(p, layer, cls, 5), lane, f.g2);
    const int ln = next_mode == 0 ? layer + 1 : layer; const float m = next_mode == 0 ? 1.0f : 0.0f;
    Row16 gg, sc, sh; load_row_f32(next_mode == 0 ? p.in[I_N1G] + ln * D : p.in[I_FG], lane, gg); load_row_f32(mod_ptr(p, ln, cls, 1), lane, sc); load_row_f32(mod_ptr(p, ln, cls, 0), lane, sh);
#pragma unroll
    for (int j = 0; j < 16; ++j) { f.n.A.v[j] = gg.v[j] * (1.0f + m * sc.v[j]); f.n.B.v[j] = m * sh.v[j]; }
}
DEVI void fin_row(const P& p, int r, int lane, int next_mode, Row16& x, const Row16& a, const FinPar& f) {
#pragma unroll
    for (int j = 0; j < 16; ++j) x.v[j] += f.g2.v[j] * a.v[j];
    if (next_mode == 0) {
        store_row_f32((float*)(p.ws + WS_X) + (size_t)r * D, lane, x);
        Row16 o; norm_ab(x, f.n, o);
        store_row_bf16((bf16_t*)(p.ws + WS_XN) + (size_t)r * D, lane, o);
    } else if (r >= TC) {
        Row16 o; norm_ab(x, f.n, o);
        store_row_f32(p.out + (size_t)(r - TC) * D, lane, o);
    }
}
DEVI void ph_peer_fin(const P& p, int layer, int r0, int next_mode) {
    const int otid_ = otid();
    const int wave = __builtin_amdgcn_readfirstlane(otid_ >> 6), lane = otid_ & 63, gw = blockIdx.x * NWV + wave, NGW = gridDim.x * NWV;
    const bf16_t* OUTP = (const bf16_t*)(p.ws + WS_SC + (size_t)MA * 4096);
    FinPar fl; finpar_load(fl, p, layer, 0, next_mode, lane);
    for (int r = r0 + gw; r < MA; r += 2 * NGW) {
        const int r1 = r + NGW;
        Row16 x0, a0, x1, a1;
        load_row_f32((const float*)(p.ws + WS_X) + (size_t)r * D, lane, x0); load_row_bf16(OUTP + (size_t)r * D, lane, a0);
        if (r1 < MA) { load_row_f32((const float*)(p.ws + WS_X) + (size_t)r1 * D, lane, x1); load_row_bf16(OUTP + (size_t)r1 * D, lane, a1); }
        FinPar f0 = fl;
        if (r < TC) finpar_load(f0, p, layer, 1, next_mode, lane);
        fin_row(p, r, lane, next_mode, x0, a0, f0);
        if (r1 < MA) fin_row(p, r1, lane, next_mode, x1, a1, fl);
    }
}

#define XB_TMO      128
#define XB_XCNT(j)  (256  + 64 * (j))
#define XB_XSUB(j)  (1280 + 64 * (j))
#define XB_XGEN(j)  (2304 + 64 * (j))
#define XB_TOP      3328
#define XB_TOPGEN   3392
#define XCD_BAR_WORDS 3456
#define XB_SPIN_CAP (1u << 20)
DEVI unsigned xb_ld(unsigned* p)              { return __hip_atomic_load(p, __ATOMIC_RELAXED, __HIP_MEMORY_SCOPE_AGENT); }
DEVI unsigned xb_add(unsigned* p, unsigned v) { return __hip_atomic_fetch_add(p, v, __ATOMIC_RELAXED, __HIP_MEMORY_SCOPE_AGENT); }
DEVI unsigned xb_xcc_id() { return (unsigned)__builtin_amdgcn_s_getreg((3 << 11) | 20) & 0xFu; }
#define XB_SPIN(cond, bar) do { unsigned _sp = 0; while (cond) { __builtin_amdgcn_s_sleep(1); \
    if ((++_sp & 255u) == 0u) { if (xb_ld(&(bar)[XB_TMO])) break; if (_sp > XB_SPIN_CAP) { atomicAdd(&(bar)[XB_TMO], 1u); break; } } } } while (0)
struct XcdBarrier { unsigned* bar; unsigned x; volatile LAS unsigned* st; };
DEVI XcdBarrier xcd_barrier_post(unsigned* bar, volatile LAS unsigned* st) {
    XcdBarrier b; b.bar = bar; b.x = xb_xcc_id(); b.st = st;
    if (threadIdx.x == 0) st[2] = xb_add(&bar[XB_XCNT(b.x)], 1u);
    return b;
}
DEVI void xcd_barrier_complete(unsigned* bar, unsigned x, unsigned& nloc, unsigned& nx) {
    const unsigned G = gridDim.x * gridDim.y * gridDim.z;
    unsigned sum, cnt, mine, sp = 0u;
    for (;;) {
        sum = 0u; cnt = 0u; mine = 0u;
#pragma unroll
        for (unsigned j = 0; j < 16; ++j) { const unsigned c = xb_ld(&bar[XB_XCNT(j)]); sum += c; cnt += (c > 0u) ? 1u : 0u; mine = (j == x) ? c : mine; }
        if (sum == G) break;
        __builtin_amdgcn_s_sleep(1);
        if ((++sp & 255u) == 0u) { if (xb_ld(&bar[XB_TMO])) break; if (sp > XB_SPIN_CAP) { atomicAdd(&bar[XB_TMO], 1u); break; } }
    }
    nloc = mine > 0u ? mine : 1u; nx = cnt > 0u ? cnt : 1u;
}
DEVI void xcd_barrier(const XcdBarrier& b) {
    asm volatile("s_waitcnt vmcnt(0)" ::: "memory");
    __syncthreads();
    if (threadIdx.x == 0) {
        unsigned* bar = b.bar;
        __builtin_amdgcn_s_waitcnt(0);
        unsigned nloc = b.st[0], nx = b.st[1];
        if (nloc == 0u) { xcd_barrier_complete(bar, b.x, nloc, nx); b.st[0] = nloc; b.st[1] = nx; }
        const unsigned old = xb_add(&bar[XB_XSUB(b.x)], 1u);
        const unsigned gen = old / nloc;
        if (old + 1u == (gen + 1u) * nloc) {
            __builtin_amdgcn_fence(__ATOMIC_RELEASE, "agent");
            asm volatile("s_waitcnt vmcnt(0)" ::: "memory");
            const unsigned og = xb_add(&bar[XB_TOP], 1u);
            const unsigned tg = og / nx;
            if (og + 1u == (tg + 1u) * nx) xb_add(&bar[XB_TOPGEN], 1u);
            else XB_SPIN(xb_ld(&bar[XB_TOPGEN]) == tg, bar);
            __builtin_amdgcn_fence(__ATOMIC_ACQUIRE, "agent");
            asm volatile("s_waitcnt vmcnt(0)" ::: "memory");
        } else {
            XB_SPIN(xb_ld(&bar[XB_TOPGEN]) == gen, bar);
            __builtin_amdgcn_fence(__ATOMIC_ACQUIRE, "agent");
            asm volatile("s_waitcnt vmcnt(0)" ::: "memory");
        }
    }
    __syncthreads();
}

DEVI SliceGeo slice_geo(const P& p, unsigned char* lds) {
    SliceGeo g;
    unsigned* bar = (unsigned*)(p.ws + WS_CTL);
    volatile LAS unsigned* st = (volatile LAS unsigned*)(lds + LDS_BYTES - 64);
    unsigned cnt[8]; unsigned tot = 0; bool ok = true;
#pragma unroll
    for (int j = 0; j < 8; ++j) { cnt[j] = xb_ld(&bar[XB_XCNT(j)]); tot += cnt[j]; ok = ok && cnt[j] > 0u; }
    const unsigned xcc = xb_xcc_id();
    if (ok && tot == gridDim.x && xcc < 8u) { g.x = (int)xcc; g.rank = (int)st[2]; g.n = 0;
#pragma unroll
        for (int j = 0; j < 8; ++j) g.n = (j == (int)xcc) ? (int)cnt[j] : g.n; }
    else { g.x = blockIdx.x & 7; g.rank = blockIdx.x >> 3; g.n = ((int)gridDim.x - g.x + 7) >> 3; }
    g.x = __builtin_amdgcn_readfirstlane(g.x); g.rank = __builtin_amdgcn_readfirstlane(g.rank); g.n = __builtin_amdgcn_readfirstlane(g.n);
    return g;
}

struct CtxBf16 { bf16_t* O; int ldc; DEVI void operator()(int tok, int n, const f32x4 v) const { *(u32x2*)(O + (size_t)tok * ldc + n) = (u32x2){pk2(v[0], v[1]), pk2(v[2], v[3])}; } };
struct CtxHgrnIn { bf16_t* O; const float* lbv;
    DEVI void operator()(int tok, int n, const f32x4 v) const { const int blk = n >> 10; float x[4] = {v[0], v[1], v[2], v[3]};
#pragma unroll
        for (int j = 0; j < 4; ++j) {
            if (blk == 0 || blk == 4) x[j] = x[j] / (1.0f + __expf(-x[j]));
            else if (blk == 2 || blk == 3) { const float lb = lbv[(blk - 2) * 1024 + (n & 1023) + j]; x[j] = __logf(lb + (1.0f - lb) / (1.0f + __expf(-x[j]))); } }
        *(u32x2*)(O + (size_t)tok * 5120 + n) = (u32x2){pk2(x[0], x[1]), pk2(x[2], x[3])}; } };
struct CtxF16 { unsigned short* O; int ldc; DEVI void operator()(int tok, int n, const f32x4 v) const { *(u32x2*)(O + (size_t)tok * ldc + n) = (u32x2){pg8::pkh2(v[0], v[1]), pg8::pkh2(v[2], v[3])}; } };
struct CtxResid { float* X; const float* gate; DEVI void operator()(int tok, int n, const f32x4 v) const { f32x4* q = (f32x4*)(X + (size_t)tok * D + n); *q = *q + *(const f32x4*)(gate + n) * v; } };
template <class Epi>
DEVI void ctx_gemm(const bf16_t* A, const bf16_t* Bt, int N, const Epi& epi, unsigned char* lds_) {
    typedef short bf16x8 __attribute__((ext_vector_type(8)));
    const int otid_ = otid();
    const int wave = otid_ >> 6, lane = otid_ & 63, c = lane & 15, q4 = lane >> 4;
    LAS f32x4* red = (LAS f32x4*)lds_;
    const int npieces = (TC / 32) * (N / 64);
    for (int pc = blockIdx.x; pc < npieces; pc += gridDim.x) {
        const int mt = pc & 7, nt = pc >> 3;
        const bf16_t* ap = A + (size_t)(32 * mt + c) * D + 8 * q4 + 128 * wave;
        const bf16_t* bp = Bt + (size_t)(64 * nt + c) * D + 8 * q4 + 128 * wave;
        bf16x8 a0[4], a1[4], bf[4][4];
#pragma unroll
        for (int s4 = 0; s4 < 4; ++s4) { a0[s4] = *(const bf16x8*)(ap + 32 * s4); a1[s4] = *(const bf16x8*)(ap + 16 * D + 32 * s4);
#pragma unroll
            for (int j = 0; j < 4; ++j) bf[j][s4] = *(const bf16x8*)(bp + (size_t)(16 * j) * D + 32 * s4); }
        f32x4 acc[4][2];
#pragma unroll
        for (int j = 0; j < 4; ++j) { acc[j][0] = (f32x4){0.f, 0.f, 0.f, 0.f}; acc[j][1] = acc[j][0]; }
#pragma unroll
        for (int s4 = 0; s4 < 4; ++s4)
#pragma unroll
            for (int j = 0; j < 4; ++j) { acc[j][0] = __builtin_amdgcn_mfma_f32_16x16x32_bf16(bf[j][s4], a0[s4], acc[j][0], 0, 0, 0); acc[j][1] = __builtin_amdgcn_mfma_f32_16x16x32_bf16(bf[j][s4], a1[s4], acc[j][1], 0, 0, 0); }
        __syncthreads();
#pragma unroll
        for (int j = 0; j < 4; ++j)
#pragma unroll
            for (int i = 0; i < 2; ++i) red[(wave * 8 + (j * 2 + i)) * 64 + lane] = acc[j][i];
        __syncthreads();
        f32x4 sum = {0.f, 0.f, 0.f, 0.f};
#pragma unroll
        for (int ww = 0; ww < 8; ++ww) sum += red[(ww * 8 + wave) * 64 + lane];
        epi(32 * mt + 16 * (wave & 1) + c, 64 * nt + 16 * (wave >> 1) + 4 * q4, sum);
    }
    __syncthreads();
}

DEVI void gemm_bf16(const P& p, const bf16_t* A, const bf16_t* Bt, int r0, int N, bf16_t* O, int ldc, unsigned char* lds) {
    pg8::Gemm g{A + (size_t)r0 * D, Bt, MA - r0, N, D}; pg8::StaticOrder S; S.init(MA - r0, N, (int)gridDim.x, (int)blockIdx.x);
    pg8::EpiBf16 E{O, ldc, r0};
    pg8::gemm_phase<pg8::EpiBf16, pg8::StaticOrder, true, true>((PG8_LAS unsigned char*)lds, g, S, E);
}
DEVI void gemm_hgrn_in(const P& p, const bf16_t* A, const bf16_t* Bt, unsigned char* lds) {
    pg8::Gemm g{A + (size_t)TC * D, Bt, T, 5120, D}; pg8::StaticOrder S; S.init(T, 5120, (int)gridDim.x, (int)blockIdx.x);
    pg8::EpiHgrnIn E{(bf16_t*)(p.ws + WS_G), 5120, TC, (const float*)(p.ws + WS_LB)};
    pg8::gemm_phase<pg8::EpiHgrnIn, pg8::StaticOrder, true, true>((PG8_LAS unsigned char*)lds, g, S, E);
}
DEVI void gemm_f16(const P& p, const bf16_t* A, const bf16_t* Bt, int r0, int N, unsigned short* O, int ldc, unsigned char* lds) {
    pg8::Gemm g{A + (size_t)r0 * D, Bt, MA - r0, N, D}; pg8::StaticOrder S; S.init(MA - r0, N, (int)gridDim.x, (int)blockIdx.x);
    pg8::EpiF16 E{O, ldc, r0};
    pg8::gemm_phase<pg8::EpiF16, pg8::StaticOrder, true, true>((PG8_LAS unsigned char*)lds, g, S, E);
}
DEVI void gemm_glu_resid(const P& p, const bf16_t* A, const bf16_t* Bt, int layer, unsigned char* lds) {
    pg8::Gemm g{A + (size_t)TC * D, Bt, T, 2048, D}; pg8::StaticOrder S; S.init(T, 2048, (int)gridDim.x, (int)blockIdx.x);
    pg8::EpiGluResid E{(float*)(p.ws + WS_X), mod_ptr(p, layer, 0, 2), TC};
    pg8::gemm_phase<pg8::EpiGluResid, pg8::StaticOrder, true, true>((PG8_LAS unsigned char*)lds, g, S, E);
}
DEVI void gemm_resid(const P& p, const bf16_t* A, const bf16_t* Bt, int r0, int layer, unsigned char* lds) {
    pg8::Gemm g{A + (size_t)r0 * D, Bt, MA - r0, D, D}; pg8::StaticOrder S; S.init(MA - r0, D, (int)gridDim.x, (int)blockIdx.x);
    pg8::EpiResid E{(float*)(p.ws + WS_X), mod_ptr(p, layer, 0, 2), mod_ptr(p, layer, 1, 2), r0, TC};
    pg8::gemm_phase<pg8::EpiResid, pg8::StaticOrder, true, true>((PG8_LAS unsigned char*)lds, g, S, E);
}

enum { PH_P0 = 0, PH_INIT, PH_GEMM_IN, PH_HGP1, PH_MIX1, PH_MIX2, PH_GEMM_OUT, PH_NORM2, PH_SCORES, PH_TOPK, PH_PEERU, PH_PEERW, PH_PEERV, PH_PEERF };

DEVI void run_phase(const P& p, int ph, int layer, unsigned char* lds) {
    const int kind = layer % 3, jj = layer / 3;
    const int r0 = (layer >= 2) ? TC : 0;
    bf16_t* WT = (bf16_t*)(p.ws + WS_WT);
    switch (ph) {
    case PH_P0: ph_ada(p, lds); ph_lb(p); ph_s5disc(p); __syncthreads(); ph_transposes(p, lds); __syncthreads(); ph_fold(p); ph_tables(p); break;
    case PH_INIT: ph_init_norm(p); break;
    case PH_GEMM_IN:
        if (kind == 0) { const bf16_t* W = WT + WT_CIN / 2 + (size_t)jj * 3072 * 1024;
            if (r0 == 0) ctx_gemm((const bf16_t*)(p.ws + WS_XN), W, 3072, CtxBf16{(bf16_t*)(p.ws + WS_G), 3072}, lds);
            gemm_bf16(p, (const bf16_t*)(p.ws + WS_XN), W, TC, 3072, (bf16_t*)(p.ws + WS_G), 3072, lds); }
        else if (kind == 1) { ctx_gemm((const bf16_t*)(p.ws + WS_XN), WT + WT_HIN / 2, 5120, CtxHgrnIn{(bf16_t*)(p.ws + WS_G), (const float*)(p.ws + WS_LB)}, lds);
            gemm_hgrn_in(p, (const bf16_t*)(p.ws + WS_XN), WT + WT_HIN / 2, lds); }
        break;
    case PH_HGP1: if (kind == 1) hg::scan<false>(p, lds); else s5::scan<false>(p, lds); break;
    case PH_MIX1:
        if (kind == 0) ph_conv(p, jj, r0); else if (kind == 1) hg::scan<true>(p, lds); else s5::scan<true>(p, lds);
        break;
    case PH_MIX2:
        if (kind == 1) ph_hgrn_readout(p); else if (kind == 2) ph_s5_elem(p);
        break;
    case PH_GEMM_OUT:
        if (kind == 0) { const bf16_t* W = WT + WT_COUT / 2 + (size_t)jj * 1024 * 1024;
            if (r0 == 0) ctx_gemm((const bf16_t*)(p.ws + WS_U), W, 1024, CtxResid{(float*)(p.ws + WS_X), mod_ptr(p, layer, 1, 2)}, lds);
            gemm_resid(p, (const bf16_t*)(p.ws + WS_U), W, TC, layer, lds); }
        else if (kind == 1) { ctx_gemm((const bf16_t*)(p.ws + WS_U), WT + WT_HOUT / 2, 1024, CtxResid{(float*)(p.ws + WS_X), mod_ptr(p, layer, 1, 2)}, lds);
            gemm_resid(p, (const bf16_t*)(p.ws + WS_U), WT + WT_HOUT / 2, TC, layer, lds); }
        else gemm_glu_resid(p, (const bf16_t*)(p.ws + WS_U), WT + WT_GLU / 2, layer, lds);
        break;
    case PH_NORM2: ph_norm2(p, layer, r0); break;
    case PH_SCORES: { const bf16_t* W = (const bf16_t*)(p.ws + WS_WQK) + (size_t)layer * 2048 * 1024;
        if (r0 == 0) ctx_gemm((const bf16_t*)(p.ws + WS_XN), W, 2048, CtxF16{(unsigned short*)(p.ws + WS_SCH), 2048}, lds);
        gemm_f16(p, (const bf16_t*)(p.ws + WS_XN), W, TC, 2048, (unsigned short*)(p.ws + WS_SCH), 2048, lds); } break;
    case PH_TOPK: ph_topk(p, layer, r0, lds); break;
    case PH_PEERU: ph_peer_u(p, layer, r0, slice_geo(p, lds), lds); break;
    case PH_PEERW: ph_peer_w(p, r0); break;
    case PH_PEERV: ph_peer_v(p, layer, r0, slice_geo(p, lds), lds); break;
    case PH_PEERF: ph_peer_fin(p, layer, r0, layer == 3 ? 1 : 0); break;
    }
}

#ifndef MK_MULTI
#define MK_MULTI 0
#endif
#if MK_MULTI
__global__ void __launch_bounds__(NTHR, 2) k_fwd(P p) {
    extern __shared__ __attribute__((aligned(16))) unsigned char lds[];
    run_phase(p, p.ph, p.arg, lds);
}
#else
__global__ void __launch_bounds__(NTHR, 2) k_fwd(P p) {
    extern __shared__ __attribute__((aligned(16))) unsigned char lds[];
    volatile LAS unsigned* st = (volatile LAS unsigned*)(lds + LDS_BYTES - 64);
    if (threadIdx.x < 16) st[threadIdx.x] = 0u;
    __syncthreads();
    const XcdBarrier bar = xcd_barrier_post((unsigned*)(p.ws + WS_CTL), st);
#define SYNC() xcd_barrier(bar)
    run_phase(p, PH_P0, 0, lds); SYNC();
    run_phase(p, PH_INIT, 0, lds); SYNC();
#pragma unroll 1
    for (int layer = 0; layer < DEPTH; ++layer) {
        const int kind = layer % 3;
        if (kind != 2) { run_phase(p, PH_GEMM_IN, layer, lds); SYNC(); }
        if (kind != 0) { run_phase(p, PH_HGP1, layer, lds); SYNC(); }
        run_phase(p, PH_MIX1, layer, lds); SYNC();
        if (kind != 0) { run_phase(p, PH_MIX2, layer, lds); SYNC(); }
        run_phase(p, PH_GEMM_OUT, layer, lds); SYNC();
        run_phase(p, PH_NORM2, layer, lds); SYNC();
        run_phase(p, PH_SCORES, layer, lds); SYNC();
        run_phase(p, PH_TOPK, layer, lds); SYNC();
        run_phase(p, PH_PEERU, layer, lds); SYNC();
        run_phase(p, PH_PEERW, layer, lds); SYNC();
        run_phase(p, PH_PEERV, layer, lds); SYNC();
        run_phase(p, PH_PEERF, layer, lds);
        if (layer != DEPTH - 1) SYNC();
    }
}
#endif

extern "C" void kernel_launch(void* const* d_in, const int* in_sizes, int n_in, void* d_out, int out_size, void* d_ws, size_t ws_size, hipStream_t stream) {
    static int grid = 0;
    if (grid == 0) {
        if (n_in != N_IN || out_size != T * D || ws_size < WS_END) { fprintf(stderr, "kernel_launch: unexpected shapes n_in %d out %d ws %zu\n", n_in, out_size, ws_size); grid = -1; return; }
        int dev = 0, cus = 0, per_cu = 0;
        if (hipGetDevice(&dev) != hipSuccess || hipDeviceGetAttribute(&cus, hipDeviceAttributeMultiprocessorCount, dev) != hipSuccess) { grid = -1; return; }
        if (hipFuncSetAttribute((const void*)k_fwd, hipFuncAttributeMaxDynamicSharedMemorySize, LDS_BYTES) != hipSuccess) { fprintf(stderr, "kernel_launch: hipFuncSetAttribute failed\n"); grid = -1; return; }
        if (hipOccupancyMaxActiveBlocksPerMultiprocessor(&per_cu, (const void*)k_fwd, NTHR, LDS_BYTES) != hipSuccess || per_cu < 1) { fprintf(stderr, "kernel_launch: occupancy query says %d blocks/CU\n", per_cu); }
        (void)hipGetLastError();
        grid = cus;
    }
    if (grid < 0) return;
    P p{};
    for (int i = 0; i < N_IN; ++i) p.in[i] = (const float*)d_in[i];
    p.out = (float*)d_out; p.ws = (unsigned char*)d_ws;
#if MK_MULTI
    auto launch = [&](int ph, int arg) { p.ph = ph; p.arg = arg; hipLaunchKernelGGL(k_fwd, dim3(grid), dim3(NTHR), LDS_BYTES, stream, p); };
    launch(PH_P0, 0); launch(PH_INIT, 0);
    for (int layer = 0; layer < DEPTH; ++layer) {
        const int kind = layer % 3;
        if (kind != 2) launch(PH_GEMM_IN, layer);
        if (kind != 0) launch(PH_HGP1, layer);
        launch(PH_MIX1, layer);
        if (kind != 0) launch(PH_MIX2, layer);
        launch(PH_GEMM_OUT, layer);
        launch(PH_NORM2, layer); launch(PH_SCORES, layer); launch(PH_TOPK, layer); launch(PH_PEERU, layer); launch(PH_PEERW, layer); launch(PH_PEERV, layer); launch(PH_PEERF, layer);
    }
#else
    if (hipMemsetAsync((char*)d_ws + WS_CTL, 0, 65536, stream) != hipSuccess) { fprintf(stderr, "kernel_launch: memset failed\n"); return; }
    void* args[] = {&p};
    const hipError_t e = hipLaunchCooperativeKernel((const void*)k_fwd, dim3(grid), dim3(NTHR), args, LDS_BYTES, stream);
    if (e != hipSuccess) fprintf(stderr, "kernel_launch: cooperative launch failed: %s (grid %d)\n", hipGetErrorString(e), grid);
#endif
}
```

```cpp
#include <hip/hip_runtime.h>
#include <cstdint>
#include <cstdio>

#define DEVI __device__ __forceinline__
#define LAS __attribute__((address_space(3)))
typedef unsigned short bf16_t;
typedef float f32x4 __attribute__((ext_vector_type(4)));
typedef unsigned u32x4 __attribute__((ext_vector_type(4)));
typedef unsigned u32x2 __attribute__((ext_vector_type(2)));
typedef int i32x4 __attribute__((ext_vector_type(4)));
typedef __bf16 bf16x2_t __attribute__((ext_vector_type(2)));

constexpr int D = 1024, T = 16384, TC = 256, MA = T + TC, DEPTH = 4;
constexpr int NTHR = 512, NWV = 8;
constexpr float EPS = 1e-6f;

constexpr size_t MiB = 1u << 20;
constexpr size_t WS_CTL = 0;
constexpr size_t WS_MOD = 1 * MiB;
constexpr size_t WS_LB = WS_MOD + 256 * 1024;
constexpr size_t WS_S5A = 2 * MiB;
constexpr size_t WS_S5B = 3 * MiB;
constexpr size_t WS_X = 8 * MiB;
constexpr size_t WS_XN = 73 * MiB;
constexpr size_t WS_U = 106 * MiB;
constexpr size_t WS_OF = 139 * MiB;
constexpr size_t WS_OB = 172 * MiB;
constexpr size_t WS_G = 205 * MiB;
constexpr size_t WS_SC = 368 * MiB;
constexpr size_t WS_SELI = 498 * MiB;
constexpr size_t WS_SELG = 507 * MiB;
constexpr size_t WS_WQK = 516 * MiB;
constexpr size_t WS_WT = 532 * MiB;
constexpr size_t WT_CIN = 0, WT_COUT = 12 * MiB, WT_HIN = 16 * MiB, WT_HOUT = 26 * MiB, WT_GLU = 28 * MiB;
constexpr size_t WS_PU = 564 * MiB;
constexpr size_t WS_PV = 628 * MiB;
constexpr size_t WS_SCL = 692 * MiB;
constexpr size_t WS_H8 = 770 * MiB;
constexpr size_t WS_HS = 788 * MiB;
constexpr size_t WS_SCH = 704 * MiB;
constexpr size_t WS_SELU = 694 * MiB;
constexpr size_t WS_XE = 820 * MiB;
constexpr size_t WS_END = 822 * MiB;

constexpr int LDS_BYTES = 147456;

enum { I_X = 0, I_C, I_CTX, I_CCTX, I_ADAW, I_ADAB, I_N1G, I_N2G, I_CWIN, I_CK, I_CWOUT, I_HWIN, I_HLB, I_HNG, I_HWOUT,
       I_S5LR, I_S5LI, I_S5LS, I_S5BR, I_S5BI, I_S5CR, I_S5CI, I_S5D, I_S5GLU, I_PWQ, I_PKEYS, I_PU, I_PV, I_FG, N_IN };

struct P {
    const float* in[N_IN];
    float* out;
    unsigned char* ws;
    int ph, arg;
};

DEVI unsigned f2bf(float f) { unsigned u = __float_as_uint(f); return (u + 0x7fffu + ((u >> 16) & 1u)) >> 16; }
typedef float f32x2_t __attribute__((ext_vector_type(2)));
DEVI unsigned pk2(float lo, float hi) { f32x2_t f = {lo, hi}; return __builtin_bit_cast(unsigned, __builtin_convertvector(f, bf16x2_t)); }
DEVI float bflo(unsigned w) { return __uint_as_float(w << 16); }
DEVI float bfhi(unsigned w) { return __uint_as_float(w & 0xffff0000u); }
DEVI float bf2f(bf16_t b) { return __uint_as_float((unsigned)b << 16); }
DEVI float frcp_(float x) { return __builtin_amdgcn_rcpf(x); }
DEVI float sigmoidf_(float x) { return frcp_(1.0f + __expf(-x)); }
DEVI float siluf_(float x) { return x * sigmoidf_(x); }
DEVI float erf_as_(float x) {
    const float ax = __builtin_fabsf(x), t = frcp_(__builtin_fmaf(0.3275911f, ax, 1.0f));
    float pl = __builtin_fmaf(1.061405429f, t, -1.453152027f); pl = __builtin_fmaf(pl, t, 1.421413741f); pl = __builtin_fmaf(pl, t, -0.284496736f); pl = __builtin_fmaf(pl, t, 0.254829592f);
    const float r = 1.0f - pl * t * __expf(-ax * ax);
    return __builtin_copysignf(r, x);
}
DEVI float geluf_(float x) { return 0.5f * x * (1.0f + erf_as_(x * 0.70710678118654752f)); }
DEVI float dot2bf(unsigned a, unsigned b, float c) { return __builtin_amdgcn_fdot2_f32_bf16(__builtin_bit_cast(bf16x2_t, a), __builtin_bit_cast(bf16x2_t, b), c, false); }
DEVI int otid() { int t = threadIdx.x; asm volatile("" : "+v"(t)); return t; }
template <int CTRL> DEVI float dpp_mov_f(float v) { return __uint_as_float(__builtin_amdgcn_update_dpp(0u, __float_as_uint(v), CTRL, 0xf, 0xf, true)); }
DEVI void rows_swap16(float& a, float& b) { const auto r = __builtin_amdgcn_permlane16_swap(__float_as_uint(a), __float_as_uint(b), false, false); a = __uint_as_float(r[0]); b = __uint_as_float(r[1]); }
DEVI void rows_swap32(float& a, float& b) { const auto r = __builtin_amdgcn_permlane32_swap(__float_as_uint(a), __float_as_uint(b), false, false); a = __uint_as_float(r[0]); b = __uint_as_float(r[1]); }
DEVI float wave_sum(float v) {
    v += dpp_mov_f<0xB1>(v); v += dpp_mov_f<0x4E>(v); v += dpp_mov_f<0x141>(v); v += dpp_mov_f<0x140>(v);
    { float a = v, b = v; rows_swap16(a, b); v = a + b; }
    { float a = v, b = v; rows_swap32(a, b); v = a + b; }
    return v;
}
DEVI float wave_max_f(float v) {
    v = __builtin_fmaxf(v, dpp_mov_f<0xB1>(v)); v = __builtin_fmaxf(v, dpp_mov_f<0x4E>(v)); v = __builtin_fmaxf(v, dpp_mov_f<0x141>(v)); v = __builtin_fmaxf(v, dpp_mov_f<0x140>(v));
    { float a = v, b = v; rows_swap16(a, b); v = __builtin_fmaxf(a, b); }
    { float a = v, b = v; rows_swap32(a, b); v = __builtin_fmaxf(a, b); }
    return v;
}
DEVI float row16_sum(float v) { v += dpp_mov_f<0xB1>(v); v += dpp_mov_f<0x4E>(v); v += dpp_mov_f<0x141>(v); v += dpp_mov_f<0x140>(v); return v; }
DEVI unsigned pk4_i8(float a, float b, float c, float d) {
    const int ia = (int)__builtin_rintf(a), ib = (int)__builtin_rintf(b), ic = (int)__builtin_rintf(c), id = (int)__builtin_rintf(d);
    return (unsigned)(ia & 255) | ((unsigned)(ib & 255) << 8) | ((unsigned)(ic & 255) << 16) | ((unsigned)id << 24);
}
DEVI int row_cls(int r) { return r < TC ? 1 : 0; }
DEVI const float* mod_ptr(const P& p, int layer, int cls, int chunk) { return (const float*)(p.ws + WS_MOD) + ((size_t)(layer * 2 + cls) * 6 + chunk) * D; }

struct Row16 { float v[16]; };
DEVI void load_row_f32(const float* row, int lane, Row16& o) {
    const f32x4* a = (const f32x4*)(row + 8 * lane); const f32x4* b = (const f32x4*)(row + 512 + 8 * lane);
    f32x4 a0 = a[0], a1 = a[1], b0 = b[0], b1 = b[1];
#pragma unroll
    for (int j = 0; j < 4; ++j) { o.v[j] = a0[j]; o.v[4 + j] = a1[j]; o.v[8 + j] = b0[j]; o.v[12 + j] = b1[j]; }
}
DEVI void store_row_f32(float* row, int lane, const Row16& o) {
    f32x4* a = (f32x4*)(row + 8 * lane); f32x4* b = (f32x4*)(row + 512 + 8 * lane);
    a[0] = (f32x4){o.v[0], o.v[1], o.v[2], o.v[3]}; a[1] = (f32x4){o.v[4], o.v[5], o.v[6], o.v[7]};
    b[0] = (f32x4){o.v[8], o.v[9], o.v[10], o.v[11]}; b[1] = (f32x4){o.v[12], o.v[13], o.v[14], o.v[15]};
}
DEVI void load_row_bf16(const bf16_t* row, int lane, Row16& o) {
    const u32x4 a = *(const u32x4*)(row + 8 * lane), b = *(const u32x4*)(row + 512 + 8 * lane);
#pragma unroll
    for (int j = 0; j < 4; ++j) { o.v[2 * j] = bflo(a[j]); o.v[2 * j + 1] = bfhi(a[j]); o.v[8 + 2 * j] = bflo(b[j]); o.v[8 + 2 * j + 1] = bfhi(b[j]); }
}
DEVI void store_row_bf16(bf16_t* row, int lane, const Row16& o) {
    u32x4 a, b;
#pragma unroll
    for (int j = 0; j < 4; ++j) { a[j] = pk2(o.v[2 * j], o.v[2 * j + 1]); b[j] = pk2(o.v[8 + 2 * j], o.v[8 + 2 * j + 1]); }
    *(u32x4*)(row + 8 * lane) = a; *(u32x4*)(row + 512 + 8 * lane) = b;
}
DEVI void norm_mod(const Row16& x, const float* g, const float* shift, const float* scale, int lane, Row16& o) {
    float ss = 0.f;
#pragma unroll
    for (int j = 0; j < 16; ++j) ss += x.v[j] * x.v[j];
    ss = wave_sum(ss);
    const float rstd = rsqrtf(ss * (1.0f / D) + EPS);
    Row16 gg, sh, sc; load_row_f32(g, lane, gg); load_row_f32(shift, lane, sh); load_row_f32(scale, lane, sc);
#pragma unroll
    for (int j = 0; j < 16; ++j) o.v[j] = x.v[j] * rstd * gg.v[j] * (1.0f + sc.v[j]) + sh.v[j];
}

DEVI void ph_ada(const P& p, unsigned char* lds) {
    const int otid_ = otid();
    float* sc = (float*)lds;
    float* red = sc + 2048;
    const int tid = otid_;
    for (int k = tid; k < 1024; k += NTHR) { sc[k] = siluf_(p.in[I_C][k]); sc[1024 + k] = siluf_(p.in[I_CCTX][k]); }
    __syncthreads();
    const int kg = tid >> 3, cl = tid & 7;
    for (int item = blockIdx.x; item < 4 * 192; item += gridDim.x) {
        const int i = item / 192, n0 = (item % 192) * 32 + cl * 4;
        const float* w = p.in[I_ADAW] + (size_t)i * 1024 * 6144 + n0 + (size_t)kg * 6144;
        f32x4 wv[16];
#pragma unroll
        for (int m = 0; m < 16; ++m) wv[m] = *(const f32x4*)(w + (size_t)m * 64 * 6144);
        f32x4 a0 = {0, 0, 0, 0}, a1 = {0, 0, 0, 0};
#pragma unroll
        for (int m = 0; m < 16; ++m) { a0 += wv[m] * sc[kg + 64 * m]; a1 += wv[m] * sc[1024 + kg + 64 * m]; }
        float* r = red + (kg * 8 + cl) * 8;
#pragma unroll
        for (int j = 0; j < 4; ++j) { r[j] = a0[j]; r[4 + j] = a1[j]; }
        __syncthreads();
        if (tid < 64) {
            const int c2 = tid >> 3, j = tid & 7; float s_ = 0.f;
            for (int g = 0; g < 64; ++g) s_ += red[(g * 8 + c2) * 8 + j];
            const int cls = j >> 2, n = (item % 192) * 32 + c2 * 4 + (j & 3);
            ((float*)(p.ws + WS_MOD))[(size_t)(i * 2 + cls) * 6144 + n] = s_ + p.in[I_ADAB][i * 6144 + n];
        }
        __syncthreads();
    }
}
DEVI void ph_lb(const P& p) {
    const int otid_ = otid();
    const int gt = blockIdx.x * NTHR + otid_;
    if (gt < 2048) {
        const float* l = p.in[I_HLB];
        float m = -1e30f; for (int i = 0; i < 4; ++i) m = fmaxf(m, l[i * 2048 + gt]);
        float s = 0.f; for (int i = 0; i < 4; ++i) s += expf(l[i * 2048 + gt] - m);
        ((float*)(p.ws + WS_LB))[gt] = expf(l[2048 + gt] - m) / s;
    }
}
DEVI void ph_s5disc(const P& p) {
    const int otid_ = otid();
    const int gt = blockIdx.x * NTHR + otid_;
    if (gt < 2 * 64 * 64) {
        const int dn = gt >> 12, g = (gt >> 6) & 63, pp = gt & 63;
        const float step = expf(p.in[I_S5LS][dn * 64 + g]);
        const float lr = fminf(p.in[I_S5LR][gt], -1e-4f), li = p.in[I_S5LI][gt];
        const float ar = step * lr, ai = step * li, mag = expf(ar);
        float sn, cs; sincosf(ai, &sn, &cs);
        const float abr = mag * cs, abi = mag * sn, den = lr * lr + li * li;
        const float fr = ((abr - 1.0f) * lr + abi * li) / den, fi = (abi * lr - (abr - 1.0f) * li) / den;
        float* A = (float*)(p.ws + WS_S5A) + (size_t)gt * 2; A[0] = abr; A[1] = abi;
        float* B = (float*)(p.ws + WS_S5B) + (size_t)gt * 32;
        const float* br = p.in[I_S5BR] + (size_t)(g * 64 + pp) * 16; const float* bi = p.in[I_S5BI] + (size_t)(g * 64 + pp) * 16;
        for (int h = 0; h < 16; ++h) { B[h] = fr * br[h] - fi * bi[h]; B[16 + h] = fr * bi[h] + fi * br[h]; }
    }
}
DEVI void transpose_item(const float* W, int K, int N, bf16_t* WT, float* scr, int item, int lane, bool glu_pair = false) {
    const int nblk = N / 32, kb = item / nblk, nb = item % nblk, k0 = 64 * kb, n0 = 32 * nb;
#pragma unroll 8
    for (int i = 0; i < 32; ++i) { const int kk = 2 * i + (lane >> 5); scr[kk * 33 + (lane & 31)] = W[(size_t)(k0 + kk) * N + n0 + (lane & 31)]; }
    __builtin_amdgcn_s_waitcnt(0); asm volatile("" ::: "memory");
    const int c = lane & 7;
#pragma unroll
    for (int j = 0; j < 4; ++j) { const int n = (lane >> 3) + 8 * j; const float* s = scr + (8 * c) * 33 + n;
        u32x4 o; o.x = pk2(s[0 * 33], s[1 * 33]); o.y = pk2(s[2 * 33], s[3 * 33]); o.z = pk2(s[4 * 33], s[5 * 33]); o.w = pk2(s[6 * 33], s[7 * 33]);
        const int dn = glu_pair ? (((n0 & 1023) >> 7) * 256 + (n0 >> 10) * 128 + (n0 & 127)) : n0;
        *(u32x4*)(WT + (size_t)(dn + n) * K + k0 + 8 * c) = o; }
    __builtin_amdgcn_s_waitcnt(0); asm volatile("" ::: "memory");
}
DEVI void ph_transposes(const P& p, unsigned char* lds) {
    const int otid_ = otid();
    const int wave = otid_ >> 6, lane = otid_ & 63;
    float* scr = (float*)lds + wave * (64 * 33);
    const int gw = blockIdx.x * NWV + wave, NGW = gridDim.x * NWV;
    bf16_t* WT = (bf16_t*)(p.ws + WS_WT);
    constexpr int I_A = (1024 / 64) * (3072 / 32), I_B = (1024 / 64) * (1024 / 32), I_C5 = (1024 / 64) * (5120 / 32), I_G = (1024 / 64) * (2048 / 32);
    constexpr int NIT = 2 * I_A + 2 * I_B + I_C5 + I_B + I_G;
    for (int it = gw; it < NIT; it += NGW) {
        int r = it;
        if (r < 2 * I_A) { const int j = r / I_A; transpose_item(p.in[I_CWIN] + (size_t)j * 1024 * 3072, 1024, 3072, WT + WT_CIN / 2 + (size_t)j * 3072 * 1024, scr, r % I_A, lane); continue; } r -= 2 * I_A;
        if (r < 2 * I_B) { const int j = r / I_B; transpose_item(p.in[I_CWOUT] + (size_t)j * 1024 * 1024, 1024, 1024, WT + WT_COUT / 2 + (size_t)j * 1024 * 1024, scr, r % I_B, lane); continue; } r -= 2 * I_B;
        if (r < I_C5) { transpose_item(p.in[I_HWIN], 1024, 5120, WT + WT_HIN / 2, scr, r, lane); continue; } r -= I_C5;
        if (r < I_B) { transpose_item(p.in[I_HWOUT], 1024, 1024, WT + WT_HOUT / 2, scr, r, lane); continue; } r -= I_B;
        transpose_item(p.in[I_S5GLU], 1024, 2048, WT + WT_GLU / 2, scr, r, lane, true);
    }
}
DEVI void ph_tables(const P& p) {
    const int otid_ = otid();
    const int wave = otid_ >> 6, lane = otid_ & 63, gw = blockIdx.x * NWV + wave, NGW = gridDim.x * NWV;
    float* SCL = (float*)(p.ws + WS_SCL);
    for (int row = gw; row < 2 * 4 * 16384; row += NGW) {
        const int w = row >> 16, rr = row & 65535;
        const f32x4* src = (const f32x4*)(p.in[w ? I_PV : I_PU] + (size_t)rr * 1024 + 16 * lane);
        const f32x4 a0 = src[0], a1 = src[1], a2 = src[2], a3 = src[3];
        float m = 0.f;
#pragma unroll
        for (int j = 0; j < 4; ++j) m = fmaxf(fmaxf(m, fmaxf(fabsf(a0[j]), fabsf(a1[j]))), fmaxf(fabsf(a2[j]), fabsf(a3[j])));
        m = wave_max_f(m);
        const float qmax = w ? 224.0f : 127.0f;
        const float sc = m > 0.f ? qmax / m : 1.0f;
        u32x4 q;
        if (w) {
            { unsigned t = 0; t = __builtin_amdgcn_cvt_pk_fp8_f32(a0[0] * sc, a0[1] * sc, t, false); t = __builtin_amdgcn_cvt_pk_fp8_f32(a0[2] * sc, a0[3] * sc, t, true); q[0] = t; }
            { unsigned t = 0; t = __builtin_amdgcn_cvt_pk_fp8_f32(a1[0] * sc, a1[1] * sc, t, false); t = __builtin_amdgcn_cvt_pk_fp8_f32(a1[2] * sc, a1[3] * sc, t, true); q[1] = t; }
            { unsigned t = 0; t = __builtin_amdgcn_cvt_pk_fp8_f32(a2[0] * sc, a2[1] * sc, t, false); t = __builtin_amdgcn_cvt_pk_fp8_f32(a2[2] * sc, a2[3] * sc, t, true); q[2] = t; }
            { unsigned t = 0; t = __builtin_amdgcn_cvt_pk_fp8_f32(a3[0] * sc, a3[1] * sc, t, false); t = __builtin_amdgcn_cvt_pk_fp8_f32(a3[2] * sc, a3[3] * sc, t, true); q[3] = t; }
        } else {
            q[0] = pk4_i8(a0[0] * sc, a0[1] * sc, a0[2] * sc, a0[3] * sc); q[1] = pk4_i8(a1[0] * sc, a1[1] * sc, a1[2] * sc, a1[3] * sc);
            q[2] = pk4_i8(a2[0] * sc, a2[1] * sc, a2[2] * sc, a2[3] * sc); q[3] = pk4_i8(a3[0] * sc, a3[1] * sc, a3[2] * sc, a3[3] * sc);
        }
        *(u32x4*)(p.ws + (w ? WS_PV : WS_PU) + (size_t)(rr >> 14) * (16384 * 1024) + (size_t)(lane >> 3) * (16384 * 128) + (size_t)(rr & 16383) * 128 + 16 * (lane & 7)) = q;
        if (lane == 0) SCL[2 * rr + w] = m > 0.f ? m / qmax : 1.0f;
    }
}
DEVI void ph_fold(const P& p) {
    const int otid_ = otid();
    const int wave = otid_ >> 6, lane = otid_ & 63, c = lane & 15, q4 = lane >> 4, gw = blockIdx.x * NWV + wave, NGW = gridDim.x * NWV;
    for (int item = gw; item < 4 * 16 * 8 * 4; item += NGW) {
        const int i = item >> 9, hc = (item >> 5) & 15, kt = (item >> 2) & 7, kq = item & 3;
        const float* ky = p.in[I_PKEYS] + (((size_t)i * 16 + hc) * 128 + 16 * kt + c) * 128 + 4 * q4;
        f32x4 kf[8];
#pragma unroll
        for (int s8 = 0; s8 < 8; ++s8) kf[s8] = *(const f32x4*)(ky + 16 * s8);
        bf16_t* out = (bf16_t*)(p.ws + WS_WQK) + ((size_t)i * 2048 + hc * 128 + 16 * kt + c) * 1024 + 4 * q4;
#pragma unroll 1
        for (int tt = 0; tt < 16; ++tt) {
            const int k1 = (kq * 16 + tt) * 16;
            const float* wq = p.in[I_PWQ] + ((size_t)i * 1024 + k1 + c) * 2048 + hc * 128 + 4 * q4;
            f32x4 wf[8];
#pragma unroll
            for (int s8 = 0; s8 < 8; ++s8) wf[s8] = *(const f32x4*)(wq + 16 * s8);
            f32x4 acc = {0.f, 0.f, 0.f, 0.f};
#pragma unroll
            for (int s8 = 0; s8 < 8; ++s8)
#pragma unroll
                for (int j = 0; j < 4; ++j) acc = __builtin_amdgcn_mfma_f32_16x16x4f32(wf[s8][j], kf[s8][j], acc, 0, 0, 0);
            *(u32x2*)(out + k1) = (u32x2){pk2(acc[0], acc[1]), pk2(acc[2], acc[3])};
        }
    }
}

struct NormAB { Row16 A, B; };
DEVI void normab_load(NormAB& n, const float* g, const float* shift, const float* scale, int lane) {
    Row16 gg, sc; load_row_f32(g, lane, gg); load_row_f32(scale, lane, sc); load_row_f32(shift, lane, n.B);
#pragma unroll
    for (int j = 0; j < 16; ++j) n.A.v[j] = gg.v[j] * (1.0f + sc.v[j]);
}
DEVI void norm_ab(const Row16& x, const NormAB& n, Row16& o) {
    float ss = 0.f;
#pragma unroll
    for (int j = 0; j < 16; ++j) ss += x.v[j] * x.v[j];
    ss = wave_sum(ss);
    const float rstd = rsqrtf(ss * (1.0f / D) + EPS);
#pragma unroll
    for (int j = 0; j < 16; ++j) o.v[j] = x.v[j] * rstd * n.A.v[j] + n.B.v[j];
}
DEVI void ph_init_norm(const P& p) {
    const int otid_ = otid();
    const int wave = __builtin_amdgcn_readfirstlane(otid_ >> 6), lane = otid_ & 63, gw = blockIdx.x * NWV + wave, NGW = gridDim.x * NWV;
    NormAB nl; normab_load(nl, p.in[I_N1G], mod_ptr(p, 0, 0, 0), mod_ptr(p, 0, 0, 1), lane);
    for (int r = gw; r < MA; r += 2 * NGW) {
        const int r1 = r + NGW;
        Row16 x0, x1, o;
        load_row_f32(r < TC ? p.in[I_CTX] + (size_t)r * D : p.in[I_X] + (size_t)(r - TC) * D, lane, x0);
        if (r1 < MA) load_row_f32(p.in[I_X] + (size_t)(r1 - TC) * D, lane, x1);
        NormAB n0 = nl;
        if (r < TC) normab_load(n0, p.in[I_N1G], mod_ptr(p, 0, 1, 0), mod_ptr(p, 0, 1, 1), lane);
        store_row_f32((float*)(p.ws + WS_X) + (size_t)r * D, lane, x0);
        norm_ab(x0, n0, o); store_row_bf16((bf16_t*)(p.ws + WS_XN) + (size_t)r * D, lane, o);
        if (r1 < MA) { store_row_f32((float*)(p.ws + WS_X) + (size_t)r1 * D, lane, x1); norm_ab(x1, nl, o); store_row_bf16((bf16_t*)(p.ws + WS_XN) + (size_t)r1 * D, lane, o); }
    }
}
DEVI void norm2_row(const P& p, int r, int lane, const Row16& x, const NormAB& n) {
    Row16 o; norm_ab(x, n, o);
    store_row_bf16((bf16_t*)(p.ws + WS_XN) + (size_t)r * D, lane, o);
    float m = 0.f;
#pragma unroll
    for (int j = 0; j < 16; ++j) m = fmaxf(m, fabsf(o.v[j]));
    m = wave_max_f(m);
    const float sc = m > 0.f ? 127.0f / m : 1.0f;
    unsigned char* h8 = p.ws + WS_H8 + (size_t)r * D;
    *(u32x2*)(h8 + 8 * lane) = (u32x2){pk4_i8(o.v[0] * sc, o.v[1] * sc, o.v[2] * sc, o.v[3] * sc), pk4_i8(o.v[4] * sc, o.v[5] * sc, o.v[6] * sc, o.v[7] * sc)};
    *(u32x2*)(h8 + 512 + 8 * lane) = (u32x2){pk4_i8(o.v[8] * sc, o.v[9] * sc, o.v[10] * sc, o.v[11] * sc), pk4_i8(o.v[12] * sc, o.v[13] * sc, o.v[14] * sc, o.v[15] * sc)};
    if (lane == 0) ((float*)(p.ws + WS_HS))[r] = m > 0.f ? m / 127.0f : 1.0f;
}
DEVI void ph_norm2(const P& p, int layer, int r0) {
    const int otid_ = otid();
    const int wave = __builtin_amdgcn_readfirstlane(otid_ >> 6), lane = otid_ & 63, gw = blockIdx.x * NWV + wave, NGW = gridDim.x * NWV;
    NormAB nl; normab_load(nl, p.in[I_N2G] + layer * D, mod_ptr(p, layer, 0, 3), mod_ptr(p, layer, 0, 4), lane);
    for (int r = r0 + gw; r < MA; r += 2 * NGW) {
        const int r1 = r + NGW;
        Row16 x0, x1; load_row_f32((const float*)(p.ws + WS_X) + (size_t)r * D, lane, x0);
        if (r1 < MA) load_row_f32((const float*)(p.ws + WS_X) + (size_t)r1 * D, lane, x1);
        NormAB n0 = nl;
        if (r < TC) normab_load(n0, p.in[I_N2G] + layer * D, mod_ptr(p, layer, 1, 3), mod_ptr(p, layer, 1, 4), lane);
        norm2_row(p, r, lane, x0, n0);
        if (r1 < MA) norm2_row(p, r1, lane, x1, nl);
    }
}

namespace pg8 {
#define PG8_LAS __attribute__((address_space(3)))
typedef unsigned short bf16_t;
typedef short bf16x8 __attribute__((ext_vector_type(8)));
typedef float f32x4 __attribute__((ext_vector_type(4)));
typedef unsigned u32x4 __attribute__((ext_vector_type(4)));
constexpr int BM = 256, BK = 64, HALF = 128, HTB = HALF * BK * 2  , STAGE_BYTES = 8 * HTB, NXCD = 8, WGM = 8;

__host__ __device__ __forceinline__ int lds_byte(int r, int c) { const int st = (r >> 4) * 2 + (c >> 5), rr = r & 15, cc = c & 31, ob = rr * 64 + cc * 2; return st * 1024 + (ob ^ (((ob >> 9) & 1) << 5)); }
__host__ __device__ __forceinline__ void stage_rc(int b, int& R, int& C) { const int st = b / 1024, sb = b % 1024, swz = sb ^ (((sb >> 9) & 1) << 5); R = (st >> 1) * 16 + swz / 64; C = (st & 1) * 32 + (swz % 64) / 2; }
__host__ __device__ __forceinline__ int perm32(int rho) { const int n = rho >> 4, i = rho & 15; return 8 * (i >> 2) + 4 * n + (i & 3); }

struct Unit { int pm, pn; };
struct Gemm { const bf16_t* A; const bf16_t* Bt; int M, N, K; };

struct StaticOrder {
    int nM, nN, nwg, G, c;
    __host__ __device__ void init(int M, int N, int G_, int c_) { nM = M / BM; nN = N / BM; nwg = nM * nN; G = G_; c = c_; }
    __host__ __device__ bool next(int i, Unit& u) const {
        const long L = (long)i * G + c; if (L >= nwg) return false;
        int wgid = (int)L; { const int q = nwg / NXCD, r = nwg % NXCD, xcd = wgid % NXCD, off = wgid / NXCD; wgid = (xcd < r ? xcd * (q + 1) : r * (q + 1) + (xcd - r) * q) + off; }
        const int nig = WGM * nN, gid = wgid / nig, fm = gid * WGM, gsz = (nM - fm) < WGM ? (nM - fm) : WGM;
        u.pm = fm + ((wgid % nig) % gsz); u.pn = (wgid % nig) / gsz; return true;
    }
    __device__ __forceinline__ void a_ready(const Unit&) const {}
    __device__ __forceinline__ void done(const Unit&) const {}
};
__device__ __forceinline__ unsigned cvt_pk_bf16(float lo, float hi) { unsigned r; asm volatile("v_cvt_pk_bf16_f32 %0, %1, %2" : "=v"(r) : "v"(lo), "v"(hi)); return r; }

struct EpiBf16 {
    static constexpr bool PERM = true, AFTER_DRAIN = false;
    bf16_t* O; int ldc; int row_base;
    __device__ __forceinline__ void operator()(const f32x4 (&acc)[2][2][4][2], const Unit& u, int wr, int wc, int fr, int fq) const {
        const int row0 = row_base + u.pm * BM + wr * 64 + fr, col0 = u.pn * BM + wc * 32 + 8 * fq;
#pragma unroll
        for (int ai = 0; ai < 2; ++ai)
#pragma unroll
            for (int m = 0; m < 4; ++m) { bf16_t* rowp = O + (size_t)(row0 + ai * HALF + m * 16) * ldc + col0;
#pragma unroll
                for (int bj = 0; bj < 2; ++bj) { const f32x4 v0 = acc[ai][bj][m][0], v1 = acc[ai][bj][m][1];
                    u32x4 w; w.x = ::pk2(v0[0], v0[1]); w.y = ::pk2(v0[2], v0[3]); w.z = ::pk2(v1[0], v1[1]); w.w = ::pk2(v1[2], v1[3]);
                    *(u32x4*)(rowp + bj * HALF) = w; } }
    }
};
struct EpiHgrnIn {
    static constexpr bool PERM = true, AFTER_DRAIN = false;
    bf16_t* O; int ldc; int row_base; const float* lbv;
    __device__ __forceinline__ void operator()(const f32x4 (&acc)[2][2][4][2], const Unit& u, int wr, int wc, int fr, int fq) const {
        const int row0 = row_base + u.pm * BM + wr * 64 + fr, col0 = u.pn * BM + wc * 32 + 8 * fq;
        const int blk = u.pn >> 2;
#pragma unroll
        for (int bj = 0; bj < 2; ++bj) {
            float lb8[8];
#pragma unroll
            for (int j = 0; j < 8; ++j) lb8[j] = (blk == 2 || blk == 3) ? lbv[(blk - 2) * 1024 + ((col0 + bj * HALF) & 1023) + j] : 0.f;
#pragma unroll
            for (int ai = 0; ai < 2; ++ai)
#pragma unroll
                for (int m = 0; m < 4; ++m) { const f32x4 v0 = acc[ai][bj][m][0], v1 = acc[ai][bj][m][1]; float x[8] = {v0[0], v0[1], v0[2], v0[3], v1[0], v1[1], v1[2], v1[3]};
#pragma unroll
                    for (int j = 0; j < 8; ++j) {
                        if (blk == 0 || blk == 4) x[j] = x[j] * frcp_(1.0f + __expf(-x[j]));
                        else if (blk == 2 || blk == 3) x[j] = __logf(lb8[j] + (1.0f - lb8[j]) * frcp_(1.0f + __expf(-x[j])));
                    }
                    u32x4 w; w.x = ::pk2(x[0], x[1]); w.y = ::pk2(x[2], x[3]); w.z = ::pk2(x[4], x[5]); w.w = ::pk2(x[6], x[7]);
                    *(u32x4*)(O + (size_t)(row0 + ai * HALF + m * 16) * ldc + col0 + bj * HALF) = w; }
        }
    }
};
typedef _Float16 f16x2_t __attribute__((ext_vector_type(2)));
__device__ __forceinline__ unsigned pkh2(float lo, float hi) { ::f32x2_t f = {lo, hi}; return __builtin_bit_cast(unsigned, __builtin_convertvector(f, f16x2_t)); }
struct EpiF16 {
    static constexpr bool PERM = true, AFTER_DRAIN = false;
    unsigned short* O; int ldc; int row_base;
    __device__ __forceinline__ void operator()(const f32x4 (&acc)[2][2][4][2], const Unit& u, int wr, int wc, int fr, int fq) const {
        const int row0 = row_base + u.pm * BM + wr * 64 + fr, col0 = u.pn * BM + wc * 32 + 8 * fq;
#pragma unroll
        for (int ai = 0; ai < 2; ++ai)
#pragma unroll
            for (int m = 0; m < 4; ++m) { unsigned short* rowp = O + (size_t)(row0 + ai * HALF + m * 16) * ldc + col0;
#pragma unroll
                for (int bj = 0; bj < 2; ++bj) { const f32x4 v0 = acc[ai][bj][m][0], v1 = acc[ai][bj][m][1];
                    u32x4 w; w.x = pkh2(v0[0], v0[1]); w.y = pkh2(v0[2], v0[3]); w.z = pkh2(v1[0], v1[1]); w.w = pkh2(v1[2], v1[3]);
                    *(u32x4*)(rowp + bj * HALF) = w; } }
    }
};
struct EpiGluResid {
    static constexpr bool PERM = false, AFTER_DRAIN = false;
    float* X; const float* gate1; int row_base;
    __device__ __forceinline__ void operator()(const f32x4 (&acc)[2][2][4][2], const Unit& u, int wr, int wc, int fr, int fq) const {
        const int row0 = row_base + u.pm * BM + wr * 64 + fr, ch0 = u.pn * HALF + wc * 32 + 4 * fq;
        f32x4 gv[2];
#pragma unroll
        for (int n = 0; n < 2; ++n) gv[n] = *(const f32x4*)(gate1 + ch0 + n * 16);
#pragma unroll
        for (int ai = 0; ai < 2; ++ai)
#pragma unroll
            for (int m = 0; m < 4; ++m) { float* rowp = X + (size_t)(row0 + ai * HALF + m * 16) * 1024 + ch0;
#pragma unroll
                for (int n = 0; n < 2; ++n) { const f32x4 v = acc[ai][0][m][n], g = acc[ai][1][m][n]; f32x4 o;
#pragma unroll
                    for (int j = 0; j < 4; ++j) o[j] = gv[n][j] * v[j] * frcp_(1.0f + __expf(-g[j]));
                    f32x4* q = (f32x4*)(rowp + n * 16); *q = *q + o; } }
    }
};
struct EpiResid {
    static constexpr bool PERM = false, AFTER_DRAIN = false;
    float* X; const float* gate_lat; const float* gate_ctx; int row_base; int tc_rows;
    __device__ __forceinline__ void operator()(const f32x4 (&acc)[2][2][4][2], const Unit& u, int wr, int wc, int fr, int fq) const {
        const int row0 = row_base + u.pm * BM + wr * 64 + fr, col0 = u.pn * BM + wc * 32 + 4 * fq;
        const float* gate = (row_base + u.pm * BM) < tc_rows ? gate_ctx : gate_lat;
        f32x4 gv[2][2];
#pragma unroll
        for (int bj = 0; bj < 2; ++bj)
#pragma unroll
            for (int n = 0; n < 2; ++n) gv[bj][n] = *(const f32x4*)(gate + col0 + bj * HALF + n * 16);
#pragma unroll
        for (int ai = 0; ai < 2; ++ai)
#pragma unroll
            for (int m = 0; m < 4; ++m) { float* rowp = X + (size_t)(row0 + ai * HALF + m * 16) * 1024 + col0;
#pragma unroll
                for (int bj = 0; bj < 2; ++bj)
#pragma unroll
                    for (int n = 0; n < 2; ++n) { f32x4* q = (f32x4*)(rowp + bj * HALF + n * 16); *q = *q + gv[bj][n] * acc[ai][bj][m][n]; } }
    }
};

template <class Epi, class Sched, bool ALIGN_EPI = false, bool SP2 = false>
__device__ __forceinline__ void gemm_phase(PG8_LAS unsigned char* lds, const Gemm g, const Sched& S, const Epi& E) {
    const int tid = otid(), wid = __builtin_amdgcn_readfirstlane(tid >> 6), lane = tid & 63, wr = wid >> 2, wc = wid & 3, fr = lane & 15, fq = lane >> 4;
    const int K = g.K, nt = K / BK;
    unsigned voffA[2], voffB[2];
#pragma unroll
    for (int i = 0; i < 2; ++i) { int R, C; stage_rc(tid * 16 + i * 8192, R, C); const int Rb = Epi::PERM ? ((R & ~31) + perm32(R & 31)) : R;
        voffA[i] = (unsigned)(R * K + C) * 2u; voffB[i] = (unsigned)(Rb * K + C) * 2u; }
    const size_t kstep = (size_t)(BK * 2);
    const size_t hstep = (size_t)HALF * K * 2;
    const size_t tstep = 2 * hstep;
    const unsigned ldsw = (unsigned)wid * 1024u;
    const int aoff = lds_byte(wr * 64 + fr, fq * 8), boff = lds_byte(wc * 32 + fr, fq * 8);
#define PG8_SA(b, h) (((b) * 2 + (h)) * HTB)
#define PG8_SB(b, h) ((4 + (b) * 2 + (h)) * HTB)
#define PG8_STAGE(bufoff, gbase, voff) do { _Pragma("unroll") for (int _i = 0; _i < 2; ++_i) \
        __builtin_amdgcn_global_load_lds((const unsigned*)((const char*)(gbase) + (voff)[_i]), (PG8_LAS unsigned*)(lds + (bufoff) + ldsw + _i * 8192), 16, 0, 0); } while (0)
#define PG8_LDA(dst, b, h) do { _Pragma("unroll") for (int m = 0; m < 4; ++m) _Pragma("unroll") for (int k = 0; k < 2; ++k) dst[m][k] = *(const PG8_LAS bf16x8*)(lds + PG8_SA(b, h) + aoff + m * 2048 + k * 1024); } while (0)
#define PG8_LDB(dst, b, h) do { _Pragma("unroll") for (int n = 0; n < 2; ++n) _Pragma("unroll") for (int k = 0; k < 2; ++k) dst[n][k] = *(const PG8_LAS bf16x8*)(lds + PG8_SB(b, h) + boff + n * 2048 + k * 1024); } while (0)
#define PG8_MMA(ai, bj, At, Bt) do { __builtin_amdgcn_s_setprio(1); _Pragma("unroll") for (int m = 0; m < 4; ++m) _Pragma("unroll") for (int n = 0; n < 2; ++n) _Pragma("unroll") for (int k = 0; k < 2; ++k) \
        acc[ai][bj][m][n] = __builtin_amdgcn_mfma_f32_16x16x32_bf16(Bt[n][k], At[m][k], acc[ai][bj][m][n], 0, 0, 0); __builtin_amdgcn_s_setprio(0); } while (0)
#define PG8_WAIT_V(n) asm volatile("s_waitcnt vmcnt(" #n ")" ::: "memory")
#define PG8_WAIT_L(n) asm volatile("s_waitcnt lgkmcnt(" #n ")" ::: "memory")
#define PG8_BAR __builtin_amdgcn_s_barrier()
#define PG8_SCHED __builtin_amdgcn_sched_barrier(0)
    Unit cur, nxt; int ui = 0;
    if (!S.next(0, cur)) return;
    f32x4 acc[2][2][4][2];
#pragma unroll
    for (int a = 0; a < 2; ++a)
#pragma unroll
        for (int b = 0; b < 2; ++b)
#pragma unroll
            for (int m = 0; m < 4; ++m)
#pragma unroll
                for (int n = 0; n < 2; ++n) acc[a][b][m][n] = (f32x4){0.f, 0.f, 0.f, 0.f};
    bf16x8 At[4][2], B0[2][2], B1[2][2];
    const char* cA = (const char*)g.A + (size_t)cur.pm * tstep; const char* cB = (const char*)g.Bt + (size_t)cur.pn * tstep;
    S.a_ready(cur);
    if constexpr (SP2) {
        PG8_STAGE(PG8_SB(0, 0), cB, voffB); PG8_STAGE(PG8_SB(0, 1), cB + hstep, voffB); PG8_STAGE(PG8_SA(0, 0), cA, voffA); PG8_STAGE(PG8_SA(0, 1), cA + hstep, voffA);
        if (wr == 1) PG8_BAR;
        PG8_WAIT_V(2); PG8_BAR;
        PG8_STAGE(PG8_SB(1, 0), cB + kstep, voffB); PG8_STAGE(PG8_SA(1, 0), cA + kstep, voffA); PG8_STAGE(PG8_SB(1, 1), cB + hstep + kstep, voffB);
        PG8_WAIT_V(6); PG8_BAR;
    } else {
        PG8_STAGE(PG8_SB(0, 0), cB, voffB); PG8_STAGE(PG8_SA(0, 0), cA, voffA); PG8_STAGE(PG8_SB(0, 1), cB + hstep, voffB); PG8_STAGE(PG8_SA(0, 1), cA + hstep, voffA);
        if (wr == 1) PG8_BAR;
        PG8_WAIT_V(4); PG8_BAR;
        PG8_STAGE(PG8_SB(1, 0), cB + kstep, voffB); PG8_STAGE(PG8_SA(1, 0), cA + kstep, voffA); PG8_STAGE(PG8_SB(1, 1), cB + hstep + kstep, voffB);
        PG8_WAIT_V(6); PG8_BAR;
    }
    for (;;) {
        const bool has_next = S.next(ui + 1, nxt);
        const char* nA = has_next ? (const char*)g.A + (size_t)nxt.pm * tstep : cA; const char* nB = has_next ? (const char*)g.Bt + (size_t)nxt.pn * tstep : cB;
        for (int t = 0; t < nt; t += 2) {
            const bool last = (t == nt - 2);
            const char* a1 = cA + (size_t)(t + 1) * kstep;
            const char* a2 = last ? nA : cA + (size_t)(t + 2) * kstep; const char* b2 = last ? nB : cB + (size_t)(t + 2) * kstep;
            const char* a3 = a2 + kstep; const char* b3 = b2 + kstep;
            if (last && has_next) S.a_ready(nxt);
            if constexpr (SP2) {
            PG8_LDB(B0, 0, 0); PG8_LDB(B1, 0, 1); PG8_SCHED; PG8_LDA(At, 0, 0); PG8_STAGE(PG8_SA(1, 1), a1 + hstep, voffA);
            PG8_WAIT_V(8); PG8_WAIT_L(0); PG8_BAR; PG8_MMA(0, 0, At, B0); PG8_MMA(0, 1, At, B1); PG8_BAR; PG8_SCHED;
            PG8_LDA(At, 0, 1); PG8_STAGE(PG8_SB(0, 0), b2, voffB); PG8_STAGE(PG8_SB(0, 1), b2 + hstep, voffB); PG8_STAGE(PG8_SA(0, 0), a2, voffA);
            PG8_WAIT_V(8); PG8_WAIT_L(0); PG8_BAR; PG8_MMA(1, 0, At, B0); PG8_MMA(1, 1, At, B1); PG8_BAR; PG8_SCHED;
            PG8_LDB(B0, 1, 0); PG8_LDB(B1, 1, 1); PG8_SCHED; PG8_LDA(At, 1, 0); PG8_STAGE(PG8_SA(0, 1), a2 + hstep, voffA);
            PG8_WAIT_V(8); PG8_WAIT_L(0); PG8_BAR; PG8_MMA(0, 0, At, B0); PG8_MMA(0, 1, At, B1); PG8_BAR; PG8_SCHED;
            PG8_LDA(At, 1, 1); PG8_STAGE(PG8_SB(1, 0), b3, voffB); PG8_STAGE(PG8_SB(1, 1), b3 + hstep, voffB); PG8_STAGE(PG8_SA(1, 0), a3, voffA);
            PG8_WAIT_V(8); PG8_WAIT_L(0); PG8_BAR; PG8_MMA(1, 0, At, B0); PG8_MMA(1, 1, At, B1); PG8_BAR; PG8_SCHED;
            } else {
            PG8_LDB(B0, 0, 0); PG8_SCHED; PG8_LDA(At, 0, 0); PG8_STAGE(PG8_SA(1, 1), a1 + hstep, voffA);
            PG8_WAIT_L(8); PG8_BAR; PG8_WAIT_L(0); PG8_MMA(0, 0, At, B0); PG8_BAR; PG8_SCHED;
            PG8_LDB(B1, 0, 1); PG8_STAGE(PG8_SB(0, 0), b2, voffB);
            PG8_BAR; PG8_WAIT_L(0); PG8_MMA(0, 1, At, B1); PG8_BAR;
            PG8_LDA(At, 0, 1); PG8_STAGE(PG8_SA(0, 0), a2, voffA);
            PG8_BAR; PG8_WAIT_L(0); PG8_MMA(1, 0, At, B0); PG8_BAR; PG8_SCHED;
            PG8_STAGE(PG8_SB(0, 1), b2 + hstep, voffB);
            PG8_WAIT_V(6); PG8_BAR; PG8_MMA(1, 1, At, B1); PG8_BAR;
            PG8_LDB(B0, 1, 0); PG8_SCHED; PG8_LDA(At, 1, 0); PG8_STAGE(PG8_SA(0, 1), a2 + hstep, voffA);
            PG8_WAIT_L(8); PG8_BAR; PG8_WAIT_L(0); PG8_MMA(0, 0, At, B0); PG8_BAR; PG8_SCHED;
            PG8_LDB(B1, 1, 1); PG8_STAGE(PG8_SB(1, 0), b3, voffB);
            PG8_BAR; PG8_WAIT_L(0); PG8_MMA(0, 1, At, B1); PG8_BAR;
            PG8_LDA(At, 1, 1); PG8_STAGE(PG8_SA(1, 0), a3, voffA);
            PG8_BAR; PG8_WAIT_L(0); PG8_MMA(1, 0, At, B0); PG8_BAR; PG8_SCHED;
            PG8_STAGE(PG8_SB(1, 1), b3 + hstep, voffB);
            PG8_WAIT_V(6); PG8_BAR; PG8_MMA(1, 1, At, B1); PG8_BAR;
            }
        }
        if constexpr (ALIGN_EPI) { if (wr == 0) PG8_BAR; }
        if constexpr (!Epi::AFTER_DRAIN) { E(acc, cur, wr, wc, fr, fq); S.done(cur); }
        if (!has_next) break;
#pragma unroll
        for (int a = 0; a < 2; ++a)
#pragma unroll
            for (int b = 0; b < 2; ++b)
#pragma unroll
                for (int m = 0; m < 4; ++m)
#pragma unroll
                    for (int n = 0; n < 2; ++n) acc[a][b][m][n] = (f32x4){0.f, 0.f, 0.f, 0.f};
        cur = nxt; cA = nA; cB = nB; ++ui;
        if constexpr (ALIGN_EPI) { if (wr == 1) PG8_BAR; }
    }
    PG8_WAIT_V(0);
    if constexpr (!ALIGN_EPI) { if (wr == 0) PG8_BAR; }
    PG8_BAR;
    if constexpr (Epi::AFTER_DRAIN) { E.fused(acc, cur, wr, wc, fr, fq, lds, wid, lane); S.done(cur); }
#undef PG8_SA
#undef PG8_SB
#undef PG8_STAGE
#undef PG8_LDA
#undef PG8_LDB
#undef PG8_MMA
#undef PG8_WAIT_V
#undef PG8_WAIT_L
#undef PG8_BAR
#undef PG8_SCHED
}
}

struct ConvRaw { u32x4 gb[2], gc[2], v[2], gcp[2], vp[2], gcn[2], vn[2]; };
DEVI void conv_raw_row(u32x4 (&o)[2], const bf16_t* row, int lane) { o[0] = *(const u32x4*)(row + 8 * lane); o[1] = *(const u32x4*)(row + 512 + 8 * lane); }
DEVI void conv_load(ConvRaw& c, const bf16_t* G, int r, int lane, bool hasp, bool hasn) {
    conv_raw_row(c.gb, G + (size_t)r * 3072, lane); conv_raw_row(c.gc, G + (size_t)r * 3072 + 1024, lane); conv_raw_row(c.v, G + (size_t)r * 3072 + 2048, lane);
    if (hasp) { conv_raw_row(c.gcp, G + (size_t)(r - 1) * 3072 + 1024, lane); conv_raw_row(c.vp, G + (size_t)(r - 1) * 3072 + 2048, lane); }
    if (hasn) { conv_raw_row(c.gcn, G + (size_t)(r + 1) * 3072 + 1024, lane); conv_raw_row(c.vn, G + (size_t)(r + 1) * 3072 + 2048, lane); }
}
DEVI void conv_unpack(const u32x4 (&a)[2], Row16& o) {
#pragma unroll
    for (int j = 0; j < 4; ++j) { o.v[2 * j] = bflo(a[0][j]); o.v[2 * j + 1] = bfhi(a[0][j]); o.v[8 + 2 * j] = bflo(a[1][j]); o.v[8 + 2 * j + 1] = bfhi(a[1][j]); }
}
DEVI void conv_finish(const P& p, const ConvRaw& c, int r, int lane, bool hasp, bool hasn, const Row16& k0, const Row16& k1, const Row16& k2) {
    Row16 gb, gc, v, acc;
    conv_unpack(c.gc, gc); conv_unpack(c.v, v);
#pragma unroll
    for (int e = 0; e < 16; ++e) acc.v[e] = gc.v[e] * v.v[e] * k1.v[e];
    if (hasp) { conv_unpack(c.gcp, gc); conv_unpack(c.vp, v);
#pragma unroll
        for (int e = 0; e < 16; ++e) acc.v[e] += gc.v[e] * v.v[e] * k0.v[e]; }
    if (hasn) { conv_unpack(c.gcn, gc); conv_unpack(c.vn, v);
#pragma unroll
        for (int e = 0; e < 16; ++e) acc.v[e] += gc.v[e] * v.v[e] * k2.v[e]; }
    conv_unpack(c.gb, gb);
#pragma unroll
    for (int e = 0; e < 16; ++e) acc.v[e] *= gb.v[e];
    store_row_bf16((bf16_t*)(p.ws + WS_U) + (size_t)r * D, lane, acc);
}
DEVI void conv_edges(int r, bool& hasp, bool& hasn) { if (r < TC) { hasp = r > 0; hasn = r < TC - 1; } else { const int t = (r - TC) & 63; hasp = t != 0; hasn = t != 63; } }
DEVI void ph_conv(const P& p, int j, int r0) {
    const int otid_ = otid();
    const int wave = __builtin_amdgcn_readfirstlane(otid_ >> 6), lane = otid_ & 63, gw = blockIdx.x * NWV + wave, NGW = gridDim.x * NWV;
    const bf16_t* G = (const bf16_t*)(p.ws + WS_G);
    Row16 k0, k1, k2;
    load_row_f32(p.in[I_CK] + (size_t)(j * 3 + 0) * D, lane, k0); load_row_f32(p.in[I_CK] + (size_t)(j * 3 + 1) * D, lane, k1); load_row_f32(p.in[I_CK] + (size_t)(j * 3 + 2) * D, lane, k2);
    for (int r = r0 + gw; r < MA; r += 2 * NGW) {
        const int r1 = r + NGW;
        bool hp0, hn0, hp1 = false, hn1 = false; conv_edges(r, hp0, hn0); if (r1 < MA) conv_edges(r1, hp1, hn1);
        ConvRaw c0, c1;
        conv_load(c0, G, r, lane, hp0, hn0);
        if (r1 < MA) conv_load(c1, G, r1, lane, hp1, hn1);
        conv_finish(p, c0, r, lane, hp0, hn0, k0, k1, k2);
        if (r1 < MA) conv_finish(p, c1, r1, lane, hp1, hn1, k0, k1, k2);
    }
}

DEVI int scan_row(int n, int dir) {
    if (dir == 0) return n;
    return n < TC ? (TC - 1 - n) : (TC + (T - 1 - (n - TC)));
}
namespace hg {
typedef short bf16x8 __attribute__((ext_vector_type(8)));
constexpr int NSEG = 16, NUNIT = 2 * 8 * NSEG;
constexpr int QSB = 272, TSB = 80;
constexpr int OFF_QT = 0, OFF_KT = 32 * QSB, OFF_QD = 2 * 32 * QSB, OFF_KDT = 3 * 32 * QSB, OFF_VT = OFF_KDT + 128 * TSB, OFF_DEC = OFF_VT + 128 * TSB, OFF_T = OFF_DEC + 512, BUFB = OFF_T + 4096;
static_assert(2 * BUFB <= 131072, "hgrn LDS");
DEVI bf16x8 mk8(unsigned a, unsigned b, unsigned c, unsigned d) { u32x4 v = {a, b, c, d}; return __builtin_bit_cast(bf16x8, v); }
DEVI unsigned cvtpk(float lo, float hi) { return pk2(lo, hi); }
#define HG_MFMA(a, b, c) __builtin_amdgcn_mfma_f32_16x16x32_bf16((a), (b), (c), 0, 0, 0)
#define HG_BAR() do { asm volatile("s_waitcnt lgkmcnt(0)" ::: "memory"); __builtin_amdgcn_s_barrier(); asm volatile("" ::: "memory"); } while (0)
template <bool PASS2>
DEVI void scan(const P& p, unsigned char* lds_) {
    for (int unit = blockIdx.x; unit < NUNIT; unit += gridDim.x) {
    __syncthreads();
    const int tid = otid(), lane = tid & 63, w = __builtin_amdgcn_readfirstlane(tid >> 6), c = lane & 15, q4 = lane >> 4;
    const int kp = tid & 63, lo = tid >> 6;
    const int d = unit / (8 * NSEG), h = (unit / NSEG) & 7, seg = unit % NSEG;
    LAS unsigned char* lds = (LAS unsigned char*)lds_;
    const bf16_t* G = (const bf16_t*)(p.ws + WS_G);
    bf16_t* O = (bf16_t*)(p.ws + (d ? WS_OB : WS_OF));
    float* SLOC = (float*)(p.ws + WS_SC);
    float* GSUM = SLOC + (size_t)NUNIT * 16384;
    f32x4 S[8];
#pragma unroll
    for (int t = 0; t < 8; ++t) S[t] = (f32x4){0.f, 0.f, 0.f, 0.f};
    if (PASS2) {
        for (int j = 0; j < seg; ++j) {
            const float* gs = GSUM + (size_t)(unit - seg + j) * 128; const float* sl = SLOC + (size_t)(unit - seg + j) * 16384 + (size_t)w * 2048;
#pragma unroll
            for (int t = 0; t < 8; ++t) { const f32x4 gg = *(const f32x4*)(gs + 16 * t + 4 * q4);
#pragma unroll
                for (int r = 0; r < 4; ++r) S[t][r] = S[t][r] * __expf(gg[r]) + sl[(t * 4 + r) * 64 + lane]; }
        }
    }
    float gsum0 = 0.f, gsum1 = 0.f;
    unsigned rq[4], ri[4], rz[4];
    const int CPS = 32 + (seg < 8 ? 1 : 0), ci0 = 32 * seg + (seg < 8 ? seg : 8);
    const bf16_t* Gk = G + h * 128 + 2 * kp + (d ? 1024 : 0);
    const long rstep = d ? -5120 : 5120;
#define HG_FETCH(ci) do { const bf16_t* g_ = Gk + (long)scan_row(32 * (ci) + 4 * lo, d) * 5120; _Pragma("unroll") for (int j = 0; j < 4; ++j) { \
        if (PASS2) rq[j] = *(const unsigned*)(g_ + (d ? -1024 : 0)); ri[j] = *(const unsigned*)(g_ + (d ? 0 : 1024)); rz[j] = *(const unsigned*)(g_ + 2048); g_ += rstep; } } while (0)
    HG_FETCH(ci0);
    for (int cc = 0; cc < CPS; ++cc) {
        const int ci = ci0 + cc;
        LAS unsigned char* B = lds + (cc & 1) * BUFB;
        float bl0[4], bl1[4], kv0[4], kv1[4]; float run0 = 0.f, run1 = 0.f;
#pragma unroll
        for (int j = 0; j < 4; ++j) { const float z0 = bflo(rz[j]), z1 = bfhi(rz[j]); run0 += z0; run1 += z1; bl0[j] = run0; bl1[j] = run1; kv0[j] = 1.0f - __expf(z0); kv1[j] = 1.0f - __expf(z1); }
        unsigned qp[4], vp[4];
#pragma unroll
        for (int j = 0; j < 4; ++j) { vp[j] = ri[j]; if (PASS2) qp[j] = rq[j]; }
        *(LAS f32x2_t*)(B + OFF_T + (lo * 128 + 2 * kp) * 4) = (f32x2_t){run0, run1};
        if (cc + 1 < CPS) HG_FETCH(ci + 1);
        HG_BAR();
        {
            float off0 = 0.f, off1 = 0.f, b15_0 = 0.f, b15_1 = 0.f, bla0 = 0.f, bla1 = 0.f;
#pragma unroll
            for (int x8 = 0; x8 < 8; ++x8) { const f32x2_t tt = *(const LAS f32x2_t*)(B + OFF_T + (x8 * 128 + 2 * kp) * 4);
                if (x8 < lo) { off0 += tt.x; off1 += tt.y; } if (x8 < 4) { b15_0 += tt.x; b15_1 += tt.y; } bla0 += tt.x; bla1 += tt.y; }
            const float e15_0 = __expf(b15_0), e15_1 = __expf(b15_1), el0 = __expf(bla0 - b15_0), el1 = __expf(bla1 - b15_1);
            float kd0[4], kd1[4];
#pragma unroll
            for (int j = 0; j < 4; ++j) {
                const int l = 4 * lo + j;
                const float b0 = bl0[j] + off0, b1 = bl1[j] + off1;
                const float kt0 = kv0[j] * __expf(b15_0 - b0), kt1 = kv1[j] * __expf(b15_1 - b1);
                kd0[j] = kt0 * el0; kd1[j] = kt1 * el1;
                if (PASS2) {
                    const float qt0 = bflo(qp[j]) * __expf(b0 - b15_0), qt1 = bfhi(qp[j]) * __expf(b1 - b15_1);
                    *(LAS unsigned*)(B + OFF_QT + l * QSB + 4 * kp) = pk2(qt0, qt1); *(LAS unsigned*)(B + OFF_QD + l * QSB + 4 * kp) = pk2(qt0 * e15_0, qt1 * e15_1);
                    *(LAS unsigned*)(B + OFF_KT + l * QSB + 4 * kp) = pk2(kt0, kt1);
                }
            }
            *(LAS u32x2*)(B + OFF_KDT + (2 * kp) * TSB + 8 * lo) = (u32x2){pk2(kd0[0], kd0[1]), pk2(kd0[2], kd0[3])};
            *(LAS u32x2*)(B + OFF_KDT + (2 * kp + 1) * TSB + 8 * lo) = (u32x2){pk2(kd1[0], kd1[1]), pk2(kd1[2], kd1[3])};
            *(LAS u32x2*)(B + OFF_VT + (2 * kp) * TSB + 8 * lo) = (u32x2){(vp[0] & 0xffffu) | (vp[1] << 16), (vp[2] & 0xffffu) | (vp[3] << 16)};
            *(LAS u32x2*)(B + OFF_VT + (2 * kp + 1) * TSB + 8 * lo) = (u32x2){(vp[0] >> 16) | (vp[1] & 0xffff0000u), (vp[2] >> 16) | (vp[3] & 0xffff0000u)};
            if (lo == 0) { *(LAS f32x2_t*)(B + OFF_DEC + 8 * kp) = (f32x2_t){__expf(bla0), __expf(bla1)}; gsum0 += bla0; gsum1 += bla1; }
        }
        HG_BAR();
        if (PASS2) {
            f32x4 p00 = {0.f, 0.f, 0.f, 0.f}, p01 = p00, p11 = p00;
#pragma unroll
            for (int s4 = 0; s4 < 4; ++s4) {
                const bf16x8 a0 = *(const LAS bf16x8*)(B + OFF_KT + c * QSB + 64 * s4 + 16 * q4), a1 = *(const LAS bf16x8*)(B + OFF_KT + (16 + c) * QSB + 64 * s4 + 16 * q4);
                const bf16x8 b0 = *(const LAS bf16x8*)(B + OFF_QT + c * QSB + 64 * s4 + 16 * q4), b1 = *(const LAS bf16x8*)(B + OFF_QT + (16 + c) * QSB + 64 * s4 + 16 * q4);
                p00 = HG_MFMA(a0, b0, p00); p01 = HG_MFMA(a0, b1, p01); p11 = HG_MFMA(a1, b1, p11);
            }
#pragma unroll
            for (int r = 0; r < 4; ++r) { const bool keep = (4 * q4 + r) <= c; p00[r] = keep ? p00[r] : 0.f; p11[r] = keep ? p11[r] : 0.f; }
            const bf16x8 bp0 = mk8(cvtpk(p00[0], p00[1]), cvtpk(p00[2], p00[3]), 0u, 0u);
            const bf16x8 bp1 = mk8(cvtpk(p01[0], p01[1]), cvtpk(p01[2], p01[3]), cvtpk(p11[0], p11[1]), cvtpk(p11[2], p11[3]));
            const u32x2 v0 = *(const LAS u32x2*)(B + OFF_VT + (16 * w + c) * TSB + 8 * q4), v1 = *(const LAS u32x2*)(B + OFF_VT + (16 * w + c) * TSB + 32 + 8 * q4);
            const bf16x8 va = mk8(v0.x, v0.y, v1.x, v1.y);
            f32x4 o0 = {0.f, 0.f, 0.f, 0.f}, o1 = o0;
            o0 = HG_MFMA(va, bp0, o0); o1 = HG_MFMA(va, bp1, o1);
#pragma unroll
            for (int s4 = 0; s4 < 4; ++s4) {
                const bf16x8 sa = mk8(cvtpk(S[2 * s4][0], S[2 * s4][1]), cvtpk(S[2 * s4][2], S[2 * s4][3]), cvtpk(S[2 * s4 + 1][0], S[2 * s4 + 1][1]), cvtpk(S[2 * s4 + 1][2], S[2 * s4 + 1][3]));
                const u32x2 x0 = *(const LAS u32x2*)(B + OFF_QD + c * QSB + 64 * s4 + 8 * q4), x1 = *(const LAS u32x2*)(B + OFF_QD + c * QSB + 64 * s4 + 32 + 8 * q4);
                const u32x2 y0 = *(const LAS u32x2*)(B + OFF_QD + (16 + c) * QSB + 64 * s4 + 8 * q4), y1 = *(const LAS u32x2*)(B + OFF_QD + (16 + c) * QSB + 64 * s4 + 32 + 8 * q4);
                o0 = HG_MFMA(sa, mk8(x0.x, x0.y, x1.x, x1.y), o0); o1 = HG_MFMA(sa, mk8(y0.x, y0.y, y1.x, y1.y), o1);
            }
            {
                const int ra = scan_row(32 * ci + c, d), rb = scan_row(32 * ci + 16 + c, d);
                *(u32x2*)(O + (size_t)ra * D + h * 128 + 16 * w + 4 * q4) = (u32x2){cvtpk(o0[0], o0[1]), cvtpk(o0[2], o0[3])};
                *(u32x2*)(O + (size_t)rb * D + h * 128 + 16 * w + 4 * q4) = (u32x2){cvtpk(o1[0], o1[1]), cvtpk(o1[2], o1[3])};
            }
        }
        {
            const bf16x8 vb = *(const LAS bf16x8*)(B + OFF_VT + (16 * w + c) * TSB + 16 * q4);
#pragma unroll
            for (int t = 0; t < 8; ++t) {
                const f32x4 dec = *(const LAS f32x4*)(B + OFF_DEC + (16 * t + 4 * q4) * 4);
                const bf16x8 ka = *(const LAS bf16x8*)(B + OFF_KDT + (16 * t + c) * TSB + 16 * q4);
                S[t] = HG_MFMA(ka, vb, S[t] * dec);
            }
        }
    }
    if (!PASS2) {
        float* sl = SLOC + (size_t)unit * 16384 + (size_t)w * 2048;
#pragma unroll
        for (int t = 0; t < 8; ++t)
#pragma unroll
            for (int r = 0; r < 4; ++r) sl[(t * 4 + r) * 64 + lane] = S[t][r];
        if (lo == 0) { GSUM[(size_t)unit * 128 + 2 * kp] = gsum0; GSUM[(size_t)unit * 128 + 2 * kp + 1] = gsum1; }
    }
#undef HG_FETCH
    }
}
}

DEVI void hgrn_readout_row(const P& p, int r, int lane, Row16& a, const Row16& b, const Row16& zg, const Row16& ng) {
    Row16 o; float s0 = 0.f, s1 = 0.f;
#pragma unroll
    for (int e = 0; e < 8; ++e) { a.v[e] += b.v[e]; a.v[8 + e] += b.v[8 + e]; s0 += a.v[e] * a.v[e]; s1 += a.v[8 + e] * a.v[8 + e]; }
    s0 = row16_sum(s0); s1 = row16_sum(s1);
    const float r0 = rsqrtf(s0 * (1.0f / 128.0f) + EPS), r1 = rsqrtf(s1 * (1.0f / 128.0f) + EPS);
#pragma unroll
    for (int e = 0; e < 8; ++e) { o.v[e] = a.v[e] * r0 * ng.v[e] * zg.v[e]; o.v[8 + e] = a.v[8 + e] * r1 * ng.v[8 + e] * zg.v[8 + e]; }
    store_row_bf16((bf16_t*)(p.ws + WS_U) + (size_t)r * D, lane, o);
}
DEVI void ph_hgrn_readout(const P& p) {
    const int otid_ = otid();
    const int wave = __builtin_amdgcn_readfirstlane(otid_ >> 6), lane = otid_ & 63, gw = blockIdx.x * NWV + wave, NGW = gridDim.x * NWV;
    Row16 ng; load_row_f32(p.in[I_HNG], lane, ng);
    for (int r = gw; r < MA; r += 2 * NGW) {
        const int r1 = r + NGW;
        Row16 a0, b0, z0, a1, b1, z1;
        load_row_bf16((const bf16_t*)(p.ws + WS_OF) + (size_t)r * D, lane, a0); load_row_bf16((const bf16_t*)(p.ws + WS_OB) + (size_t)r * D, lane, b0);
        load_row_bf16((const bf16_t*)(p.ws + WS_G) + (size_t)r * 5120 + 4096, lane, z0);
        if (r1 < MA) { load_row_bf16((const bf16_t*)(p.ws + WS_OF) + (size_t)r1 * D, lane, a1); load_row_bf16((const bf16_t*)(p.ws + WS_OB) + (size_t)r1 * D, lane, b1);
            load_row_bf16((const bf16_t*)(p.ws + WS_G) + (size_t)r1 * 5120 + 4096, lane, z1); }
        hgrn_readout_row(p, r, lane, a0, b0, z0, ng);
        if (r1 < MA) hgrn_readout_row(p, r1, lane, a1, b1, z1, ng);
    }
}

DEVI float reduce16(float (&v)[16], int lane) {
    float w8[8], w4[4], w2[2];
    const bool b5 = lane & 32, b4 = lane & 16, b3 = lane & 8, b2 = lane & 4;
#pragma unroll
    for (int i = 0; i < 8; ++i) { const float keep = b5 ? v[i + 8] : v[i], send = b5 ? v[i] : v[i + 8]; w8[i] = keep + __shfl_xor(send, 32); }
#pragma unroll
    for (int i = 0; i < 4; ++i) { const float keep = b4 ? w8[i + 4] : w8[i], send = b4 ? w8[i] : w8[i + 4]; w4[i] = keep + __shfl_xor(send, 16); }
#pragma unroll
    for (int i = 0; i < 2; ++i) { const float keep = b3 ? w4[i + 2] : w4[i], send = b3 ? w4[i] : w4[i + 2]; w2[i] = keep + __shfl_xor(send, 8); }
    const float keep = b2 ? w2[1] : w2[0], send = b2 ? w2[0] : w2[1];
    float r = keep + __shfl_xor(send, 4);
    r += __shfl_xor(r, 2); r += __shfl_xor(r, 1);
    return r;
}
namespace s5 {
typedef short bf16x8 __attribute__((ext_vector_type(8)));
constexpr int NSEG = 16, SEGLEN = MA / NSEG, CPS = SEGLEN / 16;
static_assert(SEGLEN * NSEG == MA && CPS * 16 == SEGLEN, "s5 segments");
constexpr int XSB = 272, BSB = 528, WAVE_LDS = 16 * BSB + 16 * XSB;
DEVI bf16x8 mk8(unsigned a, unsigned b, unsigned c, unsigned d) { u32x4 v = {a, b, c, d}; return __builtin_bit_cast(bf16x8, v); }
template <bool PASS2>
DEVI void scan(const P& p, unsigned char* lds_) {
    const int tid = otid(), lane = tid & 63, w = __builtin_amdgcn_readfirstlane(tid >> 6), c = lane & 15, q4 = lane >> 4;
    for (int blk = blockIdx.x; blk < 256; blk += gridDim.x) {
    const int dn = blk >> 7, seg = (blk >> 3) & 15, g = (blk & 7) * 8 + w;
    LAS unsigned char* BUS = (LAS unsigned char*)lds_ + w * WAVE_LDS; LAS unsigned char* XS = BUS + 16 * BSB;
    const bf16_t* XN = (const bf16_t*)(p.ws + WS_XN);
    bf16_t* Y = (bf16_t*)(p.ws + (dn ? WS_OB : WS_OF));
    float* XE = (float*)(p.ws + WS_XE);
    const float* Aab = (const float*)(p.ws + WS_S5A) + (size_t)((dn * 64 + g) * 64 + lane) * 2;
    const float abr = Aab[0], abi = Aab[1];
    bf16x8 bfr[8];
#pragma unroll
    for (int n = 0; n < 8; ++n) {
        if (q4 < 2) { const float* B = (const float*)(p.ws + WS_S5B) + (size_t)((dn * 64 + g) * 64 + 8 * n + (c >> 1)) * 32 + (c & 1) * 16 + 8 * q4;
            const f32x4 b0 = *(const f32x4*)B, b1 = *(const f32x4*)(B + 4); bfr[n] = mk8(pk2(b0[0], b0[1]), pk2(b0[2], b0[3]), pk2(b1[0], b1[1]), pk2(b1[2], b1[3])); }
        else bfr[n] = mk8(0u, 0u, 0u, 0u);
    }
    bf16x8 cfr[4];
    if (PASS2) {
#pragma unroll
        for (int s4 = 0; s4 < 4; ++s4) {
            const size_t o = ((size_t)(dn * 64 + g) * 16 + c) * 64 + 16 * s4 + 4 * q4;
            const f32x4 cr = *(const f32x4*)(p.in[I_S5CR] + o), ci = *(const f32x4*)(p.in[I_S5CI] + o);
            cfr[s4] = mk8(pk2(cr[0], -ci[0]), pk2(cr[1], -ci[1]), pk2(cr[2], -ci[2]), pk2(cr[3], -ci[3]));
        }
    }
    float xr = 0.f, xi = 0.f;
    if (PASS2 && seg > 0) {
        float pr = 1.f, pi = 0.f, br = abr, bi = abi;
#define S5_PIN(x) asm volatile("" : "+v"(x))
#pragma unroll 1
        for (int n = SEGLEN; n; n >>= 1) {
            if (n & 1) { float t = pr * br; S5_PIN(t); t = __builtin_fmaf(-pi, bi, t); S5_PIN(t); float u = pr * bi; S5_PIN(u); u = __builtin_fmaf(pi, br, u); S5_PIN(u); pr = t; pi = u; }
            float t2 = br * br; S5_PIN(t2); t2 = __builtin_fmaf(-bi, bi, t2); S5_PIN(t2); float u2 = 2.f * br * bi; S5_PIN(u2); br = t2; bi = u2;
        }
        for (int j = 0; j < seg; ++j) { const float* e = XE + ((size_t)((dn * 64 + g) * 16 + j) * 64 + lane) * 2; const float er = e[0], ei = e[1];
            float t = __builtin_fmaf(pr, xr, er); S5_PIN(t); t = __builtin_fmaf(-pi, xi, t); S5_PIN(t); float u = __builtin_fmaf(pr, xi, ei); S5_PIN(u); u = __builtin_fmaf(pi, xr, u); S5_PIN(u); xr = t; xi = u; }
#undef S5_PIN
    }
    const int n0 = seg * SEGLEN;
    const unsigned amask = q4 < 2 ? 0xffffffffu : 0u;
    u32x4 araw = *(const u32x4*)(XN + (size_t)scan_row(n0 + c, dn) * D + g * 16 + 8 * (q4 & 1));
#pragma unroll 1
    for (int cc = 0; cc < CPS; ++cc) {
        const u32x4 am = {araw[0] & amask, araw[1] & amask, araw[2] & amask, araw[3] & amask};
        const bf16x8 afr = __builtin_bit_cast(bf16x8, am);
        { const int cn = cc + 1 < CPS ? cc + 1 : cc; araw = *(const u32x4*)(XN + (size_t)scan_row(n0 + 16 * cn + c, dn) * D + g * 16 + 8 * (q4 & 1)); }
#pragma unroll
        for (int n = 0; n < 8; ++n) {
            const f32x4 dv = __builtin_amdgcn_mfma_f32_16x16x32_bf16(bfr[n], afr, (f32x4){0.f, 0.f, 0.f, 0.f}, 0, 0, 0);
            *(LAS f32x4*)(BUS + c * BSB + (16 * n + 4 * q4) * 4) = dv;
        }
        asm volatile("s_waitcnt lgkmcnt(0)" ::: "memory");
        f32x2_t bu[16];
#pragma unroll
        for (int t = 0; t < 16; ++t) bu[t] = *(const LAS f32x2_t*)(BUS + t * BSB + 8 * lane);
        unsigned xs[16];
#pragma unroll
        for (int t = 0; t < 16; ++t) {
            float nr = __builtin_fmaf(abr, xr, bu[t].x); asm volatile("" : "+v"(nr)); nr = __builtin_fmaf(-abi, xi, nr); asm volatile("" : "+v"(nr));
            float ni = __builtin_fmaf(abr, xi, bu[t].y); asm volatile("" : "+v"(ni)); ni = __builtin_fmaf(abi, xr, ni); asm volatile("" : "+v"(ni));
            xr = nr; xi = ni;
            if (PASS2) xs[t] = pk2(xr, xi);
        }
        if (PASS2) {
#pragma unroll
            for (int t = 0; t < 16; ++t) *(LAS unsigned*)(XS + t * XSB + 4 * lane) = xs[t];
        }
        asm volatile("s_waitcnt lgkmcnt(0)" ::: "memory");
        if (PASS2) {
            f32x4 y = {0.f, 0.f, 0.f, 0.f};
#pragma unroll
            for (int s4 = 0; s4 < 4; ++s4) { const bf16x8 xf = *(const LAS bf16x8*)(XS + c * XSB + 64 * s4 + 16 * q4); y = __builtin_amdgcn_mfma_f32_16x16x32_bf16(cfr[s4], xf, y, 0, 0, 0); }
            *(u32x2*)(Y + (size_t)scan_row(n0 + 16 * cc + c, dn) * D + g * 16 + 4 * q4) = (u32x2){pk2(y[0], y[1]), pk2(y[2], y[3])};
        }
    }
    if (!PASS2) { float* e = XE + ((size_t)((dn * 64 + g) * 16 + seg) * 64 + lane) * 2; e[0] = xr; e[1] = xi; }
    }
}
}

DEVI void ph_s5_elem(const P& p) {
    const int otid_ = otid();
    const int wave = __builtin_amdgcn_readfirstlane(otid_ >> 6), lane = otid_ & 63, gw = blockIdx.x * NWV + wave, NGW = gridDim.x * NWV;
    Row16 dd; load_row_f32(p.in[I_S5D], lane, dd);
    for (int r = gw; r < MA; r += 2 * NGW) {
        const int r1 = r + NGW;
        Row16 u0, a0, b0, u1, a1, b1, o;
        load_row_bf16((const bf16_t*)(p.ws + WS_XN) + (size_t)r * D, lane, u0);
        load_row_bf16((const bf16_t*)(p.ws + WS_OF) + (size_t)r * D, lane, a0); load_row_bf16((const bf16_t*)(p.ws + WS_OB) + (size_t)r * D, lane, b0);
        if (r1 < MA) { load_row_bf16((const bf16_t*)(p.ws + WS_XN) + (size_t)r1 * D, lane, u1);
            load_row_bf16((const bf16_t*)(p.ws + WS_OF) + (size_t)r1 * D, lane, a1); load_row_bf16((const bf16_t*)(p.ws + WS_OB) + (size_t)r1 * D, lane, b1); }
#pragma unroll
        for (int e = 0; e < 16; ++e) o.v[e] = geluf_(dd.v[e] * u0.v[e] + a0.v[e] + b0.v[e]);
        store_row_bf16((bf16_t*)(p.ws + WS_U) + (size_t)r * D, lane, o);
        if (r1 < MA) {
#pragma unroll
            for (int e = 0; e < 16; ++e) o.v[e] = geluf_(dd.v[e] * u1.v[e] + a1.v[e] + b1.v[e]);
            store_row_bf16((bf16_t*)(p.ws + WS_U) + (size_t)r1 * D, lane, o);
        }
    }
}
DEVI float score_key(float s, int e) { return __uint_as_float((__float_as_uint(s) & 0xffffff80u) | (unsigned)e); }
DEVI float key_score(float k) { return k; }
DEVI int key_idx(float k) { return (int)(__float_as_uint(k) & 127u); }
DEVI float h2f_lo(unsigned w) { return (float)__builtin_bit_cast(pg8::f16x2_t, w).x; }
DEVI float h2f_hi(unsigned w) { return (float)__builtin_bit_cast(pg8::f16x2_t, w).y; }
DEVI void topk_wave_item(const P& p, int layer, int r, int h, int lane) {
    const unsigned short* s = (const unsigned short*)(p.ws + WS_SCH) + (size_t)r * 2048 + h * 256;
    const unsigned w0 = *(const unsigned*)(s + 2 * lane), w1 = *(const unsigned*)(s + 128 + 2 * lane);
    const float NEG = -__builtin_inff();
    float k00 = score_key(h2f_lo(w0), 2 * lane), k01 = score_key(h2f_hi(w0), 2 * lane + 1), k10 = score_key(h2f_lo(w1), 2 * lane), k11 = score_key(h2f_hi(w1), 2 * lane + 1);
    float A[16], B[16];
#pragma unroll
    for (int i = 0; i < 16; ++i) {
        const float ma = wave_max_f(__builtin_fmaxf(k00, k01)), mb = wave_max_f(__builtin_fmaxf(k10, k11));
        A[i] = ma; B[i] = mb;
        k00 = (k00 == ma) ? NEG : k00; k01 = (k01 == ma) ? NEG : k01; k10 = (k10 == mb) ? NEG : k10; k11 = (k11 == mb) ? NEG : k11;
    }
    int ci = -1, cj = 0, base = 0;
#pragma unroll
    for (int i = 0; i < 16; ++i) { const int cnt = 16 / (i + 1); if (ci < 0 && lane < base + cnt) { ci = i; cj = lane - base; } base += cnt; }
    float av = A[0], bv = B[0];
#pragma unroll
    for (int i = 1; i < 16; ++i) { av = (ci == i) ? A[i] : av; bv = (cj == i) ? B[i] : bv; }
    const int payload = key_idx(av) * 128 + key_idx(bv);
    const float sum = key_score(av) + key_score(bv);
    float ck = (ci >= 0) ? __uint_as_float((__float_as_uint(sum) & 0xffffffc0u) | (unsigned)lane) : NEG;
    float mys = 0.f, best = 0.f; int myidx = 0;
#pragma unroll
    for (int j = 0; j < 16; ++j) {
        const float mm = wave_max_f(ck);
        const int src = __builtin_amdgcn_readfirstlane((int)(__float_as_uint(mm) & 63u));
        const int pl = __builtin_amdgcn_readlane(payload, src);
        if (lane == j) { mys = mm; myidx = pl; }
        if (j == 0) best = mm;
        ck = (lane == src) ? NEG : ck;
    }
    const float e = lane < 16 ? __expf(mys - best) : 0.f;
    const float tot = wave_sum(e);
    if (lane < 16) {
        const f32x2_t sc2 = ((const f32x2_t*)(p.ws + WS_SCL) + (size_t)layer * 16384)[myidx];
        const size_t o = (size_t)r * 128 + h * 16 + lane;
        ((int*)(p.ws + WS_SELI))[o] = myidx; ((float*)(p.ws + WS_SELG))[o] = e / tot * sc2.y; ((float*)(p.ws + WS_SELU))[o] = sc2.x;
    }
}
constexpr int TK_ITEM_B = 144;
DEVI void ph_topk(const P& p, int layer, int r0, unsigned char* lds_) {
    const int otid_ = otid();
    const int wave = otid_ >> 6, lane = otid_ & 63;
    const int nall = (MA - r0) * 8, nthr = (int)gridDim.x * NTHR;
    const int nleft = nall % nthr;
    const int nitems = (nleft > 0 && nleft <= nthr / 8) ? nall - nleft : nall;
    for (int e = blockIdx.x * NWV + wave + nitems; e < nall; e += (int)gridDim.x * NWV) topk_wave_item(p, layer, r0 + (e >> 3), e & 7, lane);
    const unsigned char* SCb = (const unsigned char*)(p.ws + WS_SCH);
    LAS unsigned char* tile = (LAS unsigned char*)lds_ + wave * (64 * TK_ITEM_B);
    for (int it = blockIdx.x * NTHR + otid_; it < nitems; it += gridDim.x * NTHR) {
        const int r = r0 + (it >> 3), h = it & 7;
        const unsigned char* wbase = SCb + ((size_t)(r0 + ((it - lane) >> 3)) * 2048) * 2;
        const unsigned goff = (unsigned)(lane >> 3) * 512u + 16u * (unsigned)(lane & 7);
        u32x4 g[8];
#pragma unroll
        for (int j = 0; j < 8; ++j) g[j] = *(const u32x4*)(wbase + goff + 4096 * j);
        float L0[16], L1[16];
#pragma unroll 1
        for (int k = 0; k < 4; ++k) {
#pragma unroll
            for (int j = 0; j < 8; ++j) *(LAS u32x4*)(tile + (8 * j + (lane >> 3)) * TK_ITEM_B + 16 * (lane & 7)) = g[j];
            if (k < 3) {
#pragma unroll
                for (int j = 0; j < 8; ++j) g[j] = *(const u32x4*)(wbase + goff + 4096 * j + 128 * (k + 1));
            }
            u32x4 m[8];
#pragma unroll
            for (int i = 0; i < 8; ++i) m[i] = *(const LAS u32x4*)(tile + lane * TK_ITEM_B + 16 * i);
            float L[16];
            if (k & 1) {
#pragma unroll
                for (int j = 0; j < 16; ++j) L[j] = (k == 1) ? L0[j] : L1[j];
            } else {
#pragma unroll
                for (int j = 0; j < 16; ++j) L[j] = -__builtin_inff();
            }
            const int ebase = 64 * (k & 1);
#pragma unroll
            for (int gq = 0; gq < 4; ++gq) {
                float G[16];
#pragma unroll
                for (int e = 0; e < 16; ++e) { const unsigned wd = m[2 * gq + (e >> 3)][(e & 7) >> 1]; G[e] = score_key((e & 1) ? h2f_hi(wd) : h2f_lo(wd), ebase + 16 * gq + e); }
#define CE(a, b) { const float hi_ = __builtin_fmaxf(G[a], G[b]), lo_ = __builtin_fminf(G[a], G[b]); G[a] = hi_; G[b] = lo_; }
                CE(0,1) CE(2,3) CE(0,2) CE(1,3) CE(1,2) CE(4,5) CE(6,7) CE(4,6) CE(5,7) CE(5,6) CE(0,4) CE(2,6) CE(2,4) CE(1,5) CE(3,7) CE(3,5) CE(1,2) CE(3,4) CE(5,6) CE(8,9) CE(10,11) CE(8,10) CE(9,11) CE(9,10) CE(12,13) CE(14,15) CE(12,14) CE(13,15) CE(13,14) CE(8,12) CE(10,14) CE(10,12) CE(9,13) CE(11,15) CE(11,13) CE(9,10) CE(11,12) CE(13,14) CE(0,8) CE(4,12) CE(4,8) CE(2,10) CE(6,14) CE(6,10) CE(2,4) CE(6,8) CE(10,12) CE(1,9) CE(5,13) CE(5,9) CE(3,11) CE(7,15) CE(7,11) CE(3,5) CE(7,9) CE(11,13) CE(1,2) CE(3,4) CE(5,6) CE(7,8) CE(9,10) CE(11,12) CE(13,14)
#undef CE
#pragma unroll
                for (int i = 0; i < 16; ++i) L[i] = __builtin_fmaxf(L[i], G[15 - i]);
#pragma unroll
                for (int jj = 8; jj > 0; jj >>= 1)
#pragma unroll
                    for (int i = 0; i < 16; ++i) { const int l = i ^ jj; if (l > i) { const float hi = __builtin_fmaxf(L[i], L[l]), lo = __builtin_fminf(L[i], L[l]); L[i] = hi; L[l] = lo; } }
            }
            if (k < 2) {
#pragma unroll
                for (int j = 0; j < 16; ++j) L0[j] = L[j];
            } else {
#pragma unroll
                for (int j = 0; j < 16; ++j) L1[j] = L[j];
            }
        }
        const float amx = __builtin_fmaxf(__builtin_fmaxf(__builtin_fabsf(L0[0]), __builtin_fabsf(L0[15])), __builtin_fmaxf(__builtin_fabsf(L1[0]), __builtin_fabsf(L1[15])));
        const float ksc = 65000.0f / __builtin_fmaxf(amx, 1e-30f), kinv = 1.0f / (ksc * 16384.0f);
        int KA[16], KB[16];
#pragma unroll
        for (int j = 0; j < 16; ++j) { KA[j] = ((int)__builtin_rintf(L0[j] * ksc) << 14) | (key_idx(L0[j]) << 7); KB[j] = ((int)__builtin_rintf(L1[j] * ksc) << 14) | key_idx(L1[j]); }
        int fk[16];
#pragma unroll
        for (int j = 0; j < 16; ++j) fk[j] = KA[0] + KB[j];
#pragma unroll
        for (int i = 1; i < 16; ++i)
#pragma unroll
            for (int j = 0; j < 16; ++j)
                if ((i + 1) * (j + 1) <= 16) {
                    int xk = KA[i] + KB[j];
#pragma unroll
                    for (int q = 0; q < 16; ++q) if (q >= (i + 1) * (j + 1) - 1) { const int hi = xk > fk[q] ? xk : fk[q], lo = xk > fk[q] ? fk[q] : xk; fk[q] = hi; xk = lo; }
                }
        float fs[16]; int fi[16];
#pragma unroll
        for (int j = 0; j < 16; ++j) { fs[j] = (float)fk[j] * kinv; fi[j] = fk[j] & 16383; }
        float sum = 0.f, e[16];
#pragma unroll
        for (int j = 0; j < 16; ++j) { e[j] = __expf(fs[j] - fs[0]); sum += e[j]; }
        const float inv = 1.0f / sum;
        const f32x2_t* SC2 = (const f32x2_t*)(p.ws + WS_SCL) + (size_t)layer * 16384;
        float su[16];
#pragma unroll
        for (int j = 0; j < 16; ++j) { const f32x2_t sc2 = SC2[fi[j]]; su[j] = sc2.x; e[j] = e[j] * inv * sc2.y; }
        i32x4* oi = (i32x4*)((int*)(p.ws + WS_SELI) + (size_t)r * 128 + h * 16); f32x4* og = (f32x4*)((float*)(p.ws + WS_SELG) + (size_t)r * 128 + h * 16); f32x4* ou = (f32x4*)((float*)(p.ws + WS_SELU) + (size_t)r * 128 + h * 16);
#pragma unroll
        for (int j = 0; j < 4; ++j) { oi[j] = (i32x4){fi[4 * j], fi[4 * j + 1], fi[4 * j + 2], fi[4 * j + 3]}; og[j] = (f32x4){e[4 * j], e[4 * j + 1], e[4 * j + 2], e[4 * j + 3]}; ou[j] = (f32x4){su[4 * j], su[4 * j + 1], su[4 * j + 2], su[4 * j + 3]}; }
    }
}

DEVI void fmac_vv(float& acc, float a, float b) { asm("v_fmac_f32 %0, %1, %2" : "+v"(acc) : "v"(a), "v"(b)); }

DEVI void pkfma(f32x2_t& acc, f32x2_t a, f32x2_t b) { asm("v_pk_fma_f32 %0, %1, %2, %0" : "+v"(acc) : "v"(a), "v"(b)); }
DEVI float dot16_i8(const u32x4 q, const u32x4 h) {
    int a = __builtin_amdgcn_sdot4((int)q[0], (int)h[0], 0, false); a = __builtin_amdgcn_sdot4((int)q[1], (int)h[1], a, false);
    a = __builtin_amdgcn_sdot4((int)q[2], (int)h[2], a, false); a = __builtin_amdgcn_sdot4((int)q[3], (int)h[3], a, false);
    return (float)a;
}
template <int HI, bool FIRST> DEVI void pkfma_bc(f32x2_t& acc, f32x2_t wp, f32x2_t b) {
    if (FIRST) {
        if (HI) asm volatile("v_pk_mul_f32 %0, %1, %2 op_sel:[1,0] op_sel_hi:[1,1]" : "=&v"(acc) : "v"(wp), "v"(b));
        else    asm volatile("v_pk_mul_f32 %0, %1, %2 op_sel:[0,0] op_sel_hi:[0,1]" : "=&v"(acc) : "v"(wp), "v"(b));
    } else {
        if (HI) asm volatile("v_pk_fma_f32 %0, %1, %2, %0 op_sel:[1,0,0] op_sel_hi:[1,1,1]" : "+v"(acc) : "v"(wp), "v"(b));
        else    asm volatile("v_pk_fma_f32 %0, %1, %2, %0 op_sel:[0,0,0] op_sel_hi:[0,1,1]" : "+v"(acc) : "v"(wp), "v"(b));
    }
}
template <int HI, bool FIRST> DEVI void axpy16_fp8(const u32x4 q, f32x2_t wp, f32x2_t (&acc)[8]) {
#pragma unroll
    for (int j = 0; j < 4; ++j) { const f32x2_t lo = __builtin_amdgcn_cvt_pk_f32_fp8(q[j], false), hi = __builtin_amdgcn_cvt_pk_f32_fp8(q[j], true); pkfma_bc<HI, FIRST>(acc[2 * j], wp, lo); pkfma_bc<HI, FIRST>(acc[2 * j + 1], wp, hi); }
}
template <int K, bool FIRST> DEVI void axpy_row(const u32x4 q, const f32x4 w4, f32x2_t (&acc)[8]) {
    const f32x2_t wp = (K & 2) ? __builtin_shufflevector(w4, w4, 2, 3) : __builtin_shufflevector(w4, w4, 0, 1);
    axpy16_fp8<K & 1, FIRST>(q, wp, acc);
}
DEVI void swap32f(float& a, float& b) { const auto r = __builtin_amdgcn_permlane32_swap(__float_as_uint(a), __float_as_uint(b), false, false); a = __uint_as_float(r[0]); b = __uint_as_float(r[1]); }
DEVI void swap16f(float& a, float& b) { const auto r = __builtin_amdgcn_permlane16_swap(__float_as_uint(a), __float_as_uint(b), false, false); a = __uint_as_float(r[0]); b = __uint_as_float(r[1]); }
struct SliceGeo { int x, rank, n; };
struct Seg8 { u32x4 q[8]; };
struct Idx16 { i32x4 v[4]; };
DEVI void idx16_load(Idx16& I, const int* SI, int t, int r8) { const i32x4* s = (const i32x4*)(SI + (size_t)t * 128 + r8 * 16); I.v[0] = s[0]; I.v[1] = s[1]; I.v[2] = s[2]; I.v[3] = s[3]; }
DEVI void seg8_load(Seg8& s, const __amdgpu_buffer_rsrc_t tab, const Idx16& I, int half, unsigned coff) {
#pragma unroll
    for (int k = 0; k < 8; ++k) { const int row = I.v[2 * half + (k >> 2)][k & 3]; s.q[k] = __builtin_amdgcn_raw_buffer_load_b128(tab, (unsigned)row * 128u + coff, 0, 0); }
}
DEVI float reduce8_c8(const float (&d)[8], int lane) {
    const bool b2 = lane & 4, b1 = lane & 2, b0 = lane & 1;
    float r4[4], r2[2];
#pragma unroll
    for (int i = 0; i < 4; ++i) { const float keep = b2 ? d[i + 4] : d[i], send = b2 ? d[i] : d[i + 4]; r4[i] = keep + __shfl_xor(send, 4); }
#pragma unroll
    for (int i = 0; i < 2; ++i) { const float keep = b1 ? r4[i + 2] : r4[i], send = b1 ? r4[i] : r4[i + 2]; r2[i] = keep + __shfl_xor(send, 2); }
    const float keep = b0 ? r2[1] : r2[0], send = b0 ? r2[0] : r2[1];
    return keep + __shfl_xor(send, 1);
}
struct Seg16 { u32x4 q[16]; };
template <int M> DEVI void peer_u_mm(const __amdgpu_buffer_rsrc_t PU, Seg16& Q, const Idx16& In, const i32x4 (&hc)[2], unsigned coff, i32x4 (&acc)[8]) {
    asm volatile("" : "+v"(Q.q[M]));
    if (M & 1) acc[M >> 1] = __builtin_amdgcn_mfma_i32_16x16x64_i8(hc[1], (i32x4)Q.q[M], acc[M >> 1], 0, 0, 0);
    else       acc[M >> 1] = __builtin_amdgcn_mfma_i32_16x16x64_i8(hc[0], (i32x4)Q.q[M], (i32x4){0, 0, 0, 0}, 0, 0, 0);
    Q.q[M] = __builtin_amdgcn_raw_buffer_load_b128(PU, (unsigned)In.v[M >> 2][M & 3] * 128u + coff, 0, 0);
    asm volatile("" ::: "memory");
}
DEVI int qp_xor2(int v) { return __builtin_amdgcn_update_dpp(0, v, 0x4E, 0xf, 0xf, true); }
DEVI int qp_xor1(int v) { return __builtin_amdgcn_update_dpp(0, v, 0xB1, 0xf, 0xf, true); }
typedef unsigned u32x2 __attribute__((ext_vector_type(2)));
DEVI u32x2 slot_raw_load(const void* base, int t, int lane) { return *(const u32x2*)((const unsigned*)base + (size_t)t * 128 + 2 * lane); }
DEVI void slot_redist(LAS unsigned char* wl, const u32x2 raw, int lane, int l8, Idx16& I) {
    *(LAS u32x2*)(wl + 8 * lane) = raw;
    const LAS i32x4* s = (const LAS i32x4*)(wl + 64 * l8);
    I.v[0] = s[0]; I.v[1] = s[1]; I.v[2] = s[2]; I.v[3] = s[3];
}
DEVI void peer_u_token(const __amdgpu_buffer_rsrc_t PU, const int* SI, const unsigned char* H8, const float* HS, unsigned* PREP, LAS unsigned char* wl, int t, int t1, int t3, int x, int lane, int l8,
                       unsigned coff, bool act0, bool act1, const Idx16& In, Idx16& Inn, const u32x2 rawUse, u32x2& rawLoad, const i32x4 hraw, i32x4& hrawN, Seg16& Q) {
    rawLoad = slot_raw_load(SI, t3, lane);
    hrawN = *(const i32x4*)(H8 + (size_t)t1 * D);
    asm volatile("" ::: "memory");
    i32x4 hc[2];
#pragma unroll
    for (int e = 0; e < 4; ++e) { hc[0][e] = act0 ? hraw[e] : 0; hc[1][e] = act1 ? hraw[e] : 0; }
    i32x4 acc[8];
    peer_u_mm<0>(PU, Q, In, hc, coff, acc); peer_u_mm<1>(PU, Q, In, hc, coff, acc); peer_u_mm<2>(PU, Q, In, hc, coff, acc); peer_u_mm<3>(PU, Q, In, hc, coff, acc);
    peer_u_mm<4>(PU, Q, In, hc, coff, acc); peer_u_mm<5>(PU, Q, In, hc, coff, acc); peer_u_mm<6>(PU, Q, In, hc, coff, acc); peer_u_mm<7>(PU, Q, In, hc, coff, acc);
    peer_u_mm<8>(PU, Q, In, hc, coff, acc); peer_u_mm<9>(PU, Q, In, hc, coff, acc); peer_u_mm<10>(PU, Q, In, hc, coff, acc); peer_u_mm<11>(PU, Q, In, hc, coff, acc);
    peer_u_mm<12>(PU, Q, In, hc, coff, acc); peer_u_mm<13>(PU, Q, In, hc, coff, acc); peer_u_mm<14>(PU, Q, In, hc, coff, acc); peer_u_mm<15>(PU, Q, In, hc, coff, acc);
    slot_redist(wl, rawUse, lane, l8, Inn);
    const bool c1 = lane & 1, c2 = lane & 2;
    int w[8], r4[4], f[2];
#pragma unroll
    for (int a = 0; a < 8; ++a) { const int lo = c1 ? acc[a][1] : acc[a][0], hi = c1 ? acc[a][3] : acc[a][2]; w[a] = c2 ? hi : lo; }
#pragma unroll
    for (int i = 0; i < 4; ++i) { const int keep = c2 ? w[4 + i] : w[i], send = c2 ? w[i] : w[4 + i]; r4[i] = keep + qp_xor2(send); }
#pragma unroll
    for (int i = 0; i < 2; ++i) { const int keep = c1 ? r4[2 + i] : r4[i], send = c1 ? r4[i] : r4[2 + i]; f[i] = keep + qp_xor1(send); }
    PREP[((size_t)t * 8 + x) * 64 + lane] = pk2((float)f[0], (float)f[1]);
}
DEVI void ph_peer_u(const P& p, int layer, int r0, const SliceGeo sg, unsigned char* lds) {
    const int otid_ = otid();
    const int wave = otid_ >> 6, lane = otid_ & 63, q = lane >> 4, j = lane & 15;
    const int x = __builtin_amdgcn_readfirstlane(sg.x), nws = __builtin_amdgcn_readfirstlane(sg.n * NWV);
    const __amdgpu_buffer_rsrc_t PU = __builtin_amdgcn_make_buffer_rsrc((void*)(p.ws + WS_PU + (size_t)layer * 16384 * 1024 + (size_t)x * 16384 * 128), (short)0, 16384 * 128, 0x00020000);
    const int* SI = (const int*)(p.ws + WS_SELI); const float* HS = (const float*)(p.ws + WS_HS);
    unsigned* PREP = (unsigned*)(p.ws + WS_SC);
    LAS unsigned char* wl = (LAS unsigned char*)lds + 1024 * wave;
    const int l8 = (q >> 1) * 4 + (j >> 2);
    const unsigned coff = 64u * (q & 1) + 16u * (j & 3);
    const unsigned char* H8 = p.ws + WS_H8 + 128 * x + coff;
    const bool act = (q >> 1) == ((j >> 2) & 1), act0 = act && (j >> 3) == 0, act1 = act && (j >> 3) == 1;
    int t = __builtin_amdgcn_readfirstlane(r0 + sg.rank * NWV + wave);
    if (t >= MA) return;
    Idx16 I0, I1; idx16_load(I0, SI, t, l8);
    asm volatile("" ::: "memory");
    u32x2 R0, R1; i32x4 H0, H1;
    { const int t1 = t + nws < MA ? t + nws : t, t2 = t + 2 * nws < MA ? t + 2 * nws : t1; idx16_load(I1, SI, t1, l8); R0 = slot_raw_load(SI, t2, lane); }
    H0 = *(const i32x4*)(H8 + (size_t)t * D);
    asm volatile("" ::: "memory");
    Seg16 Q;
#pragma unroll
    for (int k = 0; k < 16; ++k) { Q.q[k] = __builtin_amdgcn_raw_buffer_load_b128(PU, (unsigned)I0.v[k >> 2][k & 3] * 128u + coff, 0, 0); asm volatile("" ::: "memory"); }
    while (t < MA) {
        const int t1 = t + nws < MA ? t + nws : t, t2 = t + 2 * nws < MA ? t + 2 * nws : t1, t3 = t + 3 * nws < MA ? t + 3 * nws : t2, t4 = t + 4 * nws < MA ? t + 4 * nws : t3;
        peer_u_token(PU, SI, H8, HS, PREP, wl, t, t1, t3, x, lane, l8, coff, act0, act1, I1, I0, R0, R1, H0, H1, Q);
        peer_u_token(PU, SI, H8, HS, PREP, wl, t1, t2, t4, x, lane, l8, coff, act0, act1, I0, I1, R1, R0, H1, H0, Q);
        t += 2 * nws;
    }
}
struct PwLoad { unsigned pw[8]; float su0, su1, sg0, sg1, hs; };
DEVI void peer_w_load(PwLoad& L, const P& p, int t, int lane, int sa, int sb) {
    const unsigned* pp = (const unsigned*)(p.ws + WS_SC) + (size_t)t * 512 + lane;
    const float* SG = (const float*)(p.ws + WS_SELG) + (size_t)t * 128; const float* SU = (const float*)(p.ws + WS_SELU) + (size_t)t * 128;
#pragma unroll
    for (int xx = 0; xx < 8; ++xx) L.pw[xx] = pp[xx * 64];
    L.su0 = SU[sa]; L.su1 = SU[sb]; L.sg0 = SG[sa]; L.sg1 = SG[sb]; L.hs = ((const float*)(p.ws + WS_HS))[t];
}
DEVI void peer_w_finish(const PwLoad& L, const P& p, int t, int lane, int sa, int sb) {
    float p0 = 0.f, p1 = 0.f;
#pragma unroll
    for (int xx = 0; xx < 8; ++xx) { p0 += bflo(L.pw[xx]); p1 += bfhi(L.pw[xx]); }
    const float w0 = geluf_(p0 * (L.hs * L.su0)) * L.sg0, w1 = geluf_(p1 * (L.hs * L.su1)) * L.sg1;
    const float amax = wave_max_f(fmaxf(fabsf(w0), fabsf(w1)));
    const float sc = amax > 0.f ? 224.0f / amax : 1.0f;
    const float a0 = w0 * sc, a1 = w1 * sc;
    const unsigned hi = __builtin_amdgcn_cvt_pk_fp8_f32(a0, a1, 0u, false);
    const float h0 = __builtin_amdgcn_cvt_f32_fp8(hi, 0), h1 = __builtin_amdgcn_cvt_f32_fp8(hi, 1);
    const unsigned lo = __builtin_amdgcn_cvt_pk_fp8_f32(a0 - h0, a1 - h1, 0u, false);
    unsigned char* wt = p.ws + WS_SELU + (size_t)t * 512;
    wt[sa] = (unsigned char)(hi & 0xffu); wt[sb] = (unsigned char)((hi >> 8) & 0xffu); wt[128 + sa] = (unsigned char)(lo & 0xffu); wt[128 + sb] = (unsigned char)((lo >> 8) & 0xffu);
    if (lane == 0) *(float*)(wt + 256) = 1.0f / sc;
}
DEVI void ph_peer_w(const P& p, int r0) {
    const int otid_ = otid();
    const int wave = otid_ >> 6, lane = otid_ & 63, gw = blockIdx.x * NWV + wave, NGW = gridDim.x * NWV;
    const int sa = (4 * ((lane >> 4) & 1) + ((lane >> 2) & 3)) * 16 + 4 * (lane & 3) + (lane >> 5), sb = sa + 2;
    for (int t = r0 + gw; t < MA; t += 2 * NGW) {
        const int t1 = t + NGW;
        PwLoad A, B;
        peer_w_load(A, p, t, lane, sa, sb);
        if (t1 < MA) peer_w_load(B, p, t1, lane, sa, sb);
        asm volatile("" ::: "memory");
        peer_w_finish(A, p, t, lane, sa, sb);
        if (t1 < MA) peer_w_finish(B, p, t1, lane, sa, sb);
    }
}
template <int M> DEVI void peer_v_mm(const __amdgpu_buffer_rsrc_t PV, Seg16& Q, const i32x4 WH, const i32x4 WL, const Idx16& In, unsigned coff, const unsigned (&sel0)[4], const unsigned (&sel1)[4], f32x4 (&acc)[4]) {
    asm volatile("" : "+v"(Q.q[M]));
    const unsigned sh = (unsigned)WH[M >> 2], sl = (unsigned)WL[M >> 2];
    const unsigned h0 = __builtin_amdgcn_perm(sh, sh, sel0[M & 3]), h1 = __builtin_amdgcn_perm(sh, sh, sel1[M & 3]);
    const unsigned l0 = __builtin_amdgcn_perm(sl, sl, sel0[M & 3]), l1 = __builtin_amdgcn_perm(sl, sl, sel1[M & 3]);
    const long AH = (long)(((unsigned long)h1 << 32) | (unsigned long)h0), AL = (long)(((unsigned long)l1 << 32) | (unsigned long)l0);
    const long B0 = (long)(((unsigned long)Q.q[M][1] << 32) | (unsigned long)Q.q[M][0]), B1 = (long)(((unsigned long)Q.q[M][3] << 32) | (unsigned long)Q.q[M][2]);
    acc[0] = __builtin_amdgcn_mfma_f32_16x16x32_fp8_fp8(AH, B0, acc[0], 0, 0, 0); acc[1] = __builtin_amdgcn_mfma_f32_16x16x32_fp8_fp8(AH, B1, acc[1], 0, 0, 0);
    acc[2] = __builtin_amdgcn_mfma_f32_16x16x32_fp8_fp8(AL, B0, acc[2], 0, 0, 0); acc[3] = __builtin_amdgcn_mfma_f32_16x16x32_fp8_fp8(AL, B1, acc[3], 0, 0, 0);
    Q.q[M] = __builtin_amdgcn_raw_buffer_load_b128(PV, (unsigned)In.v[M >> 2][M & 3] * 128u + coff, 0, 0);
    asm volatile("" ::: "memory");
}
DEVI void ph_peer_v(const P& p, int layer, int r0, const SliceGeo sg, unsigned char* lds) {
    const int otid_ = otid();
    const int wave = otid_ >> 6, lane = otid_ & 63, q = lane >> 4, j = lane & 15;
    const int x = __builtin_amdgcn_readfirstlane(sg.x), nws = __builtin_amdgcn_readfirstlane(sg.n * NWV);
    const __amdgpu_buffer_rsrc_t PV = __builtin_amdgcn_make_buffer_rsrc((void*)(p.ws + WS_PV + (size_t)layer * 16384 * 1024 + (size_t)x * 16384 * 128), (short)0, 16384 * 128, 0x00020000);
    const int* SI = (const int*)(p.ws + WS_SELI); const unsigned char* W8 = p.ws + WS_SELU;
    bf16_t* OUTP = (bf16_t*)(p.ws + WS_SC + (size_t)MA * 4096);
    LAS unsigned char* wl = (LAS unsigned char*)lds + 1024 * wave;
    const int l8 = 2 * q + (j >> 3);
    const unsigned coff = 16u * (j & 7);
    unsigned sel0[4], sel1[4];
#pragma unroll
    for (int k = 0; k < 4; ++k) { const unsigned pl = 0x0c0c0c0cu ^ ((0x0cu ^ (unsigned)k) << (8 * (j & 3))); sel0[k] = (j & 4) ? 0x0c0c0c0cu : pl; sel1[k] = (j & 4) ? pl : 0x0c0c0c0cu; }
    const int bp = 4 * ((lane + 40) & 63);
    int t = __builtin_amdgcn_readfirstlane(r0 + sg.rank * NWV + wave);
    if (t >= MA) return;
    Idx16 In; i32x4 WH, WL; Seg16 Q; u32x2 rawI, rawW; float sinv;
    {
        const int t1 = t + nws < MA ? t + nws : t, t2 = t + 2 * nws < MA ? t + 2 * nws : t1;
        const u32x2 ri0 = slot_raw_load(SI, t, lane), ri1 = slot_raw_load(SI, t1, lane), rw0 = slot_raw_load(W8, t, lane);
        asm volatile("" ::: "memory");
        rawI = slot_raw_load(SI, t2, lane); rawW = slot_raw_load(W8, t1, lane);
        asm volatile("" ::: "memory");
        slot_redist(wl, ri0, lane, l8, In);
#pragma unroll
        for (int m = 0; m < 16; ++m) { Q.q[m] = __builtin_amdgcn_raw_buffer_load_b128(PV, (unsigned)In.v[m >> 2][m & 3] * 128u + coff, 0, 0); asm volatile("" ::: "memory"); }
        slot_redist(wl, ri1, lane, l8, In);
        *(LAS u32x2*)(wl + 512 + 8 * lane) = rw0;
        WH = *(const LAS i32x4*)(wl + 512 + 16 * l8); WL = *(const LAS i32x4*)(wl + 640 + 16 * l8); sinv = *(const LAS float*)(wl + 768);
    }
    while (t < MA) {
        const int t1 = t + nws < MA ? t + nws : t, t2 = t + 2 * nws < MA ? t + 2 * nws : t1, t3 = t + 3 * nws < MA ? t + 3 * nws : t2;
        const u32x2 rawIn = slot_raw_load(SI, t3, lane), rawWn = slot_raw_load(W8, t2, lane);
        asm volatile("" ::: "memory");
        f32x4 acc[4] = {(f32x4){0.f, 0.f, 0.f, 0.f}, (f32x4){0.f, 0.f, 0.f, 0.f}, (f32x4){0.f, 0.f, 0.f, 0.f}, (f32x4){0.f, 0.f, 0.f, 0.f}};
        peer_v_mm<0>(PV, Q, WH, WL, In, coff, sel0, sel1, acc); peer_v_mm<1>(PV, Q, WH, WL, In, coff, sel0, sel1, acc); peer_v_mm<2>(PV, Q, WH, WL, In, coff, sel0, sel1, acc); peer_v_mm<3>(PV, Q, WH, WL, In, coff, sel0, sel1, acc);
        peer_v_mm<4>(PV, Q, WH, WL, In, coff, sel0, sel1, acc); peer_v_mm<5>(PV, Q, WH, WL, In, coff, sel0, sel1, acc); peer_v_mm<6>(PV, Q, WH, WL, In, coff, sel0, sel1, acc); peer_v_mm<7>(PV, Q, WH, WL, In, coff, sel0, sel1, acc);
        peer_v_mm<8>(PV, Q, WH, WL, In, coff, sel0, sel1, acc); peer_v_mm<9>(PV, Q, WH, WL, In, coff, sel0, sel1, acc); peer_v_mm<10>(PV, Q, WH, WL, In, coff, sel0, sel1, acc); peer_v_mm<11>(PV, Q, WH, WL, In, coff, sel0, sel1, acc);
        peer_v_mm<12>(PV, Q, WH, WL, In, coff, sel0, sel1, acc); peer_v_mm<13>(PV, Q, WH, WL, In, coff, sel0, sel1, acc); peer_v_mm<14>(PV, Q, WH, WL, In, coff, sel0, sel1, acc); peer_v_mm<15>(PV, Q, WH, WL, In, coff, sel0, sel1, acc);
        const float sv = sinv;
        slot_redist(wl, rawI, lane, l8, In);
        *(LAS u32x2*)(wl + 512 + 8 * lane) = rawW;
        WH = *(const LAS i32x4*)(wl + 512 + 16 * l8); WL = *(const LAS i32x4*)(wl + 640 + 16 * l8); sinv = *(const LAS float*)(wl + 768);
        float A[4], Bv[4];
#pragma unroll
        for (int r = 0; r < 4; ++r) {
            const float a = acc[0][r] + acc[2][r], b = acc[1][r] + acc[3][r];
            A[r] = (a + __int_as_float(__builtin_amdgcn_ds_bpermute(bp, __float_as_int(a)))) * sv;
            Bv[r] = (b + __int_as_float(__builtin_amdgcn_ds_bpermute(bp, __float_as_int(b)))) * sv;
        }
#pragma unroll
        for (int r = 0; r < 4; ++r) swap16f(A[r], Bv[r]);
        if (j < 8 && q < 2) { u32x4 pk; pk[0] = pk2(A[0], A[1]); pk[1] = pk2(A[2], A[3]); pk[2] = pk2(Bv[0], Bv[1]); pk[3] = pk2(Bv[2], Bv[3]);
            *(u32x4*)(OUTP + (size_t)t * D + 128 * x + 16 * j + 8 * q) = pk; }
        rawI = rawIn; rawW = rawWn; t += nws;
    }
}
struct FinPar { Row16 g2; NormAB n; };
DEVI void finpar_load(FinPar& f, const P& p, int layer, int cls, int next_mode, int lane) {
    load_row_f32(mod_ptr(p, layer, cls, 5), lane, f.g2);
    const int ln = next_mode == 0 ? layer + 1 : layer; const float m = next_mode == 0 ? 1.0f : 0.0f;
    Row16 gg, sc, sh; load_row_f32(next_mode == 0 ? p.in[I_N1G] + ln * D : p.in[I_FG], lane, gg); load_row_f32(mod_ptr(p, ln, cls, 1), lane, sc); load_row_f32(mod_ptr(p, ln, cls, 0), lane, sh);
#pragma unroll
    for (int j = 0; j < 16; ++j) { f.n.A.v[j] = gg.v[j] * (1.0f + m * sc.v[j]); f.n.B.v[j] = m * sh.v[j]; }
}
DEVI void fin_row(const P& p, int r, int lane, int next_mode, Row16& x, const Row16& a, const FinPar& f) {
#pragma unroll
    for (int j = 0; j < 16; ++j) x.v[j] += f.g2.v[j] * a.v[j];
    if (next_mode == 0) {
        store_row_f32((float*)(p.ws + WS_X) + (size_t)r * D, lane, x);
        Row16 o; norm_ab(x, f.n, o);
        store_row_bf16((bf16_t*)(p.ws + WS_XN) + (size_t)r * D, lane, o);
    } else if (r >= TC) {
        Row16 o; norm_ab(x, f.n, o);
        store_row_f32(p.out + (size_t)(r - TC) * D, lane, o);
    }
}
DEVI void ph_peer_fin(const P& p, int layer, int r0, int next_mode) {
    const int otid_ = otid();
    const int wave = __builtin_amdgcn_readfirstlane(otid_ >> 6), lane = otid_ & 63, gw = blockIdx.x * NWV + wave, NGW = gridDim.x * NWV;
    const bf16_t* OUTP = (const bf16_t*)(p.ws + WS_SC + (size_t)MA * 4096);
    FinPar fl; finpar_load(fl, p, layer, 0, next_mode, lane);
    for (int r = r0 + gw; r < MA; r += 2 * NGW) {
        const int r1 = r + NGW;
        Row16 x0, a0, x1, a1;
        load_row_f32((const float*)(p.ws + WS_X) + (size_t)r * D, lane, x0); load_row_bf16(OUTP + (size_t)r * D, lane, a0);
        if (r1 < MA) { load_row_f32((const float*)(p.ws + WS_X) + (size_t)r1 * D, lane, x1); load_row_bf16(OUTP + (size_t)r1 * D, lane, a1); }
        FinPar f0 = fl;
        if (r < TC) finpar_load(f0, p, layer, 1, next_mode, lane);
        fin_row(p, r, lane, next_mode, x0, a0, f0);
        if (r1 < MA) fin_row(p, r1, lane, next_mode, x1, a1, fl);
    }
}

#define XB_TMO      128
#define XB_XCNT(j)  (256  + 64 * (j))
#define XB_XSUB(j)  (1280 + 64 * (j))
#define XB_XGEN(j)  (2304 + 64 * (j))
#define XB_TOP      3328
#define XB_TOPGEN   3392
#define XCD_BAR_WORDS 3456
#define XB_SPIN_CAP (1u << 20)
DEVI unsigned xb_ld(unsigned* p)              { return __hip_atomic_load(p, __ATOMIC_RELAXED, __HIP_MEMORY_SCOPE_AGENT); }
DEVI unsigned xb_add(unsigned* p, unsigned v) { return __hip_atomic_fetch_add(p, v, __ATOMIC_RELAXED, __HIP_MEMORY_SCOPE_AGENT); }
DEVI unsigned xb_xcc_id() { return (unsigned)__builtin_amdgcn_s_getreg((3 << 11) | 20) & 0xFu; }
#define XB_SPIN(cond, bar) do { unsigned _sp = 0; while (cond) { __builtin_amdgcn_s_sleep(1); \
    if ((++_sp & 255u) == 0u) { if (xb_ld(&(bar)[XB_TMO])) break; if (_sp > XB_SPIN_CAP) { atomicAdd(&(bar)[XB_TMO], 1u); break; } } } } while (0)
struct XcdBarrier { unsigned* bar; unsigned x; volatile LAS unsigned* st; };
DEVI XcdBarrier xcd_barrier_post(unsigned* bar, volatile LAS unsigned* st) {
    XcdBarrier b; b.bar = bar; b.x = xb_xcc_id(); b.st = st;
    if (threadIdx.x == 0) st[2] = xb_add(&bar[XB_XCNT(b.x)], 1u);
    return b;
}
DEVI void xcd_barrier_complete(unsigned* bar, unsigned x, unsigned& nloc, unsigned& nx) {
    const unsigned G = gridDim.x * gridDim.y * gridDim.z;
    unsigned sum, cnt, mine, sp = 0u;
    for (;;) {
        sum = 0u; cnt = 0u; mine = 0u;
#pragma unroll
        for (unsigned j = 0; j < 16; ++j) { const unsigned c = xb_ld(&bar[XB_XCNT(j)]); sum += c; cnt += (c > 0u) ? 1u : 0u; mine = (j == x) ? c : mine; }
        if (sum == G) break;
        __builtin_amdgcn_s_sleep(1);
        if ((++sp & 255u) == 0u) { if (xb_ld(&bar[XB_TMO])) break; if (sp > XB_SPIN_CAP) { atomicAdd(&bar[XB_TMO], 1u); break; } }
    }
    nloc = mine > 0u ? mine : 1u; nx = cnt > 0u ? cnt : 1u;
}
DEVI void xcd_barrier(const XcdBarrier& b) {
    asm volatile("s_waitcnt vmcnt(0)" ::: "memory");
    __syncthreads();
    if (threadIdx.x == 0) {
        unsigned* bar = b.bar;
        __builtin_amdgcn_s_waitcnt(0);
        unsigned nloc = b.st[0], nx = b.st[1];
        if (nloc == 0u) { xcd_barrier_complete(bar, b.x, nloc, nx); b.st[0] = nloc; b.st[1] = nx; }
        const unsigned old = xb_add(&bar[XB_XSUB(b.x)], 1u);
        const unsigned gen = old / nloc;
        if (old + 1u == (gen + 1u) * nloc) {
            __builtin_amdgcn_fence(__ATOMIC_RELEASE, "agent");
            asm volatile("s_waitcnt vmcnt(0)" ::: "memory");
            const unsigned og = xb_add(&bar[XB_TOP], 1u);
            const unsigned tg = og / nx;
            if (og + 1u == (tg + 1u) * nx) xb_add(&bar[XB_TOPGEN], 1u);
            else XB_SPIN(xb_ld(&bar[XB_TOPGEN]) == tg, bar);
            __builtin_amdgcn_fence(__ATOMIC_ACQUIRE, "agent");
            asm volatile("s_waitcnt vmcnt(0)" ::: "memory");
        } else {
            XB_SPIN(xb_ld(&bar[XB_TOPGEN]) == gen, bar);
            __builtin_amdgcn_fence(__ATOMIC_ACQUIRE, "agent");
            asm volatile("s_waitcnt vmcnt(0)" ::: "memory");
        }
    }
    __syncthreads();
}

DEVI SliceGeo slice_geo(const P& p, unsigned char* lds) {
    SliceGeo g;
    unsigned* bar = (unsigned*)(p.ws + WS_CTL);
    volatile LAS unsigned* st = (volatile LAS unsigned*)(lds + LDS_BYTES - 64);
    unsigned cnt[8]; unsigned tot = 0; bool ok = true;
#pragma unroll
    for (int j = 0; j < 8; ++j) { cnt[j] = xb_ld(&bar[XB_XCNT(j)]); tot += cnt[j]; ok = ok && cnt[j] > 0u; }
    const unsigned xcc = xb_xcc_id();
    if (ok && tot == gridDim.x && xcc < 8u) { g.x = (int)xcc; g.rank = (int)st[2]; g.n = 0;
#pragma unroll
        for (int j = 0; j < 8; ++j) g.n = (j == (int)xcc) ? (int)cnt[j] : g.n; }
    else { g.x = blockIdx.x & 7; g.rank = blockIdx.x >> 3; g.n = ((int)gridDim.x - g.x + 7) >> 3; }
    g.x = __builtin_amdgcn_readfirstlane(g.x); g.rank = __builtin_amdgcn_readfirstlane(g.rank); g.n = __builtin_amdgcn_readfirstlane(g.n);
    return g;
}

struct CtxBf16 { bf16_t* O; int ldc; DEVI void operator()(int tok, int n, const f32x4 v) const { *(u32x2*)(O + (size_t)tok * ldc + n) = (u32x2){pk2(v[0], v[1]), pk2(v[2], v[3])}; } };
struct CtxHgrnIn { bf16_t* O; const float* lbv;
    DEVI void operator()(int tok, int n, const f32x4 v) const { const int blk = n >> 10; float x[4] = {v[0], v[1], v[2], v[3]};
#pragma unroll
        for (int j = 0; j < 4; ++j) {
            if (blk == 0 || blk == 4) x[j] = x[j] * frcp_(1.0f + __expf(-x[j]));
            else if (blk == 2 || blk == 3) { const float lb = lbv[(blk - 2) * 1024 + (n & 1023) + j]; x[j] = __logf(lb + (1.0f - lb) * frcp_(1.0f + __expf(-x[j]))); } }
        *(u32x2*)(O + (size_t)tok * 5120 + n) = (u32x2){pk2(x[0], x[1]), pk2(x[2], x[3])}; } };
struct CtxF16 { unsigned short* O; int ldc; DEVI void operator()(int tok, int n, const f32x4 v) const { *(u32x2*)(O + (size_t)tok * ldc + n) = (u32x2){pg8::pkh2(v[0], v[1]), pg8::pkh2(v[2], v[3])}; } };
struct CtxResid { float* X; const float* gate; DEVI void operator()(int tok, int n, const f32x4 v) const { f32x4* q = (f32x4*)(X + (size_t)tok * D + n); *q = *q + *(const f32x4*)(gate + n) * v; } };
template <class Epi>
DEVI void ctx_gemm(const bf16_t* A, const bf16_t* Bt, int N, const Epi& epi, unsigned char* lds_) {
    typedef short bf16x8 __attribute__((ext_vector_type(8)));
    const int otid_ = otid();
    const int wave = otid_ >> 6, lane = otid_ & 63, c = lane & 15, q4 = lane >> 4;
    LAS f32x4* red = (LAS f32x4*)lds_;
    const int npieces = (TC / 32) * (N / 64);
    for (int pc = blockIdx.x; pc < npieces; pc += gridDim.x) {
        const int mt = pc & 7, nt = pc >> 3;
        const bf16_t* ap = A + (size_t)(32 * mt + c) * D + 8 * q4 + 128 * wave;
        const bf16_t* bp = Bt + (size_t)(64 * nt + c) * D + 8 * q4 + 128 * wave;
        bf16x8 a0[4], a1[4], bf[4][4];
#pragma unroll
        for (int s4 = 0; s4 < 4; ++s4) { a0[s4] = *(const bf16x8*)(ap + 32 * s4); a1[s4] = *(const bf16x8*)(ap + 16 * D + 32 * s4);
#pragma unroll
            for (int j = 0; j < 4; ++j) bf[j][s4] = *(const bf16x8*)(bp + (size_t)(16 * j) * D + 32 * s4); }
        f32x4 acc[4][2];
#pragma unroll
        for (int j = 0; j < 4; ++j) { acc[j][0] = (f32x4){0.f, 0.f, 0.f, 0.f}; acc[j][1] = acc[j][0]; }
#pragma unroll
        for (int s4 = 0; s4 < 4; ++s4)
#pragma unroll
            for (int j = 0; j < 4; ++j) { acc[j][0] = __builtin_amdgcn_mfma_f32_16x16x32_bf16(bf[j][s4], a0[s4], acc[j][0], 0, 0, 0); acc[j][1] = __builtin_amdgcn_mfma_f32_16x16x32_bf16(bf[j][s4], a1[s4], acc[j][1], 0, 0, 0); }
        __syncthreads();
#pragma unroll
        for (int j = 0; j < 4; ++j)
#pragma unroll
            for (int i = 0; i < 2; ++i) red[(wave * 8 + (j * 2 + i)) * 64 + lane] = acc[j][i];
        __syncthreads();
        f32x4 sum = {0.f, 0.f, 0.f, 0.f};
#pragma unroll
        for (int ww = 0; ww < 8; ++ww) sum += red[(ww * 8 + wave) * 64 + lane];
        epi(32 * mt + 16 * (wave & 1) + c, 64 * nt + 16 * (wave >> 1) + 4 * q4, sum);
    }
    __syncthreads();
}

DEVI void gemm_bf16(const P& p, const bf16_t* A, const bf16_t* Bt, int r0, int N, bf16_t* O, int ldc, unsigned char* lds) {
    pg8::Gemm g{A + (size_t)r0 * D, Bt, MA - r0, N, D}; pg8::StaticOrder S; S.init(MA - r0, N, (int)gridDim.x, (int)blockIdx.x);
    pg8::EpiBf16 E{O, ldc, r0};
    pg8::gemm_phase<pg8::EpiBf16, pg8::StaticOrder, true, true>((PG8_LAS unsigned char*)lds, g, S, E);
}
DEVI void gemm_hgrn_in(const P& p, const bf16_t* A, const bf16_t* Bt, unsigned char* lds) {
    pg8::Gemm g{A + (size_t)TC * D, Bt, T, 5120, D}; pg8::StaticOrder S; S.init(T, 5120, (int)gridDim.x, (int)blockIdx.x);
    pg8::EpiHgrnIn E{(bf16_t*)(p.ws + WS_G), 5120, TC, (const float*)(p.ws + WS_LB)};
    pg8::gemm_phase<pg8::EpiHgrnIn, pg8::StaticOrder, true, true>((PG8_LAS unsigned char*)lds, g, S, E);
}
DEVI void gemm_f16(const P& p, const bf16_t* A, const bf16_t* Bt, int r0, int N, unsigned short* O, int ldc, unsigned char* lds) {
    pg8::Gemm g{A + (size_t)r0 * D, Bt, MA - r0, N, D}; pg8::StaticOrder S; S.init(MA - r0, N, (int)gridDim.x, (int)blockIdx.x);
    pg8::EpiF16 E{O, ldc, r0};
    pg8::gemm_phase<pg8::EpiF16, pg8::StaticOrder, true, true>((PG8_LAS unsigned char*)lds, g, S, E);
}
DEVI void gemm_glu_resid(const P& p, const bf16_t* A, const bf16_t* Bt, int layer, unsigned char* lds) {
    pg8::Gemm g{A + (size_t)TC * D, Bt, T, 2048, D}; pg8::StaticOrder S; S.init(T, 2048, (int)gridDim.x, (int)blockIdx.x);
    pg8::EpiGluResid E{(float*)(p.ws + WS_X), mod_ptr(p, layer, 0, 2), TC};
    pg8::gemm_phase<pg8::EpiGluResid, pg8::StaticOrder, true, true>((PG8_LAS unsigned char*)lds, g, S, E);
}
DEVI void gemm_resid(const P& p, const bf16_t* A, const bf16_t* Bt, int r0, int layer, unsigned char* lds) {
    pg8::Gemm g{A + (size_t)r0 * D, Bt, MA - r0, D, D}; pg8::StaticOrder S; S.init(MA - r0, D, (int)gridDim.x, (int)blockIdx.x);
    pg8::EpiResid E{(float*)(p.ws + WS_X), mod_ptr(p, layer, 0, 2), mod_ptr(p, layer, 1, 2), r0, TC};
    pg8::gemm_phase<pg8::EpiResid, pg8::StaticOrder, true, true>((PG8_LAS unsigned char*)lds, g, S, E);
}

enum { PH_P0 = 0, PH_INIT, PH_GEMM_IN, PH_HGP1, PH_MIX1, PH_MIX2, PH_GEMM_OUT, PH_NORM2, PH_SCORES, PH_TOPK, PH_PEERU, PH_PEERW, PH_PEERV, PH_PEERF };

DEVI void run_phase(const P& p, int ph, int layer, unsigned char* lds) {
    const int kind = layer % 3, jj = layer / 3;
    const int r0 = (layer >= 2) ? TC : 0;
    bf16_t* WT = (bf16_t*)(p.ws + WS_WT);
    switch (ph) {
    case PH_P0: ph_ada(p, lds); ph_lb(p); ph_s5disc(p); __syncthreads(); ph_transposes(p, lds); __syncthreads(); ph_fold(p); ph_tables(p); break;
    case PH_INIT: ph_init_norm(p); break;
    case PH_GEMM_IN:
        if (kind == 0) { const bf16_t* W = WT + WT_CIN / 2 + (size_t)jj * 3072 * 1024;
            if (r0 == 0) ctx_gemm((const bf16_t*)(p.ws + WS_XN), W, 3072, CtxBf16{(bf16_t*)(p.ws + WS_G), 3072}, lds);
            gemm_bf16(p, (const bf16_t*)(p.ws + WS_XN), W, TC, 3072, (bf16_t*)(p.ws + WS_G), 3072, lds); }
        else if (kind == 1) { ctx_gemm((const bf16_t*)(p.ws + WS_XN), WT + WT_HIN / 2, 5120, CtxHgrnIn{(bf16_t*)(p.ws + WS_G), (const float*)(p.ws + WS_LB)}, lds);
            gemm_hgrn_in(p, (const bf16_t*)(p.ws + WS_XN), WT + WT_HIN / 2, lds); }
        break;
    case PH_HGP1: if (kind == 1) hg::scan<false>(p, lds); else s5::scan<false>(p, lds); break;
    case PH_MIX1:
        if (kind == 0) ph_conv(p, jj, r0); else if (kind == 1) hg::scan<true>(p, lds); else s5::scan<true>(p, lds);
        break;
    case PH_MIX2:
        if (kind == 1) ph_hgrn_readout(p); else if (kind == 2) ph_s5_elem(p);
        break;
    case PH_GEMM_OUT:
        if (kind == 0) { const bf16_t* W = WT + WT_COUT / 2 + (size_t)jj * 1024 * 1024;
            if (r0 == 0) ctx_gemm((const bf16_t*)(p.ws + WS_U), W, 1024, CtxResid{(float*)(p.ws + WS_X), mod_ptr(p, layer, 1, 2)}, lds);
            gemm_resid(p, (const bf16_t*)(p.ws + WS_U), W, TC, layer, lds); }
        else if (kind == 1) { ctx_gemm((const bf16_t*)(p.ws + WS_U), WT + WT_HOUT / 2, 1024, CtxResid{(float*)(p.ws + WS_X), mod_ptr(p, layer, 1, 2)}, lds);
            gemm_resid(p, (const bf16_t*)(p.ws + WS_U), WT + WT_HOUT / 2, TC, layer, lds); }
        else gemm_glu_resid(p, (const bf16_t*)(p.ws + WS_U), WT + WT_GLU / 2, layer, lds);
        break;
    case PH_NORM2: ph_norm2(p, layer, r0); break;
    case PH_SCORES: { const bf16_t* W = (const bf16_t*)(p.ws + WS_WQK) + (size_t)layer * 2048 * 1024;
        if (r0 == 0) ctx_gemm((const bf16_t*)(p.ws + WS_XN), W, 2048, CtxF16{(unsigned short*)(p.ws + WS_SCH), 2048}, lds);
        gemm_f16(p, (const bf16_t*)(p.ws + WS_XN), W, TC, 2048, (unsigned short*)(p.ws + WS_SCH), 2048, lds); } break;
    case PH_TOPK: ph_topk(p, layer, r0, lds); break;
    case PH_PEERU: ph_peer_u(p, layer, r0, slice_geo(p, lds), lds); break;
    case PH_PEERW: ph_peer_w(p, r0); break;
    case PH_PEERV: ph_peer_v(p, layer, r0, slice_geo(p, lds), lds); break;
    case PH_PEERF: ph_peer_fin(p, layer, r0, layer == 3 ? 1 : 0); break;
    }
}

#ifndef MK_MULTI
#define MK_MULTI 0
#endif
#if MK_MULTI
__global__ void __launch_bounds__(NTHR, 2) k_fwd(P p) {
    extern __shared__ __attribute__((aligned(16))) unsigned char lds[];
    run_phase(p, p.ph, p.arg, lds);
}
#else
__global__ void __launch_bounds__(NTHR, 2) k_fwd(P p) {
    extern __shared__ __attribute__((aligned(16))) unsigned char lds[];
    volatile LAS unsigned* st = (volatile LAS unsigned*)(lds + LDS_BYTES - 64);
    if (threadIdx.x < 16) st[threadIdx.x] = 0u;
    __syncthreads();
    const XcdBarrier bar = xcd_barrier_post((unsigned*)(p.ws + WS_CTL), st);
#define SYNC() xcd_barrier(bar)
    run_phase(p, PH_P0, 0, lds); SYNC();
    run_phase(p, PH_INIT, 0, lds); SYNC();
#pragma unroll 1
    for (int layer = 0; layer < DEPTH; ++layer) {
        const int kind = layer % 3;
        if (kind != 2) { run_phase(p, PH_GEMM_IN, layer, lds); SYNC(); }
        if (kind != 0) { run_phase(p, PH_HGP1, layer, lds); SYNC(); }
        run_phase(p, PH_MIX1, layer, lds); SYNC();
        if (kind != 0) { run_phase(p, PH_MIX2, layer, lds); SYNC(); }
        run_phase(p, PH_GEMM_OUT, layer, lds); SYNC();
        run_phase(p, PH_NORM2, layer, lds); SYNC();
        run_phase(p, PH_SCORES, layer, lds); SYNC();
        run_phase(p, PH_TOPK, layer, lds); SYNC();
        run_phase(p, PH_PEERU, layer, lds); SYNC();
        run_phase(p, PH_PEERW, layer, lds); SYNC();
        run_phase(p, PH_PEERV, layer, lds); SYNC();
        run_phase(p, PH_PEERF, layer, lds);
        if (layer != DEPTH - 1) SYNC();
    }
}
#endif

extern "C" void kernel_launch(void* const* d_in, const int* in_sizes, int n_in, void* d_out, int out_size, void* d_ws, size_t ws_size, hipStream_t stream) {
    static int grid = 0;
    if (grid == 0) {
        if (n_in != N_IN || out_size != T * D || ws_size < WS_END) { fprintf(stderr, "kernel_launch: unexpected shapes n_in %d out %d ws %zu\n", n_in, out_size, ws_size); grid = -1; return; }
        int dev = 0, cus = 0, per_cu = 0;
        if (hipGetDevice(&dev) != hipSuccess || hipDeviceGetAttribute(&cus, hipDeviceAttributeMultiprocessorCount, dev) != hipSuccess) { grid = -1; return; }
        if (hipFuncSetAttribute((const void*)k_fwd, hipFuncAttributeMaxDynamicSharedMemorySize, LDS_BYTES) != hipSuccess) { fprintf(stderr, "kernel_launch: hipFuncSetAttribute failed\n"); grid = -1; return; }
        if (hipOccupancyMaxActiveBlocksPerMultiprocessor(&per_cu, (const void*)k_fwd, NTHR, LDS_BYTES) != hipSuccess || per_cu < 1) { fprintf(stderr, "kernel_launch: occupancy query says %d blocks/CU\n", per_cu); }
        (void)hipGetLastError();
        grid = cus;
    }
    if (grid < 0) return;
    P p{};
    for (int i = 0; i < N_IN; ++i) p.in[i] = (const float*)d_in[i];
    p.out = (float*)d_out; p.ws = (unsigned char*)d_ws;
#if MK_MULTI
    auto launch = [&](int ph, int arg) { p.ph = ph; p.arg = arg; hipLaunchKernelGGL(k_fwd, dim3(grid), dim3(NTHR), LDS_BYTES, stream, p); };
    launch(PH_P0, 0); launch(PH_INIT, 0);
    for (int layer = 0; layer < DEPTH; ++layer) {
        const int kind = layer % 3;
        if (kind != 2) launch(PH_GEMM_IN, layer);
        if (kind != 0) launch(PH_HGP1, layer);
        launch(PH_MIX1, layer);
        if (kind != 0) launch(PH_MIX2, layer);
        launch(PH_GEMM_OUT, layer);
        launch(PH_NORM2, layer); launch(PH_SCORES, layer); launch(PH_TOPK, layer); launch(PH_PEERU, layer); launch(PH_PEERW, layer); launch(PH_PEERV, layer); launch(PH_PEERF, layer);
    }
#else
    if (hipMemsetAsync((char*)d_ws + WS_CTL, 0, 65536, stream) != hipSuccess) { fprintf(stderr, "kernel_launch: memset failed\n"); return; }
    void* args[] = {&p};
    const hipError_t e = hipLaunchCooperativeKernel((const void*)k_fwd, dim3(grid), dim3(NTHR), args, LDS_BYTES, stream);
    if (e != hipSuccess) fprintf(stderr, "kernel_launch: cooperative launch failed: %s (grid %d)\n", hipGetErrorString(e), grid);
#endif
}
```

```cpp
#include <hip/hip_runtime.h>
#include <cstdint>
#include <cstdio>

#define DEVI __device__ __forceinline__
#define LAS __attribute__((address_space(3)))
typedef unsigned short bf16_t;
typedef float f32x4 __attribute__((ext_vector_type(4)));
typedef unsigned u32x4 __attribute__((ext_vector_type(4)));
typedef unsigned u32x2 __attribute__((ext_vector_type(2)));
typedef int i32x4 __attribute__((ext_vector_type(4)));
typedef __bf16 bf16x2_t __attribute__((ext_vector_type(2)));

constexpr int D = 1024, T = 16384, TC = 256, MA = T + TC, DEPTH = 4;
constexpr int NTHR = 512, NWV = 8;
constexpr float EPS = 1e-6f;

constexpr size_t MiB = 1u << 20;
constexpr size_t WS_CTL = 0;
constexpr size_t WS_MOD = 1 * MiB;
constexpr size_t WS_LB = WS_MOD + 256 * 1024;
constexpr size_t WS_S5A = 2 * MiB;
constexpr size_t WS_S5B = 3 * MiB;
constexpr size_t WS_X = 8 * MiB;
constexpr size_t WS_XN = 73 * MiB;
constexpr size_t WS_U = 106 * MiB;
constexpr size_t WS_OF = 139 * MiB;
constexpr size_t WS_OB = 172 * MiB;
constexpr size_t WS_G = 205 * MiB;
constexpr size_t WS_SC = 368 * MiB;
constexpr size_t WS_SELI = 498 * MiB;
constexpr size_t WS_SELG = 507 * MiB;
constexpr size_t WS_WQK = 516 * MiB;
constexpr size_t WS_WT = 532 * MiB;
constexpr size_t WT_CIN = 0, WT_COUT = 12 * MiB, WT_HIN = 16 * MiB, WT_HOUT = 26 * MiB, WT_GLU = 28 * MiB;
constexpr size_t WS_PU = 564 * MiB;
constexpr size_t WS_PV = 628 * MiB;
constexpr size_t WS_SCL = 692 * MiB;
constexpr size_t WS_H8 = 770 * MiB;
constexpr size_t WS_HS = 788 * MiB;
constexpr size_t WS_SCH = 704 * MiB;
constexpr size_t WS_SELU = 694 * MiB;
constexpr size_t WS_XE = 820 * MiB;
constexpr size_t WS_END = 822 * MiB;

constexpr int LDS_BYTES = 147456;

enum { I_X = 0, I_C, I_CTX, I_CCTX, I_ADAW, I_ADAB, I_N1G, I_N2G, I_CWIN, I_CK, I_CWOUT, I_HWIN, I_HLB, I_HNG, I_HWOUT,
       I_S5LR, I_S5LI, I_S5LS, I_S5BR, I_S5BI, I_S5CR, I_S5CI, I_S5D, I_S5GLU, I_PWQ, I_PKEYS, I_PU, I_PV, I_FG, N_IN };

struct P {
    const float* in[N_IN];
    float* out;
    unsigned char* ws;
    int ph, arg;
};

DEVI unsigned f2bf(float f) { unsigned u = __float_as_uint(f); return (u + 0x7fffu + ((u >> 16) & 1u)) >> 16; }
typedef float f32x2_t __attribute__((ext_vector_type(2)));
DEVI unsigned pk2(float lo, float hi) { f32x2_t f = {lo, hi}; return __builtin_bit_cast(unsigned, __builtin_convertvector(f, bf16x2_t)); }
DEVI float bflo(unsigned w) { return __uint_as_float(w << 16); }
DEVI float bfhi(unsigned w) { return __uint_as_float(w & 0xffff0000u); }
DEVI float bf2f(bf16_t b) { return __uint_as_float((unsigned)b << 16); }
DEVI float frcp_(float x) { return __builtin_amdgcn_rcpf(x); }
DEVI float sigmoidf_(float x) { return frcp_(1.0f + __expf(-x)); }
DEVI float siluf_(float x) { return x * sigmoidf_(x); }
DEVI float erf_as_(float x) {
    const float ax = __builtin_fabsf(x), t = frcp_(__builtin_fmaf(0.3275911f, ax, 1.0f));
    float pl = __builtin_fmaf(1.061405429f, t, -1.453152027f); pl = __builtin_fmaf(pl, t, 1.421413741f); pl = __builtin_fmaf(pl, t, -0.284496736f); pl = __builtin_fmaf(pl, t, 0.254829592f);
    const float r = 1.0f - pl * t * __expf(-ax * ax);
    return __builtin_copysignf(r, x);
}
DEVI float geluf_(float x) { return 0.5f * x * (1.0f + erf_as_(x * 0.70710678118654752f)); }
DEVI float dot2bf(unsigned a, unsigned b, float c) { return __builtin_amdgcn_fdot2_f32_bf16(__builtin_bit_cast(bf16x2_t, a), __builtin_bit_cast(bf16x2_t, b), c, false); }
DEVI int otid() { int t = threadIdx.x; asm volatile("" : "+v"(t)); return t; }
template <int CTRL> DEVI float dpp_mov_f(float v) { return __uint_as_float(__builtin_amdgcn_update_dpp(0u, __float_as_uint(v), CTRL, 0xf, 0xf, true)); }
DEVI void rows_swap16(float& a, float& b) { const auto r = __builtin_amdgcn_permlane16_swap(__float_as_uint(a), __float_as_uint(b), false, false); a = __uint_as_float(r[0]); b = __uint_as_float(r[1]); }
DEVI void rows_swap32(float& a, float& b) { const auto r = __builtin_amdgcn_permlane32_swap(__float_as_uint(a), __float_as_uint(b), false, false); a = __uint_as_float(r[0]); b = __uint_as_float(r[1]); }
DEVI float wave_sum(float v) {
    v += dpp_mov_f<0xB1>(v); v += dpp_mov_f<0x4E>(v); v += dpp_mov_f<0x141>(v); v += dpp_mov_f<0x140>(v);
    { float a = v, b = v; rows_swap16(a, b); v = a + b; }
    { float a = v, b = v; rows_swap32(a, b); v = a + b; }
    return v;
}
DEVI float wave_max_f(float v) {
    v = __builtin_fmaxf(v, dpp_mov_f<0xB1>(v)); v = __builtin_fmaxf(v, dpp_mov_f<0x4E>(v)); v = __builtin_fmaxf(v, dpp_mov_f<0x141>(v)); v = __builtin_fmaxf(v, dpp_mov_f<0x140>(v));
    { float a = v, b = v; rows_swap16(a, b); v = __builtin_fmaxf(a, b); }
    { float a = v, b = v; rows_swap32(a, b); v = __builtin_fmaxf(a, b); }
    return v;
}
DEVI float row16_sum(float v) { v += dpp_mov_f<0xB1>(v); v += dpp_mov_f<0x4E>(v); v += dpp_mov_f<0x141>(v); v += dpp_mov_f<0x140>(v); return v; }
DEVI unsigned pk4_i8(float a, float b, float c, float d) {
    const int ia = (int)__builtin_rintf(a), ib = (int)__builtin_rintf(b), ic = (int)__builtin_rintf(c), id = (int)__builtin_rintf(d);
    return (unsigned)(ia & 255) | ((unsigned)(ib & 255) << 8) | ((unsigned)(ic & 255) << 16) | ((unsigned)id << 24);
}
DEVI int row_cls(int r) { return r < TC ? 1 : 0; }
DEVI const float* mod_ptr(const P& p, int layer, int cls, int chunk) { return (const float*)(p.ws + WS_MOD) + ((size_t)(layer * 2 + cls) * 6 + chunk) * D; }

struct Row16 { float v[16]; };
DEVI void load_row_f32(const float* row, int lane, Row16& o) {
    const f32x4* a = (const f32x4*)(row + 8 * lane); const f32x4* b = (const f32x4*)(row + 512 + 8 * lane);
    f32x4 a0 = a[0], a1 = a[1], b0 = b[0], b1 = b[1];
#pragma unroll
    for (int j = 0; j < 4; ++j) { o.v[j] = a0[j]; o.v[4 + j] = a1[j]; o.v[8 + j] = b0[j]; o.v[12 + j] = b1[j]; }
}
DEVI void store_row_f32(float* row, int lane, const Row16& o) {
    f32x4* a = (f32x4*)(row + 8 * lane); f32x4* b = (f32x4*)(row + 512 + 8 * lane);
    a[0] = (f32x4){o.v[0], o.v[1], o.v[2], o.v[3]}; a[1] = (f32x4){o.v[4], o.v[5], o.v[6], o.v[7]};
    b[0] = (f32x4){o.v[8], o.v[9], o.v[10], o.v[11]}; b[1] = (f32x4){o.v[12], o.v[13], o.v[14], o.v[15]};
}
DEVI void load_row_bf16(const bf16_t* row, int lane, Row16& o) {
    const u32x4 a = *(const u32x4*)(row + 8 * lane), b = *(const u32x4*)(row + 512 + 8 * lane);
#pragma unroll
    for (int j = 0; j < 4; ++j) { o.v[2 * j] = bflo(a[j]); o.v[2 * j + 1] = bfhi(a[j]); o.v[8 + 2 * j] = bflo(b[j]); o.v[8 + 2 * j + 1] = bfhi(b[j]); }
}
DEVI void store_row_bf16(bf16_t* row, int lane, const Row16& o) {
    u32x4 a, b;
#pragma unroll
    for (int j = 0; j < 4; ++j) { a[j] = pk2(o.v[2 * j], o.v[2 * j + 1]); b[j] = pk2(o.v[8 + 2 * j], o.v[8 + 2 * j + 1]); }
    *(u32x4*)(row + 8 * lane) = a; *(u32x4*)(row + 512 + 8 * lane) = b;
}
DEVI void norm_mod(const Row16& x, const float* g, const float* shift, const float* scale, int lane, Row16& o) {
    float ss = 0.f;
#pragma unroll
    for (int j = 0; j < 16; ++j) ss += x.v[j] * x.v[j];
    ss = wave_sum(ss);
    const float rstd = rsqrtf(ss * (1.0f / D) + EPS);
    Row16 gg, sh, sc; load_row_f32(g, lane, gg); load_row_f32(shift, lane, sh); load_row_f32(scale, lane, sc);
#pragma unroll
    for (int j = 0; j < 16; ++j) o.v[j] = x.v[j] * rstd * gg.v[j] * (1.0f + sc.v[j]) + sh.v[j];
}

DEVI void ph_ada(const P& p, unsigned char* lds) {
    const int otid_ = otid();
    float* sc = (float*)lds;
    float* red = sc + 2048;
    const int tid = otid_;
    for (int k = tid; k < 1024; k += NTHR) { sc[k] = siluf_(p.in[I_C][k]); sc[1024 + k] = siluf_(p.in[I_CCTX][k]); }
    __syncthreads();
    const int kg = tid >> 3, cl = tid & 7;
    for (int item = blockIdx.x; item < 4 * 192; item += gridDim.x) {
        const int i = item / 192, n0 = (item % 192) * 32 + cl * 4;
        const float* w = p.in[I_ADAW] + (size_t)i * 1024 * 6144 + n0 + (size_t)kg * 6144;
        f32x4 wv[16];
#pragma unroll
        for (int m = 0; m < 16; ++m) wv[m] = *(const f32x4*)(w + (size_t)m * 64 * 6144);
        f32x4 a0 = {0, 0, 0, 0}, a1 = {0, 0, 0, 0};
#pragma unroll
        for (int m = 0; m < 16; ++m) { a0 += wv[m] * sc[kg + 64 * m]; a1 += wv[m] * sc[1024 + kg + 64 * m]; }
        float* r = red + (kg * 8 + cl) * 8;
#pragma unroll
        for (int j = 0; j < 4; ++j) { r[j] = a0[j]; r[4 + j] = a1[j]; }
        __syncthreads();
        if (tid < 64) {
            const int c2 = tid >> 3, j = tid & 7; float s_ = 0.f;
            for (int g = 0; g < 64; ++g) s_ += red[(g * 8 + c2) * 8 + j];
            const int cls = j >> 2, n = (item % 192) * 32 + c2 * 4 + (j & 3);
            ((float*)(p.ws + WS_MOD))[(size_t)(i * 2 + cls) * 6144 + n] = s_ + p.in[I_ADAB][i * 6144 + n];
        }
        __syncthreads();
    }
}
DEVI void ph_lb(const P& p) {
    const int otid_ = otid();
    const int gt = blockIdx.x * NTHR + otid_;
    if (gt < 2048) {
        const float* l = p.in[I_HLB];
        float m = -1e30f; for (int i = 0; i < 4; ++i) m = fmaxf(m, l[i * 2048 + gt]);
        float s = 0.f; for (int i = 0; i < 4; ++i) s += expf(l[i * 2048 + gt] - m);
        ((float*)(p.ws + WS_LB))[gt] = expf(l[2048 + gt] - m) / s;
    }
}
DEVI void ph_s5disc(const P& p) {
    const int otid_ = otid();
    const int gt = blockIdx.x * NTHR + otid_;
    if (gt < 2 * 64 * 64) {
        const int dn = gt >> 12, g = (gt >> 6) & 63, pp = gt & 63;
        const float step = expf(p.in[I_S5LS][dn * 64 + g]);
        const float lr = fminf(p.in[I_S5LR][gt], -1e-4f), li = p.in[I_S5LI][gt];
        const float ar = step * lr, ai = step * li, mag = expf(ar);
        float sn, cs; sincosf(ai, &sn, &cs);
        const float abr = mag * cs, abi = mag * sn, den = lr * lr + li * li;
        const float fr = ((abr - 1.0f) * lr + abi * li) / den, fi = (abi * lr - (abr - 1.0f) * li) / den;
        float* A = (float*)(p.ws + WS_S5A) + (size_t)gt * 2; A[0] = abr; A[1] = abi;
        float* B = (float*)(p.ws + WS_S5B) + (size_t)gt * 32;
        const float* br = p.in[I_S5BR] + (size_t)(g * 64 + pp) * 16; const float* bi = p.in[I_S5BI] + (size_t)(g * 64 + pp) * 16;
        for (int h = 0; h < 16; ++h) { B[h] = fr * br[h] - fi * bi[h]; B[16 + h] = fr * bi[h] + fi * br[h]; }
    }
}
DEVI void transpose_item(const float* W, int K, int N, bf16_t* WT, float* scr, int item, int lane, bool glu_pair = false) {
    const int nblk = N / 32, kb = item / nblk, nb = item % nblk, k0 = 64 * kb, n0 = 32 * nb;
#pragma unroll 8
    for (int i = 0; i < 32; ++i) { const int kk = 2 * i + (lane >> 5); scr[kk * 33 + (lane & 31)] = W[(size_t)(k0 + kk) * N + n0 + (lane & 31)]; }
    __builtin_amdgcn_s_waitcnt(0); asm volatile("" ::: "memory");
    const int c = lane & 7;
#pragma unroll
    for (int j = 0; j < 4; ++j) { const int n = (lane >> 3) + 8 * j; const float* s = scr + (8 * c) * 33 + n;
        u32x4 o; o.x = pk2(s[0 * 33], s[1 * 33]); o.y = pk2(s[2 * 33], s[3 * 33]); o.z = pk2(s[4 * 33], s[5 * 33]); o.w = pk2(s[6 * 33], s[7 * 33]);
        const int dn = glu_pair ? (((n0 & 1023) >> 7) * 256 + (n0 >> 10) * 128 + (n0 & 127)) : n0;
        *(u32x4*)(WT + (size_t)(dn + n) * K + k0 + 8 * c) = o; }
    __builtin_amdgcn_s_waitcnt(0); asm volatile("" ::: "memory");
}
DEVI void ph_transposes(const P& p, unsigned char* lds) {
    const int otid_ = otid();
    const int wave = otid_ >> 6, lane = otid_ & 63;
    float* scr = (float*)lds + wave * (64 * 33);
    const int gw = blockIdx.x * NWV + wave, NGW = gridDim.x * NWV;
    bf16_t* WT = (bf16_t*)(p.ws + WS_WT);
    constexpr int I_A = (1024 / 64) * (3072 / 32), I_B = (1024 / 64) * (1024 / 32), I_C5 = (1024 / 64) * (5120 / 32), I_G = (1024 / 64) * (2048 / 32);
    constexpr int NIT = 2 * I_A + 2 * I_B + I_C5 + I_B + I_G;
    for (int it = gw; it < NIT; it += NGW) {
        int r = it;
        if (r < 2 * I_A) { const int j = r / I_A; transpose_item(p.in[I_CWIN] + (size_t)j * 1024 * 3072, 1024, 3072, WT + WT_CIN / 2 + (size_t)j * 3072 * 1024, scr, r % I_A, lane); continue; } r -= 2 * I_A;
        if (r < 2 * I_B) { const int j = r / I_B; transpose_item(p.in[I_CWOUT] + (size_t)j * 1024 * 1024, 1024, 1024, WT + WT_COUT / 2 + (size_t)j * 1024 * 1024, scr, r % I_B, lane); continue; } r -= 2 * I_B;
        if (r < I_C5) { transpose_item(p.in[I_HWIN], 1024, 5120, WT + WT_HIN / 2, scr, r, lane); continue; } r -= I_C5;
        if (r < I_B) { transpose_item(p.in[I_HWOUT], 1024, 1024, WT + WT_HOUT / 2, scr, r, lane); continue; } r -= I_B;
        transpose_item(p.in[I_S5GLU], 1024, 2048, WT + WT_GLU / 2, scr, r, lane, true);
    }
}
DEVI void ph_tables(const P& p) {
    const int otid_ = otid();
    const int wave = otid_ >> 6, lane = otid_ & 63, gw = blockIdx.x * NWV + wave, NGW = gridDim.x * NWV;
    float* SCL = (float*)(p.ws + WS_SCL);
    for (int row = gw; row < 2 * 4 * 16384; row += NGW) {
        const int w = row >> 16, rr = row & 65535;
        const f32x4* src = (const f32x4*)(p.in[w ? I_PV : I_PU] + (size_t)rr * 1024 + 16 * lane);
        const f32x4 a0 = src[0], a1 = src[1], a2 = src[2], a3 = src[3];
        float m = 0.f;
#pragma unroll
        for (int j = 0; j < 4; ++j) m = fmaxf(fmaxf(m, fmaxf(fabsf(a0[j]), fabsf(a1[j]))), fmaxf(fabsf(a2[j]), fabsf(a3[j])));
        m = wave_max_f(m);
        const float qmax = w ? 224.0f : 127.0f;
        const float sc = m > 0.f ? qmax / m : 1.0f;
        u32x4 q;
        if (w) {
            { unsigned t = 0; t = __builtin_amdgcn_cvt_pk_fp8_f32(a0[0] * sc, a0[1] * sc, t, false); t = __builtin_amdgcn_cvt_pk_fp8_f32(a0[2] * sc, a0[3] * sc, t, true); q[0] = t; }
            { unsigned t = 0; t = __builtin_amdgcn_cvt_pk_fp8_f32(a1[0] * sc, a1[1] * sc, t, false); t = __builtin_amdgcn_cvt_pk_fp8_f32(a1[2] * sc, a1[3] * sc, t, true); q[1] = t; }
            { unsigned t = 0; t = __builtin_amdgcn_cvt_pk_fp8_f32(a2[0] * sc, a2[1] * sc, t, false); t = __builtin_amdgcn_cvt_pk_fp8_f32(a2[2] * sc, a2[3] * sc, t, true); q[2] = t; }
            { unsigned t = 0; t = __builtin_amdgcn_cvt_pk_fp8_f32(a3[0] * sc, a3[1] * sc, t, false); t = __builtin_amdgcn_cvt_pk_fp8_f32(a3[2] * sc, a3[3] * sc, t, true); q[3] = t; }
        } else {
            q[0] = pk4_i8(a0[0] * sc, a0[1] * sc, a0[2] * sc, a0[3] * sc); q[1] = pk4_i8(a1[0] * sc, a1[1] * sc, a1[2] * sc, a1[3] * sc);
            q[2] = pk4_i8(a2[0] * sc, a2[1] * sc, a2[2] * sc, a2[3] * sc); q[3] = pk4_i8(a3[0] * sc, a3[1] * sc, a3[2] * sc, a3[3] * sc);
        }
        *(u32x4*)(p.ws + (w ? WS_PV : WS_PU) + (size_t)(rr >> 14) * (16384 * 1024) + (size_t)(lane >> 3) * (16384 * 128) + (size_t)(rr & 16383) * 128 + 16 * (lane & 7)) = q;
        if (lane == 0) SCL[2 * rr + w] = m > 0.f ? m / qmax : 1.0f;
    }
}
DEVI void ph_fold(const P& p) {
    const int otid_ = otid();
    const int wave = otid_ >> 6, lane = otid_ & 63, c = lane & 15, q4 = lane >> 4, gw = blockIdx.x * NWV + wave, NGW = gridDim.x * NWV;
    for (int item = gw; item < 4 * 16 * 8 * 4; item += NGW) {
        const int i = item >> 9, hc = (item >> 5) & 15, kt = (item >> 2) & 7, kq = item & 3;
        const float* ky = p.in[I_PKEYS] + (((size_t)i * 16 + hc) * 128 + 16 * kt + c) * 128 + 4 * q4;
        f32x4 kf[8];
#pragma unroll
        for (int s8 = 0; s8 < 8; ++s8) kf[s8] = *(const f32x4*)(ky + 16 * s8);
        bf16_t* out = (bf16_t*)(p.ws + WS_WQK) + ((size_t)i * 2048 + hc * 128 + 16 * kt + c) * 1024 + 4 * q4;
#pragma unroll 1
        for (int tt = 0; tt < 16; ++tt) {
            const int k1 = (kq * 16 + tt) * 16;
            const float* wq = p.in[I_PWQ] + ((size_t)i * 1024 + k1 + c) * 2048 + hc * 128 + 4 * q4;
            f32x4 wf[8];
#pragma unroll
            for (int s8 = 0; s8 < 8; ++s8) wf[s8] = *(const f32x4*)(wq + 16 * s8);
            f32x4 acc = {0.f, 0.f, 0.f, 0.f};
#pragma unroll
            for (int s8 = 0; s8 < 8; ++s8)
#pragma unroll
                for (int j = 0; j < 4; ++j) acc = __builtin_amdgcn_mfma_f32_16x16x4f32(wf[s8][j], kf[s8][j], acc, 0, 0, 0);
            *(u32x2*)(out + k1) = (u32x2){pk2(acc[0], acc[1]), pk2(acc[2], acc[3])};
        }
    }
}

struct NormAB { Row16 A, B; };
DEVI void normab_load(NormAB& n, const float* g, const float* shift, const float* scale, int lane) {
    Row16 gg, sc; load_row_f32(g, lane, gg); load_row_f32(scale, lane, sc); load_row_f32(shift, lane, n.B);
#pragma unroll
    for (int j = 0; j < 16; ++j) n.A.v[j] = gg.v[j] * (1.0f + sc.v[j]);
}
DEVI void norm_ab(const Row16& x, const NormAB& n, Row16& o) {
    float ss = 0.f;
#pragma unroll
    for (int j = 0; j < 16; ++j) ss += x.v[j] * x.v[j];
    ss = wave_sum(ss);
    const float rstd = rsqrtf(ss * (1.0f / D) + EPS);
#pragma unroll
    for (int j = 0; j < 16; ++j) o.v[j] = x.v[j] * rstd * n.A.v[j] + n.B.v[j];
}
DEVI void ph_init_norm(const P& p) {
    const int otid_ = otid();
    const int wave = __builtin_amdgcn_readfirstlane(otid_ >> 6), lane = otid_ & 63, gw = blockIdx.x * NWV + wave, NGW = gridDim.x * NWV;
    NormAB nl; normab_load(nl, p.in[I_N1G], mod_ptr(p, 0, 0, 0), mod_ptr(p, 0, 0, 1), lane);
    for (int r = gw; r < MA; r += 2 * NGW) {
        const int r1 = r + NGW;
        Row16 x0, x1, o;
        load_row_f32(r < TC ? p.in[I_CTX] + (size_t)r * D : p.in[I_X] + (size_t)(r - TC) * D, lane, x0);
        if (r1 < MA) load_row_f32(p.in[I_X] + (size_t)(r1 - TC) * D, lane, x1);
        NormAB n0 = nl;
        if (r < TC) normab_load(n0, p.in[I_N1G], mod_ptr(p, 0, 1, 0), mod_ptr(p, 0, 1, 1), lane);
        store_row_f32((float*)(p.ws + WS_X) + (size_t)r * D, lane, x0);
        norm_ab(x0, n0, o); store_row_bf16((bf16_t*)(p.ws + WS_XN) + (size_t)r * D, lane, o);
        if (r1 < MA) { store_row_f32((float*)(p.ws + WS_X) + (size_t)r1 * D, lane, x1); norm_ab(x1, nl, o); store_row_bf16((bf16_t*)(p.ws + WS_XN) + (size_t)r1 * D, lane, o); }
    }
}
DEVI void norm2_row(const P& p, int r, int lane, const Row16& x, const NormAB& n) {
    Row16 o; norm_ab(x, n, o);
    store_row_bf16((bf16_t*)(p.ws + WS_XN) + (size_t)r * D, lane, o);
    float m = 0.f;
#pragma unroll
    for (int j = 0; j < 16; ++j) m = fmaxf(m, fabsf(o.v[j]));
    m = wave_max_f(m);
    const float sc = m > 0.f ? 127.0f / m : 1.0f;
    unsigned char* h8 = p.ws + WS_H8 + (size_t)r * D;
    *(u32x2*)(h8 + 8 * lane) = (u32x2){pk4_i8(o.v[0] * sc, o.v[1] * sc, o.v[2] * sc, o.v[3] * sc), pk4_i8(o.v[4] * sc, o.v[5] * sc, o.v[6] * sc, o.v[7] * sc)};
    *(u32x2*)(h8 + 512 + 8 * lane) = (u32x2){pk4_i8(o.v[8] * sc, o.v[9] * sc, o.v[10] * sc, o.v[11] * sc), pk4_i8(o.v[12] * sc, o.v[13] * sc, o.v[14] * sc, o.v[15] * sc)};
    if (lane == 0) ((float*)(p.ws + WS_HS))[r] = m > 0.f ? m / 127.0f : 1.0f;
}
DEVI void ph_norm2(const P& p, int layer, int r0) {
    const int otid_ = otid();
    const int wave = __builtin_amdgcn_readfirstlane(otid_ >> 6), lane = otid_ & 63, gw = blockIdx.x * NWV + wave, NGW = gridDim.x * NWV;
    NormAB nl; normab_load(nl, p.in[I_N2G] + layer * D, mod_ptr(p, layer, 0, 3), mod_ptr(p, layer, 0, 4), lane);
    for (int r = r0 + gw; r < MA; r += 2 * NGW) {
        const int r1 = r + NGW;
        Row16 x0, x1; load_row_f32((const float*)(p.ws + WS_X) + (size_t)r * D, lane, x0);
        if (r1 < MA) load_row_f32((const float*)(p.ws + WS_X) + (size_t)r1 * D, lane, x1);
        NormAB n0 = nl;
        if (r < TC) normab_load(n0, p.in[I_N2G] + layer * D, mod_ptr(p, layer, 1, 3), mod_ptr(p, layer, 1, 4), lane);
        norm2_row(p, r, lane, x0, n0);
        if (r1 < MA) norm2_row(p, r1, lane, x1, nl);
    }
}

namespace pg8 {
#define PG8_LAS __attribute__((address_space(3)))
typedef unsigned short bf16_t;
typedef short bf16x8 __attribute__((ext_vector_type(8)));
typedef float f32x4 __attribute__((ext_vector_type(4)));
typedef unsigned u32x4 __attribute__((ext_vector_type(4)));
constexpr int BM = 256, BK = 64, HALF = 128, HTB = HALF * BK * 2  , STAGE_BYTES = 8 * HTB, NXCD = 8, WGM = 8;

__host__ __device__ __forceinline__ int lds_byte(int r, int c) { const int st = (r >> 4) * 2 + (c >> 5), rr = r & 15, cc = c & 31, ob = rr * 64 + cc * 2; return st * 1024 + (ob ^ (((ob >> 9) & 1) << 5)); }
__host__ __device__ __forceinline__ void stage_rc(int b, int& R, int& C) { const int st = b / 1024, sb = b % 1024, swz = sb ^ (((sb >> 9) & 1) << 5); R = (st >> 1) * 16 + swz / 64; C = (st & 1) * 32 + (swz % 64) / 2; }
__host__ __device__ __forceinline__ int perm32(int rho) { const int n = rho >> 4, i = rho & 15; return 8 * (i >> 2) + 4 * n + (i & 3); }

struct Unit { int pm, pn; };
struct Gemm { const bf16_t* A; const bf16_t* Bt; int M, N, K; };

struct StaticOrder {
    int nM, nN, nwg, G, c;
    __host__ __device__ void init(int M, int N, int G_, int c_) { nM = M / BM; nN = N / BM; nwg = nM * nN; G = G_; c = c_; }
    __host__ __device__ bool next(int i, Unit& u) const {
        const long L = (long)i * G + c; if (L >= nwg) return false;
        int wgid = (int)L; { const int q = nwg / NXCD, r = nwg % NXCD, xcd = wgid % NXCD, off = wgid / NXCD; wgid = (xcd < r ? xcd * (q + 1) : r * (q + 1) + (xcd - r) * q) + off; }
        const int nig = WGM * nN, gid = wgid / nig, fm = gid * WGM, gsz = (nM - fm) < WGM ? (nM - fm) : WGM;
        u.pm = fm + ((wgid % nig) % gsz); u.pn = (wgid % nig) / gsz; return true;
    }
    __device__ __forceinline__ void a_ready(const Unit&) const {}
    __device__ __forceinline__ void done(const Unit&) const {}
};
__device__ __forceinline__ unsigned cvt_pk_bf16(float lo, float hi) { unsigned r; asm volatile("v_cvt_pk_bf16_f32 %0, %1, %2" : "=v"(r) : "v"(lo), "v"(hi)); return r; }

struct EpiBf16 {
    static constexpr bool PERM = true, AFTER_DRAIN = false;
    bf16_t* O; int ldc; int row_base;
    __device__ __forceinline__ void operator()(const f32x4 (&acc)[2][2][4][2], const Unit& u, int wr, int wc, int fr, int fq) const {
        const int row0 = row_base + u.pm * BM + wr * 64 + fr, col0 = u.pn * BM + wc * 32 + 8 * fq;
#pragma unroll
        for (int ai = 0; ai < 2; ++ai)
#pragma unroll
            for (int m = 0; m < 4; ++m) { bf16_t* rowp = O + (size_t)(row0 + ai * HALF + m * 16) * ldc + col0;
#pragma unroll
                for (int bj = 0; bj < 2; ++bj) { const f32x4 v0 = acc[ai][bj][m][0], v1 = acc[ai][bj][m][1];
                    u32x4 w; w.x = ::pk2(v0[0], v0[1]); w.y = ::pk2(v0[2], v0[3]); w.z = ::pk2(v1[0], v1[1]); w.w = ::pk2(v1[2], v1[3]);
                    *(u32x4*)(rowp + bj * HALF) = w; } }
    }
};
struct EpiHgrnIn {
    static constexpr bool PERM = true, AFTER_DRAIN = false;
    bf16_t* O; int ldc; int row_base; const float* lbv;
    __device__ __forceinline__ void operator()(const f32x4 (&acc)[2][2][4][2], const Unit& u, int wr, int wc, int fr, int fq) const {
        const int row0 = row_base + u.pm * BM + wr * 64 + fr, col0 = u.pn * BM + wc * 32 + 8 * fq;
        const int blk = u.pn >> 2;
#pragma unroll
        for (int bj = 0; bj < 2; ++bj) {
            float lb8[8];
#pragma unroll
            for (int j = 0; j < 8; ++j) lb8[j] = (blk == 2 || blk == 3) ? lbv[(blk - 2) * 1024 + ((col0 + bj * HALF) & 1023) + j] : 0.f;
#pragma unroll
            for (int ai = 0; ai < 2; ++ai)
#pragma unroll
                for (int m = 0; m < 4; ++m) { const f32x4 v0 = acc[ai][bj][m][0], v1 = acc[ai][bj][m][1]; float x[8] = {v0[0], v0[1], v0[2], v0[3], v1[0], v1[1], v1[2], v1[3]};
#pragma unroll
                    for (int j = 0; j < 8; ++j) {
                        if (blk == 0 || blk == 4) x[j] = x[j] * frcp_(1.0f + __expf(-x[j]));
                        else if (blk == 2 || blk == 3) x[j] = __builtin_amdgcn_logf(lb8[j] + (1.0f - lb8[j]) * frcp_(1.0f + __expf(-x[j])));
                    }
                    u32x4 w; w.x = ::pk2(x[0], x[1]); w.y = ::pk2(x[2], x[3]); w.z = ::pk2(x[4], x[5]); w.w = ::pk2(x[6], x[7]);
                    *(u32x4*)(O + (size_t)(row0 + ai * HALF + m * 16) * ldc + col0 + bj * HALF) = w; }
        }
    }
};
typedef _Float16 f16x2_t __attribute__((ext_vector_type(2)));
__device__ __forceinline__ unsigned pkh2(float lo, float hi) { ::f32x2_t f = {lo, hi}; return __builtin_bit_cast(unsigned, __builtin_convertvector(f, f16x2_t)); }
struct EpiF16 {
    static constexpr bool PERM = true, AFTER_DRAIN = false;
    unsigned short* O; int ldc; int row_base;
    __device__ __forceinline__ void operator()(const f32x4 (&acc)[2][2][4][2], const Unit& u, int wr, int wc, int fr, int fq) const {
        const int row0 = row_base + u.pm * BM + wr * 64 + fr, col0 = u.pn * BM + wc * 32 + 8 * fq;
#pragma unroll
        for (int ai = 0; ai < 2; ++ai)
#pragma unroll
            for (int m = 0; m < 4; ++m) { unsigned short* rowp = O + (size_t)(row0 + ai * HALF + m * 16) * ldc + col0;
#pragma unroll
                for (int bj = 0; bj < 2; ++bj) { const f32x4 v0 = acc[ai][bj][m][0], v1 = acc[ai][bj][m][1];
                    u32x4 w; w.x = pkh2(v0[0], v0[1]); w.y = pkh2(v0[2], v0[3]); w.z = pkh2(v1[0], v1[1]); w.w = pkh2(v1[2], v1[3]);
                    *(u32x4*)(rowp + bj * HALF) = w; } }
    }
};
struct EpiGluResid {
    static constexpr bool PERM = false, AFTER_DRAIN = false;
    float* X; const float* gate1; int row_base;
    __device__ __forceinline__ void operator()(const f32x4 (&acc)[2][2][4][2], const Unit& u, int wr, int wc, int fr, int fq) const {
        const int row0 = row_base + u.pm * BM + wr * 64 + fr, ch0 = u.pn * HALF + wc * 32 + 4 * fq;
        f32x4 gv[2];
#pragma unroll
        for (int n = 0; n < 2; ++n) gv[n] = *(const f32x4*)(gate1 + ch0 + n * 16);
#pragma unroll
        for (int ai = 0; ai < 2; ++ai)
#pragma unroll
            for (int m = 0; m < 4; ++m) { float* rowp = X + (size_t)(row0 + ai * HALF + m * 16) * 1024 + ch0;
#pragma unroll
                for (int n = 0; n < 2; ++n) { const f32x4 v = acc[ai][0][m][n], g = acc[ai][1][m][n]; f32x4 o;
#pragma unroll
                    for (int j = 0; j < 4; ++j) o[j] = gv[n][j] * v[j] * frcp_(1.0f + __expf(-g[j]));
                    f32x4* q = (f32x4*)(rowp + n * 16); *q = *q + o; } }
    }
};
struct EpiResid {
    static constexpr bool PERM = false, AFTER_DRAIN = false;
    float* X; const float* gate_lat; const float* gate_ctx; int row_base; int tc_rows;
    __device__ __forceinline__ void operator()(const f32x4 (&acc)[2][2][4][2], const Unit& u, int wr, int wc, int fr, int fq) const {
        const int row0 = row_base + u.pm * BM + wr * 64 + fr, col0 = u.pn * BM + wc * 32 + 4 * fq;
        const float* gate = (row_base + u.pm * BM) < tc_rows ? gate_ctx : gate_lat;
        f32x4 gv[2][2];
#pragma unroll
        for (int bj = 0; bj < 2; ++bj)
#pragma unroll
            for (int n = 0; n < 2; ++n) gv[bj][n] = *(const f32x4*)(gate + col0 + bj * HALF + n * 16);
#pragma unroll
        for (int ai = 0; ai < 2; ++ai)
#pragma unroll
            for (int m = 0; m < 4; ++m) { float* rowp = X + (size_t)(row0 + ai * HALF + m * 16) * 1024 + col0;
#pragma unroll
                for (int bj = 0; bj < 2; ++bj)
#pragma unroll
                    for (int n = 0; n < 2; ++n) { f32x4* q = (f32x4*)(rowp + bj * HALF + n * 16); *q = *q + gv[bj][n] * acc[ai][bj][m][n]; } }
    }
};

template <class Epi, class Sched, bool ALIGN_EPI = false, bool SP2 = false>
__device__ __forceinline__ void gemm_phase(PG8_LAS unsigned char* lds, const Gemm g, const Sched& S, const Epi& E) {
    const int tid = otid(), wid = __builtin_amdgcn_readfirstlane(tid >> 6), lane = tid & 63, wr = wid >> 2, wc = wid & 3, fr = lane & 15, fq = lane >> 4;
    const int K = g.K, nt = K / BK;
    unsigned voffA[2], voffB[2];
#pragma unroll
    for (int i = 0; i < 2; ++i) { int R, C; stage_rc(tid * 16 + i * 8192, R, C); const int Rb = Epi::PERM ? ((R & ~31) + perm32(R & 31)) : R;
        voffA[i] = (unsigned)(R * K + C) * 2u; voffB[i] = (unsigned)(Rb * K + C) * 2u; }
    const size_t kstep = (size_t)(BK * 2);
    const size_t hstep = (size_t)HALF * K * 2;
    const size_t tstep = 2 * hstep;
    const unsigned ldsw = (unsigned)wid * 1024u;
    const int aoff = lds_byte(wr * 64 + fr, fq * 8), boff = lds_byte(wc * 32 + fr, fq * 8);
#define PG8_SA(b, h) (((b) * 2 + (h)) * HTB)
#define PG8_SB(b, h) ((4 + (b) * 2 + (h)) * HTB)
#define PG8_STAGE(bufoff, gbase, voff) do { _Pragma("unroll") for (int _i = 0; _i < 2; ++_i) \
        __builtin_amdgcn_global_load_lds((const unsigned*)((const char*)(gbase) + (voff)[_i]), (PG8_LAS unsigned*)(lds + (bufoff) + ldsw + _i * 8192), 16, 0, 0); } while (0)
#define PG8_LDA(dst, b, h) do { _Pragma("unroll") for (int m = 0; m < 4; ++m) _Pragma("unroll") for (int k = 0; k < 2; ++k) dst[m][k] = *(const PG8_LAS bf16x8*)(lds + PG8_SA(b, h) + aoff + m * 2048 + k * 1024); } while (0)
#define PG8_LDB(dst, b, h) do { _Pragma("unroll") for (int n = 0; n < 2; ++n) _Pragma("unroll") for (int k = 0; k < 2; ++k) dst[n][k] = *(const PG8_LAS bf16x8*)(lds + PG8_SB(b, h) + boff + n * 2048 + k * 1024); } while (0)
#define PG8_MMA(ai, bj, At, Bt) do { __builtin_amdgcn_s_setprio(1); _Pragma("unroll") for (int m = 0; m < 4; ++m) _Pragma("unroll") for (int n = 0; n < 2; ++n) _Pragma("unroll") for (int k = 0; k < 2; ++k) \
        acc[ai][bj][m][n] = __builtin_amdgcn_mfma_f32_16x16x32_bf16(Bt[n][k], At[m][k], acc[ai][bj][m][n], 0, 0, 0); __builtin_amdgcn_s_setprio(0); } while (0)
#define PG8_WAIT_V(n) asm volatile("s_waitcnt vmcnt(" #n ")" ::: "memory")
#define PG8_WAIT_L(n) asm volatile("s_waitcnt lgkmcnt(" #n ")" ::: "memory")
#define PG8_BAR __builtin_amdgcn_s_barrier()
#define PG8_SCHED __builtin_amdgcn_sched_barrier(0)
    Unit cur, nxt; int ui = 0;
    if (!S.next(0, cur)) return;
    f32x4 acc[2][2][4][2];
#pragma unroll
    for (int a = 0; a < 2; ++a)
#pragma unroll
        for (int b = 0; b < 2; ++b)
#pragma unroll
            for (int m = 0; m < 4; ++m)
#pragma unroll
                for (int n = 0; n < 2; ++n) acc[a][b][m][n] = (f32x4){0.f, 0.f, 0.f, 0.f};
    bf16x8 At[4][2], B0[2][2], B1[2][2];
    const char* cA = (const char*)g.A + (size_t)cur.pm * tstep; const char* cB = (const char*)g.Bt + (size_t)cur.pn * tstep;
    S.a_ready(cur);
    if constexpr (SP2) {
        PG8_STAGE(PG8_SB(0, 0), cB, voffB); PG8_STAGE(PG8_SB(0, 1), cB + hstep, voffB); PG8_STAGE(PG8_SA(0, 0), cA, voffA); PG8_STAGE(PG8_SA(0, 1), cA + hstep, voffA);
        if (wr == 1) PG8_BAR;
        PG8_WAIT_V(2); PG8_BAR;
        PG8_STAGE(PG8_SB(1, 0), cB + kstep, voffB); PG8_STAGE(PG8_SA(1, 0), cA + kstep, voffA); PG8_STAGE(PG8_SB(1, 1), cB + hstep + kstep, voffB);
        PG8_WAIT_V(6); PG8_BAR;
    } else {
        PG8_STAGE(PG8_SB(0, 0), cB, voffB); PG8_STAGE(PG8_SA(0, 0), cA, voffA); PG8_STAGE(PG8_SB(0, 1), cB + hstep, voffB); PG8_STAGE(PG8_SA(0, 1), cA + hstep, voffA);
        if (wr == 1) PG8_BAR;
        PG8_WAIT_V(4); PG8_BAR;
        PG8_STAGE(PG8_SB(1, 0), cB + kstep, voffB); PG8_STAGE(PG8_SA(1, 0), cA + kstep, voffA); PG8_STAGE(PG8_SB(1, 1), cB + hstep + kstep, voffB);
        PG8_WAIT_V(6); PG8_BAR;
    }
    for (;;) {
        const bool has_next = S.next(ui + 1, nxt);
        const char* nA = has_next ? (const char*)g.A + (size_t)nxt.pm * tstep : cA; const char* nB = has_next ? (const char*)g.Bt + (size_t)nxt.pn * tstep : cB;
        for (int t = 0; t < nt; t += 2) {
            const bool last = (t == nt - 2);
            const char* a1 = cA + (size_t)(t + 1) * kstep;
            const char* a2 = last ? nA : cA + (size_t)(t + 2) * kstep; const char* b2 = last ? nB : cB + (size_t)(t + 2) * kstep;
            const char* a3 = a2 + kstep; const char* b3 = b2 + kstep;
            if (last && has_next) S.a_ready(nxt);
            if constexpr (SP2) {
            PG8_LDB(B0, 0, 0); PG8_LDB(B1, 0, 1); PG8_SCHED; PG8_LDA(At, 0, 0); PG8_STAGE(PG8_SA(1, 1), a1 + hstep, voffA);
            PG8_WAIT_V(8); PG8_WAIT_L(0); PG8_BAR; PG8_MMA(0, 0, At, B0); PG8_MMA(0, 1, At, B1); PG8_BAR; PG8_SCHED;
            PG8_LDA(At, 0, 1); PG8_STAGE(PG8_SB(0, 0), b2, voffB); PG8_STAGE(PG8_SB(0, 1), b2 + hstep, voffB); PG8_STAGE(PG8_SA(0, 0), a2, voffA);
            PG8_WAIT_V(8); PG8_WAIT_L(0); PG8_BAR; PG8_MMA(1, 0, At, B0); PG8_MMA(1, 1, At, B1); PG8_BAR; PG8_SCHED;
            PG8_LDB(B0, 1, 0); PG8_LDB(B1, 1, 1); PG8_SCHED; PG8_LDA(At, 1, 0); PG8_STAGE(PG8_SA(0, 1), a2 + hstep, voffA);
            PG8_WAIT_V(8); PG8_WAIT_L(0); PG8_BAR; PG8_MMA(0, 0, At, B0); PG8_MMA(0, 1, At, B1); PG8_BAR; PG8_SCHED;
            PG8_LDA(At, 1, 1); PG8_STAGE(PG8_SB(1, 0), b3, voffB); PG8_STAGE(PG8_SB(1, 1), b3 + hstep, voffB); PG8_STAGE(PG8_SA(1, 0), a3, voffA);
            PG8_WAIT_V(8); PG8_WAIT_L(0); PG8_BAR; PG8_MMA(1, 0, At, B0); PG8_MMA(1, 1, At, B1); PG8_BAR; PG8_SCHED;
            } else {
            PG8_LDB(B0, 0, 0); PG8_SCHED; PG8_LDA(At, 0, 0); PG8_STAGE(PG8_SA(1, 1), a1 + hstep, voffA);
            PG8_WAIT_L(8); PG8_BAR; PG8_WAIT_L(0); PG8_MMA(0, 0, At, B0); PG8_BAR; PG8_SCHED;
            PG8_LDB(B1, 0, 1); PG8_STAGE(PG8_SB(0, 0), b2, voffB);
            PG8_BAR; PG8_WAIT_L(0); PG8_MMA(0, 1, At, B1); PG8_BAR;
            PG8_LDA(At, 0, 1); PG8_STAGE(PG8_SA(0, 0), a2, voffA);
            PG8_BAR; PG8_WAIT_L(0); PG8_MMA(1, 0, At, B0); PG8_BAR; PG8_SCHED;
            PG8_STAGE(PG8_SB(0, 1), b2 + hstep, voffB);
            PG8_WAIT_V(6); PG8_BAR; PG8_MMA(1, 1, At, B1); PG8_BAR;
            PG8_LDB(B0, 1, 0); PG8_SCHED; PG8_LDA(At, 1, 0); PG8_STAGE(PG8_SA(0, 1), a2 + hstep, voffA);
            PG8_WAIT_L(8); PG8_BAR; PG8_WAIT_L(0); PG8_MMA(0, 0, At, B0); PG8_BAR; PG8_SCHED;
            PG8_LDB(B1, 1, 1); PG8_STAGE(PG8_SB(1, 0), b3, voffB);
            PG8_BAR; PG8_WAIT_L(0); PG8_MMA(0, 1, At, B1); PG8_BAR;
            PG8_LDA(At, 1, 1); PG8_STAGE(PG8_SA(1, 0), a3, voffA);
            PG8_BAR; PG8_WAIT_L(0); PG8_MMA(1, 0, At, B0); PG8_BAR; PG8_SCHED;
            PG8_STAGE(PG8_SB(1, 1), b3 + hstep, voffB);
            PG8_WAIT_V(6); PG8_BAR; PG8_MMA(1, 1, At, B1); PG8_BAR;
            }
        }
        if constexpr (ALIGN_EPI) { if (wr == 0) PG8_BAR; }
        if constexpr (!Epi::AFTER_DRAIN) { E(acc, cur, wr, wc, fr, fq); S.done(cur); }
        if (!has_next) break;
#pragma unroll
        for (int a = 0; a < 2; ++a)
#pragma unroll
            for (int b = 0; b < 2; ++b)
#pragma unroll
                for (int m = 0; m < 4; ++m)
#pragma unroll
                    for (int n = 0; n < 2; ++n) acc[a][b][m][n] = (f32x4){0.f, 0.f, 0.f, 0.f};
        cur = nxt; cA = nA; cB = nB; ++ui;
        if constexpr (ALIGN_EPI) { if (wr == 1) PG8_BAR; }
    }
    PG8_WAIT_V(0);
    if constexpr (!ALIGN_EPI) { if (wr == 0) PG8_BAR; }
    PG8_BAR;
    if constexpr (Epi::AFTER_DRAIN) { E.fused(acc, cur, wr, wc, fr, fq, lds, wid, lane); S.done(cur); }
#undef PG8_SA
#undef PG8_SB
#undef PG8_STAGE
#undef PG8_LDA
#undef PG8_LDB
#undef PG8_MMA
#undef PG8_WAIT_V
#undef PG8_WAIT_L
#undef PG8_BAR
#undef PG8_SCHED
}
}

struct ConvRaw { u32x4 gb[2], gc[2], v[2], gcp[2], vp[2], gcn[2], vn[2]; };
DEVI void conv_raw_row(u32x4 (&o)[2], const bf16_t* row, int lane) { o[0] = *(const u32x4*)(row + 8 * lane); o[1] = *(const u32x4*)(row + 512 + 8 * lane); }
DEVI void conv_load(ConvRaw& c, const bf16_t* G, int r, int lane, bool hasp, bool hasn) {
    conv_raw_row(c.gb, G + (size_t)r * 3072, lane); conv_raw_row(c.gc, G + (size_t)r * 3072 + 1024, lane); conv_raw_row(c.v, G + (size_t)r * 3072 + 2048, lane);
    if (hasp) { conv_raw_row(c.gcp, G + (size_t)(r - 1) * 3072 + 1024, lane); conv_raw_row(c.vp, G + (size_t)(r - 1) * 3072 + 2048, lane); }
    if (hasn) { conv_raw_row(c.gcn, G + (size_t)(r + 1) * 3072 + 1024, lane); conv_raw_row(c.vn, G + (size_t)(r + 1) * 3072 + 2048, lane); }
}
DEVI void conv_unpack(const u32x4 (&a)[2], Row16& o) {
#pragma unroll
    for (int j = 0; j < 4; ++j) { o.v[2 * j] = bflo(a[0][j]); o.v[2 * j + 1] = bfhi(a[0][j]); o.v[8 + 2 * j] = bflo(a[1][j]); o.v[8 + 2 * j + 1] = bfhi(a[1][j]); }
}
DEVI void conv_finish(const P& p, const ConvRaw& c, int r, int lane, bool hasp, bool hasn, const Row16& k0, const Row16& k1, const Row16& k2) {
    Row16 gb, gc, v, acc;
    conv_unpack(c.gc, gc); conv_unpack(c.v, v);
#pragma unroll
    for (int e = 0; e < 16; ++e) acc.v[e] = gc.v[e] * v.v[e] * k1.v[e];
    if (hasp) { conv_unpack(c.gcp, gc); conv_unpack(c.vp, v);
#pragma unroll
        for (int e = 0; e < 16; ++e) acc.v[e] += gc.v[e] * v.v[e] * k0.v[e]; }
    if (hasn) { conv_unpack(c.gcn, gc); conv_unpack(c.vn, v);
#pragma unroll
        for (int e = 0; e < 16; ++e) acc.v[e] += gc.v[e] * v.v[e] * k2.v[e]; }
    conv_unpack(c.gb, gb);
#pragma unroll
    for (int e = 0; e < 16; ++e) acc.v[e] *= gb.v[e];
    store_row_bf16((bf16_t*)(p.ws + WS_U) + (size_t)r * D, lane, acc);
}
DEVI void conv_edges(int r, bool& hasp, bool& hasn) { if (r < TC) { hasp = r > 0; hasn = r < TC - 1; } else { const int t = (r - TC) & 63; hasp = t != 0; hasn = t != 63; } }
DEVI void ph_conv(const P& p, int j, int r0) {
    const int otid_ = otid();
    const int wave = __builtin_amdgcn_readfirstlane(otid_ >> 6), lane = otid_ & 63, gw = blockIdx.x * NWV + wave, NGW = gridDim.x * NWV;
    const bf16_t* G = (const bf16_t*)(p.ws + WS_G);
    Row16 k0, k1, k2;
    load_row_f32(p.in[I_CK] + (size_t)(j * 3 + 0) * D, lane, k0); load_row_f32(p.in[I_CK] + (size_t)(j * 3 + 1) * D, lane, k1); load_row_f32(p.in[I_CK] + (size_t)(j * 3 + 2) * D, lane, k2);
    for (int r = r0 + gw; r < MA; r += 2 * NGW) {
        const int r1 = r + NGW;
        bool hp0, hn0, hp1 = false, hn1 = false; conv_edges(r, hp0, hn0); if (r1 < MA) conv_edges(r1, hp1, hn1);
        ConvRaw c0, c1;
        conv_load(c0, G, r, lane, hp0, hn0);
        if (r1 < MA) conv_load(c1, G, r1, lane, hp1, hn1);
        conv_finish(p, c0, r, lane, hp0, hn0, k0, k1, k2);
        if (r1 < MA) conv_finish(p, c1, r1, lane, hp1, hn1, k0, k1, k2);
    }
}

DEVI int scan_row(int n, int dir) {
    if (dir == 0) return n;
    return n < TC ? (TC - 1 - n) : (TC + (T - 1 - (n - TC)));
}
namespace hg {
typedef short bf16x8 __attribute__((ext_vector_type(8)));
constexpr int NSEG = 16, NUNIT = 2 * 8 * NSEG;
constexpr int QSB = 272, TSB = 80;
constexpr int OFF_QT = 0, OFF_KT = 32 * QSB, OFF_QD = 2 * 32 * QSB, OFF_KDT = 3 * 32 * QSB, OFF_VT = OFF_KDT + 128 * TSB, OFF_DEC = OFF_VT + 128 * TSB, OFF_T = OFF_DEC + 512, BUFB = OFF_T + 4096;
static_assert(2 * BUFB <= 131072, "hgrn LDS");
DEVI bf16x8 mk8(unsigned a, unsigned b, unsigned c, unsigned d) { u32x4 v = {a, b, c, d}; return __builtin_bit_cast(bf16x8, v); }
DEVI unsigned cvtpk(float lo, float hi) { return pk2(lo, hi); }
#define HG_MFMA(a, b, c) __builtin_amdgcn_mfma_f32_16x16x32_bf16((a), (b), (c), 0, 0, 0)
#define HG_BAR() do { asm volatile("s_waitcnt lgkmcnt(0)" ::: "memory"); __builtin_amdgcn_s_barrier(); asm volatile("" ::: "memory"); } while (0)
template <bool PASS2>
DEVI void scan(const P& p, unsigned char* lds_) {
    for (int unit = blockIdx.x; unit < NUNIT; unit += gridDim.x) {
    __syncthreads();
    const int tid = otid(), lane = tid & 63, w = __builtin_amdgcn_readfirstlane(tid >> 6), c = lane & 15, q4 = lane >> 4;
    const int kp = tid & 63, lo = tid >> 6;
    const int d = unit / (8 * NSEG), h = (unit / NSEG) & 7, seg = unit % NSEG;
    LAS unsigned char* lds = (LAS unsigned char*)lds_;
    const bf16_t* G = (const bf16_t*)(p.ws + WS_G);
    bf16_t* O = (bf16_t*)(p.ws + (d ? WS_OB : WS_OF));
    float* SLOC = (float*)(p.ws + WS_SC);
    float* GSUM = SLOC + (size_t)NUNIT * 16384;
    f32x4 S[8];
#pragma unroll
    for (int t = 0; t < 8; ++t) S[t] = (f32x4){0.f, 0.f, 0.f, 0.f};
    if (PASS2) {
        for (int j = 0; j < seg; ++j) {
            const float* gs = GSUM + (size_t)(unit - seg + j) * 128; const float* sl = SLOC + (size_t)(unit - seg + j) * 16384 + (size_t)w * 2048;
#pragma unroll
            for (int t = 0; t < 8; ++t) { const f32x4 gg = *(const f32x4*)(gs + 16 * t + 4 * q4);
#pragma unroll
                for (int r = 0; r < 4; ++r) S[t][r] = S[t][r] * __builtin_amdgcn_exp2f(gg[r]) + sl[(t * 4 + r) * 64 + lane]; }
        }
    }
    float gsum0 = 0.f, gsum1 = 0.f;
    unsigned rq[4], ri[4], rz[4];
    const int CPS = 32 + (seg < 8 ? 1 : 0), ci0 = 32 * seg + (seg < 8 ? seg : 8);
    const bf16_t* Gk = G + h * 128 + 2 * kp + (d ? 1024 : 0);
    const long rstep = d ? -5120 : 5120;
#define HG_FETCH(ci) do { const bf16_t* g_ = Gk + (long)scan_row(32 * (ci) + 4 * lo, d) * 5120; _Pragma("unroll") for (int j = 0; j < 4; ++j) { \
        if (PASS2) rq[j] = *(const unsigned*)(g_ + (d ? -1024 : 0)); ri[j] = *(const unsigned*)(g_ + (d ? 0 : 1024)); rz[j] = *(const unsigned*)(g_ + 2048); g_ += rstep; } } while (0)
    HG_FETCH(ci0);
    for (int cc = 0; cc < CPS; ++cc) {
        const int ci = ci0 + cc;
        LAS unsigned char* B = lds + (cc & 1) * BUFB;
        float bl0[4], bl1[4], kv0[4], kv1[4]; float run0 = 0.f, run1 = 0.f;
#pragma unroll
        for (int j = 0; j < 4; ++j) { const float z0 = bflo(rz[j]), z1 = bfhi(rz[j]); run0 += z0; run1 += z1; bl0[j] = run0; bl1[j] = run1; kv0[j] = 1.0f - __builtin_amdgcn_exp2f(z0); kv1[j] = 1.0f - __builtin_amdgcn_exp2f(z1); }
        unsigned qp[4], vp[4];
#pragma unroll
        for (int j = 0; j < 4; ++j) { vp[j] = ri[j]; if (PASS2) qp[j] = rq[j]; }
        *(LAS f32x2_t*)(B + OFF_T + (lo * 128 + 2 * kp) * 4) = (f32x2_t){run0, run1};
        if (cc + 1 < CPS) HG_FETCH(ci + 1);
        HG_BAR();
        {
            float off0 = 0.f, off1 = 0.f, b15_0 = 0.f, b15_1 = 0.f, bla0 = 0.f, bla1 = 0.f;
#pragma unroll
            for (int x8 = 0; x8 < 8; ++x8) { const f32x2_t tt = *(const LAS f32x2_t*)(B + OFF_T + (x8 * 128 + 2 * kp) * 4);
                if (x8 < lo) { off0 += tt.x; off1 += tt.y; } if (x8 < 4) { b15_0 += tt.x; b15_1 += tt.y; } bla0 += tt.x; bla1 += tt.y; }
            const float e15_0 = __builtin_amdgcn_exp2f(b15_0), e15_1 = __builtin_amdgcn_exp2f(b15_1), el0 = __builtin_amdgcn_exp2f(bla0 - b15_0), el1 = __builtin_amdgcn_exp2f(bla1 - b15_1);
            float kd0[4], kd1[4];
#pragma unroll
            for (int j = 0; j < 4; ++j) {
                const int l = 4 * lo + j;
                const float b0 = bl0[j] + off0, b1 = bl1[j] + off1;
                const float kt0 = kv0[j] * __builtin_amdgcn_exp2f(b15_0 - b0), kt1 = kv1[j] * __builtin_amdgcn_exp2f(b15_1 - b1);
                kd0[j] = kt0 * el0; kd1[j] = kt1 * el1;
                if (PASS2) {
                    const float qt0 = bflo(qp[j]) * __builtin_amdgcn_exp2f(b0 - b15_0), qt1 = bfhi(qp[j]) * __builtin_amdgcn_exp2f(b1 - b15_1);
                    *(LAS unsigned*)(B + OFF_QT + l * QSB + 4 * kp) = pk2(qt0, qt1); *(LAS unsigned*)(B + OFF_QD + l * QSB + 4 * kp) = pk2(qt0 * e15_0, qt1 * e15_1);
                    *(LAS unsigned*)(B + OFF_KT + l * QSB + 4 * kp) = pk2(kt0, kt1);
                }
            }
            *(LAS u32x2*)(B + OFF_KDT + (2 * kp) * TSB + 8 * lo) = (u32x2){pk2(kd0[0], kd0[1]), pk2(kd0[2], kd0[3])};
            *(LAS u32x2*)(B + OFF_KDT + (2 * kp + 1) * TSB + 8 * lo) = (u32x2){pk2(kd1[0], kd1[1]), pk2(kd1[2], kd1[3])};
            *(LAS u32x2*)(B + OFF_VT + (2 * kp) * TSB + 8 * lo) = (u32x2){(vp[0] & 0xffffu) | (vp[1] << 16), (vp[2] & 0xffffu) | (vp[3] << 16)};
            *(LAS u32x2*)(B + OFF_VT + (2 * kp + 1) * TSB + 8 * lo) = (u32x2){(vp[0] >> 16) | (vp[1] & 0xffff0000u), (vp[2] >> 16) | (vp[3] & 0xffff0000u)};
            if (lo == 0) { *(LAS f32x2_t*)(B + OFF_DEC + 8 * kp) = (f32x2_t){__builtin_amdgcn_exp2f(bla0), __builtin_amdgcn_exp2f(bla1)}; gsum0 += bla0; gsum1 += bla1; }
        }
        HG_BAR();
        if (PASS2) {
            f32x4 p00 = {0.f, 0.f, 0.f, 0.f}, p01 = p00, p11 = p00;
#pragma unroll
            for (int s4 = 0; s4 < 4; ++s4) {
                const bf16x8 a0 = *(const LAS bf16x8*)(B + OFF_KT + c * QSB + 64 * s4 + 16 * q4), a1 = *(const LAS bf16x8*)(B + OFF_KT + (16 + c) * QSB + 64 * s4 + 16 * q4);
                const bf16x8 b0 = *(const LAS bf16x8*)(B + OFF_QT + c * QSB + 64 * s4 + 16 * q4), b1 = *(const LAS bf16x8*)(B + OFF_QT + (16 + c) * QSB + 64 * s4 + 16 * q4);
                p00 = HG_MFMA(a0, b0, p00); p01 = HG_MFMA(a0, b1, p01); p11 = HG_MFMA(a1, b1, p11);
            }
#pragma unroll
            for (int r = 0; r < 4; ++r) { const bool keep = (4 * q4 + r) <= c; p00[r] = keep ? p00[r] : 0.f; p11[r] = keep ? p11[r] : 0.f; }
            const bf16x8 bp0 = mk8(cvtpk(p00[0], p00[1]), cvtpk(p00[2], p00[3]), 0u, 0u);
            const bf16x8 bp1 = mk8(cvtpk(p01[0], p01[1]), cvtpk(p01[2], p01[3]), cvtpk(p11[0], p11[1]), cvtpk(p11[2], p11[3]));
            const u32x2 v0 = *(const LAS u32x2*)(B + OFF_VT + (16 * w + c) * TSB + 8 * q4), v1 = *(const LAS u32x2*)(B + OFF_VT + (16 * w + c) * TSB + 32 + 8 * q4);
            const bf16x8 va = mk8(v0.x, v0.y, v1.x, v1.y);
            f32x4 o0 = {0.f, 0.f, 0.f, 0.f}, o1 = o0;
            o0 = HG_MFMA(va, bp0, o0); o1 = HG_MFMA(va, bp1, o1);
#pragma unroll
            for (int s4 = 0; s4 < 4; ++s4) {
                const bf16x8 sa = mk8(cvtpk(S[2 * s4][0], S[2 * s4][1]), cvtpk(S[2 * s4][2], S[2 * s4][3]), cvtpk(S[2 * s4 + 1][0], S[2 * s4 + 1][1]), cvtpk(S[2 * s4 + 1][2], S[2 * s4 + 1][3]));
                const u32x2 x0 = *(const LAS u32x2*)(B + OFF_QD + c * QSB + 64 * s4 + 8 * q4), x1 = *(const LAS u32x2*)(B + OFF_QD + c * QSB + 64 * s4 + 32 + 8 * q4);
                const u32x2 y0 = *(const LAS u32x2*)(B + OFF_QD + (16 + c) * QSB + 64 * s4 + 8 * q4), y1 = *(const LAS u32x2*)(B + OFF_QD + (16 + c) * QSB + 64 * s4 + 32 + 8 * q4);
                o0 = HG_MFMA(sa, mk8(x0.x, x0.y, x1.x, x1.y), o0); o1 = HG_MFMA(sa, mk8(y0.x, y0.y, y1.x, y1.y), o1);
            }
            {
                const int ra = scan_row(32 * ci + c, d), rb = scan_row(32 * ci + 16 + c, d);
                *(u32x2*)(O + (size_t)ra * D + h * 128 + 16 * w + 4 * q4) = (u32x2){cvtpk(o0[0], o0[1]), cvtpk(o0[2], o0[3])};
                *(u32x2*)(O + (size_t)rb * D + h * 128 + 16 * w + 4 * q4) = (u32x2){cvtpk(o1[0], o1[1]), cvtpk(o1[2], o1[3])};
            }
        }
        {
            const bf16x8 vb = *(const LAS bf16x8*)(B + OFF_VT + (16 * w + c) * TSB + 16 * q4);
#pragma unroll
            for (int t = 0; t < 8; ++t) {
                const f32x4 dec = *(const LAS f32x4*)(B + OFF_DEC + (16 * t + 4 * q4) * 4);
                const bf16x8 ka = *(const LAS bf16x8*)(B + OFF_KDT + (16 * t + c) * TSB + 16 * q4);
                S[t] = HG_MFMA(ka, vb, S[t] * dec);
            }
        }
    }
    if (!PASS2) {
        float* sl = SLOC + (size_t)unit * 16384 + (size_t)w * 2048;
#pragma unroll
        for (int t = 0; t < 8; ++t)
#pragma unroll
            for (int r = 0; r < 4; ++r) sl[(t * 4 + r) * 64 + lane] = S[t][r];
        if (lo == 0) { GSUM[(size_t)unit * 128 + 2 * kp] = gsum0; GSUM[(size_t)unit * 128 + 2 * kp + 1] = gsum1; }
    }
#undef HG_FETCH
    }
}
}

DEVI void hgrn_readout_row(const P& p, int r, int lane, Row16& a, const Row16& b, const Row16& zg, const Row16& ng) {
    Row16 o; float s0 = 0.f, s1 = 0.f;
#pragma unroll
    for (int e = 0; e < 8; ++e) { a.v[e] += b.v[e]; a.v[8 + e] += b.v[8 + e]; s0 += a.v[e] * a.v[e]; s1 += a.v[8 + e] * a.v[8 + e]; }
    s0 = row16_sum(s0); s1 = row16_sum(s1);
    const float r0 = rsqrtf(s0 * (1.0f / 128.0f) + EPS), r1 = rsqrtf(s1 * (1.0f / 128.0f) + EPS);
#pragma unroll
    for (int e = 0; e < 8; ++e) { o.v[e] = a.v[e] * r0 * ng.v[e] * zg.v[e]; o.v[8 + e] = a.v[8 + e] * r1 * ng.v[8 + e] * zg.v[8 + e]; }
    store_row_bf16((bf16_t*)(p.ws + WS_U) + (size_t)r * D, lane, o);
}
DEVI void ph_hgrn_readout(const P& p) {
    const int otid_ = otid();
    const int wave = __builtin_amdgcn_readfirstlane(otid_ >> 6), lane = otid_ & 63, gw = blockIdx.x * NWV + wave, NGW = gridDim.x * NWV;
    Row16 ng; load_row_f32(p.in[I_HNG], lane, ng);
    for (int r = gw; r < MA; r += 2 * NGW) {
        const int r1 = r + NGW;
        Row16 a0, b0, z0, a1, b1, z1;
        load_row_bf16((const bf16_t*)(p.ws + WS_OF) + (size_t)r * D, lane, a0); load_row_bf16((const bf16_t*)(p.ws + WS_OB) + (size_t)r * D, lane, b0);
        load_row_bf16((const bf16_t*)(p.ws + WS_G) + (size_t)r * 5120 + 4096, lane, z0);
        if (r1 < MA) { load_row_bf16((const bf16_t*)(p.ws + WS_OF) + (size_t)r1 * D, lane, a1); load_row_bf16((const bf16_t*)(p.ws + WS_OB) + (size_t)r1 * D, lane, b1);
            load_row_bf16((const bf16_t*)(p.ws + WS_G) + (size_t)r1 * 5120 + 4096, lane, z1); }
        hgrn_readout_row(p, r, lane, a0, b0, z0, ng);
        if (r1 < MA) hgrn_readout_row(p, r1, lane, a1, b1, z1, ng);
    }
}

DEVI float reduce16(float (&v)[16], int lane) {
    float w8[8], w4[4], w2[2];
    const bool b5 = lane & 32, b4 = lane & 16, b3 = lane & 8, b2 = lane & 4;
#pragma unroll
    for (int i = 0; i < 8; ++i) { const float keep = b5 ? v[i + 8] : v[i], send = b5 ? v[i] : v[i + 8]; w8[i] = keep + __shfl_xor(send, 32); }
#pragma unroll
    for (int i = 0; i < 4; ++i) { const float keep = b4 ? w8[i + 4] : w8[i], send = b4 ? w8[i] : w8[i + 4]; w4[i] = keep + __shfl_xor(send, 16); }
#pragma unroll
    for (int i = 0; i < 2; ++i) { const float keep = b3 ? w4[i + 2] : w4[i], send = b3 ? w4[i] : w4[i + 2]; w2[i] = keep + __shfl_xor(send, 8); }
    const float keep = b2 ? w2[1] : w2[0], send = b2 ? w2[0] : w2[1];
    float r = keep + __shfl_xor(send, 4);
    r += __shfl_xor(r, 2); r += __shfl_xor(r, 1);
    return r;
}
namespace s5 {
typedef short bf16x8 __attribute__((ext_vector_type(8)));
constexpr int NSEG = 16, SEGLEN = MA / NSEG, CPS = SEGLEN / 16;
static_assert(SEGLEN * NSEG == MA && CPS * 16 == SEGLEN, "s5 segments");
constexpr int XSB = 272, BSB = 528, WAVE_LDS = 16 * BSB + 16 * XSB;
DEVI bf16x8 mk8(unsigned a, unsigned b, unsigned c, unsigned d) { u32x4 v = {a, b, c, d}; return __builtin_bit_cast(bf16x8, v); }
template <bool PASS2>
DEVI void scan(const P& p, unsigned char* lds_) {
    const int tid = otid(), lane = tid & 63, w = __builtin_amdgcn_readfirstlane(tid >> 6), c = lane & 15, q4 = lane >> 4;
    for (int blk = blockIdx.x; blk < 256; blk += gridDim.x) {
    const int dn = blk >> 7, seg = (blk >> 3) & 15, g = (blk & 7) * 8 + w;
    LAS unsigned char* BUS = (LAS unsigned char*)lds_ + w * WAVE_LDS; LAS unsigned char* XS = BUS + 16 * BSB;
    const bf16_t* XN = (const bf16_t*)(p.ws + WS_XN);
    bf16_t* Y = (bf16_t*)(p.ws + (dn ? WS_OB : WS_OF));
    float* XE = (float*)(p.ws + WS_XE);
    const float* Aab = (const float*)(p.ws + WS_S5A) + (size_t)((dn * 64 + g) * 64 + lane) * 2;
    const float abr = Aab[0], abi = Aab[1];
    bf16x8 bfr[8];
#pragma unroll
    for (int n = 0; n < 8; ++n) {
        if (q4 < 2) { const float* B = (const float*)(p.ws + WS_S5B) + (size_t)((dn * 64 + g) * 64 + 8 * n + (c >> 1)) * 32 + (c & 1) * 16 + 8 * q4;
            const f32x4 b0 = *(const f32x4*)B, b1 = *(const f32x4*)(B + 4); bfr[n] = mk8(pk2(b0[0], b0[1]), pk2(b0[2], b0[3]), pk2(b1[0], b1[1]), pk2(b1[2], b1[3])); }
        else bfr[n] = mk8(0u, 0u, 0u, 0u);
    }
    bf16x8 cfr[4];
    if (PASS2) {
#pragma unroll
        for (int s4 = 0; s4 < 4; ++s4) {
            const size_t o = ((size_t)(dn * 64 + g) * 16 + c) * 64 + 16 * s4 + 4 * q4;
            const f32x4 cr = *(const f32x4*)(p.in[I_S5CR] + o), ci = *(const f32x4*)(p.in[I_S5CI] + o);
            cfr[s4] = mk8(pk2(cr[0], -ci[0]), pk2(cr[1], -ci[1]), pk2(cr[2], -ci[2]), pk2(cr[3], -ci[3]));
        }
    }
    float xr = 0.f, xi = 0.f;
    if (PASS2 && seg > 0) {
        float pr = 1.f, pi = 0.f, br = abr, bi = abi;
#define S5_PIN(x) asm volatile("" : "+v"(x))
#pragma unroll 1
        for (int n = SEGLEN; n; n >>= 1) {
            if (n & 1) { float t = pr * br; S5_PIN(t); t = __builtin_fmaf(-pi, bi, t); S5_PIN(t); float u = pr * bi; S5_PIN(u); u = __builtin_fmaf(pi, br, u); S5_PIN(u); pr = t; pi = u; }
            float t2 = br * br; S5_PIN(t2); t2 = __builtin_fmaf(-bi, bi, t2); S5_PIN(t2); float u2 = 2.f * br * bi; S5_PIN(u2); br = t2; bi = u2;
        }
        for (int j = 0; j < seg; ++j) { const float* e = XE + ((size_t)((dn * 64 + g) * 16 + j) * 64 + lane) * 2; const float er = e[0], ei = e[1];
            float t = __builtin_fmaf(pr, xr, er); S5_PIN(t); t = __builtin_fmaf(-pi, xi, t); S5_PIN(t); float u = __builtin_fmaf(pr, xi, ei); S5_PIN(u); u = __builtin_fmaf(pi, xr, u); S5_PIN(u); xr = t; xi = u; }
#undef S5_PIN
    }
    const int n0 = seg * SEGLEN;
    const unsigned amask = q4 < 2 ? 0xffffffffu : 0u;
    u32x4 araw = *(const u32x4*)(XN + (size_t)scan_row(n0 + c, dn) * D + g * 16 + 8 * (q4 & 1));
#pragma unroll 1
    for (int cc = 0; cc < CPS; ++cc) {
        const u32x4 am = {araw[0] & amask, araw[1] & amask, araw[2] & amask, araw[3] & amask};
        const bf16x8 afr = __builtin_bit_cast(bf16x8, am);
        { const int cn = cc + 1 < CPS ? cc + 1 : cc; araw = *(const u32x4*)(XN + (size_t)scan_row(n0 + 16 * cn + c, dn) * D + g * 16 + 8 * (q4 & 1)); }
#pragma unroll
        for (int n = 0; n < 8; ++n) {
            const f32x4 dv = __builtin_amdgcn_mfma_f32_16x16x32_bf16(bfr[n], afr, (f32x4){0.f, 0.f, 0.f, 0.f}, 0, 0, 0);
            *(LAS f32x4*)(BUS + c * BSB + (16 * n + 4 * q4) * 4) = dv;
        }
        asm volatile("s_waitcnt lgkmcnt(0)" ::: "memory");
        f32x2_t bu[16];
#pragma unroll
        for (int t = 0; t < 16; ++t) bu[t] = *(const LAS f32x2_t*)(BUS + t * BSB + 8 * lane);
        unsigned xs[16];
#pragma unroll
        for (int t = 0; t < 16; ++t) {
            float nr = __builtin_fmaf(abr, xr, bu[t].x); asm volatile("" : "+v"(nr)); nr = __builtin_fmaf(-abi, xi, nr); asm volatile("" : "+v"(nr));
            float ni = __builtin_fmaf(abr, xi, bu[t].y); asm volatile("" : "+v"(ni)); ni = __builtin_fmaf(abi, xr, ni); asm volatile("" : "+v"(ni));
            xr = nr; xi = ni;
            if (PASS2) xs[t] = pk2(xr, xi);
        }
        if (PASS2) {
#pragma unroll
            for (int t = 0; t < 16; ++t) *(LAS unsigned*)(XS + t * XSB + 4 * lane) = xs[t];
        }
        asm volatile("s_waitcnt lgkmcnt(0)" ::: "memory");
        if (PASS2) {
            f32x4 y = {0.f, 0.f, 0.f, 0.f};
#pragma unroll
            for (int s4 = 0; s4 < 4; ++s4) { const bf16x8 xf = *(const LAS bf16x8*)(XS + c * XSB + 64 * s4 + 16 * q4); y = __builtin_amdgcn_mfma_f32_16x16x32_bf16(cfr[s4], xf, y, 0, 0, 0); }
            *(u32x2*)(Y + (size_t)scan_row(n0 + 16 * cc + c, dn) * D + g * 16 + 4 * q4) = (u32x2){pk2(y[0], y[1]), pk2(y[2], y[3])};
        }
    }
    if (!PASS2) { float* e = XE + ((size_t)((dn * 64 + g) * 16 + seg) * 64 + lane) * 2; e[0] = xr; e[1] = xi; }
    }
}
}

DEVI void ph_s5_elem(const P& p) {
    const int otid_ = otid();
    const int wave = __builtin_amdgcn_readfirstlane(otid_ >> 6), lane = otid_ & 63, gw = blockIdx.x * NWV + wave, NGW = gridDim.x * NWV;
    Row16 dd; load_row_f32(p.in[I_S5D], lane, dd);
    for (int r = gw; r < MA; r += 2 * NGW) {
        const int r1 = r + NGW;
        Row16 u0, a0, b0, u1, a1, b1, o;
        load_row_bf16((const bf16_t*)(p.ws + WS_XN) + (size_t)r * D, lane, u0);
        load_row_bf16((const bf16_t*)(p.ws + WS_OF) + (size_t)r * D, lane, a0); load_row_bf16((const bf16_t*)(p.ws + WS_OB) + (size_t)r * D, lane, b0);
        if (r1 < MA) { load_row_bf16((const bf16_t*)(p.ws + WS_XN) + (size_t)r1 * D, lane, u1);
            load_row_bf16((const bf16_t*)(p.ws + WS_OF) + (size_t)r1 * D, lane, a1); load_row_bf16((const bf16_t*)(p.ws + WS_OB) + (size_t)r1 * D, lane, b1); }
#pragma unroll
        for (int e = 0; e < 16; ++e) o.v[e] = geluf_(dd.v[e] * u0.v[e] + a0.v[e] + b0.v[e]);
        store_row_bf16((bf16_t*)(p.ws + WS_U) + (size_t)r * D, lane, o);
        if (r1 < MA) {
#pragma unroll
            for (int e = 0; e < 16; ++e) o.v[e] = geluf_(dd.v[e] * u1.v[e] + a1.v[e] + b1.v[e]);
            store_row_bf16((bf16_t*)(p.ws + WS_U) + (size_t)r1 * D, lane, o);
        }
    }
}
DEVI float score_key(float s, int e) { return __uint_as_float((__float_as_uint(s) & 0xffffff80u) | (unsigned)e); }
DEVI float key_score(float k) { return k; }
DEVI int key_idx(float k) { return (int)(__float_as_uint(k) & 127u); }
DEVI float h2f_lo(unsigned w) { return (float)__builtin_bit_cast(pg8::f16x2_t, w).x; }
DEVI float h2f_hi(unsigned w) { return (float)__builtin_bit_cast(pg8::f16x2_t, w).y; }
DEVI void topk_wave_item(const P& p, int layer, int r, int h, int lane) {
    const unsigned short* s = (const unsigned short*)(p.ws + WS_SCH) + (size_t)r * 2048 + h * 256;
    const unsigned w0 = *(const unsigned*)(s + 2 * lane), w1 = *(const unsigned*)(s + 128 + 2 * lane);
    const float NEG = -__builtin_inff();
    float k00 = score_key(h2f_lo(w0), 2 * lane), k01 = score_key(h2f_hi(w0), 2 * lane + 1), k10 = score_key(h2f_lo(w1), 2 * lane), k11 = score_key(h2f_hi(w1), 2 * lane + 1);
    float A[16], B[16];
#pragma unroll
    for (int i = 0; i < 16; ++i) {
        const float ma = wave_max_f(__builtin_fmaxf(k00, k01)), mb = wave_max_f(__builtin_fmaxf(k10, k11));
        A[i] = ma; B[i] = mb;
        k00 = (k00 == ma) ? NEG : k00; k01 = (k01 == ma) ? NEG : k01; k10 = (k10 == mb) ? NEG : k10; k11 = (k11 == mb) ? NEG : k11;
    }
    int ci = -1, cj = 0, base = 0;
#pragma unroll
    for (int i = 0; i < 16; ++i) { const int cnt = 16 / (i + 1); if (ci < 0 && lane < base + cnt) { ci = i; cj = lane - base; } base += cnt; }
    float av = A[0], bv = B[0];
#pragma unroll
    for (int i = 1; i < 16; ++i) { av = (ci == i) ? A[i] : av; bv = (cj == i) ? B[i] : bv; }
    const int payload = key_idx(av) * 128 + key_idx(bv);
    const float sum = key_score(av) + key_score(bv);
    float ck = (ci >= 0) ? __uint_as_float((__float_as_uint(sum) & 0xffffffc0u) | (unsigned)lane) : NEG;
    float mys = 0.f, best = 0.f; int myidx = 0;
#pragma unroll
    for (int j = 0; j < 16; ++j) {
        const float mm = wave_max_f(ck);
        const int src = __builtin_amdgcn_readfirstlane((int)(__float_as_uint(mm) & 63u));
        const int pl = __builtin_amdgcn_readlane(payload, src);
        if (lane == j) { mys = mm; myidx = pl; }
        if (j == 0) best = mm;
        ck = (lane == src) ? NEG : ck;
    }
    const float e = lane < 16 ? __expf(mys - best) : 0.f;
    const float tot = wave_sum(e);
    if (lane < 16) {
        const f32x2_t sc2 = ((const f32x2_t*)(p.ws + WS_SCL) + (size_t)layer * 16384)[myidx];
        const size_t o = (size_t)r * 128 + h * 16 + lane;
        ((int*)(p.ws + WS_SELI))[o] = myidx; ((float*)(p.ws + WS_SELG))[o] = e / tot * sc2.y; ((float*)(p.ws + WS_SELU))[o] = sc2.x;
    }
}
constexpr int TK_ITEM_B = 144;
DEVI void ph_topk(const P& p, int layer, int r0, unsigned char* lds_) {
    const int otid_ = otid();
    const int wave = otid_ >> 6, lane = otid_ & 63;
    const int nall = (MA - r0) * 8, nthr = (int)gridDim.x * NTHR;
    const int nleft = nall % nthr;
    const int nitems = (nleft > 0 && nleft <= nthr / 8) ? nall - nleft : nall;
    for (int e = blockIdx.x * NWV + wave + nitems; e < nall; e += (int)gridDim.x * NWV) topk_wave_item(p, layer, r0 + (e >> 3), e & 7, lane);
    const unsigned char* SCb = (const unsigned char*)(p.ws + WS_SCH);
    LAS unsigned char* tile = (LAS unsigned char*)lds_ + wave * (64 * TK_ITEM_B);
    for (int it = blockIdx.x * NTHR + otid_; it < nitems; it += gridDim.x * NTHR) {
        const int r = r0 + (it >> 3), h = it & 7;
        const unsigned char* wbase = SCb + ((size_t)(r0 + ((it - lane) >> 3)) * 2048) * 2;
        const unsigned goff = (unsigned)(lane >> 3) * 512u + 16u * (unsigned)(lane & 7);
        u32x4 g[8];
#pragma unroll
        for (int j = 0; j < 8; ++j) g[j] = *(const u32x4*)(wbase + goff + 4096 * j);
        float L0[16], L1[16];
#pragma unroll 1
        for (int k = 0; k < 4; ++k) {
#pragma unroll
            for (int j = 0; j < 8; ++j) *(LAS u32x4*)(tile + (8 * j + (lane >> 3)) * TK_ITEM_B + 16 * (lane & 7)) = g[j];
            if (k < 3) {
#pragma unroll
                for (int j = 0; j < 8; ++j) g[j] = *(const u32x4*)(wbase + goff + 4096 * j + 128 * (k + 1));
            }
            u32x4 m[8];
#pragma unroll
            for (int i = 0; i < 8; ++i) m[i] = *(const LAS u32x4*)(tile + lane * TK_ITEM_B + 16 * i);
            float L[16];
            if (k & 1) {
#pragma unroll
                for (int j = 0; j < 16; ++j) L[j] = (k == 1) ? L0[j] : L1[j];
            } else {
#pragma unroll
                for (int j = 0; j < 16; ++j) L[j] = -__builtin_inff();
            }
            const int ebase = 64 * (k & 1);
#pragma unroll
            for (int gq = 0; gq < 4; ++gq) {
                float G[16];
#pragma unroll
                for (int e = 0; e < 16; ++e) { const unsigned wd = m[2 * gq + (e >> 3)][(e & 7) >> 1]; G[e] = score_key((e & 1) ? h2f_hi(wd) : h2f_lo(wd), ebase + 16 * gq + e); }
#define CE(a, b) { const float hi_ = __builtin_fmaxf(G[a], G[b]), lo_ = __builtin_fminf(G[a], G[b]); G[a] = hi_; G[b] = lo_; }
                CE(0,1) CE(2,3) CE(0,2) CE(1,3) CE(1,2) CE(4,5) CE(6,7) CE(4,6) CE(5,7) CE(5,6) CE(0,4) CE(2,6) CE(2,4) CE(1,5) CE(3,7) CE(3,5) CE(1,2) CE(3,4) CE(5,6) CE(8,9) CE(10,11) CE(8,10) CE(9,11) CE(9,10) CE(12,13) CE(14,15) CE(12,14) CE(13,15) CE(13,14) CE(8,12) CE(10,14) CE(10,12) CE(9,13) CE(11,15) CE(11,13) CE(9,10) CE(11,12) CE(13,14) CE(0,8) CE(4,12) CE(4,8) CE(2,10) CE(6,14) CE(6,10) CE(2,4) CE(6,8) CE(10,12) CE(1,9) CE(5,13) CE(5,9) CE(3,11) CE(7,15) CE(7,11) CE(3,5) CE(7,9) CE(11,13) CE(1,2) CE(3,4) CE(5,6) CE(7,8) CE(9,10) CE(11,12) CE(13,14)
#undef CE
#pragma unroll
                for (int i = 0; i < 16; ++i) L[i] = __builtin_fmaxf(L[i], G[15 - i]);
#pragma unroll
                for (int jj = 8; jj > 0; jj >>= 1)
#pragma unroll
                    for (int i = 0; i < 16; ++i) { const int l = i ^ jj; if (l > i) { const float hi = __builtin_fmaxf(L[i], L[l]), lo = __builtin_fminf(L[i], L[l]); L[i] = hi; L[l] = lo; } }
            }
            if (k < 2) {
#pragma unroll
                for (int j = 0; j < 16; ++j) L0[j] = L[j];
            } else {
#pragma unroll
                for (int j = 0; j < 16; ++j) L1[j] = L[j];
            }
        }
        const float amx = __builtin_fmaxf(__builtin_fmaxf(__builtin_fabsf(L0[0]), __builtin_fabsf(L0[15])), __builtin_fmaxf(__builtin_fabsf(L1[0]), __builtin_fabsf(L1[15])));
        const float ksc = 65000.0f / __builtin_fmaxf(amx, 1e-30f), kinv = 1.0f / (ksc * 16384.0f);
        int KA[16], KB[16];
#pragma unroll
        for (int j = 0; j < 16; ++j) { KA[j] = ((int)__builtin_rintf(L0[j] * ksc) << 14) | (key_idx(L0[j]) << 7); KB[j] = ((int)__builtin_rintf(L1[j] * ksc) << 14) | key_idx(L1[j]); }
        int fk[16];
#pragma unroll
        for (int j = 0; j < 16; ++j) fk[j] = KA[0] + KB[j];
#pragma unroll
        for (int i = 1; i < 16; ++i)
#pragma unroll
            for (int j = 0; j < 16; ++j)
                if ((i + 1) * (j + 1) <= 16) {
                    int xk = KA[i] + KB[j];
#pragma unroll
                    for (int q = 0; q < 16; ++q) if (q >= (i + 1) * (j + 1) - 1) { const int hi = xk > fk[q] ? xk : fk[q], lo = xk > fk[q] ? fk[q] : xk; fk[q] = hi; xk = lo; }
                }
        float fs[16]; int fi[16];
#pragma unroll
        for (int j = 0; j < 16; ++j) { fs[j] = (float)fk[j] * kinv; fi[j] = fk[j] & 16383; }
        float sum = 0.f, e[16];
#pragma unroll
        for (int j = 0; j < 16; ++j) { e[j] = __expf(fs[j] - fs[0]); sum += e[j]; }
        const float inv = 1.0f / sum;
        const f32x2_t* SC2 = (const f32x2_t*)(p.ws + WS_SCL) + (size_t)layer * 16384;
        float su[16];
#pragma unroll
        for (int j = 0; j < 16; ++j) { const f32x2_t sc2 = SC2[fi[j]]; su[j] = sc2.x; e[j] = e[j] * inv * sc2.y; }
        i32x4* oi = (i32x4*)((int*)(p.ws + WS_SELI) + (size_t)r * 128 + h * 16); f32x4* og = (f32x4*)((float*)(p.ws + WS_SELG) + (size_t)r * 128 + h * 16); f32x4* ou = (f32x4*)((float*)(p.ws + WS_SELU) + (size_t)r * 128 + h * 16);
#pragma unroll
        for (int j = 0; j < 4; ++j) { oi[j] = (i32x4){fi[4 * j], fi[4 * j + 1], fi[4 * j + 2], fi[4 * j + 3]}; og[j] = (f32x4){e[4 * j], e[4 * j + 1], e[4 * j + 2], e[4 * j + 3]}; ou[j] = (f32x4){su[4 * j], su[4 * j + 1], su[4 * j + 2], su[4 * j + 3]}; }
    }
}

DEVI void fmac_vv(float& acc, float a, float b) { asm("v_fmac_f32 %0, %1, %2" : "+v"(acc) : "v"(a), "v"(b)); }

DEVI void pkfma(f32x2_t& acc, f32x2_t a, f32x2_t b) { asm("v_pk_fma_f32 %0, %1, %2, %0" : "+v"(acc) : "v"(a), "v"(b)); }
DEVI float dot16_i8(const u32x4 q, const u32x4 h) {
    int a = __builtin_amdgcn_sdot4((int)q[0], (int)h[0], 0, false); a = __builtin_amdgcn_sdot4((int)q[1], (int)h[1], a, false);
    a = __builtin_amdgcn_sdot4((int)q[2], (int)h[2], a, false); a = __builtin_amdgcn_sdot4((int)q[3], (int)h[3], a, false);
    return (float)a;
}
template <int HI, bool FIRST> DEVI void pkfma_bc(f32x2_t& acc, f32x2_t wp, f32x2_t b) {
    if (FIRST) {
        if (HI) asm volatile("v_pk_mul_f32 %0, %1, %2 op_sel:[1,0] op_sel_hi:[1,1]" : "=&v"(acc) : "v"(wp), "v"(b));
        else    asm volatile("v_pk_mul_f32 %0, %1, %2 op_sel:[0,0] op_sel_hi:[0,1]" : "=&v"(acc) : "v"(wp), "v"(b));
    } else {
        if (HI) asm volatile("v_pk_fma_f32 %0, %1, %2, %0 op_sel:[1,0,0] op_sel_hi:[1,1,1]" : "+v"(acc) : "v"(wp), "v"(b));
        else    asm volatile("v_pk_fma_f32 %0, %1, %2, %0 op_sel:[0,0,0] op_sel_hi:[0,1,1]" : "+v"(acc) : "v"(wp), "v"(b));
    }
}
template <int HI, bool FIRST> DEVI void axpy16_fp8(const u32x4 q, f32x2_t wp, f32x2_t (&acc)[8]) {
#pragma unroll
    for (int j = 0; j < 4; ++j) { const f32x2_t lo = __builtin_amdgcn_cvt_pk_f32_fp8(q[j], false), hi = __builtin_amdgcn_cvt_pk_f32_fp8(q[j], true); pkfma_bc<HI, FIRST>(acc[2 * j], wp, lo); pkfma_bc<HI, FIRST>(acc[2 * j + 1], wp, hi); }
}
template <int K, bool FIRST> DEVI void axpy_row(const u32x4 q, const f32x4 w4, f32x2_t (&acc)[8]) {
    const f32x2_t wp = (K & 2) ? __builtin_shufflevector(w4, w4, 2, 3) : __builtin_shufflevector(w4, w4, 0, 1);
    axpy16_fp8<K & 1, FIRST>(q, wp, acc);
}
DEVI void swap32f(float& a, float& b) { const auto r = __builtin_amdgcn_permlane32_swap(__float_as_uint(a), __float_as_uint(b), false, false); a = __uint_as_float(r[0]); b = __uint_as_float(r[1]); }
DEVI void swap16f(float& a, float& b) { const auto r = __builtin_amdgcn_permlane16_swap(__float_as_uint(a), __float_as_uint(b), false, false); a = __uint_as_float(r[0]); b = __uint_as_float(r[1]); }
struct SliceGeo { int x, rank, n; };
struct Seg8 { u32x4 q[8]; };
struct Idx16 { i32x4 v[4]; };
DEVI void idx16_load(Idx16& I, const int* SI, int t, int r8) { const i32x4* s = (const i32x4*)(SI + (size_t)t * 128 + r8 * 16); I.v[0] = s[0]; I.v[1] = s[1]; I.v[2] = s[2]; I.v[3] = s[3]; }
DEVI void seg8_load(Seg8& s, const __amdgpu_buffer_rsrc_t tab, const Idx16& I, int half, unsigned coff) {
#pragma unroll
    for (int k = 0; k < 8; ++k) { const int row = I.v[2 * half + (k >> 2)][k & 3]; s.q[k] = __builtin_amdgcn_raw_buffer_load_b128(tab, (unsigned)row * 128u + coff, 0, 0); }
}
DEVI float reduce8_c8(const float (&d)[8], int lane) {
    const bool b2 = lane & 4, b1 = lane & 2, b0 = lane & 1;
    float r4[4], r2[2];
#pragma unroll
    for (int i = 0; i < 4; ++i) { const float keep = b2 ? d[i + 4] : d[i], send = b2 ? d[i] : d[i + 4]; r4[i] = keep + __shfl_xor(send, 4); }
#pragma unroll
    for (int i = 0; i < 2; ++i) { const float keep = b1 ? r4[i + 2] : r4[i], send = b1 ? r4[i] : r4[i + 2]; r2[i] = keep + __shfl_xor(send, 2); }
    const float keep = b0 ? r2[1] : r2[0], send = b0 ? r2[0] : r2[1];
    return keep + __shfl_xor(send, 1);
}
struct Seg16 { u32x4 q[16]; };
template <int M> DEVI void peer_u_mm(const __amdgpu_buffer_rsrc_t PU, Seg16& Q, const Idx16& In, const i32x4 (&hc)[2], unsigned coff, i32x4 (&acc)[8]) {
    asm volatile("" : "+v"(Q.q[M]));
    if (M & 1) acc[M >> 1] = __builtin_amdgcn_mfma_i32_16x16x64_i8(hc[1], (i32x4)Q.q[M], acc[M >> 1], 0, 0, 0);
    else       acc[M >> 1] = __builtin_amdgcn_mfma_i32_16x16x64_i8(hc[0], (i32x4)Q.q[M], (i32x4){0, 0, 0, 0}, 0, 0, 0);
    Q.q[M] = __builtin_amdgcn_raw_buffer_load_b128(PU, (unsigned)In.v[M >> 2][M & 3] * 128u + coff, 0, 0);
    asm volatile("" ::: "memory");
}
DEVI int qp_xor2(int v) { return __builtin_amdgcn_update_dpp(0, v, 0x4E, 0xf, 0xf, true); }
DEVI int qp_xor1(int v) { return __builtin_amdgcn_update_dpp(0, v, 0xB1, 0xf, 0xf, true); }
typedef unsigned u32x2 __attribute__((ext_vector_type(2)));
DEVI u32x2 slot_raw_load(const void* base, int t, int lane) { return *(const u32x2*)((const unsigned*)base + (size_t)t * 128 + 2 * lane); }
DEVI void slot_redist(LAS unsigned char* wl, const u32x2 raw, int lane, int l8, Idx16& I) {
    *(LAS u32x2*)(wl + 8 * lane) = raw;
    const LAS i32x4* s = (const LAS i32x4*)(wl + 64 * l8);
    I.v[0] = s[0]; I.v[1] = s[1]; I.v[2] = s[2]; I.v[3] = s[3];
}
DEVI void peer_u_token(const __amdgpu_buffer_rsrc_t PU, const int* SI, const unsigned char* H8, const float* HS, unsigned* PREP, LAS unsigned char* wl, int t, int t1, int t3, int x, int lane, int l8,
                       unsigned coff, bool act0, bool act1, const Idx16& In, Idx16& Inn, const u32x2 rawUse, u32x2& rawLoad, const i32x4 hraw, i32x4& hrawN, Seg16& Q) {
    rawLoad = slot_raw_load(SI, t3, lane);
    hrawN = *(const i32x4*)(H8 + (size_t)t1 * D);
    asm volatile("" ::: "memory");
    i32x4 hc[2];
#pragma unroll
    for (int e = 0; e < 4; ++e) { hc[0][e] = act0 ? hraw[e] : 0; hc[1][e] = act1 ? hraw[e] : 0; }
    i32x4 acc[8];
    peer_u_mm<0>(PU, Q, In, hc, coff, acc); peer_u_mm<1>(PU, Q, In, hc, coff, acc); peer_u_mm<2>(PU, Q, In, hc, coff, acc); peer_u_mm<3>(PU, Q, In, hc, coff, acc);
    peer_u_mm<4>(PU, Q, In, hc, coff, acc); peer_u_mm<5>(PU, Q, In, hc, coff, acc); peer_u_mm<6>(PU, Q, In, hc, coff, acc); peer_u_mm<7>(PU, Q, In, hc, coff, acc);
    peer_u_mm<8>(PU, Q, In, hc, coff, acc); peer_u_mm<9>(PU, Q, In, hc, coff, acc); peer_u_mm<10>(PU, Q, In, hc, coff, acc); peer_u_mm<11>(PU, Q, In, hc, coff, acc);
    peer_u_mm<12>(PU, Q, In, hc, coff, acc); peer_u_mm<13>(PU, Q, In, hc, coff, acc); peer_u_mm<14>(PU, Q, In, hc, coff, acc); peer_u_mm<15>(PU, Q, In, hc, coff, acc);
    slot_redist(wl, rawUse, lane, l8, Inn);
    const bool c1 = lane & 1, c2 = lane & 2;
    int w[8], r4[4], f[2];
#pragma unroll
    for (int a = 0; a < 8; ++a) { const int lo = c1 ? acc[a][1] : acc[a][0], hi = c1 ? acc[a][3] : acc[a][2]; w[a] = c2 ? hi : lo; }
#pragma unroll
    for (int i = 0; i < 4; ++i) { const int keep = c2 ? w[4 + i] : w[i], send = c2 ? w[i] : w[4 + i]; r4[i] = keep + qp_xor2(send); }
#pragma unroll
    for (int i = 0; i < 2; ++i) { const int keep = c1 ? r4[2 + i] : r4[i], send = c1 ? r4[i] : r4[2 + i]; f[i] = keep + qp_xor1(send); }
    PREP[((size_t)t * 8 + x) * 64 + lane] = pk2((float)f[0], (float)f[1]);
}
DEVI void ph_peer_u(const P& p, int layer, int r0, const SliceGeo sg, unsigned char* lds) {
    const int otid_ = otid();
    const int wave = otid_ >> 6, lane = otid_ & 63, q = lane >> 4, j = lane & 15;
    const int x = __builtin_amdgcn_readfirstlane(sg.x), nws = __builtin_amdgcn_readfirstlane(sg.n * NWV);
    const __amdgpu_buffer_rsrc_t PU = __builtin_amdgcn_make_buffer_rsrc((void*)(p.ws + WS_PU + (size_t)layer * 16384 * 1024 + (size_t)x * 16384 * 128), (short)0, 16384 * 128, 0x00020000);
    const int* SI = (const int*)(p.ws + WS_SELI); const float* HS = (const float*)(p.ws + WS_HS);
    unsigned* PREP = (unsigned*)(p.ws + WS_SC);
    LAS unsigned char* wl = (LAS unsigned char*)lds + 1024 * wave;
    const int l8 = (q >> 1) * 4 + (j >> 2);
    const unsigned coff = 64u * (q & 1) + 16u * (j & 3);
    const unsigned char* H8 = p.ws + WS_H8 + 128 * x + coff;
    const bool act = (q >> 1) == ((j >> 2) & 1), act0 = act && (j >> 3) == 0, act1 = act && (j >> 3) == 1;
    int t = __builtin_amdgcn_readfirstlane(r0 + sg.rank * NWV + wave);
    if (t >= MA) return;
    Idx16 I0, I1; idx16_load(I0, SI, t, l8);
    asm volatile("" ::: "memory");
    u32x2 R0, R1; i32x4 H0, H1;
    { const int t1 = t + nws < MA ? t + nws : t, t2 = t + 2 * nws < MA ? t + 2 * nws : t1; idx16_load(I1, SI, t1, l8); R0 = slot_raw_load(SI, t2, lane); }
    H0 = *(const i32x4*)(H8 + (size_t)t * D);
    asm volatile("" ::: "memory");
    Seg16 Q;
#pragma unroll
    for (int k = 0; k < 16; ++k) { Q.q[k] = __builtin_amdgcn_raw_buffer_load_b128(PU, (unsigned)I0.v[k >> 2][k & 3] * 128u + coff, 0, 0); asm volatile("" ::: "memory"); }
    while (t < MA) {
        const int t1 = t + nws < MA ? t + nws : t, t2 = t + 2 * nws < MA ? t + 2 * nws : t1, t3 = t + 3 * nws < MA ? t + 3 * nws : t2, t4 = t + 4 * nws < MA ? t + 4 * nws : t3;
        peer_u_token(PU, SI, H8, HS, PREP, wl, t, t1, t3, x, lane, l8, coff, act0, act1, I1, I0, R0, R1, H0, H1, Q);
        peer_u_token(PU, SI, H8, HS, PREP, wl, t1, t2, t4, x, lane, l8, coff, act0, act1, I0, I1, R1, R0, H1, H0, Q);
        t += 2 * nws;
    }
}
struct PwLoad { unsigned pw[8]; float su0, su1, sg0, sg1, hs; };
DEVI void peer_w_load(PwLoad& L, const P& p, int t, int lane, int sa, int sb) {
    const unsigned* pp = (const unsigned*)(p.ws + WS_SC) + (size_t)t * 512 + lane;
    const float* SG = (const float*)(p.ws + WS_SELG) + (size_t)t * 128; const float* SU = (const float*)(p.ws + WS_SELU) + (size_t)t * 128;
#pragma unroll
    for (int xx = 0; xx < 8; ++xx) L.pw[xx] = pp[xx * 64];
    L.su0 = SU[sa]; L.su1 = SU[sb]; L.sg0 = SG[sa]; L.sg1 = SG[sb]; L.hs = ((const float*)(p.ws + WS_HS))[t];
}
DEVI void peer_w_finish(const PwLoad& L, const P& p, int t, int lane, int sa, int sb) {
    float p0 = 0.f, p1 = 0.f;
#pragma unroll
    for (int xx = 0; xx < 8; ++xx) { p0 += bflo(L.pw[xx]); p1 += bfhi(L.pw[xx]); }
    const float w0 = geluf_(p0 * (L.hs * L.su0)) * L.sg0, w1 = geluf_(p1 * (L.hs * L.su1)) * L.sg1;
    const float amax = wave_max_f(fmaxf(fabsf(w0), fabsf(w1)));
    const float sc = amax > 0.f ? 224.0f / amax : 1.0f;
    const float a0 = w0 * sc, a1 = w1 * sc;
    const unsigned hi = __builtin_amdgcn_cvt_pk_fp8_f32(a0, a1, 0u, false);
    const float h0 = __builtin_amdgcn_cvt_f32_fp8(hi, 0), h1 = __builtin_amdgcn_cvt_f32_fp8(hi, 1);
    const unsigned lo = __builtin_amdgcn_cvt_pk_fp8_f32(a0 - h0, a1 - h1, 0u, false);
    unsigned char* wt = p.ws + WS_SELU + (size_t)t * 512;
    wt[sa] = (unsigned char)(hi & 0xffu); wt[sb] = (unsigned char)((hi >> 8) & 0xffu); wt[128 + sa] = (unsigned char)(lo & 0xffu); wt[128 + sb] = (unsigned char)((lo >> 8) & 0xffu);
    if (lane == 0) *(float*)(wt + 256) = 1.0f / sc;
}
DEVI void ph_peer_w(const P& p, int r0) {
    const int otid_ = otid();
    const int wave = otid_ >> 6, lane = otid_ & 63, gw = blockIdx.x * NWV + wave, NGW = gridDim.x * NWV;
    const int sa = (4 * ((lane >> 4) & 1) + ((lane >> 2) & 3)) * 16 + 4 * (lane & 3) + (lane >> 5), sb = sa + 2;
    for (int t = r0 + gw; t < MA; t += 2 * NGW) {
        const int t1 = t + NGW;
        PwLoad A, B;
        peer_w_load(A, p, t, lane, sa, sb);
        if (t1 < MA) peer_w_load(B, p, t1, lane, sa, sb);
        asm volatile("" ::: "memory");
        peer_w_finish(A, p, t, lane, sa, sb);
        if (t1 < MA) peer_w_finish(B, p, t1, lane, sa, sb);
    }
}
template <int M> DEVI void peer_v_mm(const __amdgpu_buffer_rsrc_t PV, Seg16& Q, const i32x4 WH, const i32x4 WL, const Idx16& In, unsigned coff, const unsigned (&sel0)[4], const unsigned (&sel1)[4], f32x4 (&acc)[4]) {
    asm volatile("" : "+v"(Q.q[M]));
    const unsigned sh = (unsigned)WH[M >> 2], sl = (unsigned)WL[M >> 2];
    const unsigned h0 = __builtin_amdgcn_perm(sh, sh, sel0[M & 3]), h1 = __builtin_amdgcn_perm(sh, sh, sel1[M & 3]);
    const unsigned l0 = __builtin_amdgcn_perm(sl, sl, sel0[M & 3]), l1 = __builtin_amdgcn_perm(sl, sl, sel1[M & 3]);
    const long AH = (long)(((unsigned long)h1 << 32) | (unsigned long)h0), AL = (long)(((unsigned long)l1 << 32) | (unsigned long)l0);
    const long B0 = (long)(((unsigned long)Q.q[M][1] << 32) | (unsigned long)Q.q[M][0]), B1 = (long)(((unsigned long)Q.q[M][3] << 32) | (unsigned long)Q.q[M][2]);
    acc[0] = __builtin_amdgcn_mfma_f32_16x16x32_fp8_fp8(AH, B0, acc[0], 0, 0, 0); acc[1] = __builtin_amdgcn_mfma_f32_16x16x32_fp8_fp8(AH, B1, acc[1], 0, 0, 0);
    acc[2] = __builtin_amdgcn_mfma_f32_16x16x32_fp8_fp8(AL, B0, acc[2], 0, 0, 0); acc[3] = __builtin_amdgcn_mfma_f32_16x16x32_fp8_fp8(AL, B1, acc[3], 0, 0, 0);
    Q.q[M] = __builtin_amdgcn_raw_buffer_load_b128(PV, (unsigned)In.v[M >> 2][M & 3] * 128u + coff, 0, 0);
    asm volatile("" ::: "memory");
}
DEVI void ph_peer_v(const P& p, int layer, int r0, const SliceGeo sg, unsigned char* lds) {
    const int otid_ = otid();
    const int wave = otid_ >> 6, lane = otid_ & 63, q = lane >> 4, j = lane & 15;
    const int x = __builtin_amdgcn_readfirstlane(sg.x), nws = __builtin_amdgcn_readfirstlane(sg.n * NWV);
    const __amdgpu_buffer_rsrc_t PV = __builtin_amdgcn_make_buffer_rsrc((void*)(p.ws + WS_PV + (size_t)layer * 16384 * 1024 + (size_t)x * 16384 * 128), (short)0, 16384 * 128, 0x00020000);
    const int* SI = (const int*)(p.ws + WS_SELI); const unsigned char* W8 = p.ws + WS_SELU;
    bf16_t* OUTP = (bf16_t*)(p.ws + WS_SC + (size_t)MA * 4096);
    LAS unsigned char* wl = (LAS unsigned char*)lds + 1024 * wave;
    const int l8 = 2 * q + (j >> 3);
    const unsigned coff = 16u * (j & 7);
    unsigned sel0[4], sel1[4];
#pragma unroll
    for (int k = 0; k < 4; ++k) { const unsigned pl = 0x0c0c0c0cu ^ ((0x0cu ^ (unsigned)k) << (8 * (j & 3))); sel0[k] = (j & 4) ? 0x0c0c0c0cu : pl; sel1[k] = (j & 4) ? pl : 0x0c0c0c0cu; }
    const int bp = 4 * ((lane + 40) & 63);
    int t = __builtin_amdgcn_readfirstlane(r0 + sg.rank * NWV + wave);
    if (t >= MA) return;
    Idx16 In; i32x4 WH, WL; Seg16 Q; u32x2 rawI, rawW; float sinv;
    {
        const int t1 = t + nws < MA ? t + nws : t, t2 = t + 2 * nws < MA ? t + 2 * nws : t1;
        const u32x2 ri0 = slot_raw_load(SI, t, lane), ri1 = slot_raw_load(SI, t1, lane), rw0 = slot_raw_load(W8, t, lane);
        asm volatile("" ::: "memory");
        rawI = slot_raw_load(SI, t2, lane); rawW = slot_raw_load(W8, t1, lane);
        asm volatile("" ::: "memory");
        slot_redist(wl, ri0, lane, l8, In);
#pragma unroll
        for (int m = 0; m < 16; ++m) { Q.q[m] = __builtin_amdgcn_raw_buffer_load_b128(PV, (unsigned)In.v[m >> 2][m & 3] * 128u + coff, 0, 0); asm volatile("" ::: "memory"); }
        slot_redist(wl, ri1, lane, l8, In);
        *(LAS u32x2*)(wl + 512 + 8 * lane) = rw0;
        WH = *(const LAS i32x4*)(wl + 512 + 16 * l8); WL = *(const LAS i32x4*)(wl + 640 + 16 * l8); sinv = *(const LAS float*)(wl + 768);
    }
    while (t < MA) {
        const int t1 = t + nws < MA ? t + nws : t, t2 = t + 2 * nws < MA ? t + 2 * nws : t1, t3 = t + 3 * nws < MA ? t + 3 * nws : t2;
        const u32x2 rawIn = slot_raw_load(SI, t3, lane), rawWn = slot_raw_load(W8, t2, lane);
        asm volatile("" ::: "memory");
        f32x4 acc[4] = {(f32x4){0.f, 0.f, 0.f, 0.f}, (f32x4){0.f, 0.f, 0.f, 0.f}, (f32x4){0.f, 0.f, 0.f, 0.f}, (f32x4){0.f, 0.f, 0.f, 0.f}};
        peer_v_mm<0>(PV, Q, WH, WL, In, coff, sel0, sel1, acc); peer_v_mm<1>(PV, Q, WH, WL, In, coff, sel0, sel1, acc); peer_v_mm<2>(PV, Q, WH, WL, In, coff, sel0, sel1, acc); peer_v_mm<3>(PV, Q, WH, WL, In, coff, sel0, sel1, acc);
        peer_v_mm<4>(PV, Q, WH, WL, In, coff, sel0, sel1, acc); peer_v_mm<5>(PV, Q, WH, WL, In, coff, sel0, sel1, acc); peer_v_mm<6>(PV, Q, WH, WL, In, coff, sel0, sel1, acc); peer_v_mm<7>(PV, Q, WH, WL, In, coff, sel0, sel1, acc);
        peer_v_mm<8>(PV, Q, WH, WL, In, coff, sel0, sel1, acc); peer_v_mm<9>(PV, Q, WH, WL, In, coff, sel0, sel1, acc); peer_v_mm<10>(PV, Q, WH, WL, In, coff, sel0, sel1, acc); peer_v_mm<11>(PV, Q, WH, WL, In, coff, sel0, sel1, acc);
        peer_v_mm<12>(PV, Q, WH, WL, In, coff, sel0, sel1, acc); peer_v_mm<13>(PV, Q, WH, WL, In, coff, sel0, sel1, acc); peer_v_mm<14>(PV, Q, WH, WL, In, coff, sel0, sel1, acc); peer_v_mm<15>(PV, Q, WH, WL, In, coff, sel0, sel1, acc);
        const float sv = sinv;
        slot_redist(wl, rawI, lane, l8, In);
        *(LAS u32x2*)(wl + 512 + 8 * lane) = rawW;
        WH = *(const LAS i32x4*)(wl + 512 + 16 * l8); WL = *(const LAS i32x4*)(wl + 640 + 16 * l8); sinv = *(const LAS float*)(wl + 768);
        float A[4], Bv[4];
#pragma unroll
        for (int r = 0; r < 4; ++r) {
            const float a = acc[0][r] + acc[2][r], b = acc[1][r] + acc[3][r];
            A[r] = (a + __int_as_float(__builtin_amdgcn_ds_bpermute(bp, __float_as_int(a)))) * sv;
            Bv[r] = (b + __int_as_float(__builtin_amdgcn_ds_bpermute(bp, __float_as_int(b)))) * sv;
        }
#pragma unroll
        for (int r = 0; r < 4; ++r) swap16f(A[r], Bv[r]);
        if (j < 8 && q < 2) { u32x4 pk; pk[0] = pk2(A[0], A[1]); pk[1] = pk2(A[2], A[3]); pk[2] = pk2(Bv[0], Bv[1]); pk[3] = pk2(Bv[2], Bv[3]);
            *(u32x4*)(OUTP + (size_t)t * D + 128 * x + 16 * j + 8 * q) = pk; }
        rawI = rawIn; rawW = rawWn; t += nws;
    }
}
struct FinPar { Row16 g2; NormAB n; };
DEVI void finpar_load(FinPar& f, const P& p, int layer, int cls, int next_mode, int lane) {
    load_row_f32(mod_ptr(p, layer, cls, 5), lane, f.g2);
    const int ln = next_mode == 0 ? layer + 1 : layer; const float m = next_mode == 0 ? 1.0f : 0.0f;
    Row16 gg, sc, sh; load_row_f32(next_mode == 0 ? p.in[I_N1G] + ln * D : p.in[I_FG], lane, gg); load_row_f32(mod_ptr(p, ln, cls, 1), lane, sc); load_row_f32(mod_ptr(p, ln, cls, 0), lane, sh);
#pragma unroll
    for (int j = 0; j < 16; ++j) { f.n.A.v[j] = gg.v[j] * (1.0f + m * sc.v[j]); f.n.B.v[j] = m * sh.v[j]; }
}
DEVI void fin_row(const P& p, int r, int lane, int next_mode, Row16& x, const Row16& a, const FinPar& f) {
#pragma unroll
    for (int j = 0; j < 16; ++j) x.v[j] += f.g2.v[j] * a.v[j];
    if (next_mode == 0) {
        store_row_f32((float*)(p.ws + WS_X) + (size_t)r * D, lane, x);
        Row16 o; norm_ab(x, f.n, o);
        store_row_bf16((bf16_t*)(p.ws + WS_XN) + (size_t)r * D, lane, o);
    } else if (r >= TC) {
        Row16 o; norm_ab(x, f.n, o);
        store_row_f32(p.out + (size_t)(r - TC) * D, lane, o);
    }
}
DEVI void ph_peer_fin(const P& p, int layer, int r0, int next_mode) {
    const int otid_ = otid();
    const int wave = __builtin_amdgcn_readfirstlane(otid_ >> 6), lane = otid_ & 63, gw = blockIdx.x * NWV + wave, NGW = gridDim.x * NWV;
    const bf16_t* OUTP = (const bf16_t*)(p.ws + WS_SC + (size_t)MA * 4096);
    FinPar fl; finpar_load(fl, p, layer, 0, next_mode, lane);
    for (int r = r0 + gw; r < MA; r += 2 * NGW) {
        const int r1 = r + NGW;
        Row16 x0, a0, x1, a1;
        load_row_f32((const float*)(p.ws + WS_X) + (size_t)r * D, lane, x0); load_row_bf16(OUTP + (size_t)r * D, lane, a0);
        if (r1 < MA) { load_row_f32((const float*)(p.ws + WS_X) + (size_t)r1 * D, lane, x1); load_row_bf16(OUTP + (size_t)r1 * D, lane, a1); }
        FinPar f0 = fl;
        if (r < TC) finpar_load(f0, p, layer, 1, next_mode, lane);
        fin_row(p, r, lane, next_mode, x0, a0, f0);
        if (r1 < MA) fin_row(p, r1, lane, next_mode, x1, a1, fl);
    }
}

#define XB_TMO      128
#define XB_XCNT(j)  (256  + 64 * (j))
#define XB_XSUB(j)  (1280 + 64 * (j))
#define XB_XGEN(j)  (2304 + 64 * (j))
#define XB_TOP      3328
#define XB_TOPGEN   3392
#define XCD_BAR_WORDS 3456
#define XB_SPIN_CAP (1u << 20)
DEVI unsigned xb_ld(unsigned* p)              { return __hip_atomic_load(p, __ATOMIC_RELAXED, __HIP_MEMORY_SCOPE_AGENT); }
DEVI unsigned xb_add(unsigned* p, unsigned v) { return __hip_atomic_fetch_add(p, v, __ATOMIC_RELAXED, __HIP_MEMORY_SCOPE_AGENT); }
DEVI unsigned xb_xcc_id() { return (unsigned)__builtin_amdgcn_s_getreg((3 << 11) | 20) & 0xFu; }
#define XB_SPIN(cond, bar) do { unsigned _sp = 0; while (cond) { __builtin_amdgcn_s_sleep(1); \
    if ((++_sp & 255u) == 0u) { if (xb_ld(&(bar)[XB_TMO])) break; if (_sp > XB_SPIN_CAP) { atomicAdd(&(bar)[XB_TMO], 1u); break; } } } } while (0)
struct XcdBarrier { unsigned* bar; unsigned x; volatile LAS unsigned* st; };
DEVI XcdBarrier xcd_barrier_post(unsigned* bar, volatile LAS unsigned* st) {
    XcdBarrier b; b.bar = bar; b.x = xb_xcc_id(); b.st = st;
    if (threadIdx.x == 0) st[2] = xb_add(&bar[XB_XCNT(b.x)], 1u);
    return b;
}
DEVI void xcd_barrier_complete(unsigned* bar, unsigned x, unsigned& nloc, unsigned& nx) {
    const unsigned G = gridDim.x * gridDim.y * gridDim.z;
    unsigned sum, cnt, mine, sp = 0u;
    for (;;) {
        sum = 0u; cnt = 0u; mine = 0u;
#pragma unroll
        for (unsigned j = 0; j < 16; ++j) { const unsigned c = xb_ld(&bar[XB_XCNT(j)]); sum += c; cnt += (c > 0u) ? 1u : 0u; mine = (j == x) ? c : mine; }
        if (sum == G) break;
        __builtin_amdgcn_s_sleep(1);
        if ((++sp & 255u) == 0u) { if (xb_ld(&bar[XB_TMO])) break; if (sp > XB_SPIN_CAP) { atomicAdd(&bar[XB_TMO], 1u); break; } }
    }
    nloc = mine > 0u ? mine : 1u; nx = cnt > 0u ? cnt : 1u;
}
DEVI void xcd_barrier(const XcdBarrier& b) {
    asm volatile("s_waitcnt vmcnt(0)" ::: "memory");
    __syncthreads();
    if (threadIdx.x == 0) {
        unsigned* bar = b.bar;
        __builtin_amdgcn_s_waitcnt(0);
        unsigned nloc = b.st[0], nx = b.st[1];
        if (nloc == 0u) { xcd_barrier_complete(bar, b.x, nloc, nx); b.st[0] = nloc; b.st[1] = nx; }
        const unsigned old = xb_add(&bar[XB_XSUB(b.x)], 1u);
        const unsigned gen = old / nloc;
        if (old + 1u == (gen + 1u) * nloc) {
            __builtin_amdgcn_fence(__ATOMIC_RELEASE, "agent");
            asm volatile("s_waitcnt vmcnt(0)" ::: "memory");
            const unsigned og = xb_add(&bar[XB_TOP], 1u);
            const unsigned tg = og / nx;
            if (og + 1u == (tg + 1u) * nx) xb_add(&bar[XB_TOPGEN], 1u);
            else XB_SPIN(xb_ld(&bar[XB_TOPGEN]) == tg, bar);
            __builtin_amdgcn_fence(__ATOMIC_ACQUIRE, "agent");
            asm volatile("s_waitcnt vmcnt(0)" ::: "memory");
        } else {
            XB_SPIN(xb_ld(&bar[XB_TOPGEN]) == gen, bar);
            __builtin_amdgcn_fence(__ATOMIC_ACQUIRE, "agent");
            asm volatile("s_waitcnt vmcnt(0)" ::: "memory");
        }
    }
    __syncthreads();
}

DEVI SliceGeo slice_geo(const P& p, unsigned char* lds) {
    SliceGeo g;
    unsigned* bar = (unsigned*)(p.ws + WS_CTL);
    volatile LAS unsigned* st = (volatile LAS unsigned*)(lds + LDS_BYTES - 64);
    unsigned cnt[8]; unsigned tot = 0; bool ok = true;
#pragma unroll
    for (int j = 0; j < 8; ++j) { cnt[j] = xb_ld(&bar[XB_XCNT(j)]); tot += cnt[j]; ok = ok && cnt[j] > 0u; }
    const unsigned xcc = xb_xcc_id();
    if (ok && tot == gridDim.x && xcc < 8u) { g.x = (int)xcc; g.rank = (int)st[2]; g.n = 0;
#pragma unroll
        for (int j = 0; j < 8; ++j) g.n = (j == (int)xcc) ? (int)cnt[j] : g.n; }
    else { g.x = blockIdx.x & 7; g.rank = blockIdx.x >> 3; g.n = ((int)gridDim.x - g.x + 7) >> 3; }
    g.x = __builtin_amdgcn_readfirstlane(g.x); g.rank = __builtin_amdgcn_readfirstlane(g.rank); g.n = __builtin_amdgcn_readfirstlane(g.n);
    return g;
}

struct CtxBf16 { bf16_t* O; int ldc; DEVI void operator()(int tok, int n, const f32x4 v) const { *(u32x2*)(O + (size_t)tok * ldc + n) = (u32x2){pk2(v[0], v[1]), pk2(v[2], v[3])}; } };
struct CtxHgrnIn { bf16_t* O; const float* lbv;
    DEVI void operator()(int tok, int n, const f32x4 v) const { const int blk = n >> 10; float x[4] = {v[0], v[1], v[2], v[3]};
#pragma unroll
        for (int j = 0; j < 4; ++j) {
            if (blk == 0 || blk == 4) x[j] = x[j] * frcp_(1.0f + __expf(-x[j]));
            else if (blk == 2 || blk == 3) { const float lb = lbv[(blk - 2) * 1024 + (n & 1023) + j]; x[j] = __builtin_amdgcn_logf(lb + (1.0f - lb) * frcp_(1.0f + __expf(-x[j]))); } }
        *(u32x2*)(O + (size_t)tok * 5120 + n) = (u32x2){pk2(x[0], x[1]), pk2(x[2], x[3])}; } };
struct CtxF16 { unsigned short* O; int ldc; DEVI void operator()(int tok, int n, const f32x4 v) const { *(u32x2*)(O + (size_t)tok * ldc + n) = (u32x2){pg8::pkh2(v[0], v[1]), pg8::pkh2(v[2], v[3])}; } };
struct CtxResid { float* X; const float* gate; DEVI void operator()(int tok, int n, const f32x4 v) const { f32x4* q = (f32x4*)(X + (size_t)tok * D + n); *q = *q + *(const f32x4*)(gate + n) * v; } };
template <class Epi>
DEVI void ctx_gemm(const bf16_t* A, const bf16_t* Bt, int N, const Epi& epi, unsigned char* lds_) {
    typedef short bf16x8 __attribute__((ext_vector_type(8)));
    const int otid_ = otid();
    const int wave = otid_ >> 6, lane = otid_ & 63, c = lane & 15, q4 = lane >> 4;
    LAS f32x4* red = (LAS f32x4*)lds_;
    const int npieces = (TC / 32) * (N / 64);
    for (int pc = blockIdx.x; pc < npieces; pc += gridDim.x) {
        const int mt = pc & 7, nt = pc >> 3;
        const bf16_t* ap = A + (size_t)(32 * mt + c) * D + 8 * q4 + 128 * wave;
        const bf16_t* bp = Bt + (size_t)(64 * nt + c) * D + 8 * q4 + 128 * wave;
        bf16x8 a0[4], a1[4], bf[4][4];
#pragma unroll
        for (int s4 = 0; s4 < 4; ++s4) { a0[s4] = *(const bf16x8*)(ap + 32 * s4); a1[s4] = *(const bf16x8*)(ap + 16 * D + 32 * s4);
#pragma unroll
            for (int j = 0; j < 4; ++j) bf[j][s4] = *(const bf16x8*)(bp + (size_t)(16 * j) * D + 32 * s4); }
        f32x4 acc[4][2];
#pragma unroll
        for (int j = 0; j < 4; ++j) { acc[j][0] = (f32x4){0.f, 0.f, 0.f, 0.f}; acc[j][1] = acc[j][0]; }
#pragma unroll
        for (int s4 = 0; s4 < 4; ++s4)
#pragma unroll
            for (int j = 0; j < 4; ++j) { acc[j][0] = __builtin_amdgcn_mfma_f32_16x16x32_bf16(bf[j][s4], a0[s4], acc[j][0], 0, 0, 0); acc[j][1] = __builtin_amdgcn_mfma_f32_16x16x32_bf16(bf[j][s4], a1[s4], acc[j][1], 0, 0, 0); }
        __syncthreads();
#pragma unroll
        for (int j = 0; j < 4; ++j)
#pragma unroll
            for (int i = 0; i < 2; ++i) red[(wave * 8 + (j * 2 + i)) * 64 + lane] = acc[j][i];
        __syncthreads();
        f32x4 sum = {0.f, 0.f, 0.f, 0.f};
#pragma unroll
        for (int ww = 0; ww < 8; ++ww) sum += red[(ww * 8 + wave) * 64 + lane];
        epi(32 * mt + 16 * (wave & 1) + c, 64 * nt + 16 * (wave >> 1) + 4 * q4, sum);
    }
    __syncthreads();
}

DEVI void gemm_bf16(const P& p, const bf16_t* A, const bf16_t* Bt, int r0, int N, bf16_t* O, int ldc, unsigned char* lds) {
    pg8::Gemm g{A + (size_t)r0 * D, Bt, MA - r0, N, D}; pg8::StaticOrder S; S.init(MA - r0, N, (int)gridDim.x, (int)blockIdx.x);
    pg8::EpiBf16 E{O, ldc, r0};
    pg8::gemm_phase<pg8::EpiBf16, pg8::StaticOrder, true, true>((PG8_LAS unsigned char*)lds, g, S, E);
}
DEVI void gemm_hgrn_in(const P& p, const bf16_t* A, const bf16_t* Bt, unsigned char* lds) {
    pg8::Gemm g{A + (size_t)TC * D, Bt, T, 5120, D}; pg8::StaticOrder S; S.init(T, 5120, (int)gridDim.x, (int)blockIdx.x);
    pg8::EpiHgrnIn E{(bf16_t*)(p.ws + WS_G), 5120, TC, (const float*)(p.ws + WS_LB)};
    pg8::gemm_phase<pg8::EpiHgrnIn, pg8::StaticOrder, true, true>((PG8_LAS unsigned char*)lds, g, S, E);
}
DEVI void gemm_f16(const P& p, const bf16_t* A, const bf16_t* Bt, int r0, int N, unsigned short* O, int ldc, unsigned char* lds) {
    pg8::Gemm g{A + (size_t)r0 * D, Bt, MA - r0, N, D}; pg8::StaticOrder S; S.init(MA - r0, N, (int)gridDim.x, (int)blockIdx.x);
    pg8::EpiF16 E{O, ldc, r0};
    pg8::gemm_phase<pg8::EpiF16, pg8::StaticOrder, true, true>((PG8_LAS unsigned char*)lds, g, S, E);
}
DEVI void gemm_glu_resid(const P& p, const bf16_t* A, const bf16_t* Bt, int layer, unsigned char* lds) {
    pg8::Gemm g{A + (size_t)TC * D, Bt, T, 2048, D}; pg8::StaticOrder S; S.init(T, 2048, (int)gridDim.x, (int)blockIdx.x);
    pg8::EpiGluResid E{(float*)(p.ws + WS_X), mod_ptr(p, layer, 0, 2), TC};
    pg8::gemm_phase<pg8::EpiGluResid, pg8::StaticOrder, true, true>((PG8_LAS unsigned char*)lds, g, S, E);
}
DEVI void gemm_resid(const P& p, const bf16_t* A, const bf16_t* Bt, int r0, int layer, unsigned char* lds) {
    pg8::Gemm g{A + (size_t)r0 * D, Bt, MA - r0, D, D}; pg8::StaticOrder S; S.init(MA - r0, D, (int)gridDim.x, (int)blockIdx.x);
    pg8::EpiResid E{(float*)(p.ws + WS_X), mod_ptr(p, layer, 0, 2), mod_ptr(p, layer, 1, 2), r0, TC};
    pg8::gemm_phase<pg8::EpiResid, pg8::StaticOrder, true, true>((PG8_LAS unsigned char*)lds, g, S, E);
}

enum { PH_P0 = 0, PH_INIT, PH_GEMM_IN, PH_HGP1, PH_MIX1, PH_MIX2, PH_GEMM_OUT, PH_NORM2, PH_SCORES, PH_TOPK, PH_PEERU, PH_PEERW, PH_PEERV, PH_PEERF };

DEVI void run_phase(const P& p, int ph, int layer, unsigned char* lds) {
    const int kind = layer % 3, jj = layer / 3;
    const int r0 = (layer >= 2) ? TC : 0;
    bf16_t* WT = (bf16_t*)(p.ws + WS_WT);
    switch (ph) {
    case PH_P0: ph_ada(p, lds); ph_lb(p); ph_s5disc(p); __syncthreads(); ph_transposes(p, lds); __syncthreads(); ph_fold(p); ph_tables(p); break;
    case PH_INIT: ph_init_norm(p); break;
    case PH_GEMM_IN:
        if (kind == 0) { const bf16_t* W = WT + WT_CIN / 2 + (size_t)jj * 3072 * 1024;
            if (r0 == 0) ctx_gemm((const bf16_t*)(p.ws + WS_XN), W, 3072, CtxBf16{(bf16_t*)(p.ws + WS_G), 3072}, lds);
            gemm_bf16(p, (const bf16_t*)(p.ws + WS_XN), W, TC, 3072, (bf16_t*)(p.ws + WS_G), 3072, lds); }
        else if (kind == 1) { ctx_gemm((const bf16_t*)(p.ws + WS_XN), WT + WT_HIN / 2, 5120, CtxHgrnIn{(bf16_t*)(p.ws + WS_G), (const float*)(p.ws + WS_LB)}, lds);
            gemm_hgrn_in(p, (const bf16_t*)(p.ws + WS_XN), WT + WT_HIN / 2, lds); }
        break;
    case PH_HGP1: if (kind == 1) hg::scan<false>(p, lds); else s5::scan<false>(p, lds); break;
    case PH_MIX1:
        if (kind == 0) ph_conv(p, jj, r0); else if (kind == 1) hg::scan<true>(p, lds); else s5::scan<true>(p, lds);
        break;
    case PH_MIX2:
        if (kind == 1) ph_hgrn_readout(p); else if (kind == 2) ph_s5_elem(p);
        break;
    case PH_GEMM_OUT:
        if (kind == 0) { const bf16_t* W = WT + WT_COUT / 2 + (size_t)jj * 1024 * 1024;
            if (r0 == 0) ctx_gemm((const bf16_t*)(p.ws + WS_U), W, 1024, CtxResid{(float*)(p.ws + WS_X), mod_ptr(p, layer, 1, 2)}, lds);
            gemm_resid(p, (const bf16_t*)(p.ws + WS_U), W, TC, layer, lds); }
        else if (kind == 1) { ctx_gemm((const bf16_t*)(p.ws + WS_U), WT + WT_HOUT / 2, 1024, CtxResid{(float*)(p.ws + WS_X), mod_ptr(p, layer, 1, 2)}, lds);
            gemm_resid(p, (const bf16_t*)(p.ws + WS_U), WT + WT_HOUT / 2, TC, layer, lds); }
        else gemm_glu_resid(p, (const bf16_t*)(p.ws + WS_U), WT + WT_GLU / 2, layer, lds);
        break;
    case PH_NORM2: ph_norm2(p, layer, r0); break;
    case PH_SCORES: { const bf16_t* W = (const bf16_t*)(p.ws + WS_WQK) + (size_t)layer * 2048 * 1024;
        if (r0 == 0) ctx_gemm((const bf16_t*)(p.ws + WS_XN), W, 2048, CtxF16{(unsigned short*)(p.ws + WS_SCH), 2048}, lds);
        gemm_f16(p, (const bf16_t*)(p.ws + WS_XN), W, TC, 2048, (unsigned short*)(p.ws + WS_SCH), 2048, lds); } break;
    case PH_TOPK: ph_topk(p, layer, r0, lds); break;
    case PH_PEERU: ph_peer_u(p, layer, r0, slice_geo(p, lds), lds); break;
    case PH_PEERW: ph_peer_w(p, r0); break;
    case PH_PEERV: ph_peer_v(p, layer, r0, slice_geo(p, lds), lds); break;
    case PH_PEERF: ph_peer_fin(p, layer, r0, layer == 3 ? 1 : 0); break;
    }
}

#ifndef MK_MULTI
#define MK_MULTI 0
#endif
#if MK_MULTI
__global__ void __launch_bounds__(NTHR, 2) k_fwd(P p) {
    extern __shared__ __attribute__((aligned(16))) unsigned char lds[];
    run_phase(p, p.ph, p.arg, lds);
}
#else
__global__ void __launch_bounds__(NTHR, 2) k_fwd(P p) {
    extern __shared__ __attribute__((aligned(16))) unsigned char lds[];
    volatile LAS unsigned* st = (volatile LAS unsigned*)(lds + LDS_BYTES - 64);
    if (threadIdx.x < 16) st[threadIdx.x] = 0u;
    __syncthreads();
    const XcdBarrier bar = xcd_barrier_post((unsigned*)(p.ws + WS_CTL), st);
#define SYNC() xcd_barrier(bar)
    run_phase(p, PH_P0, 0, lds); SYNC();
    run_phase(p, PH_INIT, 0, lds); SYNC();
#pragma unroll 1
    for (int layer = 0; layer < DEPTH; ++layer) {
        const int kind = layer % 3;
        if (kind != 2) { run_phase(p, PH_GEMM_IN, layer, lds); SYNC(); }
        if (kind != 0) { run_phase(p, PH_HGP1, layer, lds); SYNC(); }
        run_phase(p, PH_MIX1, layer, lds); SYNC();
        if (kind != 0) { run_phase(p, PH_MIX2, layer, lds); SYNC(); }
        run_phase(p, PH_GEMM_OUT, layer, lds); SYNC();
        run_phase(p, PH_NORM2, layer, lds); SYNC();
        run_phase(p, PH_SCORES, layer, lds); SYNC();
        run_phase(p, PH_TOPK, layer, lds); SYNC();
        run_phase(p, PH_PEERU, layer, lds); SYNC();
        run_phase(p, PH_PEERW, layer, lds); SYNC();
        run_phase(p, PH_PEERV, layer, lds); SYNC();
        run_phase(p, PH_PEERF, layer, lds);
        if (layer != DEPTH - 1) SYNC();
    }
}
#endif

extern "C" void kernel_launch(void* const* d_in, const int* in_sizes, int n_in, void* d_out, int out_size, void* d_ws, size_t ws_size, hipStream_t stream) {
    static int grid = 0;
    if (grid == 0) {
        if (n_in != N_IN || out_size != T * D || ws_size < WS_END) { fprintf(stderr, "kernel_launch: unexpected shapes n_in %d out %d ws %zu\n", n_in, out_size, ws_size); grid = -1; return; }
        int dev = 0, cus = 0, per_cu = 0;
        if (hipGetDevice(&dev) != hipSuccess || hipDeviceGetAttribute(&cus, hipDeviceAttributeMultiprocessorCount, dev) != hipSuccess) { grid = -1; return; }
        if (hipFuncSetAttribute((const void*)k_fwd, hipFuncAttributeMaxDynamicSharedMemorySize, LDS_BYTES) != hipSuccess) { fprintf(stderr, "kernel_launch: hipFuncSetAttribute failed\n"); grid = -1; return; }
        if (hipOccupancyMaxActiveBlocksPerMultiprocessor(&per_cu, (const void*)k_fwd, NTHR, LDS_BYTES) != hipSuccess || per_cu < 1) { fprintf(stderr, "kernel_launch: occupancy query says %d blocks/CU\n", per_cu); }
        (void)hipGetLastError();
        grid = cus;
    }
    if (grid < 0) return;
    P p{};
    for (int i = 0; i < N_IN; ++i) p.in[i] = (const float*)d_in[i];
    p.out = (float*)d_out; p.ws = (unsigned char*)d_ws;
#if MK_MULTI
    auto launch = [&](int ph, int arg) { p.ph = ph; p.arg = arg; hipLaunchKernelGGL(k_fwd, dim3(grid), dim3(NTHR), LDS_BYTES, stream, p); };
    launch(PH_P0, 0); launch(PH_INIT, 0);
    for (int layer = 0; layer < DEPTH; ++layer) {
        const int kind = layer % 3;
        if (kind != 2) launch(PH_GEMM_IN, layer);
        if (kind != 0) launch(PH_HGP1, layer);
        launch(PH_MIX1, layer);
        if (kind != 0) launch(PH_MIX2, layer);
        launch(PH_GEMM_OUT, layer);
        launch(PH_NORM2, layer); launch(PH_SCORES, layer); launch(PH_TOPK, layer); launch(PH_PEERU, layer); launch(PH_PEERW, layer); launch(PH_PEERV, layer); launch(PH_PEERF, layer);
    }
#else
    if (hipMemsetAsync((char*)d_ws + WS_CTL, 0, 65536, stream) != hipSuccess) { fprintf(stderr, "kernel_launch: memset failed\n"); return; }
    void* args[] = {&p};
    const hipError_t e = hipLaunchCooperativeKernel((const void*)k_fwd, dim3(grid), dim3(NTHR), args, LDS_BYTES, stream);
    if (e != hipSuccess) fprintf(stderr, "kernel_launch: cooperative launch failed: %s (grid %d)\n", hipGetErrorString(e), grid);
#endif
}
```

```cpp
#include <hip/hip_runtime.h>
#include <cstdint>
#include <cstdio>

#define DEVI __device__ __forceinline__
#define LAS __attribute__((address_space(3)))
typedef unsigned short bf16_t;
typedef float f32x4 __attribute__((ext_vector_type(4)));
typedef unsigned u32x4 __attribute__((ext_vector_type(4)));
typedef unsigned u32x2 __attribute__((ext_vector_type(2)));
typedef int i32x4 __attribute__((ext_vector_type(4)));
typedef __bf16 bf16x2_t __attribute__((ext_vector_type(2)));

constexpr int D = 1024, T = 16384, TC = 256, MA = T + TC, DEPTH = 4;
constexpr int NTHR = 512, NWV = 8;
constexpr float EPS = 1e-6f;

constexpr size_t MiB = 1u << 20;
constexpr size_t WS_CTL = 0;
constexpr size_t WS_MOD = 1 * MiB;
constexpr size_t WS_LB = WS_MOD + 256 * 1024;
constexpr size_t WS_S5A = 2 * MiB;
constexpr size_t WS_S5B = 3 * MiB;
constexpr size_t WS_X = 8 * MiB;
constexpr size_t WS_XN = 73 * MiB;
constexpr size_t WS_U = 106 * MiB;
constexpr size_t WS_OF = 139 * MiB;
constexpr size_t WS_OB = 172 * MiB;
constexpr size_t WS_G = 205 * MiB;
constexpr size_t WS_SC = 368 * MiB;
constexpr size_t WS_SELI = 498 * MiB;
constexpr size_t WS_SELG = 507 * MiB;
constexpr size_t WS_WQK = 516 * MiB;
constexpr size_t WS_WT = 532 * MiB;
constexpr size_t WT_CIN = 0, WT_COUT = 12 * MiB, WT_HIN = 16 * MiB, WT_HOUT = 26 * MiB, WT_GLU = 28 * MiB;
constexpr size_t WS_PU = 564 * MiB;
constexpr size_t WS_PV = 628 * MiB;
constexpr size_t WS_SCL = 692 * MiB;
constexpr size_t WS_H8 = 770 * MiB;
constexpr size_t WS_HS = 788 * MiB;
constexpr size_t WS_SCH = 704 * MiB;
constexpr size_t WS_SELU = 694 * MiB;
constexpr size_t WS_XE = 820 * MiB;
constexpr size_t WS_END = 822 * MiB;

constexpr int LDS_BYTES = 147456;

enum { I_X = 0, I_C, I_CTX, I_CCTX, I_ADAW, I_ADAB, I_N1G, I_N2G, I_CWIN, I_CK, I_CWOUT, I_HWIN, I_HLB, I_HNG, I_HWOUT,
       I_S5LR, I_S5LI, I_S5LS, I_S5BR, I_S5BI, I_S5CR, I_S5CI, I_S5D, I_S5GLU, I_PWQ, I_PKEYS, I_PU, I_PV, I_FG, N_IN };

struct P {
    const float* in[N_IN];
    float* out;
    unsigned char* ws;
    int ph, arg;
};

DEVI unsigned f2bf(float f) { unsigned u = __float_as_uint(f); return (u + 0x7fffu + ((u >> 16) & 1u)) >> 16; }
typedef float f32x2_t __attribute__((ext_vector_type(2)));
DEVI unsigned pk2(float lo, float hi) { f32x2_t f = {lo, hi}; return __builtin_bit_cast(unsigned, __builtin_convertvector(f, bf16x2_t)); }
DEVI float bflo(unsigned w) { return __uint_as_float(w << 16); }
DEVI float bfhi(unsigned w) { return __uint_as_float(w & 0xffff0000u); }
DEVI float bf2f(bf16_t b) { return __uint_as_float((unsigned)b << 16); }
DEVI float frcp_(float x) { return __builtin_amdgcn_rcpf(x); }
DEVI float sigmoidf_(float x) { return frcp_(1.0f + __expf(-x)); }
DEVI float siluf_(float x) { return x * sigmoidf_(x); }
DEVI float erf_as_(float x) {
    const float ax = __builtin_fabsf(x), t = frcp_(__builtin_fmaf(0.3275911f, ax, 1.0f));
    float pl = __builtin_fmaf(1.061405429f, t, -1.453152027f); pl = __builtin_fmaf(pl, t, 1.421413741f); pl = __builtin_fmaf(pl, t, -0.284496736f); pl = __builtin_fmaf(pl, t, 0.254829592f);
    const float r = 1.0f - pl * t * __expf(-ax * ax);
    return __builtin_copysignf(r, x);
}
DEVI float geluf_(float x) { return 0.5f * x * (1.0f + erf_as_(x * 0.70710678118654752f)); }
DEVI float dot2bf(unsigned a, unsigned b, float c) { return __builtin_amdgcn_fdot2_f32_bf16(__builtin_bit_cast(bf16x2_t, a), __builtin_bit_cast(bf16x2_t, b), c, false); }
DEVI int otid() { int t = threadIdx.x; asm volatile("" : "+v"(t)); return t; }
template <int CTRL> DEVI float dpp_mov_f(float v) { return __uint_as_float(__builtin_amdgcn_update_dpp(0u, __float_as_uint(v), CTRL, 0xf, 0xf, true)); }
DEVI void rows_swap16(float& a, float& b) { const auto r = __builtin_amdgcn_permlane16_swap(__float_as_uint(a), __float_as_uint(b), false, false); a = __uint_as_float(r[0]); b = __uint_as_float(r[1]); }
DEVI void rows_swap32(float& a, float& b) { const auto r = __builtin_amdgcn_permlane32_swap(__float_as_uint(a), __float_as_uint(b), false, false); a = __uint_as_float(r[0]); b = __uint_as_float(r[1]); }
DEVI float wave_sum(float v) {
    v += dpp_mov_f<0xB1>(v); v += dpp_mov_f<0x4E>(v); v += dpp_mov_f<0x141>(v); v += dpp_mov_f<0x140>(v);
    { float a = v, b = v; rows_swap16(a, b); v = a + b; }
    { float a = v, b = v; rows_swap32(a, b); v = a + b; }
    return v;
}
DEVI float wave_max_f(float v) {
    v = __builtin_fmaxf(v, dpp_mov_f<0xB1>(v)); v = __builtin_fmaxf(v, dpp_mov_f<0x4E>(v)); v = __builtin_fmaxf(v, dpp_mov_f<0x141>(v)); v = __builtin_fmaxf(v, dpp_mov_f<0x140>(v));
    { float a = v, b = v; rows_swap16(a, b); v = __builtin_fmaxf(a, b); }
    { float a = v, b = v; rows_swap32(a, b); v = __builtin_fmaxf(a, b); }
    return v;
}
DEVI float row16_sum(float v) { v += dpp_mov_f<0xB1>(v); v += dpp_mov_f<0x4E>(v); v += dpp_mov_f<0x141>(v); v += dpp_mov_f<0x140>(v); return v; }
DEVI unsigned pk4_i8(float a, float b, float c, float d) {
    const int ia = (int)__builtin_rintf(a), ib = (int)__builtin_rintf(b), ic = (int)__builtin_rintf(c), id = (int)__builtin_rintf(d);
    return (unsigned)(ia & 255) | ((unsigned)(ib & 255) << 8) | ((unsigned)(ic & 255) << 16) | ((unsigned)id << 24);
}
DEVI int row_cls(int r) { return r < TC ? 1 : 0; }
DEVI const float* mod_ptr(const P& p, int layer, int cls, int chunk) { return (const float*)(p.ws + WS_MOD) + ((size_t)(layer * 2 + cls) * 6 + chunk) * D; }

struct Row16 { float v[16]; };
DEVI void load_row_f32(const float* row, int lane, Row16& o) {
    const f32x4* a = (const f32x4*)(row + 8 * lane); const f32x4* b = (const f32x4*)(row + 512 + 8 * lane);
    f32x4 a0 = a[0], a1 = a[1], b0 = b[0], b1 = b[1];
#pragma unroll
    for (int j = 0; j < 4; ++j) { o.v[j] = a0[j]; o.v[4 + j] = a1[j]; o.v[8 + j] = b0[j]; o.v[12 + j] = b1[j]; }
}
DEVI void store_row_f32(float* row, int lane, const Row16& o) {
    f32x4* a = (f32x4*)(row + 8 * lane); f32x4* b = (f32x4*)(row + 512 + 8 * lane);
    a[0] = (f32x4){o.v[0], o.v[1], o.v[2], o.v[3]}; a[1] = (f32x4){o.v[4], o.v[5], o.v[6], o.v[7]};
    b[0] = (f32x4){o.v[8], o.v[9], o.v[10], o.v[11]}; b[1] = (f32x4){o.v[12], o.v[13], o.v[14], o.v[15]};
}
DEVI void load_row_bf16(const bf16_t* row, int lane, Row16& o) {
    const u32x4 a = *(const u32x4*)(row + 8 * lane), b = *(const u32x4*)(row + 512 + 8 * lane);
#pragma unroll
    for (int j = 0; j < 4; ++j) { o.v[2 * j] = bflo(a[j]); o.v[2 * j + 1] = bfhi(a[j]); o.v[8 + 2 * j] = bflo(b[j]); o.v[8 + 2 * j + 1] = bfhi(b[j]); }
}
DEVI void store_row_bf16(bf16_t* row, int lane, const Row16& o) {
    u32x4 a, b;
#pragma unroll
    for (int j = 0; j < 4; ++j) { a[j] = pk2(o.v[2 * j], o.v[2 * j + 1]); b[j] = pk2(o.v[8 + 2 * j], o.v[8 + 2 * j + 1]); }
    *(u32x4*)(row + 8 * lane) = a; *(u32x4*)(row + 512 + 8 * lane) = b;
}
DEVI void norm_mod(const Row16& x, const float* g, const float* shift, const float* scale, int lane, Row16& o) {
    float ss = 0.f;
#pragma unroll
    for (int j = 0; j < 16; ++j) ss += x.v[j] * x.v[j];
    ss = wave_sum(ss);
    const float rstd = rsqrtf(ss * (1.0f / D) + EPS);
    Row16 gg, sh, sc; load_row_f32(g, lane, gg); load_row_f32(shift, lane, sh); load_row_f32(scale, lane, sc);
#pragma unroll
    for (int j = 0; j < 16; ++j) o.v[j] = x.v[j] * rstd * gg.v[j] * (1.0f + sc.v[j]) + sh.v[j];
}

DEVI void ph_ada(const P& p, unsigned char* lds) {
    const int otid_ = otid();
    float* sc = (float*)lds;
    float* red = sc + 2048;
    const int tid = otid_;
    for (int k = tid; k < 1024; k += NTHR) { sc[k] = siluf_(p.in[I_C][k]); sc[1024 + k] = siluf_(p.in[I_CCTX][k]); }
    __syncthreads();
    const int kg = tid >> 3, cl = tid & 7;
    for (int item = blockIdx.x; item < 4 * 192; item += gridDim.x) {
        const int i = item / 192, n0 = (item % 192) * 32 + cl * 4;
        const float* w = p.in[I_ADAW] + (size_t)i * 1024 * 6144 + n0 + (size_t)kg * 6144;
        f32x4 wv[16];
#pragma unroll
        for (int m = 0; m < 16; ++m) wv[m] = *(const f32x4*)(w + (size_t)m * 64 * 6144);
        f32x4 a0 = {0, 0, 0, 0}, a1 = {0, 0, 0, 0};
#pragma unroll
        for (int m = 0; m < 16; ++m) { a0 += wv[m] * sc[kg + 64 * m]; a1 += wv[m] * sc[1024 + kg + 64 * m]; }
        float* r = red + (kg * 8 + cl) * 8;
#pragma unroll
        for (int j = 0; j < 4; ++j) { r[j] = a0[j]; r[4 + j] = a1[j]; }
        __syncthreads();
        if (tid < 64) {
            const int c2 = tid >> 3, j = tid & 7; float s_ = 0.f;
            for (int g = 0; g < 64; ++g) s_ += red[(g * 8 + c2) * 8 + j];
            const int cls = j >> 2, n = (item % 192) * 32 + c2 * 4 + (j & 3);
            ((float*)(p.ws + WS_MOD))[(size_t)(i * 2 + cls) * 6144 + n] = s_ + p.in[I_ADAB][i * 6144 + n];
        }
        __syncthreads();
    }
}
DEVI void ph_lb(const P& p) {
    const int otid_ = otid();
    const int gt = blockIdx.x * NTHR + otid_;
    if (gt < 2048) {
        const float* l = p.in[I_HLB];
        float m = -1e30f; for (int i = 0; i < 4; ++i) m = fmaxf(m, l[i * 2048 + gt]);
        float s = 0.f; for (int i = 0; i < 4; ++i) s += expf(l[i * 2048 + gt] - m);
        ((float*)(p.ws + WS_LB))[gt] = expf(l[2048 + gt] - m) / s;
    }
}
DEVI void ph_s5disc(const P& p) {
    const int otid_ = otid();
    const int gt = blockIdx.x * NTHR + otid_;
    if (gt < 2 * 64 * 64) {
        const int dn = gt >> 12, g = (gt >> 6) & 63, pp = gt & 63;
        const float step = expf(p.in[I_S5LS][dn * 64 + g]);
        const float lr = fminf(p.in[I_S5LR][gt], -1e-4f), li = p.in[I_S5LI][gt];
        const float ar = step * lr, ai = step * li, mag = expf(ar);
        float sn, cs; sincosf(ai, &sn, &cs);
        const float abr = mag * cs, abi = mag * sn, den = lr * lr + li * li;
        const float fr = ((abr - 1.0f) * lr + abi * li) / den, fi = (abi * lr - (abr - 1.0f) * li) / den;
        float* A = (float*)(p.ws + WS_S5A) + (size_t)gt * 2; A[0] = abr; A[1] = abi;
        float* B = (float*)(p.ws + WS_S5B) + (size_t)gt * 32;
        const float* br = p.in[I_S5BR] + (size_t)(g * 64 + pp) * 16; const float* bi = p.in[I_S5BI] + (size_t)(g * 64 + pp) * 16;
        for (int h = 0; h < 16; ++h) { B[h] = fr * br[h] - fi * bi[h]; B[16 + h] = fr * bi[h] + fi * br[h]; }
    }
}
DEVI void transpose_item(const float* W, int K, int N, bf16_t* WT, float* scr, int item, int lane, bool glu_pair = false) {
    const int nblk = N / 32, kb = item / nblk, nb = item % nblk, k0 = 64 * kb, n0 = 32 * nb;
#pragma unroll 8
    for (int i = 0; i < 32; ++i) { const int kk = 2 * i + (lane >> 5); scr[kk * 33 + (lane & 31)] = W[(size_t)(k0 + kk) * N + n0 + (lane & 31)]; }
    __builtin_amdgcn_s_waitcnt(0); asm volatile("" ::: "memory");
    const int c = lane & 7;
#pragma unroll
    for (int j = 0; j < 4; ++j) { const int n = (lane >> 3) + 8 * j; const float* s = scr + (8 * c) * 33 + n;
        u32x4 o; o.x = pk2(s[0 * 33], s[1 * 33]); o.y = pk2(s[2 * 33], s[3 * 33]); o.z = pk2(s[4 * 33], s[5 * 33]); o.w = pk2(s[6 * 33], s[7 * 33]);
        const int dn = glu_pair ? (((n0 & 1023) >> 7) * 256 + (n0 >> 10) * 128 + (n0 & 127)) : n0;
        *(u32x4*)(WT + (size_t)(dn + n) * K + k0 + 8 * c) = o; }
    __builtin_amdgcn_s_waitcnt(0); asm volatile("" ::: "memory");
}
DEVI void ph_transposes(const P& p, unsigned char* lds) {
    const int otid_ = otid();
    const int wave = otid_ >> 6, lane = otid_ & 63;
    float* scr = (float*)lds + wave * (64 * 33);
    const int gw = blockIdx.x * NWV + wave, NGW = gridDim.x * NWV;
    bf16_t* WT = (bf16_t*)(p.ws + WS_WT);
    constexpr int I_A = (1024 / 64) * (3072 / 32), I_B = (1024 / 64) * (1024 / 32), I_C5 = (1024 / 64) * (5120 / 32), I_G = (1024 / 64) * (2048 / 32);
    constexpr int NIT = 2 * I_A + 2 * I_B + I_C5 + I_B + I_G;
    for (int it = gw; it < NIT; it += NGW) {
        int r = it;
        if (r < 2 * I_A) { const int j = r / I_A; transpose_item(p.in[I_CWIN] + (size_t)j * 1024 * 3072, 1024, 3072, WT + WT_CIN / 2 + (size_t)j * 3072 * 1024, scr, r % I_A, lane); continue; } r -= 2 * I_A;
        if (r < 2 * I_B) { const int j = r / I_B; transpose_item(p.in[I_CWOUT] + (size_t)j * 1024 * 1024, 1024, 1024, WT + WT_COUT / 2 + (size_t)j * 1024 * 1024, scr, r % I_B, lane); continue; } r -= 2 * I_B;
        if (r < I_C5) { transpose_item(p.in[I_HWIN], 1024, 5120, WT + WT_HIN / 2, scr, r, lane); continue; } r -= I_C5;
        if (r < I_B) { transpose_item(p.in[I_HWOUT], 1024, 1024, WT + WT_HOUT / 2, scr, r, lane); continue; } r -= I_B;
        transpose_item(p.in[I_S5GLU], 1024, 2048, WT + WT_GLU / 2, scr, r, lane, true);
    }
}
DEVI void ph_tables(const P& p) {
    const int otid_ = otid();
    const int wave = otid_ >> 6, lane = otid_ & 63, gw = blockIdx.x * NWV + wave, NGW = gridDim.x * NWV;
    float* SCL = (float*)(p.ws + WS_SCL);
    for (int row = gw; row < 2 * 4 * 16384; row += NGW) {
        const int w = row >> 16, rr = row & 65535;
        const f32x4* src = (const f32x4*)(p.in[w ? I_PV : I_PU] + (size_t)rr * 1024 + 16 * lane);
        const f32x4 a0 = src[0], a1 = src[1], a2 = src[2], a3 = src[3];
        float m = 0.f;
#pragma unroll
        for (int j = 0; j < 4; ++j) m = fmaxf(fmaxf(m, fmaxf(fabsf(a0[j]), fabsf(a1[j]))), fmaxf(fabsf(a2[j]), fabsf(a3[j])));
        m = wave_max_f(m);
        const float qmax = w ? 224.0f : 127.0f;
        const float sc = m > 0.f ? qmax / m : 1.0f;
        u32x4 q;
        if (w) {
            { unsigned t = 0; t = __builtin_amdgcn_cvt_pk_fp8_f32(a0[0] * sc, a0[1] * sc, t, false); t = __builtin_amdgcn_cvt_pk_fp8_f32(a0[2] * sc, a0[3] * sc, t, true); q[0] = t; }
            { unsigned t = 0; t = __builtin_amdgcn_cvt_pk_fp8_f32(a1[0] * sc, a1[1] * sc, t, false); t = __builtin_amdgcn_cvt_pk_fp8_f32(a1[2] * sc, a1[3] * sc, t, true); q[1] = t; }
            { unsigned t = 0; t = __builtin_amdgcn_cvt_pk_fp8_f32(a2[0] * sc, a2[1] * sc, t, false); t = __builtin_amdgcn_cvt_pk_fp8_f32(a2[2] * sc, a2[3] * sc, t, true); q[2] = t; }
            { unsigned t = 0; t = __builtin_amdgcn_cvt_pk_fp8_f32(a3[0] * sc, a3[1] * sc, t, false); t = __builtin_amdgcn_cvt_pk_fp8_f32(a3[2] * sc, a3[3] * sc, t, true); q[3] = t; }
        } else {
            q[0] = pk4_i8(a0[0] * sc, a0[1] * sc, a0[2] * sc, a0[3] * sc); q[1] = pk4_i8(a1[0] * sc, a1[1] * sc, a1[2] * sc, a1[3] * sc);
            q[2] = pk4_i8(a2[0] * sc, a2[1] * sc, a2[2] * sc, a2[3] * sc); q[3] = pk4_i8(a3[0] * sc, a3[1] * sc, a3[2] * sc, a3[3] * sc);
        }
        *(u32x4*)(p.ws + (w ? WS_PV : WS_PU) + (size_t)(rr >> 14) * (16384 * 1024) + (size_t)(lane >> 3) * (16384 * 128) + (size_t)(rr & 16383) * 128 + 16 * (lane & 7)) = q;
        if (lane == 0) SCL[2 * rr + w] = m > 0.f ? m / qmax : 1.0f;
    }
}
DEVI void ph_fold(const P& p) {
    const int otid_ = otid();
    const int wave = otid_ >> 6, lane = otid_ & 63, c = lane & 15, q4 = lane >> 4, gw = blockIdx.x * NWV + wave, NGW = gridDim.x * NWV;
    for (int item = gw; item < 4 * 16 * 8 * 4; item += NGW) {
        const int i = item >> 9, hc = (item >> 5) & 15, kt = (item >> 2) & 7, kq = item & 3;
        const float* ky = p.in[I_PKEYS] + (((size_t)i * 16 + hc) * 128 + 16 * kt + c) * 128 + 4 * q4;
        f32x4 kf[8];
#pragma unroll
        for (int s8 = 0; s8 < 8; ++s8) kf[s8] = *(const f32x4*)(ky + 16 * s8);
        bf16_t* out = (bf16_t*)(p.ws + WS_WQK) + ((size_t)i * 2048 + hc * 128 + 16 * kt + c) * 1024 + 4 * q4;
#pragma unroll 1
        for (int tt = 0; tt < 16; ++tt) {
            const int k1 = (kq * 16 + tt) * 16;
            const float* wq = p.in[I_PWQ] + ((size_t)i * 1024 + k1 + c) * 2048 + hc * 128 + 4 * q4;
            f32x4 wf[8];
#pragma unroll
            for (int s8 = 0; s8 < 8; ++s8) wf[s8] = *(const f32x4*)(wq + 16 * s8);
            f32x4 acc = {0.f, 0.f, 0.f, 0.f};
#pragma unroll
            for (int s8 = 0; s8 < 8; ++s8)
#pragma unroll
                for (int j = 0; j < 4; ++j) acc = __builtin_amdgcn_mfma_f32_16x16x4f32(wf[s8][j], kf[s8][j], acc, 0, 0, 0);
            *(u32x2*)(out + k1) = (u32x2){pk2(acc[0], acc[1]), pk2(acc[2], acc[3])};
        }
    }
}

struct NormAB { Row16 A, B; };
DEVI void normab_load(NormAB& n, const float* g, const float* shift, const float* scale, int lane) {
    Row16 gg, sc; load_row_f32(g, lane, gg); load_row_f32(scale, lane, sc); load_row_f32(shift, lane, n.B);
#pragma unroll
    for (int j = 0; j < 16; ++j) n.A.v[j] = gg.v[j] * (1.0f + sc.v[j]);
}
DEVI void norm_ab(const Row16& x, const NormAB& n, Row16& o) {
    float ss = 0.f;
#pragma unroll
    for (int j = 0; j < 16; ++j) ss += x.v[j] * x.v[j];
    ss = wave_sum(ss);
    const float rstd = rsqrtf(ss * (1.0f / D) + EPS);
#pragma unroll
    for (int j = 0; j < 16; ++j) o.v[j] = x.v[j] * rstd * n.A.v[j] + n.B.v[j];
}
DEVI void ph_init_norm(const P& p) {
    const int otid_ = otid();
    const int wave = __builtin_amdgcn_readfirstlane(otid_ >> 6), lane = otid_ & 63, gw = blockIdx.x * NWV + wave, NGW = gridDim.x * NWV;
    NormAB nl; normab_load(nl, p.in[I_N1G], mod_ptr(p, 0, 0, 0), mod_ptr(p, 0, 0, 1), lane);
    for (int r = gw; r < MA; r += 2 * NGW) {
        const int r1 = r + NGW;
        Row16 x0, x1, o;
        load_row_f32(r < TC ? p.in[I_CTX] + (size_t)r * D : p.in[I_X] + (size_t)(r - TC) * D, lane, x0);
        if (r1 < MA) load_row_f32(p.in[I_X] + (size_t)(r1 - TC) * D, lane, x1);
        NormAB n0 = nl;
        if (r < TC) normab_load(n0, p.in[I_N1G], mod_ptr(p, 0, 1, 0), mod_ptr(p, 0, 1, 1), lane);
        store_row_f32((float*)(p.ws + WS_X) + (size_t)r * D, lane, x0);
        norm_ab(x0, n0, o); store_row_bf16((bf16_t*)(p.ws + WS_XN) + (size_t)r * D, lane, o);
        if (r1 < MA) { store_row_f32((float*)(p.ws + WS_X) + (size_t)r1 * D, lane, x1); norm_ab(x1, nl, o); store_row_bf16((bf16_t*)(p.ws + WS_XN) + (size_t)r1 * D, lane, o); }
    }
}
DEVI void norm2_row(const P& p, int r, int lane, const Row16& x, const NormAB& n) {
    Row16 o; norm_ab(x, n, o);
    store_row_bf16((bf16_t*)(p.ws + WS_XN) + (size_t)r * D, lane, o);
    float m = 0.f;
#pragma unroll
    for (int j = 0; j < 16; ++j) m = fmaxf(m, fabsf(o.v[j]));
    m = wave_max_f(m);
    const float sc = m > 0.f ? 127.0f / m : 1.0f;
    unsigned char* h8 = p.ws + WS_H8 + (size_t)r * D;
    *(u32x2*)(h8 + 8 * lane) = (u32x2){pk4_i8(o.v[0] * sc, o.v[1] * sc, o.v[2] * sc, o.v[3] * sc), pk4_i8(o.v[4] * sc, o.v[5] * sc, o.v[6] * sc, o.v[7] * sc)};
    *(u32x2*)(h8 + 512 + 8 * lane) = (u32x2){pk4_i8(o.v[8] * sc, o.v[9] * sc, o.v[10] * sc, o.v[11] * sc), pk4_i8(o.v[12] * sc, o.v[13] * sc, o.v[14] * sc, o.v[15] * sc)};
    if (lane == 0) ((float*)(p.ws + WS_HS))[r] = m > 0.f ? m / 127.0f : 1.0f;
}
DEVI void ph_norm2(const P& p, int layer, int r0) {
    const int otid_ = otid();
    const int wave = __builtin_amdgcn_readfirstlane(otid_ >> 6), lane = otid_ & 63, gw = blockIdx.x * NWV + wave, NGW = gridDim.x * NWV;
    NormAB nl; normab_load(nl, p.in[I_N2G] + layer * D, mod_ptr(p, layer, 0, 3), mod_ptr(p, layer, 0, 4), lane);
    for (int r = r0 + gw; r < MA; r += 2 * NGW) {
        const int r1 = r + NGW;
        Row16 x0, x1; load_row_f32((const float*)(p.ws + WS_X) + (size_t)r * D, lane, x0);
        if (r1 < MA) load_row_f32((const float*)(p.ws + WS_X) + (size_t)r1 * D, lane, x1);
        NormAB n0 = nl;
        if (r < TC) normab_load(n0, p.in[I_N2G] + layer * D, mod_ptr(p, layer, 1, 3), mod_ptr(p, layer, 1, 4), lane);
        norm2_row(p, r, lane, x0, n0);
        if (r1 < MA) norm2_row(p, r1, lane, x1, nl);
    }
}

namespace pg8 {
#define PG8_LAS __attribute__((address_space(3)))
typedef unsigned short bf16_t;
typedef short bf16x8 __attribute__((ext_vector_type(8)));
typedef float f32x4 __attribute__((ext_vector_type(4)));
typedef unsigned u32x4 __attribute__((ext_vector_type(4)));
constexpr int BM = 256, BK = 64, HALF = 128, HTB = HALF * BK * 2  , STAGE_BYTES = 8 * HTB, NXCD = 8, WGM = 8;

__host__ __device__ __forceinline__ int lds_byte(int r, int c) { const int st = (r >> 4) * 2 + (c >> 5), rr = r & 15, cc = c & 31, ob = rr * 64 + cc * 2; return st * 1024 + (ob ^ (((ob >> 9) & 1) << 5)); }
__host__ __device__ __forceinline__ void stage_rc(int b, int& R, int& C) { const int st = b / 1024, sb = b % 1024, swz = sb ^ (((sb >> 9) & 1) << 5); R = (st >> 1) * 16 + swz / 64; C = (st & 1) * 32 + (swz % 64) / 2; }
__host__ __device__ __forceinline__ int perm32(int rho) { const int n = rho >> 4, i = rho & 15; return 8 * (i >> 2) + 4 * n + (i & 3); }

struct Unit { int pm, pn; };
struct Gemm { const bf16_t* A; const bf16_t* Bt; int M, N, K; };

struct StaticOrder {
    int nM, nN, nwg, G, c;
    __host__ __device__ void init(int M, int N, int G_, int c_) { nM = M / BM; nN = N / BM; nwg = nM * nN; G = G_; c = c_; }
    __host__ __device__ bool next(int i, Unit& u) const {
        const long L = (long)i * G + c; if (L >= nwg) return false;
        int wgid = (int)L; { const int q = nwg / NXCD, r = nwg % NXCD, xcd = wgid % NXCD, off = wgid / NXCD; wgid = (xcd < r ? xcd * (q + 1) : r * (q + 1) + (xcd - r) * q) + off; }
        const int nig = WGM * nN, gid = wgid / nig, fm = gid * WGM, gsz = (nM - fm) < WGM ? (nM - fm) : WGM;
        u.pm = fm + ((wgid % nig) % gsz); u.pn = (wgid % nig) / gsz; return true;
    }
    __device__ __forceinline__ void a_ready(const Unit&) const {}
    __device__ __forceinline__ void done(const Unit&) const {}
};
__device__ __forceinline__ unsigned cvt_pk_bf16(float lo, float hi) { unsigned r; asm volatile("v_cvt_pk_bf16_f32 %0, %1, %2" : "=v"(r) : "v"(lo), "v"(hi)); return r; }

struct EpiBf16 {
    static constexpr bool PERM = true, AFTER_DRAIN = false;
    bf16_t* O; int ldc; int row_base;
    __device__ __forceinline__ void operator()(const f32x4 (&acc)[2][2][4][2], const Unit& u, int wr, int wc, int fr, int fq) const {
        const int row0 = row_base + u.pm * BM + wr * 64 + fr, col0 = u.pn * BM + wc * 32 + 8 * fq;
#pragma unroll
        for (int ai = 0; ai < 2; ++ai)
#pragma unroll
            for (int m = 0; m < 4; ++m) { bf16_t* rowp = O + (size_t)(row0 + ai * HALF + m * 16) * ldc + col0;
#pragma unroll
                for (int bj = 0; bj < 2; ++bj) { const f32x4 v0 = acc[ai][bj][m][0], v1 = acc[ai][bj][m][1];
                    u32x4 w; w.x = ::pk2(v0[0], v0[1]); w.y = ::pk2(v0[2], v0[3]); w.z = ::pk2(v1[0], v1[1]); w.w = ::pk2(v1[2], v1[3]);
                    *(u32x4*)(rowp + bj * HALF) = w; } }
    }
};
struct EpiHgrnIn {
    static constexpr bool PERM = true, AFTER_DRAIN = false;
    bf16_t* O; int ldc; int row_base; const float* lbv;
    __device__ __forceinline__ void operator()(const f32x4 (&acc)[2][2][4][2], const Unit& u, int wr, int wc, int fr, int fq) const {
        const int row0 = row_base + u.pm * BM + wr * 64 + fr, col0 = u.pn * BM + wc * 32 + 8 * fq;
        const int blk = u.pn >> 2;
#pragma unroll
        for (int bj = 0; bj < 2; ++bj) {
            float lb8[8];
#pragma unroll
            for (int j = 0; j < 8; ++j) lb8[j] = (blk == 2 || blk == 3) ? lbv[(blk - 2) * 1024 + ((col0 + bj * HALF) & 1023) + j] : 0.f;
#pragma unroll
            for (int ai = 0; ai < 2; ++ai)
#pragma unroll
                for (int m = 0; m < 4; ++m) { const f32x4 v0 = acc[ai][bj][m][0], v1 = acc[ai][bj][m][1]; float x[8] = {v0[0], v0[1], v0[2], v0[3], v1[0], v1[1], v1[2], v1[3]};
#pragma unroll
                    for (int j = 0; j < 8; ++j) {
                        if (blk == 0 || blk == 4) x[j] = x[j] * frcp_(1.0f + __expf(-x[j]));
                        else if (blk == 2 || blk == 3) x[j] = __builtin_amdgcn_logf(lb8[j] + (1.0f - lb8[j]) * frcp_(1.0f + __expf(-x[j])));
                    }
                    u32x4 w; w.x = ::pk2(x[0], x[1]); w.y = ::pk2(x[2], x[3]); w.z = ::pk2(x[4], x[5]); w.w = ::pk2(x[6], x[7]);
                    *(u32x4*)(O + (size_t)(row0 + ai * HALF + m * 16) * ldc + col0 + bj * HALF) = w; }
        }
    }
};
typedef _Float16 f16x2_t __attribute__((ext_vector_type(2)));
__device__ __forceinline__ unsigned pkh2(float lo, float hi) { ::f32x2_t f = {lo, hi}; return __builtin_bit_cast(unsigned, __builtin_convertvector(f, f16x2_t)); }
struct EpiF16 {
    static constexpr bool PERM = true, AFTER_DRAIN = false;
    unsigned short* O; int ldc; int row_base;
    __device__ __forceinline__ void operator()(const f32x4 (&acc)[2][2][4][2], const Unit& u, int wr, int wc, int fr, int fq) const {
        const int row0 = row_base + u.pm * BM + wr * 64 + fr, col0 = u.pn * BM + wc * 32 + 8 * fq;
#pragma unroll
        for (int ai = 0; ai < 2; ++ai)
#pragma unroll
            for (int m = 0; m < 4; ++m) { unsigned short* rowp = O + (size_t)(row0 + ai * HALF + m * 16) * ldc + col0;
#pragma unroll
                for (int bj = 0; bj < 2; ++bj) { const f32x4 v0 = acc[ai][bj][m][0], v1 = acc[ai][bj][m][1];
                    u32x4 w; w.x = pkh2(v0[0], v0[1]); w.y = pkh2(v0[2], v0[3]); w.z = pkh2(v1[0], v1[1]); w.w = pkh2(v1[2], v1[3]);
                    *(u32x4*)(rowp + bj * HALF) = w; } }
    }
};
struct EpiGluResid {
    static constexpr bool PERM = false, AFTER_DRAIN = false;
    float* X; const float* gate1; int row_base;
    __device__ __forceinline__ void operator()(const f32x4 (&acc)[2][2][4][2], const Unit& u, int wr, int wc, int fr, int fq) const {
        const int row0 = row_base + u.pm * BM + wr * 64 + fr, ch0 = u.pn * HALF + wc * 32 + 4 * fq;
        f32x4 gv[2];
#pragma unroll
        for (int n = 0; n < 2; ++n) gv[n] = *(const f32x4*)(gate1 + ch0 + n * 16);
#pragma unroll
        for (int ai = 0; ai < 2; ++ai)
#pragma unroll
            for (int m = 0; m < 4; ++m) { float* rowp = X + (size_t)(row0 + ai * HALF + m * 16) * 1024 + ch0;
#pragma unroll
                for (int n = 0; n < 2; ++n) { const f32x4 v = acc[ai][0][m][n], g = acc[ai][1][m][n]; f32x4 o;
#pragma unroll
                    for (int j = 0; j < 4; ++j) o[j] = gv[n][j] * v[j] * frcp_(1.0f + __expf(-g[j]));
                    f32x4* q = (f32x4*)(rowp + n * 16); *q = *q + o; } }
    }
};
struct EpiResid {
    static constexpr bool PERM = false, AFTER_DRAIN = false;
    float* X; const float* gate_lat; const float* gate_ctx; int row_base; int tc_rows;
    __device__ __forceinline__ void operator()(const f32x4 (&acc)[2][2][4][2], const Unit& u, int wr, int wc, int fr, int fq) const {
        const int row0 = row_base + u.pm * BM + wr * 64 + fr, col0 = u.pn * BM + wc * 32 + 4 * fq;
        const float* gate = (row_base + u.pm * BM) < tc_rows ? gate_ctx : gate_lat;
        f32x4 gv[2][2];
#pragma unroll
        for (int bj = 0; bj < 2; ++bj)
#pragma unroll
            for (int n = 0; n < 2; ++n) gv[bj][n] = *(const f32x4*)(gate + col0 + bj * HALF + n * 16);
#pragma unroll
        for (int ai = 0; ai < 2; ++ai)
#pragma unroll
            for (int m = 0; m < 4; ++m) { float* rowp = X + (size_t)(row0 + ai * HALF + m * 16) * 1024 + col0;
#pragma unroll
                for (int bj = 0; bj < 2; ++bj)
#pragma unroll
                    for (int n = 0; n < 2; ++n) { f32x4* q = (f32x4*)(rowp + bj * HALF + n * 16); *q = *q + gv[bj][n] * acc[ai][bj][m][n]; } }
    }
};

template <class Epi, class Sched, bool ALIGN_EPI = false, bool SP2 = false>
__device__ __forceinline__ void gemm_phase(PG8_LAS unsigned char* lds, const Gemm g, const Sched& S, const Epi& E) {
    const int tid = otid(), wid = __builtin_amdgcn_readfirstlane(tid >> 6), lane = tid & 63, wr = wid >> 2, wc = wid & 3, fr = lane & 15, fq = lane >> 4;
    const int K = g.K, nt = K / BK;
    unsigned voffA[2], voffB[2];
#pragma unroll
    for (int i = 0; i < 2; ++i) { int R, C; stage_rc(tid * 16 + i * 8192, R, C); const int Rb = Epi::PERM ? ((R & ~31) + perm32(R & 31)) : R;
        voffA[i] = (unsigned)(R * K + C) * 2u; voffB[i] = (unsigned)(Rb * K + C) * 2u; }
    const size_t kstep = (size_t)(BK * 2);
    const size_t hstep = (size_t)HALF * K * 2;
    const size_t tstep = 2 * hstep;
    const unsigned ldsw = (unsigned)wid * 1024u;
    const int aoff = lds_byte(wr * 64 + fr, fq * 8), boff = lds_byte(wc * 32 + fr, fq * 8);
#define PG8_SA(b, h) (((b) * 2 + (h)) * HTB)
#define PG8_SB(b, h) ((4 + (b) * 2 + (h)) * HTB)
#define PG8_STAGE(bufoff, gbase, voff) do { _Pragma("unroll") for (int _i = 0; _i < 2; ++_i) \
        __builtin_amdgcn_global_load_lds((const unsigned*)((const char*)(gbase) + (voff)[_i]), (PG8_LAS unsigned*)(lds + (bufoff) + ldsw + _i * 8192), 16, 0, 0); } while (0)
#define PG8_LDA(dst, b, h) do { _Pragma("unroll") for (int m = 0; m < 4; ++m) _Pragma("unroll") for (int k = 0; k < 2; ++k) dst[m][k] = *(const PG8_LAS bf16x8*)(lds + PG8_SA(b, h) + aoff + m * 2048 + k * 1024); } while (0)
#define PG8_LDB(dst, b, h) do { _Pragma("unroll") for (int n = 0; n < 2; ++n) _Pragma("unroll") for (int k = 0; k < 2; ++k) dst[n][k] = *(const PG8_LAS bf16x8*)(lds + PG8_SB(b, h) + boff + n * 2048 + k * 1024); } while (0)
#define PG8_MMA(ai, bj, At, Bt) do { __builtin_amdgcn_s_setprio(1); _Pragma("unroll") for (int m = 0; m < 4; ++m) _Pragma("unroll") for (int n = 0; n < 2; ++n) _Pragma("unroll") for (int k = 0; k < 2; ++k) \
        acc[ai][bj][m][n] = __builtin_amdgcn_mfma_f32_16x16x32_bf16(Bt[n][k], At[m][k], acc[ai][bj][m][n], 0, 0, 0); __builtin_amdgcn_s_setprio(0); } while (0)
#define PG8_WAIT_V(n) asm volatile("s_waitcnt vmcnt(" #n ")" ::: "memory")
#define PG8_WAIT_L(n) asm volatile("s_waitcnt lgkmcnt(" #n ")" ::: "memory")
#define PG8_BAR __builtin_amdgcn_s_barrier()
#define PG8_SCHED __builtin_amdgcn_sched_barrier(0)
    Unit cur, nxt; int ui = 0;
    if (!S.next(0, cur)) return;
    f32x4 acc[2][2][4][2];
#pragma unroll
    for (int a = 0; a < 2; ++a)
#pragma unroll
        for (int b = 0; b < 2; ++b)
#pragma unroll
            for (int m = 0; m < 4; ++m)
#pragma unroll
                for (int n = 0; n < 2; ++n) acc[a][b][m][n] = (f32x4){0.f, 0.f, 0.f, 0.f};
    bf16x8 At[4][2], B0[2][2], B1[2][2];
    const char* cA = (const char*)g.A + (size_t)cur.pm * tstep; const char* cB = (const char*)g.Bt + (size_t)cur.pn * tstep;
    S.a_ready(cur);
    if constexpr (SP2) {
        PG8_STAGE(PG8_SB(0, 0), cB, voffB); PG8_STAGE(PG8_SB(0, 1), cB + hstep, voffB); PG8_STAGE(PG8_SA(0, 0), cA, voffA); PG8_STAGE(PG8_SA(0, 1), cA + hstep, voffA);
        if (wr == 1) PG8_BAR;
        PG8_WAIT_V(2); PG8_BAR;
        PG8_STAGE(PG8_SB(1, 0), cB + kstep, voffB); PG8_STAGE(PG8_SA(1, 0), cA + kstep, voffA); PG8_STAGE(PG8_SB(1, 1), cB + hstep + kstep, voffB);
        PG8_WAIT_V(6); PG8_BAR;
    } else {
        PG8_STAGE(PG8_SB(0, 0), cB, voffB); PG8_STAGE(PG8_SA(0, 0), cA, voffA); PG8_STAGE(PG8_SB(0, 1), cB + hstep, voffB); PG8_STAGE(PG8_SA(0, 1), cA + hstep, voffA);
        if (wr == 1) PG8_BAR;
        PG8_WAIT_V(4); PG8_BAR;
        PG8_STAGE(PG8_SB(1, 0), cB + kstep, voffB); PG8_STAGE(PG8_SA(1, 0), cA + kstep, voffA); PG8_STAGE(PG8_SB(1, 1), cB + hstep + kstep, voffB);
        PG8_WAIT_V(6); PG8_BAR;
    }
    for (;;) {
        const bool has_next = S.next(ui + 1, nxt);
        const char* nA = has_next ? (const char*)g.A + (size_t)nxt.pm * tstep : cA; const char* nB = has_next ? (const char*)g.Bt + (size_t)nxt.pn * tstep : cB;
        for (int t = 0; t < nt; t += 2) {
            const bool last = (t == nt - 2);
            const char* a1 = cA + (size_t)(t + 1) * kstep;
            const char* a2 = last ? nA : cA + (size_t)(t + 2) * kstep; const char* b2 = last ? nB : cB + (size_t)(t + 2) * kstep;
            const char* a3 = a2 + kstep; const char* b3 = b2 + kstep;
            if (last && has_next) S.a_ready(nxt);
            if constexpr (SP2) {
            PG8_LDB(B0, 0, 0); PG8_LDB(B1, 0, 1); PG8_SCHED; PG8_LDA(At, 0, 0); PG8_STAGE(PG8_SA(1, 1), a1 + hstep, voffA);
            PG8_WAIT_V(8); PG8_WAIT_L(0); PG8_BAR; PG8_MMA(0, 0, At, B0); PG8_MMA(0, 1, At, B1); PG8_BAR; PG8_SCHED;
            PG8_LDA(At, 0, 1); PG8_STAGE(PG8_SB(0, 0), b2, voffB); PG8_STAGE(PG8_SB(0, 1), b2 + hstep, voffB); PG8_STAGE(PG8_SA(0, 0), a2, voffA);
            PG8_WAIT_V(8); PG8_WAIT_L(0); PG8_BAR; PG8_MMA(1, 0, At, B0); PG8_MMA(1, 1, At, B1); PG8_BAR; PG8_SCHED;
            PG8_LDB(B0, 1, 0); PG8_LDB(B1, 1, 1); PG8_SCHED; PG8_LDA(At, 1, 0); PG8_STAGE(PG8_SA(0, 1), a2 + hstep, voffA);
            PG8_WAIT_V(8); PG8_WAIT_L(0); PG8_BAR; PG8_MMA(0, 0, At, B0); PG8_MMA(0, 1, At, B1); PG8_BAR; PG8_SCHED;
            PG8_LDA(At, 1, 1); PG8_STAGE(PG8_SB(1, 0), b3, voffB); PG8_STAGE(PG8_SB(1, 1), b3 + hstep, voffB); PG8_STAGE(PG8_SA(1, 0), a3, voffA);
            PG8_WAIT_V(8); PG8_WAIT_L(0); PG8_BAR; PG8_MMA(1, 0, At, B0); PG8_MMA(1, 1, At, B1); PG8_BAR; PG8_SCHED;
            } else {
            PG8_LDB(B0, 0, 0); PG8_SCHED; PG8_LDA(At, 0, 0); PG8_STAGE(PG8_SA(1, 1), a1 + hstep, voffA);
            PG8_WAIT_L(8); PG8_BAR; PG8_WAIT_L(0); PG8_MMA(0, 0, At, B0); PG8_BAR; PG8_SCHED;
            PG8_LDB(B1, 0, 1); PG8_STAGE(PG8_SB(0, 0), b2, voffB);
            PG8_BAR; PG8_WAIT_L(0); PG8_MMA(0, 1, At, B1); PG8_BAR;
            PG8_LDA(At, 0, 1); PG8_STAGE(PG8_SA(0, 0), a2, voffA);
            PG8_BAR; PG8_WAIT_L(0); PG8_MMA(1, 0, At, B0); PG8_BAR; PG8_SCHED;
            PG8_STAGE(PG8_SB(0, 1), b2 + hstep, voffB);
            PG8_WAIT_V(6); PG8_BAR; PG8_MMA(1, 1, At, B1); PG8_BAR;
            PG8_LDB(B0, 1, 0); PG8_SCHED; PG8_LDA(At, 1, 0); PG8_STAGE(PG8_SA(0, 1), a2 + hstep, voffA);
            PG8_WAIT_L(8); PG8_BAR; PG8_WAIT_L(0); PG8_MMA(0, 0, At, B0); PG8_BAR; PG8_SCHED;
            PG8_LDB(B1, 1, 1); PG8_STAGE(PG8_SB(1, 0), b3, voffB);
            PG8_BAR; PG8_WAIT_L(0); PG8_MMA(0, 1, At, B1); PG8_BAR;
            PG8_LDA(At, 1, 1); PG8_STAGE(PG8_SA(1, 0), a3, voffA);
            PG8_BAR; PG8_WAIT_L(0); PG8_MMA(1, 0, At, B0); PG8_BAR; PG8_SCHED;
            PG8_STAGE(PG8_SB(1, 1), b3 + hstep, voffB);
            PG8_WAIT_V(6); PG8_BAR; PG8_MMA(1, 1, At, B1); PG8_BAR;
            }
        }
        if constexpr (ALIGN_EPI) { if (wr == 0) PG8_BAR; }
        if constexpr (!Epi::AFTER_DRAIN) { E(acc, cur, wr, wc, fr, fq); S.done(cur); }
        if (!has_next) break;
#pragma unroll
        for (int a = 0; a < 2; ++a)
#pragma unroll
            for (int b = 0; b < 2; ++b)
#pragma unroll
                for (int m = 0; m < 4; ++m)
#pragma unroll
                    for (int n = 0; n < 2; ++n) acc[a][b][m][n] = (f32x4){0.f, 0.f, 0.f, 0.f};
        cur = nxt; cA = nA; cB = nB; ++ui;
        if constexpr (ALIGN_EPI) { if (wr == 1) PG8_BAR; }
    }
    PG8_WAIT_V(0);
    if constexpr (!ALIGN_EPI) { if (wr == 0) PG8_BAR; }
    PG8_BAR;
    if constexpr (Epi::AFTER_DRAIN) { E.fused(acc, cur, wr, wc, fr, fq, lds, wid, lane); S.done(cur); }
#undef PG8_SA
#undef PG8_SB
#undef PG8_STAGE
#undef PG8_LDA
#undef PG8_LDB
#undef PG8_MMA
#undef PG8_WAIT_V
#undef PG8_WAIT_L
#undef PG8_BAR
#undef PG8_SCHED
}
}

struct ConvRaw { u32x4 gb[2], gc[2], v[2], gcp[2], vp[2], gcn[2], vn[2]; };
DEVI void conv_raw_row(u32x4 (&o)[2], const bf16_t* row, int lane) { o[0] = *(const u32x4*)(row + 8 * lane); o[1] = *(const u32x4*)(row + 512 + 8 * lane); }
DEVI void conv_load(ConvRaw& c, const bf16_t* G, int r, int lane, bool hasp, bool hasn) {
    conv_raw_row(c.gb, G + (size_t)r * 3072, lane); conv_raw_row(c.gc, G + (size_t)r * 3072 + 1024, lane); conv_raw_row(c.v, G + (size_t)r * 3072 + 2048, lane);
    if (hasp) { conv_raw_row(c.gcp, G + (size_t)(r - 1) * 3072 + 1024, lane); conv_raw_row(c.vp, G + (size_t)(r - 1) * 3072 + 2048, lane); }
    if (hasn) { conv_raw_row(c.gcn, G + (size_t)(r + 1) * 3072 + 1024, lane); conv_raw_row(c.vn, G + (size_t)(r + 1) * 3072 + 2048, lane); }
}
DEVI void conv_unpack(const u32x4 (&a)[2], Row16& o) {
#pragma unroll
    for (int j = 0; j < 4; ++j) { o.v[2 * j] = bflo(a[0][j]); o.v[2 * j + 1] = bfhi(a[0][j]); o.v[8 + 2 * j] = bflo(a[1][j]); o.v[8 + 2 * j + 1] = bfhi(a[1][j]); }
}
DEVI void conv_finish(const P& p, const ConvRaw& c, int r, int lane, bool hasp, bool hasn, const Row16& k0, const Row16& k1, const Row16& k2) {
    Row16 gb, gc, v, acc;
    conv_unpack(c.gc, gc); conv_unpack(c.v, v);
#pragma unroll
    for (int e = 0; e < 16; ++e) acc.v[e] = gc.v[e] * v.v[e] * k1.v[e];
    if (hasp) { conv_unpack(c.gcp, gc); conv_unpack(c.vp, v);
#pragma unroll
        for (int e = 0; e < 16; ++e) acc.v[e] += gc.v[e] * v.v[e] * k0.v[e]; }
    if (hasn) { conv_unpack(c.gcn, gc); conv_unpack(c.vn, v);
#pragma unroll
        for (int e = 0; e < 16; ++e) acc.v[e] += gc.v[e] * v.v[e] * k2.v[e]; }
    conv_unpack(c.gb, gb);
#pragma unroll
    for (int e = 0; e < 16; ++e) acc.v[e] *= gb.v[e];
    store_row_bf16((bf16_t*)(p.ws + WS_U) + (size_t)r * D, lane, acc);
}
DEVI void conv_edges(int r, bool& hasp, bool& hasn) { if (r < TC) { hasp = r > 0; hasn = r < TC - 1; } else { const int t = (r - TC) & 63; hasp = t != 0; hasn = t != 63; } }
DEVI void ph_conv(const P& p, int j, int r0) {
    const int otid_ = otid();
    const int wave = __builtin_amdgcn_readfirstlane(otid_ >> 6), lane = otid_ & 63, gw = blockIdx.x * NWV + wave, NGW = gridDim.x * NWV;
    const bf16_t* G = (const bf16_t*)(p.ws + WS_G);
    Row16 k0, k1, k2;
    load_row_f32(p.in[I_CK] + (size_t)(j * 3 + 0) * D, lane, k0); load_row_f32(p.in[I_CK] + (size_t)(j * 3 + 1) * D, lane, k1); load_row_f32(p.in[I_CK] + (size_t)(j * 3 + 2) * D, lane, k2);
    for (int r = r0 + gw; r < MA; r += 2 * NGW) {
        const int r1 = r + NGW;
        bool hp0, hn0, hp1 = false, hn1 = false; conv_edges(r, hp0, hn0); if (r1 < MA) conv_edges(r1, hp1, hn1);
        ConvRaw c0, c1;
        conv_load(c0, G, r, lane, hp0, hn0);
        if (r1 < MA) conv_load(c1, G, r1, lane, hp1, hn1);
        conv_finish(p, c0, r, lane, hp0, hn0, k0, k1, k2);
        if (r1 < MA) conv_finish(p, c1, r1, lane, hp1, hn1, k0, k1, k2);
    }
}

DEVI int scan_row(int n, int dir) {
    if (dir == 0) return n;
    return n < TC ? (TC - 1 - n) : (TC + (T - 1 - (n - TC)));
}
namespace hg {
typedef short bf16x8 __attribute__((ext_vector_type(8)));
constexpr int NSEG = 16, NUNIT = 2 * 8 * NSEG;
constexpr int QSB = 272, TSB = 80;
constexpr int OFF_QT = 0, OFF_KT = 32 * QSB, OFF_QD = 2 * 32 * QSB, OFF_KDT = 3 * 32 * QSB, OFF_VT = OFF_KDT + 128 * TSB, OFF_DEC = OFF_VT + 128 * TSB, OFF_T = OFF_DEC + 512, BUFB = OFF_T + 4096;
static_assert(2 * BUFB <= 131072, "hgrn LDS");
DEVI bf16x8 mk8(unsigned a, unsigned b, unsigned c, unsigned d) { u32x4 v = {a, b, c, d}; return __builtin_bit_cast(bf16x8, v); }
DEVI unsigned cvtpk(float lo, float hi) { return pk2(lo, hi); }
#define HG_MFMA(a, b, c) __builtin_amdgcn_mfma_f32_16x16x32_bf16((a), (b), (c), 0, 0, 0)
#define HG_BAR() do { asm volatile("s_waitcnt lgkmcnt(0)" ::: "memory"); __builtin_amdgcn_s_barrier(); asm volatile("" ::: "memory"); } while (0)
template <bool PASS2>
DEVI void scan(const P& p, unsigned char* lds_) {
    for (int unit = blockIdx.x; unit < NUNIT; unit += gridDim.x) {
    __syncthreads();
    const int tid = otid(), lane = tid & 63, w = __builtin_amdgcn_readfirstlane(tid >> 6), c = lane & 15, q4 = lane >> 4;
    const int kp = lane, lo = w;
    const int d = unit / (8 * NSEG), h = (unit / NSEG) & 7, seg = unit % NSEG;
    LAS unsigned char* lds = (LAS unsigned char*)lds_;
    const bf16_t* G = (const bf16_t*)(p.ws + WS_G);
    bf16_t* O = (bf16_t*)(p.ws + (d ? WS_OB : WS_OF));
    float* SLOC = (float*)(p.ws + WS_SC);
    float* GSUM = SLOC + (size_t)NUNIT * 16384;
    f32x4 S[8];
#pragma unroll
    for (int t = 0; t < 8; ++t) S[t] = (f32x4){0.f, 0.f, 0.f, 0.f};
    if (PASS2) {
        for (int j = 0; j < seg; ++j) {
            const float* gs = GSUM + (size_t)(unit - seg + j) * 128; const float* sl = SLOC + (size_t)(unit - seg + j) * 16384 + (size_t)w * 2048;
#pragma unroll
            for (int t = 0; t < 8; ++t) { const f32x4 gg = *(const f32x4*)(gs + 16 * t + 4 * q4);
#pragma unroll
                for (int r = 0; r < 4; ++r) S[t][r] = S[t][r] * __builtin_amdgcn_exp2f(gg[r]) + sl[(t * 4 + r) * 64 + lane]; }
        }
    }
    float gsum0 = 0.f, gsum1 = 0.f;
    unsigned rq[4], ri[4], rz[4];
    const int CPS = 32 + (seg < 8 ? 1 : 0), ci0 = 32 * seg + (seg < 8 ? seg : 8);
    const bf16_t* Gk = G + h * 128 + 2 * kp + (d ? 1024 : 0);
    const long rstep = d ? -5120 : 5120;
#define HG_FETCH(ci) do { const bf16_t* g_ = Gk + (long)scan_row(32 * (ci) + 4 * lo, d) * 5120; _Pragma("unroll") for (int j = 0; j < 4; ++j) { \
        if (PASS2) rq[j] = *(const unsigned*)(g_ + (d ? -1024 : 0)); ri[j] = *(const unsigned*)(g_ + (d ? 0 : 1024)); rz[j] = *(const unsigned*)(g_ + 2048); g_ += rstep; } } while (0)
    HG_FETCH(ci0);
    for (int cc = 0; cc < CPS; ++cc) {
        const int ci = ci0 + cc;
        LAS unsigned char* B = lds + (cc & 1) * BUFB;
        float bl0[4], bl1[4], kv0[4], kv1[4]; float run0 = 0.f, run1 = 0.f;
#pragma unroll
        for (int j = 0; j < 4; ++j) { const float z0 = bflo(rz[j]), z1 = bfhi(rz[j]); run0 += z0; run1 += z1; bl0[j] = run0; bl1[j] = run1; kv0[j] = 1.0f - __builtin_amdgcn_exp2f(z0); kv1[j] = 1.0f - __builtin_amdgcn_exp2f(z1); }
        unsigned qp[4], vp[4];
#pragma unroll
        for (int j = 0; j < 4; ++j) { vp[j] = ri[j]; if (PASS2) qp[j] = rq[j]; }
        *(LAS f32x2_t*)(B + OFF_T + (lo * 128 + 2 * kp) * 4) = (f32x2_t){run0, run1};
        if (cc + 1 < CPS) HG_FETCH(ci + 1);
        HG_BAR();
        {
            float off0 = 0.f, off1 = 0.f, b15_0 = 0.f, b15_1 = 0.f, bla0 = 0.f, bla1 = 0.f;
#pragma unroll
            for (int x8 = 0; x8 < 8; ++x8) { const f32x2_t tt = *(const LAS f32x2_t*)(B + OFF_T + (x8 * 128 + 2 * kp) * 4);
                if (x8 < lo) { off0 += tt.x; off1 += tt.y; } if (x8 < 4) { b15_0 += tt.x; b15_1 += tt.y; } bla0 += tt.x; bla1 += tt.y; }
            const float e15_0 = __builtin_amdgcn_exp2f(b15_0), e15_1 = __builtin_amdgcn_exp2f(b15_1), el0 = __builtin_amdgcn_exp2f(bla0 - b15_0), el1 = __builtin_amdgcn_exp2f(bla1 - b15_1);
            float kd0[4], kd1[4];
#pragma unroll
            for (int j = 0; j < 4; ++j) {
                const int l = 4 * lo + j;
                const float b0 = bl0[j] + off0, b1 = bl1[j] + off1;
                const float kt0 = kv0[j] * __builtin_amdgcn_exp2f(b15_0 - b0), kt1 = kv1[j] * __builtin_amdgcn_exp2f(b15_1 - b1);
                kd0[j] = kt0 * el0; kd1[j] = kt1 * el1;
                if (PASS2) {
                    const float qt0 = bflo(qp[j]) * __builtin_amdgcn_exp2f(b0 - b15_0), qt1 = bfhi(qp[j]) * __builtin_amdgcn_exp2f(b1 - b15_1);
                    *(LAS unsigned*)(B + OFF_QT + l * QSB + 4 * kp) = pk2(qt0, qt1); *(LAS unsigned*)(B + OFF_QD + l * QSB + 4 * kp) = pk2(qt0 * e15_0, qt1 * e15_1);
                    *(LAS unsigned*)(B + OFF_KT + l * QSB + 4 * kp) = pk2(kt0, kt1);
                }
            }
            *(LAS u32x2*)(B + OFF_KDT + (2 * kp) * TSB + 8 * lo) = (u32x2){pk2(kd0[0], kd0[1]), pk2(kd0[2], kd0[3])};
            *(LAS u32x2*)(B + OFF_KDT + (2 * kp + 1) * TSB + 8 * lo) = (u32x2){pk2(kd1[0], kd1[1]), pk2(kd1[2], kd1[3])};
            *(LAS u32x2*)(B + OFF_VT + (2 * kp) * TSB + 8 * lo) = (u32x2){(vp[0] & 0xffffu) | (vp[1] << 16), (vp[2] & 0xffffu) | (vp[3] << 16)};
            *(LAS u32x2*)(B + OFF_VT + (2 * kp + 1) * TSB + 8 * lo) = (u32x2){(vp[0] >> 16) | (vp[1] & 0xffff0000u), (vp[2] >> 16) | (vp[3] & 0xffff0000u)};
            if (lo == 0) { *(LAS f32x2_t*)(B + OFF_DEC + 8 * kp) = (f32x2_t){__builtin_amdgcn_exp2f(bla0), __builtin_amdgcn_exp2f(bla1)}; gsum0 += bla0; gsum1 += bla1; }
        }
        HG_BAR();
        if (PASS2) {
            f32x4 p00 = {0.f, 0.f, 0.f, 0.f}, p01 = p00, p11 = p00;
#pragma unroll
            for (int s4 = 0; s4 < 4; ++s4) {
                const bf16x8 a0 = *(const LAS bf16x8*)(B + OFF_KT + c * QSB + 64 * s4 + 16 * q4), a1 = *(const LAS bf16x8*)(B + OFF_KT + (16 + c) * QSB + 64 * s4 + 16 * q4);
                const bf16x8 b0 = *(const LAS bf16x8*)(B + OFF_QT + c * QSB + 64 * s4 + 16 * q4), b1 = *(const LAS bf16x8*)(B + OFF_QT + (16 + c) * QSB + 64 * s4 + 16 * q4);
                p00 = HG_MFMA(a0, b0, p00); p01 = HG_MFMA(a0, b1, p01); p11 = HG_MFMA(a1, b1, p11);
            }
#pragma unroll
            for (int r = 0; r < 4; ++r) { const bool keep = (4 * q4 + r) <= c; p00[r] = keep ? p00[r] : 0.f; p11[r] = keep ? p11[r] : 0.f; }
            const bf16x8 bp0 = mk8(cvtpk(p00[0], p00[1]), cvtpk(p00[2], p00[3]), 0u, 0u);
            const bf16x8 bp1 = mk8(cvtpk(p01[0], p01[1]), cvtpk(p01[2], p01[3]), cvtpk(p11[0], p11[1]), cvtpk(p11[2], p11[3]));
            const u32x2 v0 = *(const LAS u32x2*)(B + OFF_VT + (16 * w + c) * TSB + 8 * q4), v1 = *(const LAS u32x2*)(B + OFF_VT + (16 * w + c) * TSB + 32 + 8 * q4);
            const bf16x8 va = mk8(v0.x, v0.y, v1.x, v1.y);
            f32x4 o0 = {0.f, 0.f, 0.f, 0.f}, o1 = o0;
            o0 = HG_MFMA(va, bp0, o0); o1 = HG_MFMA(va, bp1, o1);
#pragma unroll
            for (int s4 = 0; s4 < 4; ++s4) {
                const bf16x8 sa = mk8(cvtpk(S[2 * s4][0], S[2 * s4][1]), cvtpk(S[2 * s4][2], S[2 * s4][3]), cvtpk(S[2 * s4 + 1][0], S[2 * s4 + 1][1]), cvtpk(S[2 * s4 + 1][2], S[2 * s4 + 1][3]));
                const u32x2 x0 = *(const LAS u32x2*)(B + OFF_QD + c * QSB + 64 * s4 + 8 * q4), x1 = *(const LAS u32x2*)(B + OFF_QD + c * QSB + 64 * s4 + 32 + 8 * q4);
                const u32x2 y0 = *(const LAS u32x2*)(B + OFF_QD + (16 + c) * QSB + 64 * s4 + 8 * q4), y1 = *(const LAS u32x2*)(B + OFF_QD + (16 + c) * QSB + 64 * s4 + 32 + 8 * q4);
                o0 = HG_MFMA(sa, mk8(x0.x, x0.y, x1.x, x1.y), o0); o1 = HG_MFMA(sa, mk8(y0.x, y0.y, y1.x, y1.y), o1);
            }
            {
                const int ra = scan_row(32 * ci + c, d), rb = scan_row(32 * ci + 16 + c, d);
                *(u32x2*)(O + (size_t)ra * D + h * 128 + 16 * w + 4 * q4) = (u32x2){cvtpk(o0[0], o0[1]), cvtpk(o0[2], o0[3])};
                *(u32x2*)(O + (size_t)rb * D + h * 128 + 16 * w + 4 * q4) = (u32x2){cvtpk(o1[0], o1[1]), cvtpk(o1[2], o1[3])};
            }
        }
        {
            const bf16x8 vb = *(const LAS bf16x8*)(B + OFF_VT + (16 * w + c) * TSB + 16 * q4);
#pragma unroll
            for (int t = 0; t < 8; ++t) {
                const f32x4 dec = *(const LAS f32x4*)(B + OFF_DEC + (16 * t + 4 * q4) * 4);
                const bf16x8 ka = *(const LAS bf16x8*)(B + OFF_KDT + (16 * t + c) * TSB + 16 * q4);
                S[t] = HG_MFMA(ka, vb, S[t] * dec);
            }
        }
    }
    if (!PASS2) {
        float* sl = SLOC + (size_t)unit * 16384 + (size_t)w * 2048;
#pragma unroll
        for (int t = 0; t < 8; ++t)
#pragma unroll
            for (int r = 0; r < 4; ++r) sl[(t * 4 + r) * 64 + lane] = S[t][r];
        if (lo == 0) { GSUM[(size_t)unit * 128 + 2 * kp] = gsum0; GSUM[(size_t)unit * 128 + 2 * kp + 1] = gsum1; }
    }
#undef HG_FETCH
    }
}
}

DEVI void hgrn_readout_row(const P& p, int r, int lane, Row16& a, const Row16& b, const Row16& zg, const Row16& ng) {
    Row16 o; float s0 = 0.f, s1 = 0.f;
#pragma unroll
    for (int e = 0; e < 8; ++e) { a.v[e] += b.v[e]; a.v[8 + e] += b.v[8 + e]; s0 += a.v[e] * a.v[e]; s1 += a.v[8 + e] * a.v[8 + e]; }
    s0 = row16_sum(s0); s1 = row16_sum(s1);
    const float r0 = rsqrtf(s0 * (1.0f / 128.0f) + EPS), r1 = rsqrtf(s1 * (1.0f / 128.0f) + EPS);
#pragma unroll
    for (int e = 0; e < 8; ++e) { o.v[e] = a.v[e] * r0 * ng.v[e] * zg.v[e]; o.v[8 + e] = a.v[8 + e] * r1 * ng.v[8 + e] * zg.v[8 + e]; }
    store_row_bf16((bf16_t*)(p.ws + WS_U) + (size_t)r * D, lane, o);
}
DEVI void ph_hgrn_readout(const P& p) {
    const int otid_ = otid();
    const int wave = __builtin_amdgcn_readfirstlane(otid_ >> 6), lane = otid_ & 63, gw = blockIdx.x * NWV + wave, NGW = gridDim.x * NWV;
    Row16 ng; load_row_f32(p.in[I_HNG], lane, ng);
    for (int r = gw; r < MA; r += 2 * NGW) {
        const int r1 = r + NGW;
        Row16 a0, b0, z0, a1, b1, z1;
        load_row_bf16((const bf16_t*)(p.ws + WS_OF) + (size_t)r * D, lane, a0); load_row_bf16((const bf16_t*)(p.ws + WS_OB) + (size_t)r * D, lane, b0);
        load_row_bf16((const bf16_t*)(p.ws + WS_G) + (size_t)r * 5120 + 4096, lane, z0);
        if (r1 < MA) { load_row_bf16((const bf16_t*)(p.ws + WS_OF) + (size_t)r1 * D, lane, a1); load_row_bf16((const bf16_t*)(p.ws + WS_OB) + (size_t)r1 * D, lane, b1);
            load_row_bf16((const bf16_t*)(p.ws + WS_G) + (size_t)r1 * 5120 + 4096, lane, z1); }
        hgrn_readout_row(p, r, lane, a0, b0, z0, ng);
        if (r1 < MA) hgrn_readout_row(p, r1, lane, a1, b1, z1, ng);
    }
}

DEVI float reduce16(float (&v)[16], int lane) {
    float w8[8], w4[4], w2[2];
    const bool b5 = lane & 32, b4 = lane & 16, b3 = lane & 8, b2 = lane & 4;
#pragma unroll
    for (int i = 0; i < 8; ++i) { const float keep = b5 ? v[i + 8] : v[i], send = b5 ? v[i] : v[i + 8]; w8[i] = keep + __shfl_xor(send, 32); }
#pragma unroll
    for (int i = 0; i < 4; ++i) { const float keep = b4 ? w8[i + 4] : w8[i], send = b4 ? w8[i] : w8[i + 4]; w4[i] = keep + __shfl_xor(send, 16); }
#pragma unroll
    for (int i = 0; i < 2; ++i) { const float keep = b3 ? w4[i + 2] : w4[i], send = b3 ? w4[i] : w4[i + 2]; w2[i] = keep + __shfl_xor(send, 8); }
    const float keep = b2 ? w2[1] : w2[0], send = b2 ? w2[0] : w2[1];
    float r = keep + __shfl_xor(send, 4);
    r += __shfl_xor(r, 2); r += __shfl_xor(r, 1);
    return r;
}
namespace s5 {
typedef short bf16x8 __attribute__((ext_vector_type(8)));
constexpr int NSEG = 16, SEGLEN = MA / NSEG, CPS = SEGLEN / 16;
static_assert(SEGLEN * NSEG == MA && CPS * 16 == SEGLEN, "s5 segments");
constexpr int XSB = 272, BSB = 528, WAVE_LDS = 16 * BSB + 16 * XSB;
DEVI bf16x8 mk8(unsigned a, unsigned b, unsigned c, unsigned d) { u32x4 v = {a, b, c, d}; return __builtin_bit_cast(bf16x8, v); }
template <bool PASS2>
DEVI void scan(const P& p, unsigned char* lds_) {
    const int tid = otid(), lane = tid & 63, w = __builtin_amdgcn_readfirstlane(tid >> 6), c = lane & 15, q4 = lane >> 4;
    for (int blk = blockIdx.x; blk < 256; blk += gridDim.x) {
    const int dn = blk >> 7, seg = (blk >> 3) & 15, g = (blk & 7) * 8 + w;
    LAS unsigned char* BUS = (LAS unsigned char*)lds_ + w * WAVE_LDS; LAS unsigned char* XS = BUS + 16 * BSB;
    const bf16_t* XN = (const bf16_t*)(p.ws + WS_XN);
    bf16_t* Y = (bf16_t*)(p.ws + (dn ? WS_OB : WS_OF));
    float* XE = (float*)(p.ws + WS_XE);
    const float* Aab = (const float*)(p.ws + WS_S5A) + (size_t)((dn * 64 + g) * 64 + lane) * 2;
    const float abr = Aab[0], abi = Aab[1];
    bf16x8 bfr[8];
#pragma unroll
    for (int n = 0; n < 8; ++n) {
        if (q4 < 2) { const float* B = (const float*)(p.ws + WS_S5B) + (size_t)((dn * 64 + g) * 64 + 8 * n + (c >> 1)) * 32 + (c & 1) * 16 + 8 * q4;
            const f32x4 b0 = *(const f32x4*)B, b1 = *(const f32x4*)(B + 4); bfr[n] = mk8(pk2(b0[0], b0[1]), pk2(b0[2], b0[3]), pk2(b1[0], b1[1]), pk2(b1[2], b1[3])); }
        else bfr[n] = mk8(0u, 0u, 0u, 0u);
    }
    bf16x8 cfr[4];
    if (PASS2) {
#pragma unroll
        for (int s4 = 0; s4 < 4; ++s4) {
            const size_t o = ((size_t)(dn * 64 + g) * 16 + c) * 64 + 16 * s4 + 4 * q4;
            const f32x4 cr = *(const f32x4*)(p.in[I_S5CR] + o), ci = *(const f32x4*)(p.in[I_S5CI] + o);
            cfr[s4] = mk8(pk2(cr[0], -ci[0]), pk2(cr[1], -ci[1]), pk2(cr[2], -ci[2]), pk2(cr[3], -ci[3]));
        }
    }
    float xr = 0.f, xi = 0.f;
    if (PASS2 && seg > 0) {
        float pr = 1.f, pi = 0.f, br = abr, bi = abi;
#define S5_PIN(x) asm volatile("" : "+v"(x))
#pragma unroll 1
        for (int n = SEGLEN; n; n >>= 1) {
            if (n & 1) { float t = pr * br; S5_PIN(t); t = __builtin_fmaf(-pi, bi, t); S5_PIN(t); float u = pr * bi; S5_PIN(u); u = __builtin_fmaf(pi, br, u); S5_PIN(u); pr = t; pi = u; }
            float t2 = br * br; S5_PIN(t2); t2 = __builtin_fmaf(-bi, bi, t2); S5_PIN(t2); float u2 = 2.f * br * bi; S5_PIN(u2); br = t2; bi = u2;
        }
        for (int j = 0; j < seg; ++j) { const float* e = XE + ((size_t)((dn * 64 + g) * 16 + j) * 64 + lane) * 2; const float er = e[0], ei = e[1];
            float t = __builtin_fmaf(pr, xr, er); S5_PIN(t); t = __builtin_fmaf(-pi, xi, t); S5_PIN(t); float u = __builtin_fmaf(pr, xi, ei); S5_PIN(u); u = __builtin_fmaf(pi, xr, u); S5_PIN(u); xr = t; xi = u; }
#undef S5_PIN
    }
    const int n0 = seg * SEGLEN;
    const unsigned amask = q4 < 2 ? 0xffffffffu : 0u;
    u32x4 araw = *(const u32x4*)(XN + (size_t)scan_row(n0 + c, dn) * D + g * 16 + 8 * (q4 & 1));
#pragma unroll 1
    for (int cc = 0; cc < CPS; ++cc) {
        const u32x4 am = {araw[0] & amask, araw[1] & amask, araw[2] & amask, araw[3] & amask};
        const bf16x8 afr = __builtin_bit_cast(bf16x8, am);
        { const int cn = cc + 1 < CPS ? cc + 1 : cc; araw = *(const u32x4*)(XN + (size_t)scan_row(n0 + 16 * cn + c, dn) * D + g * 16 + 8 * (q4 & 1)); }
#pragma unroll
        for (int n = 0; n < 8; ++n) {
            const f32x4 dv = __builtin_amdgcn_mfma_f32_16x16x32_bf16(bfr[n], afr, (f32x4){0.f, 0.f, 0.f, 0.f}, 0, 0, 0);
            *(LAS f32x4*)(BUS + c * BSB + (16 * n + 4 * q4) * 4) = dv;
        }
        asm volatile("s_waitcnt lgkmcnt(0)" ::: "memory");
        f32x2_t bu[16];
#pragma unroll
        for (int t = 0; t < 16; ++t) bu[t] = *(const LAS f32x2_t*)(BUS + t * BSB + 8 * lane);
        unsigned xs[16];
#pragma unroll
        for (int t = 0; t < 16; ++t) {
            float nr = __builtin_fmaf(abr, xr, bu[t].x); asm volatile("" : "+v"(nr)); nr = __builtin_fmaf(-abi, xi, nr); asm volatile("" : "+v"(nr));
            float ni = __builtin_fmaf(abr, xi, bu[t].y); asm volatile("" : "+v"(ni)); ni = __builtin_fmaf(abi, xr, ni); asm volatile("" : "+v"(ni));
            xr = nr; xi = ni;
            if (PASS2) xs[t] = pk2(xr, xi);
        }
        if (PASS2) {
#pragma unroll
            for (int t = 0; t < 16; ++t) *(LAS unsigned*)(XS + t * XSB + 4 * lane) = xs[t];
        }
        asm volatile("s_waitcnt lgkmcnt(0)" ::: "memory");
        if (PASS2) {
            f32x4 y = {0.f, 0.f, 0.f, 0.f};
#pragma unroll
            for (int s4 = 0; s4 < 4; ++s4) { const bf16x8 xf = *(const LAS bf16x8*)(XS + c * XSB + 64 * s4 + 16 * q4); y = __builtin_amdgcn_mfma_f32_16x16x32_bf16(cfr[s4], xf, y, 0, 0, 0); }
            *(u32x2*)(Y + (size_t)scan_row(n0 + 16 * cc + c, dn) * D + g * 16 + 4 * q4) = (u32x2){pk2(y[0], y[1]), pk2(y[2], y[3])};
        }
    }
    if (!PASS2) { float* e = XE + ((size_t)((dn * 64 + g) * 16 + seg) * 64 + lane) * 2; e[0] = xr; e[1] = xi; }
    }
}
}

DEVI void ph_s5_elem(const P& p) {
    const int otid_ = otid();
    const int wave = __builtin_amdgcn_readfirstlane(otid_ >> 6), lane = otid_ & 63, gw = blockIdx.x * NWV + wave, NGW = gridDim.x * NWV;
    Row16 dd; load_row_f32(p.in[I_S5D], lane, dd);
    for (int r = gw; r < MA; r += 2 * NGW) {
        const int r1 = r + NGW;
        Row16 u0, a0, b0, u1, a1, b1, o;
        load_row_bf16((const bf16_t*)(p.ws + WS_XN) + (size_t)r * D, lane, u0);
        load_row_bf16((const bf16_t*)(p.ws + WS_OF) + (size_t)r * D, lane, a0); load_row_bf16((const bf16_t*)(p.ws + WS_OB) + (size_t)r * D, lane, b0);
        if (r1 < MA) { load_row_bf16((const bf16_t*)(p.ws + WS_XN) + (size_t)r1 * D, lane, u1);
            load_row_bf16((const bf16_t*)(p.ws + WS_OF) + (size_t)r1 * D, lane, a1); load_row_bf16((const bf16_t*)(p.ws + WS_OB) + (size_t)r1 * D, lane, b1); }
#pragma unroll
        for (int e = 0; e < 16; ++e) o.v[e] = geluf_(dd.v[e] * u0.v[e] + a0.v[e] + b0.v[e]);
        store_row_bf16((bf16_t*)(p.ws + WS_U) + (size_t)r * D, lane, o);
        if (r1 < MA) {
#pragma unroll
            for (int e = 0; e < 16; ++e) o.v[e] = geluf_(dd.v[e] * u1.v[e] + a1.v[e] + b1.v[e]);
            store_row_bf16((bf16_t*)(p.ws + WS_U) + (size_t)r1 * D, lane, o);
        }
    }
}
DEVI float score_key(float s, int e) { return __uint_as_float((__float_as_uint(s) & 0xffffff80u) | (unsigned)e); }
DEVI float key_score(float k) { return k; }
DEVI int key_idx(float k) { return (int)(__float_as_uint(k) & 127u); }
DEVI float h2f_lo(unsigned w) { return (float)__builtin_bit_cast(pg8::f16x2_t, w).x; }
DEVI float h2f_hi(unsigned w) { return (float)__builtin_bit_cast(pg8::f16x2_t, w).y; }
DEVI void topk_wave_item(const P& p, int layer, int r, int h, int lane) {
    const unsigned short* s = (const unsigned short*)(p.ws + WS_SCH) + (size_t)r * 2048 + h * 256;
    const unsigned w0 = *(const unsigned*)(s + 2 * lane), w1 = *(const unsigned*)(s + 128 + 2 * lane);
    const float NEG = -__builtin_inff();
    float k00 = score_key(h2f_lo(w0), 2 * lane), k01 = score_key(h2f_hi(w0), 2 * lane + 1), k10 = score_key(h2f_lo(w1), 2 * lane), k11 = score_key(h2f_hi(w1), 2 * lane + 1);
    float A[16], B[16];
#pragma unroll
    for (int i = 0; i < 16; ++i) {
        const float ma = wave_max_f(__builtin_fmaxf(k00, k01)), mb = wave_max_f(__builtin_fmaxf(k10, k11));
        A[i] = ma; B[i] = mb;
        k00 = (k00 == ma) ? NEG : k00; k01 = (k01 == ma) ? NEG : k01; k10 = (k10 == mb) ? NEG : k10; k11 = (k11 == mb) ? NEG : k11;
    }
    int ci = -1, cj = 0, base = 0;
#pragma unroll
    for (int i = 0; i < 16; ++i) { const int cnt = 16 / (i + 1); if (ci < 0 && lane < base + cnt) { ci = i; cj = lane - base; } base += cnt; }
    float av = A[0], bv = B[0];
#pragma unroll
    for (int i = 1; i < 16; ++i) { av = (ci == i) ? A[i] : av; bv = (cj == i) ? B[i] : bv; }
    const int payload = key_idx(av) * 128 + key_idx(bv);
    const float sum = key_score(av) + key_score(bv);
    float ck = (ci >= 0) ? __uint_as_float((__float_as_uint(sum) & 0xffffffc0u) | (unsigned)lane) : NEG;
    float mys = 0.f, best = 0.f; int myidx = 0;
#pragma unroll
    for (int j = 0; j < 16; ++j) {
        const float mm = wave_max_f(ck);
        const int src = __builtin_amdgcn_readfirstlane((int)(__float_as_uint(mm) & 63u));
        const int pl = __builtin_amdgcn_readlane(payload, src);
        if (lane == j) { mys = mm; myidx = pl; }
        if (j == 0) best = mm;
        ck = (lane == src) ? NEG : ck;
    }
    const float e = lane < 16 ? __expf(mys - best) : 0.f;
    const float tot = wave_sum(e);
    if (lane < 16) {
        const f32x2_t sc2 = ((const f32x2_t*)(p.ws + WS_SCL) + (size_t)layer * 16384)[myidx];
        const size_t o = (size_t)r * 128 + h * 16 + lane;
        ((int*)(p.ws + WS_SELI))[o] = myidx; ((float*)(p.ws + WS_SELG))[o] = e / tot * sc2.y; ((float*)(p.ws + WS_SELU))[o] = sc2.x;
    }
}
constexpr int TK_ITEM_B = 144;
DEVI void ph_topk(const P& p, int layer, int r0, unsigned char* lds_) {
    const int otid_ = otid();
    const int wave = otid_ >> 6, lane = otid_ & 63;
    const int nall = (MA - r0) * 8, nthr = (int)gridDim.x * NTHR;
    const int nleft = nall % nthr;
    const int nitems = (nleft > 0 && nleft <= nthr / 8) ? nall - nleft : nall;
    for (int e = blockIdx.x * NWV + wave + nitems; e < nall; e += (int)gridDim.x * NWV) topk_wave_item(p, layer, r0 + (e >> 3), e & 7, lane);
    const unsigned char* SCb = (const unsigned char*)(p.ws + WS_SCH);
    LAS unsigned char* tile = (LAS unsigned char*)lds_ + wave * (64 * TK_ITEM_B);
    for (int it = blockIdx.x * NTHR + otid_; it < nitems; it += gridDim.x * NTHR) {
        const int r = r0 + (it >> 3), h = it & 7;
        const unsigned char* wbase = SCb + ((size_t)(r0 + ((it - lane) >> 3)) * 2048) * 2;
        const unsigned goff = (unsigned)(lane >> 3) * 512u + 16u * (unsigned)(lane & 7);
        u32x4 g[8];
#pragma unroll
        for (int j = 0; j < 8; ++j) g[j] = *(const u32x4*)(wbase + goff + 4096 * j);
        float L0[16], L1[16];
#pragma unroll 1
        for (int k = 0; k < 4; ++k) {
#pragma unroll
            for (int j = 0; j < 8; ++j) *(LAS u32x4*)(tile + (8 * j + (lane >> 3)) * TK_ITEM_B + 16 * (lane & 7)) = g[j];
            if (k < 3) {
#pragma unroll
                for (int j = 0; j < 8; ++j) g[j] = *(const u32x4*)(wbase + goff + 4096 * j + 128 * (k + 1));
            }
            u32x4 m[8];
#pragma unroll
            for (int i = 0; i < 8; ++i) m[i] = *(const LAS u32x4*)(tile + lane * TK_ITEM_B + 16 * i);
            float L[16];
            if (k & 1) {
#pragma unroll
                for (int j = 0; j < 16; ++j) L[j] = (k == 1) ? L0[j] : L1[j];
            } else {
#pragma unroll
                for (int j = 0; j < 16; ++j) L[j] = -__builtin_inff();
            }
            const int ebase = 64 * (k & 1);
#pragma unroll
            for (int gq = 0; gq < 4; ++gq) {
                float G[16];
#pragma unroll
                for (int e = 0; e < 16; ++e) { const unsigned wd = m[2 * gq + (e >> 3)][(e & 7) >> 1]; G[e] = score_key((e & 1) ? h2f_hi(wd) : h2f_lo(wd), ebase + 16 * gq + e); }
#define CE(a, b) { const float hi_ = __builtin_fmaxf(G[a], G[b]), lo_ = __builtin_fminf(G[a], G[b]); G[a] = hi_; G[b] = lo_; }
                CE(0,1) CE(2,3) CE(0,2) CE(1,3) CE(1,2) CE(4,5) CE(6,7) CE(4,6) CE(5,7) CE(5,6) CE(0,4) CE(2,6) CE(2,4) CE(1,5) CE(3,7) CE(3,5) CE(1,2) CE(3,4) CE(5,6) CE(8,9) CE(10,11) CE(8,10) CE(9,11) CE(9,10) CE(12,13) CE(14,15) CE(12,14) CE(13,15) CE(13,14) CE(8,12) CE(10,14) CE(10,12) CE(9,13) CE(11,15) CE(11,13) CE(9,10) CE(11,12) CE(13,14) CE(0,8) CE(4,12) CE(4,8) CE(2,10) CE(6,14) CE(6,10) CE(2,4) CE(6,8) CE(10,12) CE(1,9) CE(5,13) CE(5,9) CE(3,11) CE(7,15) CE(7,11) CE(3,5) CE(7,9) CE(11,13) CE(1,2) CE(3,4) CE(5,6) CE(7,8) CE(9,10) CE(11,12) CE(13,14)
#undef CE
#pragma unroll
                for (int i = 0; i < 16; ++i) L[i] = __builtin_fmaxf(L[i], G[15 - i]);
#pragma unroll
                for (int jj = 8; jj > 0; jj >>= 1)
#pragma unroll
                    for (int i = 0; i < 16; ++i) { const int l = i ^ jj; if (l > i) { const float hi = __builtin_fmaxf(L[i], L[l]), lo = __builtin_fminf(L[i], L[l]); L[i] = hi; L[l] = lo; } }
            }
            if (k < 2) {
#pragma unroll
                for (int j = 0; j < 16; ++j) L0[j] = L[j];
            } else {
#pragma unroll
                for (int j = 0; j < 16; ++j) L1[j] = L[j];
            }
        }
        const float amx = __builtin_fmaxf(__builtin_fmaxf(__builtin_fabsf(L0[0]), __builtin_fabsf(L0[15])), __builtin_fmaxf(__builtin_fabsf(L1[0]), __builtin_fabsf(L1[15])));
        const float ksc = 65000.0f / __builtin_fmaxf(amx, 1e-30f), kinv = 1.0f / (ksc * 16384.0f);
        int KA[16], KB[16];
#pragma unroll
        for (int j = 0; j < 16; ++j) { KA[j] = ((int)__builtin_rintf(L0[j] * ksc) << 14) | (key_idx(L0[j]) << 7); KB[j] = ((int)__builtin_rintf(L1[j] * ksc) << 14) | key_idx(L1[j]); }
        int fk[16];
#pragma unroll
        for (int j = 0; j < 16; ++j) fk[j] = KA[0] + KB[j];
#pragma unroll
        for (int i = 1; i < 16; ++i)
#pragma unroll
            for (int j = 0; j < 16; ++j)
                if ((i + 1) * (j + 1) <= 16) {
                    int xk = KA[i] + KB[j];
#pragma unroll
                    for (int q = 0; q < 16; ++q) if (q >= (i + 1) * (j + 1) - 1) { const int hi = xk > fk[q] ? xk : fk[q], lo = xk > fk[q] ? fk[q] : xk; fk[q] = hi; xk = lo; }
                }
        float fs[16]; int fi[16];
#pragma unroll
        for (int j = 0; j < 16; ++j) { fs[j] = (float)fk[j] * kinv; fi[j] = fk[j] & 16383; }
        float sum = 0.f, e[16];
#pragma unroll
        for (int j = 0; j < 16; ++j) { e[j] = __expf(fs[j] - fs[0]); sum += e[j]; }
        const float inv = 1.0f / sum;
        const f32x2_t* SC2 = (const f32x2_t*)(p.ws + WS_SCL) + (size_t)layer * 16384;
        float su[16];
#pragma unroll
        for (int j = 0; j < 16; ++j) { const f32x2_t sc2 = SC2[fi[j]]; su[j] = sc2.x; e[j] = e[j] * inv * sc2.y; }
        i32x4* oi = (i32x4*)((int*)(p.ws + WS_SELI) + (size_t)r * 128 + h * 16); f32x4* og = (f32x4*)((float*)(p.ws + WS_SELG) + (size_t)r * 128 + h * 16); f32x4* ou = (f32x4*)((float*)(p.ws + WS_SELU) + (size_t)r * 128 + h * 16);
#pragma unroll
        for (int j = 0; j < 4; ++j) { oi[j] = (i32x4){fi[4 * j], fi[4 * j + 1], fi[4 * j + 2], fi[4 * j + 3]}; og[j] = (f32x4){e[4 * j], e[4 * j + 1], e[4 * j + 2], e[4 * j + 3]}; ou[j] = (f32x4){su[4 * j], su[4 * j + 1], su[4 * j + 2], su[4 * j + 3]}; }
    }
}

DEVI void fmac_vv(float& acc, float a, float b) { asm("v_fmac_f32 %0, %1, %2" : "+v"(acc) : "v"(a), "v"(b)); }

DEVI void pkfma(f32x2_t& acc, f32x2_t a, f32x2_t b) { asm("v_pk_fma_f32 %0, %1, %2, %0" : "+v"(acc) : "v"(a), "v"(b)); }
DEVI float dot16_i8(const u32x4 q, const u32x4 h) {
    int a = __builtin_amdgcn_sdot4((int)q[0], (int)h[0], 0, false); a = __builtin_amdgcn_sdot4((int)q[1], (int)h[1], a, false);
    a = __builtin_amdgcn_sdot4((int)q[2], (int)h[2], a, false); a = __builtin_amdgcn_sdot4((int)q[3], (int)h[3], a, false);
    return (float)a;
}
template <int HI, bool FIRST> DEVI void pkfma_bc(f32x2_t& acc, f32x2_t wp, f32x2_t b) {
    if (FIRST) {
        if (HI) asm volatile("v_pk_mul_f32 %0, %1, %2 op_sel:[1,0] op_sel_hi:[1,1]" : "=&v"(acc) : "v"(wp), "v"(b));
        else    asm volatile("v_pk_mul_f32 %0, %1, %2 op_sel:[0,0] op_sel_hi:[0,1]" : "=&v"(acc) : "v"(wp), "v"(b));
    } else {
        if (HI) asm volatile("v_pk_fma_f32 %0, %1, %2, %0 op_sel:[1,0,0] op_sel_hi:[1,1,1]" : "+v"(acc) : "v"(wp), "v"(b));
        else    asm volatile("v_pk_fma_f32 %0, %1, %2, %0 op_sel:[0,0,0] op_sel_hi:[0,1,1]" : "+v"(acc) : "v"(wp), "v"(b));
    }
}
template <int HI, bool FIRST> DEVI void axpy16_fp8(const u32x4 q, f32x2_t wp, f32x2_t (&acc)[8]) {
#pragma unroll
    for (int j = 0; j < 4; ++j) { const f32x2_t lo = __builtin_amdgcn_cvt_pk_f32_fp8(q[j], false), hi = __builtin_amdgcn_cvt_pk_f32_fp8(q[j], true); pkfma_bc<HI, FIRST>(acc[2 * j], wp, lo); pkfma_bc<HI, FIRST>(acc[2 * j + 1], wp, hi); }
}
template <int K, bool FIRST> DEVI void axpy_row(const u32x4 q, const f32x4 w4, f32x2_t (&acc)[8]) {
    const f32x2_t wp = (K & 2) ? __builtin_shufflevector(w4, w4, 2, 3) : __builtin_shufflevector(w4, w4, 0, 1);
    axpy16_fp8<K & 1, FIRST>(q, wp, acc);
}
DEVI void swap32f(float& a, float& b) { const auto r = __builtin_amdgcn_permlane32_swap(__float_as_uint(a), __float_as_uint(b), false, false); a = __uint_as_float(r[0]); b = __uint_as_float(r[1]); }
DEVI void swap16f(float& a, float& b) { const auto r = __builtin_amdgcn_permlane16_swap(__float_as_uint(a), __float_as_uint(b), false, false); a = __uint_as_float(r[0]); b = __uint_as_float(r[1]); }
struct SliceGeo { int x, rank, n; };
struct Seg8 { u32x4 q[8]; };
struct Idx16 { i32x4 v[4]; };
DEVI void idx16_load(Idx16& I, const int* SI, int t, int r8) { const i32x4* s = (const i32x4*)(SI + (size_t)t * 128 + r8 * 16); I.v[0] = s[0]; I.v[1] = s[1]; I.v[2] = s[2]; I.v[3] = s[3]; }
DEVI void seg8_load(Seg8& s, const __amdgpu_buffer_rsrc_t tab, const Idx16& I, int half, unsigned coff) {
#pragma unroll
    for (int k = 0; k < 8; ++k) { const int row = I.v[2 * half + (k >> 2)][k & 3]; s.q[k] = __builtin_amdgcn_raw_buffer_load_b128(tab, (unsigned)row * 128u + coff, 0, 0); }
}
DEVI float reduce8_c8(const float (&d)[8], int lane) {
    const bool b2 = lane & 4, b1 = lane & 2, b0 = lane & 1;
    float r4[4], r2[2];
#pragma unroll
    for (int i = 0; i < 4; ++i) { const float keep = b2 ? d[i + 4] : d[i], send = b2 ? d[i] : d[i + 4]; r4[i] = keep + __shfl_xor(send, 4); }
#pragma unroll
    for (int i = 0; i < 2; ++i) { const float keep = b1 ? r4[i + 2] : r4[i], send = b1 ? r4[i] : r4[i + 2]; r2[i] = keep + __shfl_xor(send, 2); }
    const float keep = b0 ? r2[1] : r2[0], send = b0 ? r2[0] : r2[1];
    return keep + __shfl_xor(send, 1);
}
struct Seg16 { u32x4 q[16]; };
template <int M> DEVI void peer_u_mm(const __amdgpu_buffer_rsrc_t PU, Seg16& Q, const Idx16& In, const i32x4 (&hc)[2], unsigned coff, i32x4 (&acc)[8]) {
    asm volatile("" : "+v"(Q.q[M]));
    if (M & 1) acc[M >> 1] = __builtin_amdgcn_mfma_i32_16x16x64_i8(hc[1], (i32x4)Q.q[M], acc[M >> 1], 0, 0, 0);
    else       acc[M >> 1] = __builtin_amdgcn_mfma_i32_16x16x64_i8(hc[0], (i32x4)Q.q[M], (i32x4){0, 0, 0, 0}, 0, 0, 0);
    Q.q[M] = __builtin_amdgcn_raw_buffer_load_b128(PU, (unsigned)In.v[M >> 2][M & 3] * 128u + coff, 0, 0);
    asm volatile("" ::: "memory");
}
DEVI int qp_xor2(int v) { return __builtin_amdgcn_update_dpp(0, v, 0x4E, 0xf, 0xf, true); }
DEVI int qp_xor1(int v) { return __builtin_amdgcn_update_dpp(0, v, 0xB1, 0xf, 0xf, true); }
typedef unsigned u32x2 __attribute__((ext_vector_type(2)));
DEVI u32x2 slot_raw_load(const void* base, int t, int lane) { return *(const u32x2*)((const unsigned*)base + (size_t)t * 128 + 2 * lane); }
DEVI void slot_redist(LAS unsigned char* wl, const u32x2 raw, int lane, int l8, Idx16& I) {
    *(LAS u32x2*)(wl + 8 * lane) = raw;
    const LAS i32x4* s = (const LAS i32x4*)(wl + 64 * l8);
    I.v[0] = s[0]; I.v[1] = s[1]; I.v[2] = s[2]; I.v[3] = s[3];
}
DEVI void peer_u_token(const __amdgpu_buffer_rsrc_t PU, const int* SI, const unsigned char* H8, const float* HS, unsigned* PREP, LAS unsigned char* wl, int t, int t1, int t3, int x, int lane, int l8,
                       unsigned coff, bool act0, bool act1, const Idx16& In, Idx16& Inn, const u32x2 rawUse, u32x2& rawLoad, const i32x4 hraw, i32x4& hrawN, Seg16& Q) {
    rawLoad = slot_raw_load(SI, t3, lane);
    hrawN = *(const i32x4*)(H8 + (size_t)t1 * D);
    asm volatile("" ::: "memory");
    i32x4 hc[2];
#pragma unroll
    for (int e = 0; e < 4; ++e) { hc[0][e] = act0 ? hraw[e] : 0; hc[1][e] = act1 ? hraw[e] : 0; }
    i32x4 acc[8];
    peer_u_mm<0>(PU, Q, In, hc, coff, acc); peer_u_mm<1>(PU, Q, In, hc, coff, acc); peer_u_mm<2>(PU, Q, In, hc, coff, acc); peer_u_mm<3>(PU, Q, In, hc, coff, acc);
    peer_u_mm<4>(PU, Q, In, hc, coff, acc); peer_u_mm<5>(PU, Q, In, hc, coff, acc); peer_u_mm<6>(PU, Q, In, hc, coff, acc); peer_u_mm<7>(PU, Q, In, hc, coff, acc);
    peer_u_mm<8>(PU, Q, In, hc, coff, acc); peer_u_mm<9>(PU, Q, In, hc, coff, acc); peer_u_mm<10>(PU, Q, In, hc, coff, acc); peer_u_mm<11>(PU, Q, In, hc, coff, acc);
    peer_u_mm<12>(PU, Q, In, hc, coff, acc); peer_u_mm<13>(PU, Q, In, hc, coff, acc); peer_u_mm<14>(PU, Q, In, hc, coff, acc); peer_u_mm<15>(PU, Q, In, hc, coff, acc);
    slot_redist(wl, rawUse, lane, l8, Inn);
    const bool c1 = lane & 1, c2 = lane & 2;
    int w[8], r4[4], f[2];
#pragma unroll
    for (int a = 0; a < 8; ++a) { const int lo = c1 ? acc[a][1] : acc[a][0], hi = c1 ? acc[a][3] : acc[a][2]; w[a] = c2 ? hi : lo; }
#pragma unroll
    for (int i = 0; i < 4; ++i) { const int keep = c2 ? w[4 + i] : w[i], send = c2 ? w[i] : w[4 + i]; r4[i] = keep + qp_xor2(send); }
#pragma unroll
    for (int i = 0; i < 2; ++i) { const int keep = c1 ? r4[2 + i] : r4[i], send = c1 ? r4[i] : r4[2 + i]; f[i] = keep + qp_xor1(send); }
    PREP[((size_t)t * 8 + x) * 64 + lane] = pk2((float)f[0], (float)f[1]);
}
DEVI void ph_peer_u(const P& p, int layer, int r0, const SliceGeo sg, unsigned char* lds) {
    const int otid_ = otid();
    const int wave = otid_ >> 6, lane = otid_ & 63, q = lane >> 4, j = lane & 15;
    const int x = __builtin_amdgcn_readfirstlane(sg.x), nws = __builtin_amdgcn_readfirstlane(sg.n * NWV);
    const __amdgpu_buffer_rsrc_t PU = __builtin_amdgcn_make_buffer_rsrc((void*)(p.ws + WS_PU + (size_t)layer * 16384 * 1024 + (size_t)x * 16384 * 128), (short)0, 16384 * 128, 0x00020000);
    const int* SI = (const int*)(p.ws + WS_SELI); const float* HS = (const float*)(p.ws + WS_HS);
    unsigned* PREP = (unsigned*)(p.ws + WS_SC);
    LAS unsigned char* wl = (LAS unsigned char*)lds + 1024 * wave;
    const int l8 = (q >> 1) * 4 + (j >> 2);
    const unsigned coff = 64u * (q & 1) + 16u * (j & 3);
    const unsigned char* H8 = p.ws + WS_H8 + 128 * x + coff;
    const bool act = (q >> 1) == ((j >> 2) & 1), act0 = act && (j >> 3) == 0, act1 = act && (j >> 3) == 1;
    int t = __builtin_amdgcn_readfirstlane(r0 + sg.rank * NWV + wave);
    if (t >= MA) return;
    Idx16 I0, I1; idx16_load(I0, SI, t, l8);
    asm volatile("" ::: "memory");
    u32x2 R0, R1; i32x4 H0, H1;
    { const int t1 = t + nws < MA ? t + nws : t, t2 = t + 2 * nws < MA ? t + 2 * nws : t1; idx16_load(I1, SI, t1, l8); R0 = slot_raw_load(SI, t2, lane); }
    H0 = *(const i32x4*)(H8 + (size_t)t * D);
    asm volatile("" ::: "memory");
    Seg16 Q;
#pragma unroll
    for (int k = 0; k < 16; ++k) { Q.q[k] = __builtin_amdgcn_raw_buffer_load_b128(PU, (unsigned)I0.v[k >> 2][k & 3] * 128u + coff, 0, 0); asm volatile("" ::: "memory"); }
    while (t < MA) {
        const int t1 = t + nws < MA ? t + nws : t, t2 = t + 2 * nws < MA ? t + 2 * nws : t1, t3 = t + 3 * nws < MA ? t + 3 * nws : t2, t4 = t + 4 * nws < MA ? t + 4 * nws : t3;
        peer_u_token(PU, SI, H8, HS, PREP, wl, t, t1, t3, x, lane, l8, coff, act0, act1, I1, I0, R0, R1, H0, H1, Q);
        peer_u_token(PU, SI, H8, HS, PREP, wl, t1, t2, t4, x, lane, l8, coff, act0, act1, I0, I1, R1, R0, H1, H0, Q);
        t += 2 * nws;
    }
}
struct PwLoad { unsigned pw[8]; float su0, su1, sg0, sg1, hs; };
DEVI void peer_w_load(PwLoad& L, const P& p, int t, int lane, int sa, int sb) {
    const unsigned* pp = (const unsigned*)(p.ws + WS_SC) + (size_t)t * 512 + lane;
    const float* SG = (const float*)(p.ws + WS_SELG) + (size_t)t * 128; const float* SU = (const float*)(p.ws + WS_SELU) + (size_t)t * 128;
#pragma unroll
    for (int xx = 0; xx < 8; ++xx) L.pw[xx] = pp[xx * 64];
    L.su0 = SU[sa]; L.su1 = SU[sb]; L.sg0 = SG[sa]; L.sg1 = SG[sb]; L.hs = ((const float*)(p.ws + WS_HS))[t];
}
DEVI void peer_w_finish(const PwLoad& L, const P& p, int t, int lane, int sa, int sb) {
    float p0 = 0.f, p1 = 0.f;
#pragma unroll
    for (int xx = 0; xx < 8; ++xx) { p0 += bflo(L.pw[xx]); p1 += bfhi(L.pw[xx]); }
    const float w0 = geluf_(p0 * (L.hs * L.su0)) * L.sg0, w1 = geluf_(p1 * (L.hs * L.su1)) * L.sg1;
    const float amax = wave_max_f(fmaxf(fabsf(w0), fabsf(w1)));
    const float sc = amax > 0.f ? 224.0f / amax : 1.0f;
    const float a0 = w0 * sc, a1 = w1 * sc;
    const unsigned hi = __builtin_amdgcn_cvt_pk_fp8_f32(a0, a1, 0u, false);
    const float h0 = __builtin_amdgcn_cvt_f32_fp8(hi, 0), h1 = __builtin_amdgcn_cvt_f32_fp8(hi, 1);
    const unsigned lo = __builtin_amdgcn_cvt_pk_fp8_f32(a0 - h0, a1 - h1, 0u, false);
    unsigned char* wt = p.ws + WS_SELU + (size_t)t * 512;
    wt[sa] = (unsigned char)(hi & 0xffu); wt[sb] = (unsigned char)((hi >> 8) & 0xffu); wt[128 + sa] = (unsigned char)(lo & 0xffu); wt[128 + sb] = (unsigned char)((lo >> 8) & 0xffu);
    if (lane == 0) *(float*)(wt + 256) = 1.0f / sc;
}
DEVI void ph_peer_w(const P& p, int r0) {
    const int otid_ = otid();
    const int wave = __builtin_amdgcn_readfirstlane(otid_ >> 6), lane = otid_ & 63, gw = blockIdx.x * NWV + wave, NGW = gridDim.x * NWV;
    const int sa = (4 * ((lane >> 4) & 1) + ((lane >> 2) & 3)) * 16 + 4 * (lane & 3) + (lane >> 5), sb = sa + 2;
    for (int t = r0 + gw; t < MA; t += 2 * NGW) {
        const int t1 = t + NGW;
        PwLoad A, B;
        peer_w_load(A, p, t, lane, sa, sb);
        if (t1 < MA) peer_w_load(B, p, t1, lane, sa, sb);
        asm volatile("" ::: "memory");
        peer_w_finish(A, p, t, lane, sa, sb);
        if (t1 < MA) peer_w_finish(B, p, t1, lane, sa, sb);
    }
}
template <int M> DEVI void peer_v_mm(const __amdgpu_buffer_rsrc_t PV, Seg16& Q, const i32x4 WH, const i32x4 WL, const Idx16& In, unsigned coff, const unsigned (&sel0)[4], const unsigned (&sel1)[4], f32x4 (&acc)[4]) {
    asm volatile("" : "+v"(Q.q[M]));
    const unsigned sh = (unsigned)WH[M >> 2], sl = (unsigned)WL[M >> 2];
    const unsigned h0 = __builtin_amdgcn_perm(sh, sh, sel0[M & 3]), h1 = __builtin_amdgcn_perm(sh, sh, sel1[M & 3]);
    const unsigned l0 = __builtin_amdgcn_perm(sl, sl, sel0[M & 3]), l1 = __builtin_amdgcn_perm(sl, sl, sel1[M & 3]);
    const long AH = (long)(((unsigned long)h1 << 32) | (unsigned long)h0), AL = (long)(((unsigned long)l1 << 32) | (unsigned long)l0);
    const long B0 = (long)(((unsigned long)Q.q[M][1] << 32) | (unsigned long)Q.q[M][0]), B1 = (long)(((unsigned long)Q.q[M][3] << 32) | (unsigned long)Q.q[M][2]);
    acc[0] = __builtin_amdgcn_mfma_f32_16x16x32_fp8_fp8(AH, B0, acc[0], 0, 0, 0); acc[1] = __builtin_amdgcn_mfma_f32_16x16x32_fp8_fp8(AH, B1, acc[1], 0, 0, 0);
    acc[2] = __builtin_amdgcn_mfma_f32_16x16x32_fp8_fp8(AL, B0, acc[2], 0, 0, 0); acc[3] = __builtin_amdgcn_mfma_f32_16x16x32_fp8_fp8(AL, B1, acc[3], 0, 0, 0);
    Q.q[M] = __builtin_amdgcn_raw_buffer_load_b128(PV, (unsigned)In.v[M >> 2][M & 3] * 128u + coff, 0, 0);
    asm volatile("" ::: "memory");
}
DEVI void ph_peer_v(const P& p, int layer, int r0, const SliceGeo sg, unsigned char* lds) {
    const int otid_ = otid();
    const int wave = otid_ >> 6, lane = otid_ & 63, q = lane >> 4, j = lane & 15;
    const int x = __builtin_amdgcn_readfirstlane(sg.x), nws = __builtin_amdgcn_readfirstlane(sg.n * NWV);
    const __amdgpu_buffer_rsrc_t PV = __builtin_amdgcn_make_buffer_rsrc((void*)(p.ws + WS_PV + (size_t)layer * 16384 * 1024 + (size_t)x * 16384 * 128), (short)0, 16384 * 128, 0x00020000);
    const int* SI = (const int*)(p.ws + WS_SELI); const unsigned char* W8 = p.ws + WS_SELU;
    bf16_t* OUTP = (bf16_t*)(p.ws + WS_SC + (size_t)MA * 4096);
    LAS unsigned char* wl = (LAS unsigned char*)lds + 1024 * wave;
    const int l8 = 2 * q + (j >> 3);
    const unsigned coff = 16u * (j & 7);
    unsigned sel0[4], sel1[4];
#pragma unroll
    for (int k = 0; k < 4; ++k) { const unsigned pl = 0x0c0c0c0cu ^ ((0x0cu ^ (unsigned)k) << (8 * (j & 3))); sel0[k] = (j & 4) ? 0x0c0c0c0cu : pl; sel1[k] = (j & 4) ? pl : 0x0c0c0c0cu; }
    const int bp = 4 * ((lane + 40) & 63);
    int t = __builtin_amdgcn_readfirstlane(r0 + sg.rank * NWV + wave);
    if (t >= MA) return;
    Idx16 In; i32x4 WH, WL; Seg16 Q; u32x2 rawI, rawW; float sinv;
    {
        const int t1 = t + nws < MA ? t + nws : t, t2 = t + 2 * nws < MA ? t + 2 * nws : t1;
        const u32x2 ri0 = slot_raw_load(SI, t, lane), ri1 = slot_raw_load(SI, t1, lane), rw0 = slot_raw_load(W8, t, lane);
        asm volatile("" ::: "memory");
        rawI = slot_raw_load(SI, t2, lane); rawW = slot_raw_load(W8, t1, lane);
        asm volatile("" ::: "memory");
        slot_redist(wl, ri0, lane, l8, In);
#pragma unroll
        for (int m = 0; m < 16; ++m) { Q.q[m] = __builtin_amdgcn_raw_buffer_load_b128(PV, (unsigned)In.v[m >> 2][m & 3] * 128u + coff, 0, 0); asm volatile("" ::: "memory"); }
        slot_redist(wl, ri1, lane, l8, In);
        *(LAS u32x2*)(wl + 512 + 8 * lane) = rw0;
        WH = *(const LAS i32x4*)(wl + 512 + 16 * l8); WL = *(const LAS i32x4*)(wl + 640 + 16 * l8); sinv = *(const LAS float*)(wl + 768);
    }
    while (t < MA) {
        const int t1 = t + nws < MA ? t + nws : t, t2 = t + 2 * nws < MA ? t + 2 * nws : t1, t3 = t + 3 * nws < MA ? t + 3 * nws : t2;
        const u32x2 rawIn = slot_raw_load(SI, t3, lane), rawWn = slot_raw_load(W8, t2, lane);
        asm volatile("" ::: "memory");
        f32x4 acc[4] = {(f32x4){0.f, 0.f, 0.f, 0.f}, (f32x4){0.f, 0.f, 0.f, 0.f}, (f32x4){0.f, 0.f, 0.f, 0.f}, (f32x4){0.f, 0.f, 0.f, 0.f}};
        peer_v_mm<0>(PV, Q, WH, WL, In, coff, sel0, sel1, acc); peer_v_mm<1>(PV, Q, WH, WL, In, coff, sel0, sel1, acc); peer_v_mm<2>(PV, Q, WH, WL, In, coff, sel0, sel1, acc); peer_v_mm<3>(PV, Q, WH, WL, In, coff, sel0, sel1, acc);
        peer_v_mm<4>(PV, Q, WH, WL, In, coff, sel0, sel1, acc); peer_v_mm<5>(PV, Q, WH, WL, In, coff, sel0, sel1, acc); peer_v_mm<6>(PV, Q, WH, WL, In, coff, sel0, sel1, acc); peer_v_mm<7>(PV, Q, WH, WL, In, coff, sel0, sel1, acc);
        peer_v_mm<8>(PV, Q, WH, WL, In, coff, sel0, sel1, acc); peer_v_mm<9>(PV, Q, WH, WL, In, coff, sel0, sel1, acc); peer_v_mm<10>(PV, Q, WH, WL, In, coff, sel0, sel1, acc); peer_v_mm<11>(PV, Q, WH, WL, In, coff, sel0, sel1, acc);
        peer_v_mm<12>(PV, Q, WH, WL, In, coff, sel0, sel1, acc); peer_v_mm<13>(PV, Q, WH, WL, In, coff, sel0, sel1, acc); peer_v_mm<14>(PV, Q, WH, WL, In, coff, sel0, sel1, acc); peer_v_mm<15>(PV, Q, WH, WL, In, coff, sel0, sel1, acc);
        const float sv = sinv;
        slot_redist(wl, rawI, lane, l8, In);
        *(LAS u32x2*)(wl + 512 + 8 * lane) = rawW;
        WH = *(const LAS i32x4*)(wl + 512 + 16 * l8); WL = *(const LAS i32x4*)(wl + 640 + 16 * l8); sinv = *(const LAS float*)(wl + 768);
        float A[4], Bv[4];
#pragma unroll
        for (int r = 0; r < 4; ++r) {
            const float a = acc[0][r] + acc[2][r], b = acc[1][r] + acc[3][r];
            A[r] = (a + __int_as_float(__builtin_amdgcn_ds_bpermute(bp, __float_as_int(a)))) * sv;
            Bv[r] = (b + __int_as_float(__builtin_amdgcn_ds_bpermute(bp, __float_as_int(b)))) * sv;
        }
#pragma unroll
        for (int r = 0; r < 4; ++r) swap16f(A[r], Bv[r]);
        if (j < 8 && q < 2) { u32x4 pk; pk[0] = pk2(A[0], A[1]); pk[1] = pk2(A[2], A[3]); pk[2] = pk2(Bv[0], Bv[1]); pk[3] = pk2(Bv[2], Bv[3]);
            *(u32x4*)(OUTP + (size_t)t * D + 128 * x + 16 * j + 8 * q) = pk; }
        rawI = rawIn; rawW = rawWn; t += nws;
    }
}
struct FinPar { Row16 g2; NormAB n; };
DEVI void finpar_load(FinPar& f, const P& p, int layer, int cls, int next_mode, int lane) {
    load_row_f32(mod_ptr(p, layer, cls, 5), lane, f.g2);
    const int ln = next_mode == 0 ? layer + 1 : layer; const float m = next_mode == 0 ? 1.0f : 0.0f;
    Row16 gg, sc, sh; load_row_f32(next_mode == 0 ? p.in[I_N1G] + ln * D : p.in[I_FG], lane, gg); load_row_f32(mod_ptr(p, ln, cls, 1), lane, sc); load_row_f32(mod_ptr(p, ln, cls, 0), lane, sh);
#pragma unroll
    for (int j = 0; j < 16; ++j) { f.n.A.v[j] = gg.v[j] * (1.0f + m * sc.v[j]); f.n.B.v[j] = m * sh.v[j]; }
}
DEVI void fin_row(const P& p, int r, int lane, int next_mode, Row16& x, const Row16& a, const FinPar& f) {
#pragma unroll
    for (int j = 0; j < 16; ++j) x.v[j] += f.g2.v[j] * a.v[j];
    if (next_mode == 0) {
        store_row_f32((float*)(p.ws + WS_X) + (size_t)r * D, lane, x);
        Row16 o; norm_ab(x, f.n, o);
        store_row_bf16((bf16_t*)(p.ws + WS_XN) + (size_t)r * D, lane, o);
    } else if (r >= TC) {
        Row16 o; norm_ab(x, f.n, o);
        store_row_f32(p.out + (size_t)(r - TC) * D, lane, o);
    }
}
DEVI void ph_peer_fin(const P& p, int layer, int r0, int next_mode) {
    const int otid_ = otid();
    const int wave = __builtin_amdgcn_readfirstlane(otid_ >> 6), lane = otid_ & 63, gw = blockIdx.x * NWV + wave, NGW = gridDim.x * NWV;
    const bf16_t* OUTP = (const bf16_t*)(p.ws + WS_SC + (size_t)MA * 4096);
    FinPar fl; finpar_load(fl, p, layer, 0, next_mode, lane);
    for (int r = r0 + gw; r < MA; r += 2 * NGW) {
        const int r1 = r + NGW;
        Row16 x0, a0, x1, a1;
        load_row_f32((const float*)(p.ws + WS_X) + (size_t)r * D, lane, x0); load_row_bf16(OUTP + (size_t)r * D, lane, a0);
        if (r1 < MA) { load_row_f32((const float*)(p.ws + WS_X) + (size_t)r1 * D, lane, x1); load_row_bf16(OUTP + (size_t)r1 * D, lane, a1); }
        FinPar f0 = fl;
        if (r < TC) finpar_load(f0, p, layer, 1, next_mode, lane);
        fin_row(p, r, lane, next_mode, x0, a0, f0);
        if (r1 < MA) fin_row(p, r1, lane, next_mode, x1, a1, fl);
    }
}

#define XB_TMO      128
#define XB_XCNT(j)  (256  + 64 * (j))
#define XB_XSUB(j)  (1280 + 64 * (j))
#define XB_XGEN(j)  (2304 + 64 * (j))
#define XB_TOP      3328
#define XB_TOPGEN   3392
#define XCD_BAR_WORDS 3456
#define XB_SPIN_CAP (1u << 20)
DEVI unsigned xb_ld(unsigned* p)              { return __hip_atomic_load(p, __ATOMIC_RELAXED, __HIP_MEMORY_SCOPE_AGENT); }
DEVI unsigned xb_add(unsigned* p, unsigned v) { return __hip_atomic_fetch_add(p, v, __ATOMIC_RELAXED, __HIP_MEMORY_SCOPE_AGENT); }
DEVI unsigned xb_xcc_id() { return (unsigned)__builtin_amdgcn_s_getreg((3 << 11) | 20) & 0xFu; }
#define XB_SPIN(cond, bar) do { unsigned _sp = 0; while (cond) { __builtin_amdgcn_s_sleep(1); \
    if ((++_sp & 255u) == 0u) { if (xb_ld(&(bar)[XB_TMO])) break; if (_sp > XB_SPIN_CAP) { atomicAdd(&(bar)[XB_TMO], 1u); break; } } } } while (0)
struct XcdBarrier { unsigned* bar; unsigned x; volatile LAS unsigned* st; };
DEVI XcdBarrier xcd_barrier_post(unsigned* bar, volatile LAS unsigned* st) {
    XcdBarrier b; b.bar = bar; b.x = xb_xcc_id(); b.st = st;
    if (threadIdx.x == 0) st[2] = xb_add(&bar[XB_XCNT(b.x)], 1u);
    return b;
}
DEVI void xcd_barrier_complete(unsigned* bar, unsigned x, unsigned& nloc, unsigned& nx) {
    const unsigned G = gridDim.x * gridDim.y * gridDim.z;
    unsigned sum, cnt, mine, sp = 0u;
    for (;;) {
        sum = 0u; cnt = 0u; mine = 0u;
#pragma unroll
        for (unsigned j = 0; j < 16; ++j) { const unsigned c = xb_ld(&bar[XB_XCNT(j)]); sum += c; cnt += (c > 0u) ? 1u : 0u; mine = (j == x) ? c : mine; }
        if (sum == G) break;
        __builtin_amdgcn_s_sleep(1);
        if ((++sp & 255u) == 0u) { if (xb_ld(&bar[XB_TMO])) break; if (sp > XB_SPIN_CAP) { atomicAdd(&bar[XB_TMO], 1u); break; } }
    }
    nloc = mine > 0u ? mine : 1u; nx = cnt > 0u ? cnt : 1u;
}
DEVI void xcd_barrier(const XcdBarrier& b) {
    asm volatile("s_waitcnt vmcnt(0)" ::: "memory");
    __syncthreads();
    if (threadIdx.x == 0) {
        unsigned* bar = b.bar;
        __builtin_amdgcn_s_waitcnt(0);
        unsigned nloc = b.st[0], nx = b.st[1];
        if (nloc == 0u) { xcd_barrier_complete(bar, b.x, nloc, nx); b.st[0] = nloc; b.st[1] = nx; }
        const unsigned old = xb_add(&bar[XB_XSUB(b.x)], 1u);
        const unsigned gen = old / nloc;
        if (old + 1u == (gen + 1u) * nloc) {
            __builtin_amdgcn_fence(__ATOMIC_RELEASE, "agent");
            asm volatile("s_waitcnt vmcnt(0)" ::: "memory");
            const unsigned og = xb_add(&bar[XB_TOP], 1u);
            const unsigned tg = og / nx;
            if (og + 1u == (tg + 1u) * nx) xb_add(&bar[XB_TOPGEN], 1u);
            else XB_SPIN(xb_ld(&bar[XB_TOPGEN]) == tg, bar);
            __builtin_amdgcn_fence(__ATOMIC_ACQUIRE, "agent");
            asm volatile("s_waitcnt vmcnt(0)" ::: "memory");
        } else {
            XB_SPIN(xb_ld(&bar[XB_TOPGEN]) == gen, bar);
            __builtin_amdgcn_fence(__ATOMIC_ACQUIRE, "agent");
            asm volatile("s_waitcnt vmcnt(0)" ::: "memory");
        }
    }
    __syncthreads();
}

DEVI SliceGeo slice_geo(const P& p, unsigned char* lds) {
    SliceGeo g;
    unsigned* bar = (unsigned*)(p.ws + WS_CTL);
    volatile LAS unsigned* st = (volatile LAS unsigned*)(lds + LDS_BYTES - 64);
    unsigned cnt[8]; unsigned tot = 0; bool ok = true;
#pragma unroll
    for (int j = 0; j < 8; ++j) { cnt[j] = xb_ld(&bar[XB_XCNT(j)]); tot += cnt[j]; ok = ok && cnt[j] > 0u; }
    const unsigned xcc = xb_xcc_id();
    if (ok && tot == gridDim.x && xcc < 8u) { g.x = (int)xcc; g.rank = (int)st[2]; g.n = 0;
#pragma unroll
        for (int j = 0; j < 8; ++j) g.n = (j == (int)xcc) ? (int)cnt[j] : g.n; }
    else { g.x = blockIdx.x & 7; g.rank = blockIdx.x >> 3; g.n = ((int)gridDim.x - g.x + 7) >> 3; }
    g.x = __builtin_amdgcn_readfirstlane(g.x); g.rank = __builtin_amdgcn_readfirstlane(g.rank); g.n = __builtin_amdgcn_readfirstlane(g.n);
    return g;
}

struct CtxBf16 { bf16_t* O; int ldc; DEVI void operator()(int tok, int n, const f32x4 v) const { *(u32x2*)(O + (size_t)tok * ldc + n) = (u32x2){pk2(v[0], v[1]), pk2(v[2], v[3])}; } };
struct CtxHgrnIn { bf16_t* O; const float* lbv;
    DEVI void operator()(int tok, int n, const f32x4 v) const { const int blk = n >> 10; float x[4] = {v[0], v[1], v[2], v[3]};
#pragma unroll
        for (int j = 0; j < 4; ++j) {
            if (blk == 0 || blk == 4) x[j] = x[j] * frcp_(1.0f + __expf(-x[j]));
            else if (blk == 2 || blk == 3) { const float lb = lbv[(blk - 2) * 1024 + (n & 1023) + j]; x[j] = __builtin_amdgcn_logf(lb + (1.0f - lb) * frcp_(1.0f + __expf(-x[j]))); } }
        *(u32x2*)(O + (size_t)tok * 5120 + n) = (u32x2){pk2(x[0], x[1]), pk2(x[2], x[3])}; } };
struct CtxF16 { unsigned short* O; int ldc; DEVI void operator()(int tok, int n, const f32x4 v) const { *(u32x2*)(O + (size_t)tok * ldc + n) = (u32x2){pg8::pkh2(v[0], v[1]), pg8::pkh2(v[2], v[3])}; } };
struct CtxResid { float* X; const float* gate; DEVI void operator()(int tok, int n, const f32x4 v) const { f32x4* q = (f32x4*)(X + (size_t)tok * D + n); *q = *q + *(const f32x4*)(gate + n) * v; } };
template <class Epi>
DEVI void ctx_gemm(const bf16_t* A, const bf16_t* Bt, int N, const Epi& epi, unsigned char* lds_) {
    typedef short bf16x8 __attribute__((ext_vector_type(8)));
    const int otid_ = otid();
    const int wave = otid_ >> 6, lane = otid_ & 63, c = lane & 15, q4 = lane >> 4;
    LAS f32x4* red = (LAS f32x4*)lds_;
    const int npieces = (TC / 32) * (N / 64);
    for (int pc = blockIdx.x; pc < npieces; pc += gridDim.x) {
        const int mt = pc & 7, nt = pc >> 3;
        const bf16_t* ap = A + (size_t)(32 * mt + c) * D + 8 * q4 + 128 * wave;
        const bf16_t* bp = Bt + (size_t)(64 * nt + c) * D + 8 * q4 + 128 * wave;
        bf16x8 a0[4], a1[4], bf[4][4];
#pragma unroll
        for (int s4 = 0; s4 < 4; ++s4) { a0[s4] = *(const bf16x8*)(ap + 32 * s4); a1[s4] = *(const bf16x8*)(ap + 16 * D + 32 * s4);
#pragma unroll
            for (int j = 0; j < 4; ++j) bf[j][s4] = *(const bf16x8*)(bp + (size_t)(16 * j) * D + 32 * s4); }
        f32x4 acc[4][2];
#pragma unroll
        for (int j = 0; j < 4; ++j) { acc[j][0] = (f32x4){0.f, 0.f, 0.f, 0.f}; acc[j][1] = acc[j][0]; }
#pragma unroll
        for (int s4 = 0; s4 < 4; ++s4)
#pragma unroll
            for (int j = 0; j < 4; ++j) { acc[j][0] = __builtin_amdgcn_mfma_f32_16x16x32_bf16(bf[j][s4], a0[s4], acc[j][0], 0, 0, 0); acc[j][1] = __builtin_amdgcn_mfma_f32_16x16x32_bf16(bf[j][s4], a1[s4], acc[j][1], 0, 0, 0); }
        __syncthreads();
#pragma unroll
        for (int j = 0; j < 4; ++j)
#pragma unroll
            for (int i = 0; i < 2; ++i) red[(wave * 8 + (j * 2 + i)) * 64 + lane] = acc[j][i];
        __syncthreads();
        f32x4 sum = {0.f, 0.f, 0.f, 0.f};
#pragma unroll
        for (int ww = 0; ww < 8; ++ww) sum += red[(ww * 8 + wave) * 64 + lane];
        epi(32 * mt + 16 * (wave & 1) + c, 64 * nt + 16 * (wave >> 1) + 4 * q4, sum);
    }
    __syncthreads();
}

DEVI void gemm_bf16(const P& p, const bf16_t* A, const bf16_t* Bt, int r0, int N, bf16_t* O, int ldc, unsigned char* lds) {
    pg8::Gemm g{A + (size_t)r0 * D, Bt, MA - r0, N, D}; pg8::StaticOrder S; S.init(MA - r0, N, (int)gridDim.x, (int)blockIdx.x);
    pg8::EpiBf16 E{O, ldc, r0};
    pg8::gemm_phase<pg8::EpiBf16, pg8::StaticOrder, true, true>((PG8_LAS unsigned char*)lds, g, S, E);
}
DEVI void gemm_hgrn_in(const P& p, const bf16_t* A, const bf16_t* Bt, unsigned char* lds) {
    pg8::Gemm g{A + (size_t)TC * D, Bt, T, 5120, D}; pg8::StaticOrder S; S.init(T, 5120, (int)gridDim.x, (int)blockIdx.x);
    pg8::EpiHgrnIn E{(bf16_t*)(p.ws + WS_G), 5120, TC, (const float*)(p.ws + WS_LB)};
    pg8::gemm_phase<pg8::EpiHgrnIn, pg8::StaticOrder, true, true>((PG8_LAS unsigned char*)lds, g, S, E);
}
DEVI void gemm_f16(const P& p, const bf16_t* A, const bf16_t* Bt, int r0, int N, unsigned short* O, int ldc, unsigned char* lds) {
    pg8::Gemm g{A + (size_t)r0 * D, Bt, MA - r0, N, D}; pg8::StaticOrder S; S.init(MA - r0, N, (int)gridDim.x, (int)blockIdx.x);
    pg8::EpiF16 E{O, ldc, r0};
    pg8::gemm_phase<pg8::EpiF16, pg8::StaticOrder, true, true>((PG8_LAS unsigned char*)lds, g, S, E);
}
DEVI void gemm_glu_resid(const P& p, const bf16_t* A, const bf16_t* Bt, int layer, unsigned char* lds) {
    pg8::Gemm g{A + (size_t)TC * D, Bt, T, 2048, D}; pg8::StaticOrder S; S.init(T, 2048, (int)gridDim.x, (int)blockIdx.x);
    pg8::EpiGluResid E{(float*)(p.ws + WS_X), mod_ptr(p, layer, 0, 2), TC};
    pg8::gemm_phase<pg8::EpiGluResid, pg8::StaticOrder, true, true>((PG8_LAS unsigned char*)lds, g, S, E);
}
DEVI void gemm_resid(const P& p, const bf16_t* A, const bf16_t* Bt, int r0, int layer, unsigned char* lds) {
    pg8::Gemm g{A + (size_t)r0 * D, Bt, MA - r0, D, D}; pg8::StaticOrder S; S.init(MA - r0, D, (int)gridDim.x, (int)blockIdx.x);
    pg8::EpiResid E{(float*)(p.ws + WS_X), mod_ptr(p, layer, 0, 2), mod_ptr(p, layer, 1, 2), r0, TC};
    pg8::gemm_phase<pg8::EpiResid, pg8::StaticOrder, true, true>((PG8_LAS unsigned char*)lds, g, S, E);
}

enum { PH_P0 = 0, PH_INIT, PH_GEMM_IN, PH_HGP1, PH_MIX1, PH_MIX2, PH_GEMM_OUT, PH_NORM2, PH_SCORES, PH_TOPK, PH_PEERU, PH_PEERW, PH_PEERV, PH_PEERF };

DEVI void run_phase(const P& p, int ph, int layer, unsigned char* lds) {
    const int kind = layer % 3, jj = layer / 3;
    const int r0 = (layer >= 2) ? TC : 0;
    bf16_t* WT = (bf16_t*)(p.ws + WS_WT);
    switch (ph) {
    case PH_P0: ph_ada(p, lds); ph_lb(p); ph_s5disc(p); __syncthreads(); ph_transposes(p, lds); __syncthreads(); ph_fold(p); ph_tables(p); break;
    case PH_INIT: ph_init_norm(p); break;
    case PH_GEMM_IN:
        if (kind == 0) { const bf16_t* W = WT + WT_CIN / 2 + (size_t)jj * 3072 * 1024;
            if (r0 == 0) ctx_gemm((const bf16_t*)(p.ws + WS_XN), W, 3072, CtxBf16{(bf16_t*)(p.ws + WS_G), 3072}, lds);
            gemm_bf16(p, (const bf16_t*)(p.ws + WS_XN), W, TC, 3072, (bf16_t*)(p.ws + WS_G), 3072, lds); }
        else if (kind == 1) { ctx_gemm((const bf16_t*)(p.ws + WS_XN), WT + WT_HIN / 2, 5120, CtxHgrnIn{(bf16_t*)(p.ws + WS_G), (const float*)(p.ws + WS_LB)}, lds);
            gemm_hgrn_in(p, (const bf16_t*)(p.ws + WS_XN), WT + WT_HIN / 2, lds); }
        break;
    case PH_HGP1: if (kind == 1) hg::scan<false>(p, lds); else s5::scan<false>(p, lds); break;
    case PH_MIX1:
        if (kind == 0) ph_conv(p, jj, r0); else if (kind == 1) hg::scan<true>(p, lds); else s5::scan<true>(p, lds);
        break;
    case PH_MIX2:
        if (kind == 1) ph_hgrn_readout(p); else if (kind == 2) ph_s5_elem(p);
        break;
    case PH_GEMM_OUT:
        if (kind == 0) { const bf16_t* W = WT + WT_COUT / 2 + (size_t)jj * 1024 * 1024;
            if (r0 == 0) ctx_gemm((const bf16_t*)(p.ws + WS_U), W, 1024, CtxResid{(float*)(p.ws + WS_X), mod_ptr(p, layer, 1, 2)}, lds);
            gemm_resid(p, (const bf16_t*)(p.ws + WS_U), W, TC, layer, lds); }
        else if (kind == 1) { ctx_gemm((const bf16_t*)(p.ws + WS_U), WT + WT_HOUT / 2, 1024, CtxResid{(float*)(p.ws + WS_X), mod_ptr(p, layer, 1, 2)}, lds);
            gemm_resid(p, (const bf16_t*)(p.ws + WS_U), WT + WT_HOUT / 2, TC, layer, lds); }
        else gemm_glu_resid(p, (const bf16_t*)(p.ws + WS_U), WT + WT_GLU / 2, layer, lds);
        break;
    case PH_NORM2: ph_norm2(p, layer, r0); break;
    case PH_SCORES: { const bf16_t* W = (const bf16_t*)(p.ws + WS_WQK) + (size_t)layer * 2048 * 1024;
        if (r0 == 0) ctx_gemm((const bf16_t*)(p.ws + WS_XN), W, 2048, CtxF16{(unsigned short*)(p.ws + WS_SCH), 2048}, lds);
        gemm_f16(p, (const bf16_t*)(p.ws + WS_XN), W, TC, 2048, (unsigned short*)(p.ws + WS_SCH), 2048, lds); } break;
    case PH_TOPK: ph_topk(p, layer, r0, lds); break;
    case PH_PEERU: ph_peer_u(p, layer, r0, slice_geo(p, lds), lds); break;
    case PH_PEERW: ph_peer_w(p, r0); break;
    case PH_PEERV: ph_peer_v(p, layer, r0, slice_geo(p, lds), lds); break;
    case PH_PEERF: ph_peer_fin(p, layer, r0, layer == 3 ? 1 : 0); break;
    }
}

#ifndef MK_MULTI
#define MK_MULTI 0
#endif
#if MK_MULTI
__global__ void __launch_bounds__(NTHR, 2) k_fwd(P p) {
    extern __shared__ __attribute__((aligned(16))) unsigned char lds[];
    run_phase(p, p.ph, p.arg, lds);
}
#else
__global__ void __launch_bounds__(NTHR, 2) k_fwd(P p) {
    extern __shared__ __attribute__((aligned(16))) unsigned char lds[];
    volatile LAS unsigned* st = (volatile LAS unsigned*)(lds + LDS_BYTES - 64);
    if (threadIdx.x < 16) st[threadIdx.x] = 0u;
    __syncthreads();
    const XcdBarrier bar = xcd_barrier_post((unsigned*)(p.ws + WS_CTL), st);
#define SYNC() xcd_barrier(bar)
    run_phase(p, PH_P0, 0, lds); SYNC();
    run_phase(p, PH_INIT, 0, lds); SYNC();
#pragma unroll 1
    for (int layer = 0; layer < DEPTH; ++layer) {
        const int kind = layer % 3;
        if (kind != 2) { run_phase(p, PH_GEMM_IN, layer, lds); SYNC(); }
        if (kind != 0) { run_phase(p, PH_HGP1, layer, lds); SYNC(); }
        run_phase(p, PH_MIX1, layer, lds); SYNC();
        if (kind != 0) { run_phase(p, PH_MIX2, layer, lds); SYNC(); }
        run_phase(p, PH_GEMM_OUT, layer, lds); SYNC();
        run_phase(p, PH_NORM2, layer, lds); SYNC();
        run_phase(p, PH_SCORES, layer, lds); SYNC();
        run_phase(p, PH_TOPK, layer, lds); SYNC();
        run_phase(p, PH_PEERU, layer, lds); SYNC();
        run_phase(p, PH_PEERW, layer, lds); SYNC();
        run_phase(p, PH_PEERV, layer, lds); SYNC();
        run_phase(p, PH_PEERF, layer, lds);
        if (layer != DEPTH - 1) SYNC();
    }
}
#endif

extern "C" void kernel_launch(void* const* d_in, const int* in_sizes, int n_in, void* d_out, int out_size, void* d_ws, size_t ws_size, hipStream_t stream) {
    static int grid = 0;
    if (grid == 0) {
        if (n_in != N_IN || out_size != T * D || ws_size < WS_END) { fprintf(stderr, "kernel_launch: unexpected shapes n_in %d out %d ws %zu\n", n_in, out_size, ws_size); grid = -1; return; }
        int dev = 0, cus = 0, per_cu = 0;
        if (hipGetDevice(&dev) != hipSuccess || hipDeviceGetAttribute(&cus, hipDeviceAttributeMultiprocessorCount, dev) != hipSuccess) { grid = -1; return; }
        if (hipFuncSetAttribute((const void*)k_fwd, hipFuncAttributeMaxDynamicSharedMemorySize, LDS_BYTES) != hipSuccess) { fprintf(stderr, "kernel_launch: hipFuncSetAttribute failed\n"); grid = -1; return; }
        if (hipOccupancyMaxActiveBlocksPerMultiprocessor(&per_cu, (const void*)k_fwd, NTHR, LDS_BYTES) != hipSuccess || per_cu < 1) { fprintf(stderr, "kernel_launch: occupancy query says %d blocks/CU\n", per_cu); }
        (void)hipGetLastError();
        grid = cus;
    }
    if (grid < 0) return;
    P p{};
    for (int i = 0; i < N_IN; ++i) p.in[i] = (const float*)d_in[i];
    p.out = (float*)d_out; p.ws = (unsigned char*)d_ws;
#if MK_MULTI
    auto launch = [&](int ph, int arg) { p.ph = ph; p.arg = arg; hipLaunchKernelGGL(k_fwd, dim3(grid), dim3(NTHR), LDS_BYTES, stream, p); };
    launch(PH_P0, 0); launch(PH_INIT, 0);
    for (int layer = 0; layer < DEPTH; ++layer) {
        const int kind = layer % 3;
        if (kind != 2) launch(PH_GEMM_IN, layer);
        if (kind != 0) launch(PH_HGP1, layer);
        launch(PH_MIX1, layer);
        if (kind != 0) launch(PH_MIX2, layer);
        launch(PH_GEMM_OUT, layer);
        launch(PH_NORM2, layer); launch(PH_SCORES, layer); launch(PH_TOPK, layer); launch(PH_PEERU, layer); launch(PH_PEERW, layer); launch(PH_PEERV, layer); launch(PH_PEERF, layer);
    }
#else
    if (hipMemsetAsync((char*)d_ws + WS_CTL, 0, 65536, stream) != hipSuccess) { fprintf(stderr, "kernel_launch: memset failed\n"); return; }
    void* args[] = {&p};
    const hipError_t e = hipLaunchCooperativeKernel((const void*)k_fwd, dim3(grid), dim3(NTHR), args, LDS_BYTES, stream);
    if (e != hipSuccess) fprintf(stderr, "kernel_launch: cooperative launch failed: %s (grid %d)\n", hipGetErrorString(e), grid);
#endif
}
```
